# Optimizing an MI355X kernel written in HIP

```python
import math
import jax, jax.numpy as jnp
from jax import lax
import numpy as np

D_MODEL = 2048
BATCH = 2
SEQ = 4096
DEPTH = 1

N_META = 16
BLOCK_Q = 128
ROPE_THETA = 500000.0
EPS = 1e-6
N_DIFF_HEADS = 8
DIFF_HEAD_DIM = 64
DIFF_V_DIM = 2 * DIFF_HEAD_DIM
DIFF_ROT_DIM = DIFF_HEAD_DIM // 4
N_FOX_HEADS = 8
FOX_HEAD_DIM = 128
N_BRANCH = 2
DIFF_QK_W = N_DIFF_HEADS * 2 * DIFF_HEAD_DIM
DIFF_V_W = N_DIFF_HEADS * DIFF_V_DIM
FOX_W = N_FOX_HEADS * FOX_HEAD_DIM
W_IN_SPLITS = (DIFF_QK_W, DIFF_QK_W, DIFF_V_W, FOX_W, FOX_W, FOX_W, N_FOX_HEADS, D_MODEL, D_MODEL)
W_IN_COLS = sum(W_IN_SPLITS)
PEER_HEADS = 8
PEER_N_KEYS = 128
PEER_N_EXPERTS = PEER_N_KEYS * PEER_N_KEYS
PEER_KEY_DIM = 128
PEER_HALF = PEER_KEY_DIM // 2
PEER_TOPK = 16
PEER_CHUNK = 128

kernel_name = 'hybrid_diff_fox_peer_meta'


def rms_norm(x, g):
    x32 = x.astype(jnp.float32)
    y = x32 * lax.rsqrt(jnp.mean(x32 * x32, axis=-1, keepdims=True) + EPS)
    return (y * g.astype(jnp.float32)).astype(x.dtype)


def rope_tables(length, rot_dim):
    inv = ROPE_THETA ** (-jnp.arange(0, rot_dim, 2, dtype=jnp.float32) / rot_dim)
    ang = jnp.arange(length, dtype=jnp.float32)[:, None] * inv[None, :]
    return jnp.cos(ang), jnp.sin(ang)


def partial_rope(x, cos, sin):
    half = cos.shape[-1]
    r = 2 * half
    shape = (1, cos.shape[0]) + (1,) * (x.ndim - 3) + (half,)
    c, s = cos.reshape(shape), sin.reshape(shape)
    xr = x[..., :r].astype(jnp.float32)
    x1, x2 = xr[..., :half], xr[..., half:]
    rot = jnp.concatenate([x1 * c - x2 * s, x2 * c + x1 * s], axis=-1).astype(x.dtype)
    return jnp.concatenate([rot, x[..., r:]], axis=-1)


def block_ranges(length):
    n_blocks = (length - N_META) // BLOCK_Q
    return [(0, N_META)] + [(N_META + i * BLOCK_Q, N_META + (i + 1) * BLOCK_Q) for i in range(n_blocks)]


def causal_mask(lo, hi):
    qpos = jnp.arange(lo, hi)
    kpos = jnp.arange(hi)
    return kpos[None, :] <= qpos[:, None]


def diff_attention(q1, q2, k1, k2, v, lam):
    scale = DIFF_HEAD_DIM ** -0.5
    outs = []
    for lo, hi in block_ranges(q1.shape[1]):
        mask = causal_mask(lo, hi)

        def probs(q, k):
            s = jnp.einsum('bqhd,bkhd->bhqk', q[:, lo:hi], k[:, :hi]).astype(jnp.float32) * scale
            return jax.nn.softmax(jnp.where(mask, s, -jnp.inf), axis=-1)

        p = probs(q1, k1) - lam * probs(q2, k2)
        outs.append(jnp.einsum('bhqk,bkhd->bqhd', p.astype(v.dtype), v[:, :hi]))
    return jnp.concatenate(outs, axis=1)


def forgetting_attention(q, k, v, cum_logf):
    scale = FOX_HEAD_DIM ** -0.5
    outs = []
    for lo, hi in block_ranges(q.shape[1]):
        mask = causal_mask(lo, hi)
        s = jnp.einsum('bqhd,bkhd->bhqk', q[:, lo:hi], k[:, :hi]).astype(jnp.float32) * scale
        s = s + cum_logf[:, :, lo:hi, None] - cum_logf[:, :, None, :hi]
        p = jax.nn.softmax(jnp.where(mask, s, -jnp.inf), axis=-1)
        outs.append(jnp.einsum('bhqk,bkhd->bqhd', p.astype(v.dtype), v[:, :hi]))
    return jnp.concatenate(outs, axis=1)


def split_cols(y, sizes):
    points, acc = [], 0
    for sz in sizes[:-1]:
        acc += sz
        points.append(acc)
    return jnp.split(y, points, axis=-1)


def peer(h, w_query, sub_keys, expert_u, expert_v):
    b, length, d = h.shape
    t = h.reshape(b * length, d)
    n_tok = t.shape[0]
    q = (t @ w_query).reshape(n_tok, PEER_HEADS, 2, PEER_HALF)
    s = jnp.einsum('thcd,hcnd->thcn', q, sub_keys).astype(jnp.float32)
    v1, i1 = lax.top_k(s[:, :, 0], PEER_TOPK)
    v2, i2 = lax.top_k(s[:, :, 1], PEER_TOPK)
    cand = (v1[..., :, None] + v2[..., None, :]).reshape(n_tok, PEER_HEADS, PEER_TOPK * PEER_TOPK)
    best, j = lax.top_k(cand, PEER_TOPK)
    e_idx = (jnp.take_along_axis(i1, j // PEER_TOPK, axis=-1) * PEER_N_KEYS
             + jnp.take_along_axis(i2, j % PEER_TOPK, axis=-1))
    gate = jax.nn.softmax(best, axis=-1)
    pad = (-n_tok) % PEER_CHUNK
    tp = jnp.pad(t, ((0, pad), (0, 0))).reshape(-1, PEER_CHUNK, d)
    ep = jnp.pad(e_idx, ((0, pad), (0, 0), (0, 0))).reshape(-1, PEER_CHUNK, PEER_HEADS, PEER_TOPK)
    gp = jnp.pad(gate, ((0, pad), (0, 0), (0, 0))).reshape(-1, PEER_CHUNK, PEER_HEADS, PEER_TOPK)

    def chunk(args):
        tc, ec, gc = args
        u_sel = expert_u[ec]
        a = jax.nn.gelu(jnp.einsum('cd,chkd->chk', tc, u_sel).astype(jnp.float32), approximate=False)
        w = (gc * a).astype(tc.dtype)
        return jnp.einsum('chk,chkd->cd', w, expert_v[ec])

    out = lax.map(chunk, (tp, ep, gp))
    return out.reshape(-1, d)[:n_tok].reshape(b, length, d)


def setup_inputs(seed: int = 0) -> dict:
    key = jax.random.key(seed)
    ks = jax.random.split(key, 24)
    f32 = jnp.float32
    nrm = lambda k, shape, sc: jax.random.normal(k, shape, f32) * sc
    L_ = DEPTH
    return {
        'x': nrm(ks[0], (BATCH, SEQ, D_MODEL), 1.0),
        'meta_tokens': nrm(ks[1], (N_META, D_MODEL), 1.0),
        'norm_mix_g': 1.0 + nrm(ks[2], (L_, D_MODEL), 0.02),
        'w_in': nrm(ks[3], (L_, D_MODEL, W_IN_COLS), D_MODEL ** -0.5),
        'b_forget': 2.0 + nrm(ks[4], (L_, N_FOX_HEADS), 0.5),
        'b_gate': nrm(ks[5], (L_, N_BRANCH, D_MODEL), 0.02),
        'diff_q_norm_g': 1.0 + nrm(ks[6], (L_, DIFF_HEAD_DIM), 0.02),
        'diff_k_norm_g': 1.0 + nrm(ks[7], (L_, DIFF_HEAD_DIM), 0.02),
        'fox_q_norm_g': 1.0 + nrm(ks[8], (L_, FOX_HEAD_DIM), 0.02),
        'fox_k_norm_g': 1.0 + nrm(ks[9], (L_, FOX_HEAD_DIM), 0.02),
        'lambda_q1': nrm(ks[10], (L_, DIFF_HEAD_DIM), 0.1),
        'lambda_k1': nrm(ks[11], (L_, DIFF_HEAD_DIM), 0.1),
        'lambda_q2': nrm(ks[12], (L_, DIFF_HEAD_DIM), 0.1),
        'lambda_k2': nrm(ks[13], (L_, DIFF_HEAD_DIM), 0.1),
        'diff_subln_g': 1.0 + nrm(ks[14], (L_, DIFF_V_DIM), 0.02),
        'w_branch_diff': nrm(ks[15], (L_, DIFF_V_W, D_MODEL), DIFF_V_W ** -0.5),
        'w_branch_fox': nrm(ks[16], (L_, FOX_W, D_MODEL), FOX_W ** -0.5),
        'w_out': nrm(ks[17], (L_, D_MODEL, D_MODEL), D_MODEL ** -0.5),
        'norm_peer_g': 1.0 + nrm(ks[18], (L_, D_MODEL), 0.02),
        'peer_w_query': nrm(ks[19], (L_, D_MODEL, PEER_HEADS * PEER_KEY_DIM), D_MODEL ** -0.5),
        'peer_sub_keys': nrm(ks[20], (L_, PEER_HEADS, 2, PEER_N_KEYS, PEER_HALF), PEER_HALF ** -0.5),
        'peer_expert_u': nrm(ks[21], (L_, PEER_N_EXPERTS, D_MODEL), D_MODEL ** -0.5),
        'peer_expert_v': nrm(ks[22], (L_, PEER_N_EXPERTS, D_MODEL), PEER_HEADS ** -0.5),
    }


def reference(x, meta_tokens, norm_mix_g, w_in, b_forget, b_gate, diff_q_norm_g, diff_k_norm_g,
              fox_q_norm_g, fox_k_norm_g, lambda_q1, lambda_k1, lambda_q2, lambda_k2, diff_subln_g,
              w_branch_diff, w_branch_fox, w_out, norm_peer_g, peer_w_query, peer_sub_keys,
              peer_expert_u, peer_expert_v):
    b = x.shape[0]
    meta = jnp.broadcast_to(meta_tokens.astype(x.dtype)[None], (b, N_META, D_MODEL))
    h_res = jnp.concatenate([meta, x], axis=1)
    length = h_res.shape[1]
    cos, sin = rope_tables(length, DIFF_ROT_DIM)
    for l in range(DEPTH):
        h = rms_norm(h_res, norm_mix_g[l])
        dq, dk, dv, fq, fk, fv, f_logit, g_a, g_b = split_cols(h @ w_in[l], W_IN_SPLITS)
        dq = partial_rope(rms_norm(dq.reshape(b, length, N_DIFF_HEADS, 2, DIFF_HEAD_DIM), diff_q_norm_g[l]), cos, sin)
        dk = partial_rope(rms_norm(dk.reshape(b, length, N_DIFF_HEADS, 2, DIFF_HEAD_DIM), diff_k_norm_g[l]), cos, sin)
        dv = dv.reshape(b, length, N_DIFF_HEADS, DIFF_V_DIM)
        lam_init = 0.8 - 0.6 * math.exp(-0.3 * l)
        lam = (jnp.exp(jnp.sum(lambda_q1[l].astype(jnp.float32) * lambda_k1[l].astype(jnp.float32)))
               - jnp.exp(jnp.sum(lambda_q2[l].astype(jnp.float32) * lambda_k2[l].astype(jnp.float32)))
               + lam_init)
        o_diff = diff_attention(dq[..., 0, :], dq[..., 1, :], dk[..., 0, :], dk[..., 1, :], dv, lam)
        o_diff = rms_norm(o_diff, diff_subln_g[l]) * (1.0 - lam_init)
        y_diff = o_diff.reshape(b, length, DIFF_V_W) @ w_branch_diff[l]
        fq = rms_norm(fq.reshape(b, length, N_FOX_HEADS, FOX_HEAD_DIM), fox_q_norm_g[l])
        fk = rms_norm(fk.reshape(b, length, N_FOX_HEADS, FOX_HEAD_DIM), fox_k_norm_g[l])
        fv = fv.reshape(b, length, N_FOX_HEADS, FOX_HEAD_DIM)
        log_f = jax.nn.log_sigmoid((f_logit + b_forget[l]).astype(jnp.float32))
        cum_logf = jnp.transpose(jnp.cumsum(log_f, axis=1), (0, 2, 1))
        o_fox = forgetting_attention(fq, fk, fv, cum_logf)
        y_fox = o_fox.reshape(b, length, FOX_W) @ w_branch_fox[l]
        merged = jax.nn.sigmoid(g_a + b_gate[l, 0]) * y_diff + jax.nn.sigmoid(g_b + b_gate[l, 1]) * y_fox
        h_res = h_res + merged @ w_out[l]
        h2 = rms_norm(h_res, norm_peer_g[l])
        h_res = h_res + peer(h2, peer_w_query[l], peer_sub_keys[l], peer_expert_u[l], peer_expert_v[l])
    return h_res[:, N_META:]
```

```cpp
#include <hip/hip_runtime.h>
#include <cstdio>
#include <cstdint>
#include <cmath>
namespace pg8 {
#define PG8_LAS __attribute__((address_space(3)))
typedef unsigned short bf16_t;
typedef short bf16x8 __attribute__((ext_vector_type(8)));
typedef float f32x4 __attribute__((ext_vector_type(4)));
typedef unsigned u32x4 __attribute__((ext_vector_type(4)));
constexpr int BM = 256, BK = 64, HALF = 128, HTB = HALF * BK * 2  , STAGE_BYTES = 8 * HTB, NXCD = 8, WGM = 8;

__host__ __device__ __forceinline__ int lds_byte(int r, int c) { const int st = (r >> 4) * 2 + (c >> 5), rr = r & 15, cc = c & 31, ob = rr * 64 + cc * 2; return st * 1024 + (ob ^ (((ob >> 9) & 1) << 5)); }
__host__ __device__ __forceinline__ void stage_rc(int b, int& R, int& C) { const int st = b / 1024, sb = b % 1024, swz = sb ^ (((sb >> 9) & 1) << 5); R = (st >> 1) * 16 + swz / 64; C = (st & 1) * 32 + (swz % 64) / 2; }
__host__ __device__ __forceinline__ int perm32(int rho) { const int n = rho >> 4, i = rho & 15; return 8 * (i >> 2) + 4 * n + (i & 3); }

struct Unit { int pm, pn; };
struct Gemm { const bf16_t* A; const bf16_t* Bt; int M, N, K; };

struct StaticOrder {
    int nM, nN, nwg, G, c;
    __host__ __device__ void init(int M, int N, int G_, int c_) { nM = M / BM; nN = N / BM; nwg = nM * nN; G = G_; c = c_; }
    __host__ __device__ bool next(int i, Unit& u) const {
        const long L = (long)i * G + c; if (L >= nwg) return false;
        int wgid = (int)L; { const int q = nwg / NXCD, r = nwg % NXCD, xcd = wgid % NXCD, off = wgid / NXCD; wgid = (xcd < r ? xcd * (q + 1) : r * (q + 1) + (xcd - r) * q) + off; }
        const int nig = WGM * nN, gid = wgid / nig, fm = gid * WGM, gsz = (nM - fm) < WGM ? (nM - fm) : WGM;
        u.pm = fm + ((wgid % nig) % gsz); u.pn = (wgid % nig) / gsz; return true;
    }
    __device__ __forceinline__ void a_ready(const Unit&) const {}
    __device__ __forceinline__ void done(const Unit&) const {}
};
__device__ __forceinline__ unsigned cvt_pk_bf16(float lo, float hi) { unsigned r; asm volatile("v_cvt_pk_bf16_f32 %0, %1, %2" : "=v"(r) : "v"(lo), "v"(hi)); return r; }
typedef float f32x2 __attribute__((ext_vector_type(2)));
template <class F> struct EpiGen {
    static constexpr bool PERM = true, AFTER_DRAIN = false;
    F f;
    __device__ __forceinline__ void operator()(const f32x4 (&acc)[2][2][4][2], const Unit& u, int wr, int wc, int fr, int fq) const {
        F g = f; if (!g.begin(u)) return;
#pragma unroll
        for (int ai = 0; ai < 2; ++ai)
#pragma unroll
            for (int m = 0; m < 4; ++m) { const int rt = ai * HALF + wr * 64 + m * 16 + fr;
#pragma unroll
                for (int bj = 0; bj < 2; ++bj) g.chunk(u, rt, bj * HALF + wc * 32 + 8 * fq, acc[ai][bj][m][0], acc[ai][bj][m][1]); }
    }
};
template <class Epi, class Sched, bool ALIGN_EPI = false, bool SP2 = false>
__device__ __forceinline__ void gemm_phase(PG8_LAS unsigned char* lds, const Gemm g, const Sched& S, const Epi& E) {
    const int tid = threadIdx.x, wid = __builtin_amdgcn_readfirstlane(tid >> 6), lane = tid & 63, wr = wid >> 2, wc = wid & 3, fr = lane & 15, fq = lane >> 4;
    const int K = g.K, nt = K / BK;
    unsigned voffA[2], voffB[2];
#pragma unroll
    for (int i = 0; i < 2; ++i) { int R, C; stage_rc(tid * 16 + i * 8192, R, C); const int Rb = Epi::PERM ? ((R & ~31) + perm32(R & 31)) : R;
        voffA[i] = (unsigned)(R * K + C) * 2u; voffB[i] = (unsigned)(Rb * K + C) * 2u; }
    const size_t kstep = (size_t)(BK * 2);
    const size_t hstep = (size_t)HALF * K * 2;
    const size_t tstep = 2 * hstep;
    const unsigned ldsw = (unsigned)wid * 1024u;
    const int aoff = lds_byte(wr * 64 + fr, fq * 8), boff = lds_byte(wc * 32 + fr, fq * 8);
#define PG8_SA(b, h) (((b) * 2 + (h)) * HTB)
#define PG8_SB(b, h) ((4 + (b) * 2 + (h)) * HTB)
#define PG8_STAGE(bufoff, gbase, voff) do { _Pragma("unroll") for (int _i = 0; _i < 2; ++_i) \
        __builtin_amdgcn_global_load_lds((const unsigned*)((const char*)(gbase) + (voff)[_i]), (PG8_LAS unsigned*)(lds + (bufoff) + ldsw + _i * 8192), 16, 0, 0); } while (0)
#define PG8_LDA(dst, b, h) do { _Pragma("unroll") for (int m = 0; m < 4; ++m) _Pragma("unroll") for (int k = 0; k < 2; ++k) dst[m][k] = *(const PG8_LAS bf16x8*)(lds + PG8_SA(b, h) + aoff + m * 2048 + k * 1024); } while (0)
#define PG8_LDB(dst, b, h) do { _Pragma("unroll") for (int n = 0; n < 2; ++n) _Pragma("unroll") for (int k = 0; k < 2; ++k) dst[n][k] = *(const PG8_LAS bf16x8*)(lds + PG8_SB(b, h) + boff + n * 2048 + k * 1024); } while (0)
#define PG8_MMA(ai, bj, At, Bt) do { __builtin_amdgcn_s_setprio(1); _Pragma("unroll") for (int m = 0; m < 4; ++m) _Pragma("unroll") for (int n = 0; n < 2; ++n) _Pragma("unroll") for (int k = 0; k < 2; ++k) \
        acc[ai][bj][m][n] = __builtin_amdgcn_mfma_f32_16x16x32_bf16(Bt[n][k], At[m][k], acc[ai][bj][m][n], 0, 0, 0); __builtin_amdgcn_s_setprio(0); } while (0)
#define PG8_WAIT_V(n) asm volatile("s_waitcnt vmcnt(" #n ")" ::: "memory")
#define PG8_WAIT_L(n) asm volatile("s_waitcnt lgkmcnt(" #n ")" ::: "memory")
#define PG8_BAR __builtin_amdgcn_s_barrier()
#define PG8_SCHED __builtin_amdgcn_sched_barrier(0)
    Unit cur, nxt; int ui = 0;
    if (!S.next(0, cur)) return;
    f32x4 acc[2][2][4][2];
#pragma unroll
    for (int a = 0; a < 2; ++a)
#pragma unroll
        for (int b = 0; b < 2; ++b)
#pragma unroll
            for (int m = 0; m < 4; ++m)
#pragma unroll
                for (int n = 0; n < 2; ++n) acc[a][b][m][n] = (f32x4){0.f, 0.f, 0.f, 0.f};
    bf16x8 At[4][2], B0[2][2], B1[2][2];
    const char* cA = (const char*)g.A + (size_t)cur.pm * tstep; const char* cB = (const char*)g.Bt + (size_t)cur.pn * tstep;
    S.a_ready(cur);
    if constexpr (SP2) {
        PG8_STAGE(PG8_SB(0, 0), cB, voffB); PG8_STAGE(PG8_SB(0, 1), cB + hstep, voffB); PG8_STAGE(PG8_SA(0, 0), cA, voffA); PG8_STAGE(PG8_SA(0, 1), cA + hstep, voffA);
        if (wr == 1) PG8_BAR;
        PG8_WAIT_V(2); PG8_BAR;
        PG8_STAGE(PG8_SB(1, 0), cB + kstep, voffB); PG8_STAGE(PG8_SA(1, 0), cA + kstep, voffA); PG8_STAGE(PG8_SB(1, 1), cB + hstep + kstep, voffB);
        PG8_WAIT_V(6); PG8_BAR;
    } else {
        PG8_STAGE(PG8_SB(0, 0), cB, voffB); PG8_STAGE(PG8_SA(0, 0), cA, voffA); PG8_STAGE(PG8_SB(0, 1), cB + hstep, voffB); PG8_STAGE(PG8_SA(0, 1), cA + hstep, voffA);
        if (wr == 1) PG8_BAR;
        PG8_WAIT_V(4); PG8_BAR;
        PG8_STAGE(PG8_SB(1, 0), cB + kstep, voffB); PG8_STAGE(PG8_SA(1, 0), cA + kstep, voffA); PG8_STAGE(PG8_SB(1, 1), cB + hstep + kstep, voffB);
        PG8_WAIT_V(6); PG8_BAR;
    }
    for (;;) {
        const bool has_next = S.next(ui + 1, nxt);
        const char* nA = has_next ? (const char*)g.A + (size_t)nxt.pm * tstep : cA; const char* nB = has_next ? (const char*)g.Bt + (size_t)nxt.pn * tstep : cB;
        for (int t = 0; t < nt; t += 2) {
            const bool last = (t == nt - 2);
            const char* a1 = cA + (size_t)(t + 1) * kstep;
            const char* a2 = last ? nA : cA + (size_t)(t + 2) * kstep; const char* b2 = last ? nB : cB + (size_t)(t + 2) * kstep;
            const char* a3 = a2 + kstep; const char* b3 = b2 + kstep;
            if (last && has_next) S.a_ready(nxt);
            if constexpr (SP2) {
            PG8_LDB(B0, 0, 0); PG8_LDB(B1, 0, 1); PG8_SCHED; PG8_LDA(At, 0, 0); PG8_STAGE(PG8_SA(1, 1), a1 + hstep, voffA);
            PG8_WAIT_V(8); PG8_WAIT_L(0); PG8_BAR; PG8_MMA(0, 0, At, B0); PG8_MMA(0, 1, At, B1); PG8_BAR; PG8_SCHED;
            PG8_LDA(At, 0, 1); PG8_STAGE(PG8_SB(0, 0), b2, voffB); PG8_STAGE(PG8_SB(0, 1), b2 + hstep, voffB); PG8_STAGE(PG8_SA(0, 0), a2, voffA);
            PG8_WAIT_V(8); PG8_WAIT_L(0); PG8_BAR; PG8_MMA(1, 0, At, B0); PG8_MMA(1, 1, At, B1); PG8_BAR; PG8_SCHED;
            PG8_LDB(B0, 1, 0); PG8_LDB(B1, 1, 1); PG8_SCHED; PG8_LDA(At, 1, 0); PG8_STAGE(PG8_SA(0, 1), a2 + hstep, voffA);
            PG8_WAIT_V(8); PG8_WAIT_L(0); PG8_BAR; PG8_MMA(0, 0, At, B0); PG8_MMA(0, 1, At, B1); PG8_BAR; PG8_SCHED;
            PG8_LDA(At, 1, 1); PG8_STAGE(PG8_SB(1, 0), b3, voffB); PG8_STAGE(PG8_SB(1, 1), b3 + hstep, voffB); PG8_STAGE(PG8_SA(1, 0), a3, voffA);
            PG8_WAIT_V(8); PG8_WAIT_L(0); PG8_BAR; PG8_MMA(1, 0, At, B0); PG8_MMA(1, 1, At, B1); PG8_BAR; PG8_SCHED;
            } else {
            PG8_LDB(B0, 0, 0); PG8_SCHED; PG8_LDA(At, 0, 0); PG8_STAGE(PG8_SA(1, 1), a1 + hstep, voffA);
            PG8_WAIT_L(8); PG8_BAR; PG8_WAIT_L(0); PG8_MMA(0, 0, At, B0); PG8_BAR; PG8_SCHED;
            PG8_LDB(B1, 0, 1); PG8_STAGE(PG8_SB(0, 0), b2, voffB);
            PG8_BAR; PG8_WAIT_L(0); PG8_MMA(0, 1, At, B1); PG8_BAR;
            PG8_LDA(At, 0, 1); PG8_STAGE(PG8_SA(0, 0), a2, voffA);
            PG8_BAR; PG8_WAIT_L(0); PG8_MMA(1, 0, At, B0); PG8_BAR; PG8_SCHED;
            PG8_STAGE(PG8_SB(0, 1), b2 + hstep, voffB);
            PG8_WAIT_V(6); PG8_BAR; PG8_MMA(1, 1, At, B1); PG8_BAR;
            PG8_LDB(B0, 1, 0); PG8_SCHED; PG8_LDA(At, 1, 0); PG8_STAGE(PG8_SA(0, 1), a2 + hstep, voffA);
            PG8_WAIT_L(8); PG8_BAR; PG8_WAIT_L(0); PG8_MMA(0, 0, At, B0); PG8_BAR; PG8_SCHED;
            PG8_LDB(B1, 1, 1); PG8_STAGE(PG8_SB(1, 0), b3, voffB);
            PG8_BAR; PG8_WAIT_L(0); PG8_MMA(0, 1, At, B1); PG8_BAR;
            PG8_LDA(At, 1, 1); PG8_STAGE(PG8_SA(1, 0), a3, voffA);
            PG8_BAR; PG8_WAIT_L(0); PG8_MMA(1, 0, At, B0); PG8_BAR; PG8_SCHED;
            PG8_STAGE(PG8_SB(1, 1), b3 + hstep, voffB);
            PG8_WAIT_V(6); PG8_BAR; PG8_MMA(1, 1, At, B1); PG8_BAR;
            }
        }
        if constexpr (ALIGN_EPI) { if (wr == 0) PG8_BAR; }
        if constexpr (!Epi::AFTER_DRAIN) { E(acc, cur, wr, wc, fr, fq); S.done(cur); }
        if (!has_next) break;
#pragma unroll
        for (int a = 0; a < 2; ++a)
#pragma unroll
            for (int b = 0; b < 2; ++b)
#pragma unroll
                for (int m = 0; m < 4; ++m)
#pragma unroll
                    for (int n = 0; n < 2; ++n) acc[a][b][m][n] = (f32x4){0.f, 0.f, 0.f, 0.f};
        cur = nxt; cA = nA; cB = nB; ++ui;
        if constexpr (ALIGN_EPI) { if (wr == 1) PG8_BAR; }
    }
    PG8_WAIT_V(0);
    if constexpr (!ALIGN_EPI) { if (wr == 0) PG8_BAR; }
    PG8_BAR;
    if constexpr (Epi::AFTER_DRAIN) { E.fused(acc, cur, wr, wc, fr, fq, lds, wid, lane); S.done(cur); }
#undef PG8_SA
#undef PG8_SB
#undef PG8_STAGE
#undef PG8_LDA
#undef PG8_LDB
#undef PG8_MMA
#undef PG8_WAIT_V
#undef PG8_WAIT_L
#undef PG8_BAR
#undef PG8_SCHED
}
}
#ifndef PG8_SP2
#define PG8_SP2 true
#endif
#ifndef PG8_ALIGN
#define PG8_ALIGN true
#endif
namespace att {
typedef unsigned short bf16;
typedef short bf16x8 __attribute__((ext_vector_type(8)));
typedef short s16x4 __attribute__((ext_vector_type(4)));
typedef float f32x16 __attribute__((ext_vector_type(16)));
typedef float f32x4 __attribute__((ext_vector_type(4)));
typedef unsigned u32x4 __attribute__((ext_vector_type(4)));
constexpr int NW = 8, QBLK = 32, KVBLK = 64, QB = NW * QBLK, D = 128, PITCH = 1024;
constexpr int SHM_V = KVBLK * D * 2, SHM_K = KVBLK * D * 2;
constexpr int OFF_V = 0, OFF_K = 2 * SHM_V, OFF_WS = OFF_K + 2 * SHM_K, OFF_B = OFF_WS + NW * 64 * 4, LDS_BYTES = OFF_B + 2 * 256;
constexpr float THR = 8.f;
#define KSWZ(row, colB) ((row) * 256 + ((colB) ^ (((row) & 7) << 4)))
#define SBAR() __builtin_amdgcn_sched_barrier(0)
__device__ __forceinline__ int v_st(int k, int c) { const int kk = (k & ~0xC) | ((k & 4) << 1) | ((k & 8) >> 1); return ((kk >> 3) * 4 + (c >> 5)) * 512 + ((kk & 7) * 32 + (c & 31)) * 2; }
__device__ __forceinline__ int v_rd_base(int lane) { return ((lane & 3) << 3) | (((lane >> 2) & 3) << 6) | (((lane >> 4) & 1) << 5) | (((lane >> 5) & 1) << 8); }
constexpr int v_rd_off(int d0, int ks, int half) { return d0 * 512 + ks * 4096 + half * 2048; }
__device__ __forceinline__ int crow(int r, int hi) { return (r & 3) + 8 * (r >> 2) + 4 * hi; }
__device__ __forceinline__ unsigned cvtpk(float lo, float hi) {
    unsigned r; asm volatile("v_cvt_pk_bf16_f32 %0, %1, %2" : "=v"(r) : "v"(lo), "v"(hi)); return r;
}
__device__ __forceinline__ bf16x8 load8(const bf16* p) { return *reinterpret_cast<const bf16x8*>(p); }
__device__ __forceinline__ void mask_tile(f32x16& p0, f32x16& p1, int dq, unsigned W) {
    const float NEG = -__builtin_inff();
#pragma unroll
    for (int r = 0; r < 16; ++r) {
        const int c = (r & 3) + 8 * (r >> 2);
        if ((unsigned)(dq - c) >= W) p0[r] = NEG;
        if ((unsigned)(dq - c - 32) >= W) p1[r] = NEG;
    }
}
template <int DQK>
__device__ __forceinline__ void partialSM(f32x16& p0, f32x16& p1, float& m_reg, float& mn, float& alpha) {
    constexpr float SCALE = DQK == 64 ? 0.125f : 0.08838834764831845f;
    float pmax = p0[0]; for (int r = 1; r < 16; ++r) pmax = fmaxf(pmax, p0[r]); for (int r = 0; r < 16; ++r) pmax = fmaxf(pmax, p1[r]);
    { auto rr = __builtin_amdgcn_permlane32_swap(__float_as_uint(pmax), __float_as_uint(pmax), false, false);
      pmax = fmaxf(__uint_as_float(rr[0]), __uint_as_float(rr[1])); }
    constexpr float C2 = 1.4426950408889634f * SCALE;
    if (__builtin_expect(__all((pmax - m_reg) * SCALE <= THR), 1)) { mn = m_reg; alpha = 1.f; }
    else { mn = fmaxf(m_reg, pmax); alpha = __builtin_amdgcn_exp2f((m_reg - mn) * C2); m_reg = mn; }
    const float mnL = -mn * C2;
    for (int r = 0; r < 16; ++r) p0[r] = fmaf(p0[r], C2, mnL); for (int r = 0; r < 16; ++r) p1[r] = fmaf(p1[r], C2, mnL);
    for (int r = 0; r < 16; ++r) p0[r] = __builtin_amdgcn_exp2f(p0[r]);
}
__device__ __forceinline__ void finishSM(f32x16& p0, f32x16& p1, float alpha, float& l_reg, bf16x8& pa0, bf16x8& pa1, bf16x8& pa2, bf16x8& pa3) {
    for (int r = 0; r < 16; ++r) p1[r] = __builtin_amdgcn_exp2f(p1[r]);
    float ps = 0; for (int r = 0; r < 16; ++r) ps += p0[r]; for (int r = 0; r < 16; ++r) ps += p1[r];
    { auto rr = __builtin_amdgcn_permlane32_swap(__float_as_uint(ps), __float_as_uint(ps), false, false);
      ps = __uint_as_float(rr[0]) + __uint_as_float(rr[1]); }
    l_reg = l_reg * alpha + ps;
#define PK4(P, B_, OUT) do { unsigned a0 = cvtpk(P[B_+0], P[B_+1]), a1 = cvtpk(P[B_+2], P[B_+3]);                          \
        unsigned b0 = cvtpk(P[B_+4], P[B_+5]), b1 = cvtpk(P[B_+6], P[B_+7]);                                             \
        auto r0 = __builtin_amdgcn_permlane32_swap(a0, b0, false, false); auto r1 = __builtin_amdgcn_permlane32_swap(a1, b1, false, false); \
        u32x4 w = {r0[0], r1[0], r0[1], r1[1]}; OUT = *reinterpret_cast<bf16x8*>(&w); } while (0)
    PK4(p0, 0, pa0); PK4(p0, 8, pa1); PK4(p1, 0, pa2); PK4(p1, 8, pa3);
#undef PK4
}
template <int KB, int DQK>
__device__ __forceinline__ void qkt(f32x16& p0, f32x16& p1, const char* K_lds, const char* B_lds, int r32, int hi, const bf16x8* qr) {
    const char* bb = B_lds + KB * 256 + hi * 16;
#pragma unroll
    for (int g = 0; g < 4; ++g) { const f32x4 t0 = *reinterpret_cast<const f32x4*>(bb + 32 * g), t1 = *reinterpret_cast<const f32x4*>(bb + 32 * g + 128);
        p0[4 * g] = t0[0]; p0[4 * g + 1] = t0[1]; p0[4 * g + 2] = t0[2]; p0[4 * g + 3] = t0[3];
        p1[4 * g] = t1[0]; p1[4 * g + 1] = t1[1]; p1[4 * g + 2] = t1[2]; p1[4 * g + 3] = t1[3]; }
    const char* kb[4];
#pragma unroll
    for (int dd = 0; dd < 4; ++dd) kb[dd] = K_lds + KB * SHM_K + KSWZ(r32, (dd * 16 + hi * 8) * 2);
#pragma unroll
    for (int d0 = 0; d0 < DQK / 16; ++d0) { const char* a = kb[d0 & 3] + (d0 >> 2) * 128;
        bf16x8 b0 = *reinterpret_cast<const bf16x8*>(a);
        bf16x8 b1 = *reinterpret_cast<const bf16x8*>(a + 32 * 256);
        p0 = __builtin_amdgcn_mfma_f32_32x32x16_bf16(b0, qr[d0], p0, 0, 0, 0);
        p1 = __builtin_amdgcn_mfma_f32_32x32x16_bf16(b1, qr[d0], p1, 0, 0, 0); }
}
template <int VB>
__device__ __forceinline__ void pv_tile(f32x16* o, int vb0, bf16x8 pa0, bf16x8 pa1, bf16x8 pa2, bf16x8 pa3) {
#define TRRD(dst, off) asm volatile("ds_read_b64_tr_b16 %0, %1 offset:%2" : "=&v"(dst) : "v"(vb0), "i"(off) : "memory")
#define PV_D0(d0) do { s16x4 l0, l1, l2, l3, h0, h1, h2, h3; constexpr int b_ = VB * SHM_V + v_rd_off(d0, 0, 0);     \
        TRRD(l0, b_); TRRD(h0, b_ + 2048); TRRD(l1, b_ + 4096); TRRD(h1, b_ + 6144); TRRD(l2, b_ + 8192); TRRD(h2, b_ + 10240); TRRD(l3, b_ + 12288); TRRD(h3, b_ + 14336); \
        asm volatile("s_waitcnt lgkmcnt(0)" ::: "memory"); SBAR();                 \
        o[d0] = __builtin_amdgcn_mfma_f32_32x32x16_bf16(pa0, (bf16x8){l0[0], l0[1], l0[2], l0[3], h0[0], h0[1], h0[2], h0[3]}, o[d0], 0, 0, 0);   \
        o[d0] = __builtin_amdgcn_mfma_f32_32x32x16_bf16(pa1, (bf16x8){l1[0], l1[1], l1[2], l1[3], h1[0], h1[1], h1[2], h1[3]}, o[d0], 0, 0, 0);   \
        o[d0] = __builtin_amdgcn_mfma_f32_32x32x16_bf16(pa2, (bf16x8){l2[0], l2[1], l2[2], l2[3], h2[0], h2[1], h2[2], h2[3]}, o[d0], 0, 0, 0);   \
        o[d0] = __builtin_amdgcn_mfma_f32_32x32x16_bf16(pa3, (bf16x8){l3[0], l3[1], l3[2], l3[3], h3[0], h3[1], h3[2], h3[3]}, o[d0], 0, 0, 0); } while (0)
    PV_D0(0); PV_D0(1); PV_D0(2); PV_D0(3);
#undef PV_D0
#undef TRRD
}
struct BlockRef { const bf16* Q; const bf16* K; const bf16* V; const float* KB; bf16* O; int P0; int dqk; };
#define ROW(p, k0, rr) ((p) + (size_t)((k0) + (rr)) * PITCH + sc)
#define VMW() asm volatile("s_waitcnt vmcnt(0)" ::: "memory")
#define SLOAD_H(k0) do { st_v0 = load8(ROW(cur.V, k0, sr)); st_v1 = load8(ROW(cur.V, k0, 32 + sr));              \
                         if (sc < DQK) { st_k0 = load8(ROW(cur.K, k0, sr)); st_k1 = load8(ROW(cur.K, k0, 32 + sr)); }    \
                         if (tid < 64) st_b = cur.KB[(k0) + tid]; } while (0)
#define SWRITE_H(bf) do { *(bf16x8*)(V_lds + (bf) * SHM_V + vst0) = st_v0; *(bf16x8*)(V_lds + (bf) * SHM_V + vst1) = st_v1; \
                         if (sc < DQK) { *(bf16x8*)(K_lds + (bf) * SHM_K + kws) = st_k0; *(bf16x8*)(K_lds + (bf) * SHM_K + kws + 32 * 256) = st_k1; } \
                         if (tid < 64) *(float*)(B_lds + (bf) * 256 + tid * 4) = st_b; } while (0)
template <int DQK>
__device__ __forceinline__ void block(const BlockRef& cur, int skv, char* lds) {
    const int tid = threadIdx.x, wid = __builtin_amdgcn_readfirstlane(tid >> 6), lane = tid & 63, r32 = lane & 31, hi = lane >> 5;
    constexpr unsigned W = 1u << 30;
    int j_hi = (cur.P0 + QB - 1) / KVBLK + 1; if (j_hi > skv / KVBLK) j_hi = skv / KVBLK;
    const int NT = j_hi;
    const int qlo = cur.P0 + wid * QBLK, qm = qlo + r32 - 4 * hi;
    char* V_lds = lds + OFF_V; char* K_lds = lds + OFF_K; char* B_lds = lds + OFF_B;
    float* ws = (float*)(lds + OFF_WS) + wid * 64; float* li_l = ws, * al_l = ws + 32;
    float m_reg = -1e30f, l_reg = 0; f32x16 o[4] = {};
    const int sr = tid >> 4, sc = (tid & 15) * 8, vst0 = v_st(sr, sc), vst1 = v_st(32 + sr, sc), kws = KSWZ(sr, sc * 2);
    const int vb0 = (int)(uintptr_t)V_lds + v_rd_base(lane);
    bf16x8 qr[DQK / 16];
#pragma unroll
    for (int d0 = 0; d0 < DQK / 16; ++d0) qr[d0] = load8(cur.Q + (size_t)(wid * QBLK + r32) * PITCH + d0 * 16 + hi * 8);
    bf16x8 st_v0, st_v1, st_k0, st_k1; float st_b;
    SLOAD_H(0); VMW(); SWRITE_H(0);
    __syncthreads();
#define RESC(a) do { if (__any((a) < 1.f)) { if (hi == 0) al_l[r32] = (a); asm volatile("s_waitcnt lgkmcnt(0)" ::: "memory");              \
                     for (int d_ = 0; d_ < 4; ++d_) for (int r = 0; r < 16; ++r) o[d_][r] *= al_l[crow(r, hi)]; } } while (0)
#define TILE(t, BUF) do { f32x16 p0, p1; float mn, al; bf16x8 pa0, pa1, pa2, pa3;                                             \
        if ((t) + 1 < NT) { SLOAD_H(((t) + 1) * KVBLK); }                                                                      \
        SBAR(); qkt<BUF, DQK>(p0, p1, K_lds, B_lds, r32, hi, qr);                                                             \
        { const int kb_ = (t) * KVBLK; if (kb_ + KVBLK - 1 > qlo) mask_tile(p0, p1, qm - kb_, W); }                            \
        partialSM<DQK>(p0, p1, m_reg, mn, al); RESC(al);                                                                      \
        finishSM(p0, p1, al, l_reg, pa0, pa1, pa2, pa3); SBAR();                                                              \
        pv_tile<BUF>(o, vb0, pa0, pa1, pa2, pa3);                                                                             \
        if ((t) + 1 < NT) { VMW(); SWRITE_H(1 - (BUF)); }                                                                      \
        __syncthreads(); } while (0)
    for (int t = 0; t < NT; t += 2) {
        TILE(t, 0);
        if (t + 1 < NT) TILE(t + 1, 1);
    }
    if (hi == 0) li_l[r32] = l_reg; asm volatile("s_waitcnt lgkmcnt(0)" ::: "memory");
    float rli[16];
#pragma unroll
    for (int r = 0; r < 16; ++r) rli[r] = __builtin_amdgcn_rcpf(li_l[crow(r, hi)]);
    bf16* Ow = cur.O + (size_t)(wid * QBLK) * PITCH;
#pragma unroll
    for (int r = 0; r < 16; ++r) { const int orow = crow(r, hi);
#pragma unroll
        for (int d0 = 0; d0 < 4; ++d0) { const float v = o[d0][r] * rli[r];
            const float vn = __shfl_xor(v, 1);
            if ((r32 & 1) == 0) *(unsigned*)(Ow + (size_t)orow * PITCH + d0 * 32 + r32) = cvtpk(v, vn); } }
    __syncthreads();
#undef RESC
#undef TILE
}
#undef ROW
#undef VMW
#undef SLOAD_H
#undef SWRITE_H
#undef KSWZ
#undef SBAR
}
constexpr int NWAVES = 8;
#ifndef MK_N_LAUNCHES
#define MK_N_LAUNCHES 11
#endif
constexpr int N_PHASES = 11;
constexpr int N_LAUNCHES = MK_N_LAUNCHES;
static_assert(N_LAUNCHES == 1 || N_LAUNCHES == N_PHASES, "MK_N_LAUNCHES is 1 or 11");

constexpr int BATCH = 2, SEQ = 4096, DM = 2048, NMETA = 16, MREAL = BATCH * SEQ;
constexpr int LSEQ = NMETA + SEQ;
constexpr int LP = 4160, PADF = 48;
constexpr int M1 = 8448;
constexpr int N1 = 10240;
constexpr int WIN_LD = 10248;
constexpr int NEXP = 16384, PEER_H = 8, PEER_K = 16;
constexpr float EPS = 1e-6f;

constexpr size_t MiB = 1u << 20;
constexpr size_t WS_CTL = 0, CTL_ZERO_BYTES = 1 * MiB;
constexpr size_t WS_WIN = 2 * MiB, WS_WBD = 42 * MiB, WS_WBF = 46 * MiB, WS_WOUT = 50 * MiB, WS_WPQ = 58 * MiB;
constexpr size_t WS_EU = 62 * MiB, WS_EV = 126 * MiB;
constexpr size_t WS_XN = 190 * MiB;
constexpr size_t WS_H2N = 190 * MiB;
constexpr size_t WS_DQ = 223 * MiB, WS_DK = 239 * MiB, WS_DV = 256 * MiB, WS_FQ = 273 * MiB, WS_FK = 289 * MiB, WS_FV = 306 * MiB;
constexpr size_t WS_GA = 323 * MiB, WS_GB = 355 * MiB;
constexpr size_t WS_O1 = 387 * MiB, WS_O2 = 403 * MiB, WS_OF = 419 * MiB;
constexpr size_t WS_OD = 435 * MiB;
constexpr size_t WS_T = 223 * MiB;
constexpr size_t WS_MG = 289 * MiB;
constexpr size_t WS_QP = 323 * MiB;
constexpr size_t WS_IDX = 355 * MiB, WS_GATE = 359 * MiB;
constexpr size_t WS_LOGF = 451 * MiB;
constexpr size_t WS_KBIAS = 452 * MiB;
constexpr size_t WS_END = 453 * MiB;
static_assert(WS_T + (size_t)MREAL * DM * 4 <= WS_FK && WS_MG + (size_t)MREAL * DM * 2 <= WS_GA && WS_XN + (size_t)M1 * DM * 2 <= WS_DQ, "d_ws map");
static_assert(WS_DK + (size_t)BATCH * LP * 1024 * 2 <= WS_DV && WS_FV + (size_t)BATCH * LP * 1024 * 2 <= WS_GA, "d_ws map");

constexpr int CW_TMO = 0, CW_CODE = 1;
constexpr int CW_BAR = 4096;
constexpr int RING_OFF = 0, RING_BYTES = 131072;
constexpr int LDSCTL_OFF = RING_BYTES, MISC_OFF = LDSCTL_OFF + 320;
constexpr int LDS_BYTES = 147456;
#define GAS __attribute__((address_space(1)))
#define LAS __attribute__((address_space(3)))
typedef unsigned short bf16;
typedef unsigned v4u __attribute__((ext_vector_type(4)));
typedef float f32x4 __attribute__((ext_vector_type(4)));
typedef short bf16x8 __attribute__((ext_vector_type(8)));
typedef GAS unsigned gu32;
typedef GAS unsigned long long gu64;
#define RLX_AGENT __ATOMIC_RELAXED, __HIP_MEMORY_SCOPE_AGENT
#define LDS_WAIT() asm volatile("s_waitcnt lgkmcnt(0)" ::: "memory")
#define VM_WAIT() asm volatile("s_waitcnt vmcnt(0)" ::: "memory")
__device__ __forceinline__ unsigned long long rt() { return __builtin_amdgcn_s_memrealtime(); }
__device__ __forceinline__ unsigned f2bf(float f) { unsigned u = __builtin_bit_cast(unsigned, f); return (u + 0x7fffu + ((u >> 16) & 1u)) >> 16; }
__device__ __forceinline__ unsigned pk2(float lo, float hi) { return f2bf(lo) | (f2bf(hi) << 16); }
#define XB_TMO      128
#define XB_XCNT(j)  (256  + 64 * (j))
#define XB_XSUB(j)  (1280 + 64 * (j))
#define XB_XGEN(j)  (2304 + 64 * (j))
#define XB_TOP      3328
#define XB_TOPGEN   3392
#define XCD_BAR_WORDS 3456
#define XB_SPIN_CAP (1u << 18)

__device__ __forceinline__ unsigned xb_ld(unsigned* p)              { return __hip_atomic_load(p, __ATOMIC_RELAXED, __HIP_MEMORY_SCOPE_AGENT); }
__device__ __forceinline__ unsigned xb_add(unsigned* p, unsigned v) { return __hip_atomic_fetch_add(p, v, __ATOMIC_RELAXED, __HIP_MEMORY_SCOPE_AGENT); }
__device__ __forceinline__ unsigned xb_xcc_id() { return (unsigned)__builtin_amdgcn_s_getreg((3 << 11) | 20) & 0xFu; }
#define XB_SPIN(cond, bar) do { unsigned _sp = 0; while (cond) { __builtin_amdgcn_s_sleep(1); \
    if ((++_sp & 255u) == 0u) { if (xb_ld(&(bar)[XB_TMO])) break; if (_sp > XB_SPIN_CAP) { atomicAdd(&(bar)[XB_TMO], 1u); break; } } } } while (0)

struct XcdBarrier {
    unsigned* bar; unsigned x;
    volatile LAS unsigned* st;
};

__device__ __forceinline__ XcdBarrier xcd_barrier_post(unsigned* bar, volatile LAS unsigned* st) {
    XcdBarrier b; b.bar = bar; b.x = xb_xcc_id(); b.st = st;
    if (threadIdx.x == 0) (void)xb_add(&bar[XB_XCNT(b.x)], 1u);
    return b;
}
__device__ __forceinline__ void xcd_barrier_complete(unsigned* bar, unsigned x, unsigned& nloc, unsigned& nx) {
    const unsigned G = gridDim.x * gridDim.y * gridDim.z;
    unsigned sum, cnt, mine, sp = 0u;
    for (;;) {
        sum = 0u; cnt = 0u; mine = 0u;
#pragma unroll
        for (unsigned j = 0; j < 16; ++j) { const unsigned c = xb_ld(&bar[XB_XCNT(j)]); sum += c; cnt += (c > 0u) ? 1u : 0u; mine = (j == x) ? c : mine; }
        if (sum == G) break;
        __builtin_amdgcn_s_sleep(1);
        if ((++sp & 255u) == 0u) { if (xb_ld(&bar[XB_TMO])) break; if (sp > XB_SPIN_CAP) { atomicAdd(&bar[XB_TMO], 1u); break; } }
    }
    nloc = mine > 0u ? mine : 1u; nx = cnt > 0u ? cnt : 1u;
}

__device__ __forceinline__ void xcd_barrier(const XcdBarrier& b) {
    asm volatile("s_waitcnt vmcnt(0)" ::: "memory");
    __syncthreads();
    if (threadIdx.x == 0) {
        unsigned* bar = b.bar;
        __builtin_amdgcn_s_waitcnt(0);
        unsigned nloc = b.st[0], nx = b.st[1];
        if (nloc == 0u) { xcd_barrier_complete(bar, b.x, nloc, nx); b.st[0] = nloc; b.st[1] = nx; }
        const unsigned old = xb_add(&bar[XB_XSUB(b.x)], 1u);
        const unsigned gen = old / nloc;
        if (old + 1u == (gen + 1u) * nloc) {
            __builtin_amdgcn_fence(__ATOMIC_RELEASE, "agent");
            asm volatile("s_waitcnt vmcnt(0)" ::: "memory");
            const unsigned og = xb_add(&bar[XB_TOP], 1u);
            const unsigned tg = og / nx;
            if (og + 1u == (tg + 1u) * nx) xb_add(&bar[XB_TOPGEN], 1u);
            else XB_SPIN(xb_ld(&bar[XB_TOPGEN]) == tg, bar);
            __builtin_amdgcn_fence(__ATOMIC_ACQUIRE, "agent");
            xb_add(&bar[XB_XGEN(b.x)], 1u);
            asm volatile("s_waitcnt vmcnt(0)" ::: "memory");
        } else {
            XB_SPIN(xb_ld(&bar[XB_XGEN(b.x)]) == gen, bar);
            __builtin_amdgcn_fence(__ATOMIC_ACQUIRE, "agent");
            asm volatile("s_waitcnt vmcnt(0)" ::: "memory");
        }
    }
    __syncthreads();
}
__device__ __forceinline__ float wave_sum(float v) {
#pragma unroll
    for (int o = 1; o < 64; o <<= 1) v += __shfl_xor(v, o);
    return v;
}
struct Frame {
    LAS unsigned char* lds;
    volatile LAS unsigned* MISC;
    gu32* ctl;
    int tid, lane, wave;
    int vcu, G;
    int gw, NGW;
    const float* in[23];
    float* out;
    unsigned char* ws;
};
enum { I_X = 0, I_META, I_GMIX, I_WIN, I_BFORGET, I_BGATE, I_DQG, I_DKG, I_FQG, I_FKG, I_LQ1, I_LK1, I_LQ2, I_LK2, I_SUBLN, I_WBD, I_WBF, I_WOUT, I_GPEER, I_WPQ, I_SUBK, I_EU, I_EV };

__device__ __forceinline__ float bf2f(unsigned short b) { return __uint_as_float((unsigned)b << 16); }
__device__ __forceinline__ float bflo(unsigned w) { return __uint_as_float(w << 16); }
__device__ __forceinline__ float bfhi(unsigned w) { return __uint_as_float(w & 0xffff0000u); }
__device__ __forceinline__ float sigmoidf_(float x) { return 1.f / (1.f + __expf(-x)); }

__device__ __forceinline__ void p0_transpose_item2(const float* W, int ldw, int ncols, int K, bf16* WT, int row_off, LAS float* scr, int item, int lane) {
    const int nblk = ncols / 32, kb = item / nblk, nb = item % nblk, k0 = 64 * kb, n0 = 32 * nb;
#pragma unroll 8
    for (int i = 0; i < 32; ++i) { const int kk = 2 * i + (lane >> 5); scr[kk * 33 + (lane & 31)] = W[(size_t)(k0 + kk) * ldw + n0 + (lane & 31)]; }
    LDS_WAIT(); asm volatile("" ::: "memory");
    const int c = lane & 7;
#pragma unroll
    for (int j = 0; j < 4; ++j) { const int n = (lane >> 3) + 8 * j; const LAS float* s = scr + (8 * c) * 33 + n;
        v4u o; o.x = pk2(s[0 * 33], s[1 * 33]); o.y = pk2(s[2 * 33], s[3 * 33]); o.z = pk2(s[4 * 33], s[5 * 33]); o.w = pk2(s[6 * 33], s[7 * 33]);
        *(GAS v4u*)(WT + (size_t)(row_off + n0 + n) * K + k0 + 8 * c) = o; }
    LDS_WAIT(); asm volatile("" ::: "memory");
}

__device__ __forceinline__ void p0_prologue(Frame& F) {
    unsigned char* ws = F.ws;
    {   LAS float* WF = (LAS float*)(F.lds + RING_OFF);
        const float* win = F.in[I_WIN];
        for (int i = F.tid; i < DM * 2; i += NWAVES * 64) { const int k = i >> 1, hh = (i & 1) * 4;
            const f32x4 v = *(const f32x4*)(win + (size_t)k * WIN_LD + 6144 + hh); *(LAS f32x4*)(WF + k * 8 + hh) = v; }
        __syncthreads();
        bf16* XN = (bf16*)(ws + WS_XN); float* LOGF = (float*)(ws + WS_LOGF);
        const float* gmix = F.in[I_GMIX]; const float* bfg = F.in[I_BFORGET];
        for (int m = F.gw; m < M1; m += F.NGW) {
            GAS unsigned long long* o8 = (GAS unsigned long long*)(XN + (size_t)m * DM) + F.lane;
            if (m >= MREAL + NMETA) {
#pragma unroll
                for (int j = 0; j < 8; ++j) o8[64 * j] = 0ull;
                continue; }
            const float* xrow = m < MREAL ? F.in[I_X] + (size_t)m * DM : F.in[I_META] + (size_t)(m - MREAL) * DM;
            const GAS f32x4* xr = (const GAS f32x4*)xrow + F.lane;
            f32x4 v[8]; float s2 = 0.f;
#pragma unroll
            for (int j = 0; j < 8; ++j) { v[j] = xr[64 * j]; s2 += (v[j].x * v[j].x + v[j].y * v[j].y) + (v[j].z * v[j].z + v[j].w * v[j].w); }
            const float rstd = 1.f / sqrtf(wave_sum(s2) * (1.f / DM) + EPS);
            float fl[8];
#pragma unroll
            for (int h = 0; h < 8; ++h) fl[h] = 0.f;
#pragma unroll
            for (int j = 0; j < 8; ++j) { const f32x4 g = *((const GAS f32x4*)gmix + 64 * j + F.lane);
                v[j].x = v[j].x * rstd * g.x; v[j].y = v[j].y * rstd * g.y; v[j].z = v[j].z * rstd * g.z; v[j].w = v[j].w * rstd * g.w;
                o8[64 * j] = (unsigned long long)pk2(v[j].x, v[j].y) | ((unsigned long long)pk2(v[j].z, v[j].w) << 32);
                const int k0 = 256 * j + 4 * F.lane;
#pragma unroll
                for (int i = 0; i < 4; ++i) { const float xv = i == 0 ? v[j].x : i == 1 ? v[j].y : i == 2 ? v[j].z : v[j].w;
                    const f32x4 w0 = *(const LAS f32x4*)(WF + (k0 + i) * 8), w1 = *(const LAS f32x4*)(WF + (k0 + i) * 8 + 4);
                    fl[0] += xv * w0.x; fl[1] += xv * w0.y; fl[2] += xv * w0.z; fl[3] += xv * w0.w; fl[4] += xv * w1.x; fl[5] += xv * w1.y; fl[6] += xv * w1.z; fl[7] += xv * w1.w; } }
#pragma unroll
            for (int h = 0; h < 8; ++h) fl[h] = wave_sum(fl[h]);
            if (F.lane < 8) { float z = 0.f;
#pragma unroll
                for (int h = 0; h < 8; ++h) z = (F.lane == h) ? fl[h] : z;
                z += bfg[F.lane];
                const float lf = fminf(z, 0.f) - log1pf(__expf(-fabsf(z)));
                if (m < MREAL) { const int b = m >> 12, s = m & 4095; LOGF[((size_t)b * 8 + F.lane) * LSEQ + NMETA + s] = lf; }
                else { const int t = m - MREAL; LOGF[((size_t)0 * 8 + F.lane) * LSEQ + t] = lf; LOGF[((size_t)1 * 8 + F.lane) * LSEQ + t] = lf; } }
        }
        __syncthreads();
    }
    {   LAS float* scr = (LAS float*)(F.lds + RING_OFF + F.wave * 16384);
        const float* win = F.in[I_WIN];
        constexpr int I_A = (DM / 64) * (6144 / 32), I_G = (DM / 64) * (2048 / 32), I_BD = (1024 / 64) * (DM / 32), I_O = (DM / 64) * (DM / 32), I_P = (DM / 64) * (1024 / 32);
        constexpr int NITEMS = I_A + 2 * I_G + 2 * I_BD + I_O + I_P;
        bf16* WIN = (bf16*)(ws + WS_WIN);
        for (int it = F.gw; it < NITEMS; it += F.NGW) {
            int r = it;
            if (r < I_A) { p0_transpose_item2(win, WIN_LD, 6144, DM, WIN, 0, scr, r, F.lane); continue; } r -= I_A;
            if (r < I_G) { p0_transpose_item2(win + 6152, WIN_LD, 2048, DM, WIN, 6144, scr, r, F.lane); continue; } r -= I_G;
            if (r < I_G) { p0_transpose_item2(win + 8200, WIN_LD, 2048, DM, WIN, 8192, scr, r, F.lane); continue; } r -= I_G;
            if (r < I_BD) { p0_transpose_item2(F.in[I_WBD], DM, DM, 1024, (bf16*)(ws + WS_WBD), 0, scr, r, F.lane); continue; } r -= I_BD;
            if (r < I_BD) { p0_transpose_item2(F.in[I_WBF], DM, DM, 1024, (bf16*)(ws + WS_WBF), 0, scr, r, F.lane); continue; } r -= I_BD;
            if (r < I_O) { p0_transpose_item2(F.in[I_WOUT], DM, DM, DM, (bf16*)(ws + WS_WOUT), 0, scr, r, F.lane); continue; } r -= I_O;
            p0_transpose_item2(F.in[I_WPQ], 1024, 1024, DM, (bf16*)(ws + WS_WPQ), 0, scr, r, F.lane);
        }
    }
    {   const size_t nchunk = (size_t)NEXP * DM / 8; const size_t gt = (size_t)F.vcu * (NWAVES * 64) + F.tid, GT = (size_t)F.G * NWAVES * 64;
#pragma unroll 1
        for (int tsel = 0; tsel < 2; ++tsel) { const GAS f32x4* src = (const GAS f32x4*)(F.in[tsel ? I_EV : I_EU]); GAS v4u* dst = (GAS v4u*)(ws + (tsel ? WS_EV : WS_EU));
#pragma unroll 4
            for (size_t c = gt; c < nchunk; c += GT) { const f32x4 a = src[2 * c], b = src[2 * c + 1]; v4u o; o.x = pk2(a.x, a.y); o.y = pk2(a.z, a.w); o.z = pk2(b.x, b.y); o.w = pk2(b.z, b.w); dst[c] = o; } }
    }
    {   const size_t gt = (size_t)F.vcu * (NWAVES * 64) + F.tid, GT = (size_t)F.G * NWAVES * 64;
        constexpr size_t per = (size_t)PADF * 1024 * 2 / 16;
        for (size_t c = gt; c < 8 * per; c += GT) { const int a = (int)(c / per), off = (int)(c % per); const int arr = a >> 1, b = a & 1;
            const size_t base = arr == 0 ? WS_DK : arr == 1 ? WS_DV : arr == 2 ? WS_FK : WS_FV;
            ((GAS v4u*)(ws + base + (size_t)b * LP * 1024 * 2))[off] = (v4u){0u, 0u, 0u, 0u}; }
        float* KBD = (float*)(ws + WS_KBIAS) + (size_t)16 * LP;
        for (size_t p = gt; p < LP; p += GT) KBD[p] = p < PADF ? -__builtin_inff() : 0.f;
    }
}
using pg8::Unit;
__device__ __forceinline__ v4u pack8bf(const f32x4& a, const f32x4& b) { v4u w; w.x = pg8::cvt_pk_bf16(a[0], a[1]); w.y = pg8::cvt_pk_bf16(a[2], a[3]); w.z = pg8::cvt_pk_bf16(b[0], b[1]); w.w = pg8::cvt_pk_bf16(b[2], b[3]); return w; }
struct F_Gemm1 {
    unsigned char* ws; bf16* base; int ldc, colt, kind;
    __device__ __forceinline__ bool begin(const Unit& u) {
        const int ncol = u.pn * 256;
        if (ncol < 6144) { const int seg = ncol >> 10; colt = ncol & 1023; ldc = 1024;
            const size_t off = seg == 0 ? WS_DQ : seg == 1 ? WS_DK : seg == 2 ? WS_DV : seg == 3 ? WS_FQ : seg == 4 ? WS_FK : WS_FV; base = (bf16*)(ws + off);
            kind = (seg == 1 || seg == 2 || seg == 4 || seg == 5) ? 1 : 0; }
        else if (ncol < 8192) { base = (bf16*)(ws + WS_GA); colt = ncol - 6144; ldc = 2048; kind = 0; }
        else { base = (bf16*)(ws + WS_GB); colt = ncol - 8192; ldc = 2048; kind = 0; }
        return !(u.pm == 32 && kind == 0);
    }
    __device__ __forceinline__ void chunk(const Unit& u, int rt, int ct, const f32x4& v0, const f32x4& v1) const {
        const v4u w = pack8bf(v0, v1);
        if (u.pm < 32) { const int m = u.pm * 256 + rt; const size_t row = kind ? (size_t)(m + 64 + 64 * (m >> 12)) : (size_t)m;
            *(GAS v4u*)(base + row * ldc + colt + ct) = w; }
        else if (rt < NMETA) { *(GAS v4u*)(base + (size_t)(PADF + rt) * ldc + colt + ct) = w; *(GAS v4u*)(base + (size_t)(LP + PADF + rt) * ldc + colt + ct) = w; }
    }
};
struct F_Gemm2a {
    const bf16* G; const float* bg; float* T;
    __device__ __forceinline__ bool begin(const Unit&) { return true; }
    __device__ __forceinline__ void chunk(const Unit& u, int rt, int ct, const f32x4& v0, const f32x4& v1) const {
        const size_t row = (size_t)u.pm * 256 + rt; const int col = u.pn * 256 + ct;
        const v4u g = *(const GAS v4u*)(G + row * DM + col); const f32x4 b0 = *(const f32x4*)(bg + col), b1 = *(const f32x4*)(bg + col + 4);
        f32x4 o0, o1;
        o0[0] = sigmoidf_(bflo(g.x) + b0[0]) * v0[0]; o0[1] = sigmoidf_(bfhi(g.x) + b0[1]) * v0[1]; o0[2] = sigmoidf_(bflo(g.y) + b0[2]) * v0[2]; o0[3] = sigmoidf_(bfhi(g.y) + b0[3]) * v0[3];
        o1[0] = sigmoidf_(bflo(g.z) + b1[0]) * v1[0]; o1[1] = sigmoidf_(bfhi(g.z) + b1[1]) * v1[1]; o1[2] = sigmoidf_(bflo(g.w) + b1[2]) * v1[2]; o1[3] = sigmoidf_(bfhi(g.w) + b1[3]) * v1[3];
        *(GAS f32x4*)(T + row * DM + col) = o0; *(GAS f32x4*)(T + row * DM + col + 4) = o1;
    }
};
struct F_Gemm2b {
    const bf16* G; const float* bg; const float* T; bf16* MG;
    __device__ __forceinline__ bool begin(const Unit&) { return true; }
    __device__ __forceinline__ void chunk(const Unit& u, int rt, int ct, const f32x4& v0, const f32x4& v1) const {
        const size_t row = (size_t)u.pm * 256 + rt; const int col = u.pn * 256 + ct;
        const v4u g = *(const GAS v4u*)(G + row * DM + col); const f32x4 b0 = *(const f32x4*)(bg + col), b1 = *(const f32x4*)(bg + col + 4);
        const f32x4 t0 = *(const GAS f32x4*)(T + row * DM + col), t1 = *(const GAS f32x4*)(T + row * DM + col + 4);
        f32x4 o0, o1;
        o0[0] = t0[0] + sigmoidf_(bflo(g.x) + b0[0]) * v0[0]; o0[1] = t0[1] + sigmoidf_(bfhi(g.x) + b0[1]) * v0[1]; o0[2] = t0[2] + sigmoidf_(bflo(g.y) + b0[2]) * v0[2]; o0[3] = t0[3] + sigmoidf_(bfhi(g.y) + b0[3]) * v0[3];
        o1[0] = t1[0] + sigmoidf_(bflo(g.z) + b1[0]) * v1[0]; o1[1] = t1[1] + sigmoidf_(bfhi(g.z) + b1[1]) * v1[1]; o1[2] = t1[2] + sigmoidf_(bflo(g.w) + b1[2]) * v1[2]; o1[3] = t1[3] + sigmoidf_(bfhi(g.w) + b1[3]) * v1[3];
        *(GAS v4u*)(MG + row * DM + col) = pack8bf(o0, o1);
    }
};
struct F_Gemm3 {
    const float* X; float* O;
    __device__ __forceinline__ bool begin(const Unit&) { return true; }
    __device__ __forceinline__ void chunk(const Unit& u, int rt, int ct, const f32x4& v0, const f32x4& v1) const {
        const size_t off = ((size_t)u.pm * 256 + rt) * DM + u.pn * 256 + ct;
        const f32x4 x0 = *(const GAS f32x4*)(X + off), x1 = *(const GAS f32x4*)(X + off + 4);
        *(GAS f32x4*)(O + off) = x0 + v0; *(GAS f32x4*)(O + off + 4) = x1 + v1;
    }
};
struct F_Gemm4 {
    float* Q;
    __device__ __forceinline__ bool begin(const Unit&) { return true; }
    __device__ __forceinline__ void chunk(const Unit& u, int rt, int ct, const f32x4& v0, const f32x4& v1) const {
        const size_t off = ((size_t)u.pm * 256 + rt) * 1024 + u.pn * 256 + ct;
        *(GAS f32x4*)(Q + off) = v0; *(GAS f32x4*)(Q + off + 4) = v1;
    }
};

__device__ __forceinline__ void p2_norm_row(bf16* rowp, const float* gain, int grp  , bool rope, float pos, int lane) {
    const v4u w0 = *(const GAS v4u*)(rowp + 16 * lane), w1 = *(const GAS v4u*)(rowp + 16 * lane + 8);
    float x[16];
    x[0] = bflo(w0.x); x[1] = bfhi(w0.x); x[2] = bflo(w0.y); x[3] = bfhi(w0.y); x[4] = bflo(w0.z); x[5] = bfhi(w0.z); x[6] = bflo(w0.w); x[7] = bfhi(w0.w);
    x[8] = bflo(w1.x); x[9] = bfhi(w1.x); x[10] = bflo(w1.y); x[11] = bfhi(w1.y); x[12] = bflo(w1.z); x[13] = bfhi(w1.z); x[14] = bflo(w1.w); x[15] = bfhi(w1.w);
    float ss = 0.f;
#pragma unroll
    for (int i = 0; i < 16; ++i) ss += x[i] * x[i];
    ss += __shfl_xor(ss, 1); ss += __shfl_xor(ss, 2); if (grp == 128) ss += __shfl_xor(ss, 4);
    const float r = 1.f / sqrtf(ss / (float)grp + EPS);
    const int d0 = (16 * lane) & (grp - 1);
#pragma unroll
    for (int i = 0; i < 16; i += 4) { const f32x4 g = *(const f32x4*)(gain + d0 + i); x[i] = x[i] * r * g[0]; x[i + 1] = x[i + 1] * r * g[1]; x[i + 2] = x[i + 2] * r * g[2]; x[i + 3] = x[i + 3] * r * g[3]; }
    if (rope && (lane & 3) == 0) {
        const float inv[8] = {1.0f, 0.1939227432012558f, 0.03760603070259094f, 0.007292664609849453f, 0.0014142135623842478f, 0.00027424818836152554f, 5.318296098266728e-05f, 1.0313386155758053e-05f};
#pragma unroll
        for (int i = 0; i < 8; ++i) { const float ang = pos * inv[i]; const float c = cosf(ang), s = sinf(ang); const float a = x[i], b = x[i + 8]; x[i] = a * c - b * s; x[i + 8] = b * c + a * s; }
    }
    v4u o0, o1;
    o0.x = pk2(x[0], x[1]); o0.y = pk2(x[2], x[3]); o0.z = pk2(x[4], x[5]); o0.w = pk2(x[6], x[7]); o1.x = pk2(x[8], x[9]); o1.y = pk2(x[10], x[11]); o1.z = pk2(x[12], x[13]); o1.w = pk2(x[14], x[15]);
    *(GAS v4u*)(rowp + 16 * lane) = o0; *(GAS v4u*)(rowp + 16 * lane + 8) = o1;
}
__device__ __forceinline__ void p2_norms(Frame& F) {
    unsigned char* ws = F.ws;
    if (F.gw < 16) {
        const float* lf = (const float*)(ws + WS_LOGF) + (size_t)F.gw * LSEQ; float* kb = (float*)(ws + WS_KBIAS) + (size_t)F.gw * LP;
        constexpr int CH = 65; const int t0 = F.lane * CH;
        float s = 0.f;
        for (int i = 0; i < CH; ++i) { const int t = t0 + i; if (t < LSEQ) s += lf[t]; }
        float incl = s;
#pragma unroll
        for (int o = 1; o < 64; o <<= 1) { const float n = __shfl_up(incl, o); if (F.lane >= o) incl += n; }
        float run = incl - s;
        for (int i = 0; i < CH; ++i) { const int t = t0 + i; if (t < LSEQ) { run += lf[t]; kb[PADF + t] = -run * 11.313708498984761f; } }
        if (F.lane < PADF) kb[F.lane] = -__builtin_inff();
    }
    constexpr int NKR = BATCH * LSEQ;
    const int total = 2 * MREAL + 2 * NKR;
    for (int it = F.gw; it < total; it += F.NGW) {
        int r = it;
        if (r < MREAL) { p2_norm_row((bf16*)(ws + WS_DQ) + (size_t)r * 1024, F.in[I_DQG], 64, true, (float)(NMETA + (r & 4095)), F.lane); continue; } r -= MREAL;
        if (r < NKR) { const int b = r / LSEQ, t = r % LSEQ; p2_norm_row((bf16*)(ws + WS_DK) + ((size_t)b * LP + PADF + t) * 1024, F.in[I_DKG], 64, true, (float)t, F.lane); continue; } r -= NKR;
        if (r < MREAL) { p2_norm_row((bf16*)(ws + WS_FQ) + (size_t)r * 1024, F.in[I_FQG], 128, false, 0.f, F.lane); continue; } r -= MREAL;
        { const int b = r / LSEQ, t = r % LSEQ; p2_norm_row((bf16*)(ws + WS_FK) + ((size_t)b * LP + PADF + t) * 1024, F.in[I_FKG], 128, false, 0.f, F.lane); }
    }
}

__device__ const unsigned char ATT_TAB[32][4] = {
{16,95,84,112},{0,79,68,112},{22,48,94,112},{6,32,78,112},{54,93,82,112},{38,77,66,112},{63,23,81,112},{47,7,65,112},{31,52,85,112},{15,36,69,112},{55,51,92,112},{39,35,76,112},{62,24,49,112},{46,8,33,112},{30,86,83,112},{14,70,67,112},{56,20,91,112},{40,4,75,112},{61,25,17,112},{45,9,1,112},{29,19,87,112},{13,3,71,112},{57,21,90,112},{41,5,74,112},{60,26,80,112},{44,10,64,112},{28,50,88,112},{12,34,72,112},{59,18,89,112},{43,2,73,112},{27,58,53,112},{11,42,37,112}};
__device__ __forceinline__ att::BlockRef att_ref(unsigned char* ws, int x, int code) {
    const int hl = code >> 4, j = code & 15; att::BlockRef r;
    if (hl < 4) { const int dp = 2 * x + (hl >> 1), b = dp >> 3, h = dp & 7, i = hl & 1;
        r.Q = (const bf16*)(ws + WS_DQ) + ((size_t)b * SEQ + 256 * j) * 1024 + h * 128 + i * 64;
        r.K = (const bf16*)(ws + WS_DK) + (size_t)b * LP * 1024 + h * 128 + i * 64;
        r.V = (const bf16*)(ws + WS_DV) + (size_t)b * LP * 1024 + h * 128;
        r.KB = (const float*)(ws + WS_KBIAS) + (size_t)16 * LP;
        r.O = (bf16*)(ws + (i ? WS_O2 : WS_O1)) + ((size_t)b * SEQ + 256 * j) * 1024 + h * 128; r.dqk = 64; }
    else { const int fh = 2 * x + (hl - 4), b = fh >> 3, h = fh & 7;
        r.Q = (const bf16*)(ws + WS_FQ) + ((size_t)b * SEQ + 256 * j) * 1024 + h * 128;
        r.K = (const bf16*)(ws + WS_FK) + (size_t)b * LP * 1024 + h * 128;
        r.V = (const bf16*)(ws + WS_FV) + (size_t)b * LP * 1024 + h * 128;
        r.KB = (const float*)(ws + WS_KBIAS) + (size_t)fh * LP;
        r.O = (bf16*)(ws + WS_OF) + ((size_t)b * SEQ + 256 * j) * 1024 + h * 128; r.dqk = 128; }
    r.P0 = 64 + 256 * j; return r;
}
__device__ __forceinline__ void p3_attention(Frame& F, char* lds) {
    for (int v = F.vcu; v < 256; v += F.G) {
        const int x = v >> 5, slot = v & 31;
        int n = 0; while (n < 4 && ATT_TAB[slot][n] != 112) ++n;
        if (n == 0) continue;
        for (int i = 0; i < n; ++i) {
            const att::BlockRef cur = att_ref(F.ws, x, ATT_TAB[slot][i]);
            if (cur.dqk == 64) att::block<64>(cur, LP, lds); else att::block<128>(cur, LP, lds);
        }
    }
}
__device__ __forceinline__ float diff_lambda(Frame& F) {
    const float a = F.in[I_LQ1][F.lane] * F.in[I_LK1][F.lane], b = F.in[I_LQ2][F.lane] * F.in[I_LK2][F.lane];
    return __expf(wave_sum(a)) - __expf(wave_sum(b)) + 0.2f;
}
__device__ __forceinline__ void p4_combine(Frame& F) {
    const float lam = diff_lambda(F);
    const bf16* O1 = (const bf16*)(F.ws + WS_O1); const bf16* O2 = (const bf16*)(F.ws + WS_O2); bf16* OD = (bf16*)(F.ws + WS_OD);
    const float* g = F.in[I_SUBLN];
    const int d0 = (16 * F.lane) & 127;
    for (int m = F.gw; m < MREAL; m += F.NGW) {
        const size_t off = (size_t)m * 1024 + 16 * F.lane;
        const v4u a0 = *(const GAS v4u*)(O1 + off), a1 = *(const GAS v4u*)(O1 + off + 8), b0 = *(const GAS v4u*)(O2 + off), b1 = *(const GAS v4u*)(O2 + off + 8);
        float x[16];
        x[0] = bflo(a0.x) - lam * bflo(b0.x); x[1] = bfhi(a0.x) - lam * bfhi(b0.x); x[2] = bflo(a0.y) - lam * bflo(b0.y); x[3] = bfhi(a0.y) - lam * bfhi(b0.y);
        x[4] = bflo(a0.z) - lam * bflo(b0.z); x[5] = bfhi(a0.z) - lam * bfhi(b0.z); x[6] = bflo(a0.w) - lam * bflo(b0.w); x[7] = bfhi(a0.w) - lam * bfhi(b0.w);
        x[8] = bflo(a1.x) - lam * bflo(b1.x); x[9] = bfhi(a1.x) - lam * bfhi(b1.x); x[10] = bflo(a1.y) - lam * bflo(b1.y); x[11] = bfhi(a1.y) - lam * bfhi(b1.y);
        x[12] = bflo(a1.z) - lam * bflo(b1.z); x[13] = bfhi(a1.z) - lam * bfhi(b1.z); x[14] = bflo(a1.w) - lam * bflo(b1.w); x[15] = bfhi(a1.w) - lam * bfhi(b1.w);
        float ss = 0.f;
#pragma unroll
        for (int i = 0; i < 16; ++i) ss += x[i] * x[i];
        ss += __shfl_xor(ss, 1); ss += __shfl_xor(ss, 2); ss += __shfl_xor(ss, 4);
        const float r = 0.8f / sqrtf(ss * (1.f / 128.f) + EPS);
#pragma unroll
        for (int i = 0; i < 16; i += 4) { const f32x4 gg = *(const f32x4*)(g + d0 + i); x[i] *= r * gg[0]; x[i + 1] *= r * gg[1]; x[i + 2] *= r * gg[2]; x[i + 3] *= r * gg[3]; }
        v4u o0, o1;
        o0.x = pk2(x[0], x[1]); o0.y = pk2(x[2], x[3]); o0.z = pk2(x[4], x[5]); o0.w = pk2(x[6], x[7]); o1.x = pk2(x[8], x[9]); o1.y = pk2(x[10], x[11]); o1.z = pk2(x[12], x[13]); o1.w = pk2(x[14], x[15]);
        *(GAS v4u*)(OD + off) = o0; *(GAS v4u*)(OD + off + 8) = o1;
    }
}
__device__ __forceinline__ void p7_norm(Frame& F) {
    bf16* H2N = (bf16*)(F.ws + WS_H2N); const float* gp = F.in[I_GPEER];
    for (int m = F.gw; m < MREAL; m += F.NGW) {
        const GAS f32x4* xr = (const GAS f32x4*)(F.out + (size_t)m * DM) + F.lane;
        GAS unsigned long long* o8 = (GAS unsigned long long*)(H2N + (size_t)m * DM) + F.lane;
        f32x4 v[8]; float s2 = 0.f;
#pragma unroll
        for (int j = 0; j < 8; ++j) { v[j] = xr[64 * j]; s2 += (v[j].x * v[j].x + v[j].y * v[j].y) + (v[j].z * v[j].z + v[j].w * v[j].w); }
        const float rstd = 1.f / sqrtf(wave_sum(s2) * (1.f / DM) + EPS);
#pragma unroll
        for (int j = 0; j < 8; ++j) { const f32x4 g = *((const GAS f32x4*)gp + 64 * j + F.lane);
            o8[64 * j] = (unsigned long long)pk2(v[j].x * rstd * g.x, v[j].y * rstd * g.y) | ((unsigned long long)pk2(v[j].z * rstd * g.z, v[j].w * rstd * g.w) << 32); }
    }
}
#define TOPINS(V, I, s_, i_) do { float s__ = (s_); int i__ = (i_);                                             \
    _Pragma("unroll") for (int j_ = 0; j_ < 16; ++j_) { const bool gt_ = s__ > V[j_]; const float tv_ = gt_ ? V[j_] : s__; const int ti_ = gt_ ? I[j_] : i__; \
        V[j_] = gt_ ? s__ : V[j_]; I[j_] = gt_ ? i__ : I[j_]; s__ = tv_; i__ = ti_; } } while (0)
__device__ __forceinline__ void p9_route(Frame& F) {
    LAS float* KS = (LAS float*)(F.lds + RING_OFF);
    LAS float* XV = (LAS float*)(F.lds + RING_OFF + 65536);
    LAS int*   XI = (LAS int*)(F.lds + RING_OFF + 65536 + 16384);
    const float* QP = (const float*)(F.ws + WS_QP); int* IDX = (int*)(F.ws + WS_IDX); float* GATE = (float*)(F.ws + WS_GATE);
    const int c = F.tid >> 8, tl = F.tid & 255;
    for (int task = F.vcu; task < PEER_H * (MREAL / 256); task += F.G) {
        const int h = task & 7, tok = (task >> 3) * 256 + tl;
        __syncthreads();
        { const GAS f32x4* src = (const GAS f32x4*)(F.in[I_SUBK] + (size_t)h * 2 * 128 * 64);
          for (int i = F.tid; i < 2 * 128 * 64 / 4; i += NWAVES * 64) *(LAS f32x4*)(KS + 4 * i) = src[i]; }
        f32x4 q[16];
        { const GAS f32x4* qp = (const GAS f32x4*)(QP + (size_t)tok * 1024 + h * 128 + c * 64);
#pragma unroll
          for (int i = 0; i < 16; ++i) q[i] = qp[i]; }
        __syncthreads();
        float v[16]; int ix[16];
#pragma unroll
        for (int j = 0; j < 16; ++j) { v[j] = -__builtin_inff(); ix[j] = 0; }
        const LAS float* kc = KS + c * 128 * 64;
#pragma unroll 2
        for (int n = 0; n < 128; ++n) {
            float s0 = 0.f, s1 = 0.f;
#pragma unroll
            for (int i = 0; i < 16; i += 2) { const f32x4 k0 = *(const LAS f32x4*)(kc + n * 64 + 4 * i), k1 = *(const LAS f32x4*)(kc + n * 64 + 4 * i + 4);
                s0 += q[i].x * k0.x; s0 += q[i].y * k0.y; s0 += q[i].z * k0.z; s0 += q[i].w * k0.w;
                s1 += q[i + 1].x * k1.x; s1 += q[i + 1].y * k1.y; s1 += q[i + 1].z * k1.z; s1 += q[i + 1].w * k1.w; }
            TOPINS(v, ix, s0 + s1, n);
        }
        if (c == 1) {
#pragma unroll
            for (int j = 0; j < 16; ++j) { XV[tl * 16 + j] = v[j]; XI[tl * 16 + j] = ix[j]; } }
        __syncthreads();
        if (c == 0) {
            float v2[16]; int i2[16];
#pragma unroll
            for (int j = 0; j < 16; ++j) { v2[j] = XV[tl * 16 + j]; i2[j] = XI[tl * 16 + j]; }
            float bv[16]; int be[16];
#pragma unroll
            for (int j = 0; j < 16; ++j) { bv[j] = -__builtin_inff(); be[j] = 0; }
#pragma unroll
            for (int a = 0; a < 16; ++a)
#pragma unroll
                for (int b = 0; b < 16; ++b) if ((a + 1) * (b + 1) <= 16) TOPINS(bv, be, v[a] + v2[b], ix[a] * 128 + i2[b]);
            float e[16], sum = 0.f;
#pragma unroll
            for (int j = 0; j < 16; ++j) { e[j] = __expf(bv[j] - bv[0]); sum += e[j]; }
            const float rs = 1.f / sum;
            GAS int* io = (GAS int*)(IDX + (size_t)tok * 128 + h * 16); GAS float* go = (GAS float*)(GATE + (size_t)tok * 128 + h * 16);
#pragma unroll
            for (int j = 0; j < 16; ++j) { io[j] = be[j]; go[j] = e[j] * rs; }
        }
    }
}
__device__ __forceinline__ float dot8(const v4u& a, const v4u& b, float acc) {
    acc += bflo(a.x) * bflo(b.x); acc += bfhi(a.x) * bfhi(b.x); acc += bflo(a.y) * bflo(b.y); acc += bfhi(a.y) * bfhi(b.y);
    acc += bflo(a.z) * bflo(b.z); acc += bfhi(a.z) * bfhi(b.z); acc += bflo(a.w) * bflo(b.w); acc += bfhi(a.w) * bfhi(b.w); return acc;
}
__device__ __forceinline__ void axpy8(float* acc, float w, const v4u& b) {
    acc[0] += w * bflo(b.x); acc[1] += w * bfhi(b.x); acc[2] += w * bflo(b.y); acc[3] += w * bfhi(b.y); acc[4] += w * bflo(b.z); acc[5] += w * bfhi(b.z); acc[6] += w * bflo(b.w); acc[7] += w * bfhi(b.w);
}
__device__ __forceinline__ void p10_experts(Frame& F) {
    const bf16* H2N = (const bf16*)(F.ws + WS_H2N); const int* IDX = (const int*)(F.ws + WS_IDX); const float* GATE = (const float*)(F.ws + WS_GATE);
    const GAS v4u* EU = (const GAS v4u*)(F.ws + WS_EU); const GAS v4u* EV = (const GAS v4u*)(F.ws + WS_EV);
    for (int tok = F.gw; tok < MREAL; tok += F.NGW) {
        v4u hn[4];
#pragma unroll
        for (int j = 0; j < 4; ++j) hn[j] = *((const GAS v4u*)(H2N + (size_t)tok * DM) + F.lane + 64 * j);
        const int e0 = IDX[(size_t)tok * 128 + F.lane], e1 = IDX[(size_t)tok * 128 + 64 + F.lane];
        const float g0 = GATE[(size_t)tok * 128 + F.lane], g1 = GATE[(size_t)tok * 128 + 64 + F.lane];
        float acc[32];
#pragma unroll
        for (int i = 0; i < 32; ++i) acc[i] = 0.f;
#pragma unroll 1
        for (int g = 0; g < 32; ++g) {
            int e[4]; float gt[4]; float d[4];
#pragma unroll
            for (int i = 0; i < 4; ++i) { const int k = 4 * g + i; e[i] = __shfl(k < 64 ? e0 : e1, k & 63); gt[i] = __shfl(k < 64 ? g0 : g1, k & 63); e[i] = __builtin_amdgcn_readfirstlane(e[i]); }
            v4u u[4][4];
#pragma unroll
            for (int i = 0; i < 4; ++i)
#pragma unroll
                for (int j = 0; j < 4; ++j) u[i][j] = EU[(size_t)e[i] * 256 + F.lane + 64 * j];
#pragma unroll
            for (int i = 0; i < 4; ++i) { float s = 0.f;
#pragma unroll
                for (int j = 0; j < 4; ++j) s = dot8(hn[j], u[i][j], s);
                d[i] = wave_sum(s); }
#pragma unroll
            for (int i = 0; i < 4; ++i)
#pragma unroll
                for (int j = 0; j < 4; ++j) u[i][j] = EV[(size_t)e[i] * 256 + F.lane + 64 * j];
#pragma unroll
            for (int i = 0; i < 4; ++i) { const float a = 0.5f * d[i] * (1.f + erff(d[i] * 0.70710678118654752f)); const float w = gt[i] * a;
#pragma unroll
                for (int j = 0; j < 4; ++j) axpy8(acc + 8 * j, w, u[i][j]); }
        }
#pragma unroll
        for (int j = 0; j < 4; ++j) { GAS f32x4* op = (GAS f32x4*)(F.out + (size_t)tok * DM) + 2 * (F.lane + 64 * j);
            f32x4 a = op[0], b = op[1];
            a[0] += acc[8 * j]; a[1] += acc[8 * j + 1]; a[2] += acc[8 * j + 2]; a[3] += acc[8 * j + 3]; b[0] += acc[8 * j + 4]; b[1] += acc[8 * j + 5]; b[2] += acc[8 * j + 6]; b[3] += acc[8 * j + 7];
            op[0] = a; op[1] = b; }
    }
}
struct Args { const float* in[23]; float* out; unsigned char* ws; int ph_lo, ph_hi, li, pad; };
__global__ void __launch_bounds__(NWAVES * 64, 2) mega_fwd(Args args) {
    extern __shared__ __attribute__((aligned(16))) unsigned char lds[];
    Frame F;
    F.lds = (LAS unsigned char*)lds;
    F.MISC = (volatile LAS unsigned*)(F.lds + MISC_OFF);
    F.tid = threadIdx.x; F.lane = F.tid & 63; F.wave = __builtin_amdgcn_readfirstlane(F.tid >> 6);
    F.G = gridDim.x; { const int bx = blockIdx.x; F.vcu = (F.G % 8 == 0) ? (bx % 8) * (F.G / 8) + bx / 8 : bx; }
    F.gw = F.vcu * NWAVES + F.wave; F.NGW = F.G * NWAVES;
#pragma unroll
    for (int i = 0; i < 23; ++i) F.in[i] = args.in[i];
    F.out = args.out; F.ws = args.ws;
    F.ctl = (gu32*)(args.ws + WS_CTL);
    for (int u = F.tid; u < (LDS_BYTES - LDSCTL_OFF) / 4; u += NWAVES * 64) ((LAS unsigned*)(F.lds + LDSCTL_OFF))[u] = 0u;
    __syncthreads();
    XcdBarrier bar; bar.bar = (unsigned*)(F.ctl + CW_BAR); bar.x = 0; bar.st = nullptr;
    if (N_LAUNCHES == 1) bar = xcd_barrier_post((unsigned*)(F.ctl + CW_BAR), F.MISC + 8);
#define GRID_BAR(seam) do { if (N_LAUNCHES != 1) { if (F.tid == 0) __hip_atomic_store(F.ctl + CW_TMO, 0xBADBA0u | (unsigned)(seam), RLX_AGENT); } else { xcd_barrier(bar); } } while (0)
    const int lo = args.ph_lo, hi = args.ph_hi;
#ifndef PH_MASK
#define PH_MASK 0x7ff
#endif
#define IN(k) ((((PH_MASK) >> (k)) & 1) && lo <= (k) && (k) < hi)
#define BOTH(k) (IN(k) && IN((k) + 1))
    unsigned char* ws = args.ws;
    typedef pg8::bf16_t pb;
    if (IN(0)) { p0_prologue(F); if (BOTH(0)) GRID_BAR(0); }
    if (IN(1)) {
        pg8::Gemm g{(const pb*)(ws + WS_XN), (const pb*)(ws + WS_WIN), M1, N1, DM}; pg8::StaticOrder S; S.init(M1, N1, F.G, (int)blockIdx.x);
        pg8::EpiGen<F_Gemm1> E{F_Gemm1{ws, nullptr, 0, 0, 0}};
        pg8::gemm_phase<pg8::EpiGen<F_Gemm1>, pg8::StaticOrder, PG8_ALIGN, PG8_SP2>(F.lds + RING_OFF, g, S, E);
        if (BOTH(1)) GRID_BAR(1);
    }
    if (IN(2)) { p2_norms(F); if (BOTH(2)) GRID_BAR(2); }
    if (IN(3)) { p3_attention(F, (char*)lds + RING_OFF); if (BOTH(3)) GRID_BAR(3); }
    if (IN(4)) { p4_combine(F); if (BOTH(4)) GRID_BAR(4); }
    if (IN(5)) {
        { pg8::Gemm g{(const pb*)(ws + WS_OD), (const pb*)(ws + WS_WBD), MREAL, DM, 1024}; pg8::StaticOrder S; S.init(MREAL, DM, F.G, (int)blockIdx.x);
          pg8::EpiGen<F_Gemm2a> E{F_Gemm2a{(const bf16*)(ws + WS_GA), F.in[I_BGATE], (float*)(ws + WS_T)}};
          pg8::gemm_phase<pg8::EpiGen<F_Gemm2a>, pg8::StaticOrder, PG8_ALIGN, PG8_SP2>(F.lds + RING_OFF, g, S, E); }
        { pg8::Gemm g{(const pb*)(ws + WS_OF), (const pb*)(ws + WS_WBF), MREAL, DM, 1024}; pg8::StaticOrder S; S.init(MREAL, DM, F.G, (int)blockIdx.x);
          pg8::EpiGen<F_Gemm2b> E{F_Gemm2b{(const bf16*)(ws + WS_GB), F.in[I_BGATE] + DM, (const float*)(ws + WS_T), (bf16*)(ws + WS_MG)}};
          pg8::gemm_phase<pg8::EpiGen<F_Gemm2b>, pg8::StaticOrder, PG8_ALIGN, PG8_SP2>(F.lds + RING_OFF, g, S, E); }
        if (BOTH(5)) GRID_BAR(5);
    }
    if (IN(6)) {
        pg8::Gemm g{(const pb*)(ws + WS_MG), (const pb*)(ws + WS_WOUT), MREAL, DM, DM}; pg8::StaticOrder S; S.init(MREAL, DM, F.G, (int)blockIdx.x);
        pg8::EpiGen<F_Gemm3> E{F_Gemm3{F.in[I_X], F.out}};
        pg8::gemm_phase<pg8::EpiGen<F_Gemm3>, pg8::StaticOrder, PG8_ALIGN, PG8_SP2>(F.lds + RING_OFF, g, S, E);
        if (BOTH(6)) GRID_BAR(6);
    }
    if (IN(7)) { p7_norm(F); if (BOTH(7)) GRID_BAR(7); }
    if (IN(8)) {
        pg8::Gemm g{(const pb*)(ws + WS_H2N), (const pb*)(ws + WS_WPQ), MREAL, 1024, DM}; pg8::StaticOrder S; S.init(MREAL, 1024, F.G, (int)blockIdx.x);
        pg8::EpiGen<F_Gemm4> E{F_Gemm4{(float*)(ws + WS_QP)}};
        pg8::gemm_phase<pg8::EpiGen<F_Gemm4>, pg8::StaticOrder, PG8_ALIGN, PG8_SP2>(F.lds + RING_OFF, g, S, E);
        if (BOTH(8)) GRID_BAR(8);
    }
    if (IN(9)) { p9_route(F); if (BOTH(9)) GRID_BAR(9); }
    if (IN(10)) { p10_experts(F); }
#undef IN
#undef BOTH
}

extern "C" void kernel_launch(void* const* d_in, const int* in_sizes, int n_in, void* d_out, int out_size, void* d_ws, size_t ws_size, hipStream_t stream) {
    static int grid = 0;
    if (grid == 0) {
        if (n_in != 23 || in_sizes[0] != MREAL * DM || out_size != MREAL * DM || ws_size < WS_END) {
            fprintf(stderr, "kernel_launch: built for 23 inputs, x/out of %d floats, >= %zu bytes of workspace; got n_in %d, in0 %d, out %d, ws %zu; nothing launched\n", MREAL * DM, (size_t)WS_END, n_in, n_in > 0 ? in_sizes[0] : -1, out_size, ws_size); grid = -1; return; }
        int dev = 0, cus = 0, per_cu = 0;
        if (hipGetDevice(&dev) != hipSuccess || hipDeviceGetAttribute(&cus, hipDeviceAttributeMultiprocessorCount, dev) != hipSuccess) { fprintf(stderr, "kernel_launch: device query failed\n"); grid = -1; return; }
        if (hipFuncSetAttribute((const void*)mega_fwd, hipFuncAttributeMaxDynamicSharedMemorySize, LDS_BYTES) != hipSuccess) { fprintf(stderr, "kernel_launch: hipFuncSetAttribute failed\n"); grid = -1; return; }
        if (hipOccupancyMaxActiveBlocksPerMultiprocessor(&per_cu, (const void*)mega_fwd, NWAVES * 64, LDS_BYTES) != hipSuccess || per_cu < 1) {
            fprintf(stderr, "kernel_launch: occupancy query reports %d workgroups per CU; nothing launched\n", per_cu); (void)hipGetLastError(); grid = -1; return; }
        grid = cus;
    }
    if (grid < 0) return;
    if (hipMemsetAsync((char*)d_ws + WS_CTL, 0, CTL_ZERO_BYTES, stream) != hipSuccess) { fprintf(stderr, "kernel_launch: hipMemsetAsync failed\n"); return; }
    Args a{};
    for (int i = 0; i < 23; ++i) a.in[i] = (const float*)d_in[i];
    a.out = (float*)d_out; a.ws = (unsigned char*)d_ws;
    for (int li = 0; li < N_LAUNCHES; ++li) {
        a.ph_lo = (N_LAUNCHES == 1) ? 0 : li; a.ph_hi = (N_LAUNCHES == 1) ? N_PHASES : li + 1; a.li = li;
        hipLaunchKernelGGL(mega_fwd, dim3(grid), dim3(NWAVES * 64), LDS_BYTES, stream, a);
        const hipError_t le = hipPeekAtLastError();
        if (le != hipSuccess) { fprintf(stderr, "kernel_launch: launch %d failed: %s\n", li, hipGetErrorName(le)); break; }
    }
}
```

```cpp
#include <hip/hip_runtime.h>
#include <cstdio>
#include <cstdint>
#include <cmath>
#define PH_REP_MASK 0x0
#define ATT_ABL 0
namespace pg8 {
#define PG8_LAS __attribute__((address_space(3)))
typedef unsigned short bf16_t;
typedef short bf16x8 __attribute__((ext_vector_type(8)));
typedef float f32x4 __attribute__((ext_vector_type(4)));
typedef unsigned u32x4 __attribute__((ext_vector_type(4)));
constexpr int BM = 256, BK = 64, HALF = 128, HTB = HALF * BK * 2  , STAGE_BYTES = 8 * HTB, NXCD = 8, WGM = 8;

__host__ __device__ __forceinline__ int lds_byte(int r, int c) { const int st = (r >> 4) * 2 + (c >> 5), rr = r & 15, cc = c & 31, ob = rr * 64 + cc * 2; return st * 1024 + (ob ^ (((ob >> 9) & 1) << 5)); }
__host__ __device__ __forceinline__ void stage_rc(int b, int& R, int& C) { const int st = b / 1024, sb = b % 1024, swz = sb ^ (((sb >> 9) & 1) << 5); R = (st >> 1) * 16 + swz / 64; C = (st & 1) * 32 + (swz % 64) / 2; }
__host__ __device__ __forceinline__ int perm32(int rho) { const int n = rho >> 4, i = rho & 15; return 8 * (i >> 2) + 4 * n + (i & 3); }

struct Unit { int pm, pn, ko, kob, chain; };
struct Gemm { const bf16_t* A; const bf16_t* Bt; int M, N, K, ld; };

struct StaticOrder {
    int nM, nN, nwg, G, c;
    __host__ __device__ void init(int M, int N, int G_, int c_) { nM = M / BM; nN = N / BM; nwg = nM * nN; G = G_; c = c_; }
    __host__ __device__ bool next(int i, Unit& u) const {
        const long L = (long)i * G + c; if (L >= nwg) return false;
        int wgid = (int)L; { const int q = nwg / NXCD, r = nwg % NXCD, xcd = wgid % NXCD, off = wgid / NXCD; wgid = (xcd < r ? xcd * (q + 1) : r * (q + 1) + (xcd - r) * q) + off; }
        const int nig = WGM * nN, gid = wgid / nig, fm = gid * WGM, gsz = (nM - fm) < WGM ? (nM - fm) : WGM;
        u.pm = fm + ((wgid % nig) % gsz); u.pn = (wgid % nig) / gsz; u.ko = 0; u.kob = 0; u.chain = 0; return true;
    }
    __device__ __forceinline__ void a_ready(const Unit&) const {}
    __device__ __forceinline__ void done(const Unit&) const {}
};
__device__ __forceinline__ unsigned cvt_pk_bf16(float lo, float hi) { unsigned r; asm volatile("v_cvt_pk_bf16_f32 %0, %1, %2" : "=v"(r) : "v"(lo), "v"(hi)); return r; }
typedef float f32x2 __attribute__((ext_vector_type(2)));
template <class F> struct EpiGen {
    static constexpr bool PERM = true, AFTER_DRAIN = false;
    F f;
    __device__ __forceinline__ void operator()(const f32x4 (&acc)[2][2][4][2], const Unit& u, int wr, int wc, int fr, int fq) const {
        F g = f; if (!g.begin(u)) return;
        asm volatile("" : "+v"(fr), "+v"(fq));
#pragma unroll
        for (int ai = 0; ai < 2; ++ai)
#pragma unroll
            for (int m = 0; m < 4; ++m) { const int rt = ai * HALF + wr * 64 + m * 16 + fr; g.row_begin();
#pragma unroll
                for (int bj = 0; bj < 2; ++bj) g.chunk(u, rt, bj * HALF + wc * 32 + 8 * fq, acc[ai][bj][m][0], acc[ai][bj][m][1]);
                g.row_end(u, rt, wc, fq); }
    }
    __device__ __forceinline__ void scale(f32x4 (&acc)[2][2][4][2], const Unit& u, int wr, int wc, int fr, int fq) const {
        F g = f;
        asm volatile("" : "+v"(fr), "+v"(fq));
#pragma unroll
        for (int ai = 0; ai < 2; ++ai)
#pragma unroll
            for (int m = 0; m < 4; ++m) { const int rt = ai * HALF + wr * 64 + m * 16 + fr;
#pragma unroll
                for (int bj = 0; bj < 2; ++bj) g.scale_chunk(u, rt, bj * HALF + wc * 32 + 8 * fq, acc[ai][bj][m][0], acc[ai][bj][m][1]);
                asm volatile("" ::: "memory"); __builtin_amdgcn_sched_barrier(0); }
    }
};
template <class Epi, class Sched, bool ALIGN_EPI = false, bool SP2 = false>
__device__ __forceinline__ void gemm_phase(PG8_LAS unsigned char* lds, const Gemm g, const Sched& S, const Epi& E) {
    const int tid = threadIdx.x, wid = __builtin_amdgcn_readfirstlane(tid >> 6), lane = tid & 63, wr = wid >> 2, wc = wid & 3, fr = lane & 15, fq = lane >> 4;
    const int K = g.K, nt = K / BK, LD = g.ld;
    unsigned voffA[2], voffB[2];
#pragma unroll
    for (int i = 0; i < 2; ++i) { int R, C; stage_rc(tid * 16 + i * 8192, R, C); const int Rb = Epi::PERM ? ((R & ~31) + perm32(R & 31)) : R;
        voffA[i] = (unsigned)(R * LD + C) * 2u; voffB[i] = (unsigned)(Rb * LD + C) * 2u; }
    const size_t kstep = (size_t)(BK * 2);
    const size_t hstep = (size_t)HALF * LD * 2;
    const size_t tstep = 2 * hstep;
    const unsigned ldsw = (unsigned)wid * 1024u;
    const int aoff = lds_byte(wr * 64 + fr, fq * 8), boff = lds_byte(wc * 32 + fr, fq * 8);
#define PG8_SA(b, h) (((b) * 2 + (h)) * HTB)
#define PG8_SB(b, h) ((4 + (b) * 2 + (h)) * HTB)
#define PG8_STAGE(bufoff, gbase, voff) do { _Pragma("unroll") for (int _i = 0; _i < 2; ++_i) \
        __builtin_amdgcn_global_load_lds((const unsigned*)((const char*)(gbase) + (voff)[_i]), (PG8_LAS unsigned*)(lds + (bufoff) + ldsw + _i * 8192), 16, 0, 0); } while (0)
#define PG8_LDA(dst, b, h) do { _Pragma("unroll") for (int m = 0; m < 4; ++m) _Pragma("unroll") for (int k = 0; k < 2; ++k) dst[m][k] = *(const PG8_LAS bf16x8*)(lds + PG8_SA(b, h) + aoff + m * 2048 + k * 1024); } while (0)
#define PG8_LDB(dst, b, h) do { _Pragma("unroll") for (int n = 0; n < 2; ++n) _Pragma("unroll") for (int k = 0; k < 2; ++k) dst[n][k] = *(const PG8_LAS bf16x8*)(lds + PG8_SB(b, h) + boff + n * 2048 + k * 1024); } while (0)
#define PG8_MMA(ai, bj, At, Bt) do { __builtin_amdgcn_s_setprio(1); _Pragma("unroll") for (int m = 0; m < 4; ++m) _Pragma("unroll") for (int n = 0; n < 2; ++n) _Pragma("unroll") for (int k = 0; k < 2; ++k) \
        acc[ai][bj][m][n] = __builtin_amdgcn_mfma_f32_16x16x32_bf16(Bt[n][k], At[m][k], acc[ai][bj][m][n], 0, 0, 0); __builtin_amdgcn_s_setprio(0); } while (0)
#define PG8_WAIT_V(n) asm volatile("s_waitcnt vmcnt(" #n ")" ::: "memory")
#define PG8_WAIT_L(n) asm volatile("s_waitcnt lgkmcnt(" #n ")" ::: "memory")
#define PG8_BAR __builtin_amdgcn_s_barrier()
#define PG8_SCHED __builtin_amdgcn_sched_barrier(0)
    Unit cur, nxt; int ui = 0;
    if (!S.next(0, cur)) return;
    f32x4 acc[2][2][4][2];
#pragma unroll
    for (int a = 0; a < 2; ++a)
#pragma unroll
        for (int b = 0; b < 2; ++b)
#pragma unroll
            for (int m = 0; m < 4; ++m)
#pragma unroll
                for (int n = 0; n < 2; ++n) acc[a][b][m][n] = (f32x4){0.f, 0.f, 0.f, 0.f};
    bf16x8 At[4][2], B0[2][2], B1[2][2];
    const char* cA = (const char*)g.A + (size_t)cur.pm * tstep + cur.ko; const char* cB = (const char*)g.Bt + (size_t)cur.pn * tstep + cur.kob;
    S.a_ready(cur);
    if constexpr (SP2) {
        PG8_STAGE(PG8_SB(0, 0), cB, voffB); PG8_STAGE(PG8_SB(0, 1), cB + hstep, voffB); PG8_STAGE(PG8_SA(0, 0), cA, voffA); PG8_STAGE(PG8_SA(0, 1), cA + hstep, voffA);
        if (wr == 1) PG8_BAR;
        PG8_WAIT_V(2); PG8_BAR;
        PG8_STAGE(PG8_SB(1, 0), cB + kstep, voffB); PG8_STAGE(PG8_SA(1, 0), cA + kstep, voffA); PG8_STAGE(PG8_SB(1, 1), cB + hstep + kstep, voffB);
        PG8_WAIT_V(6); PG8_BAR;
    } else {
        PG8_STAGE(PG8_SB(0, 0), cB, voffB); PG8_STAGE(PG8_SA(0, 0), cA, voffA); PG8_STAGE(PG8_SB(0, 1), cB + hstep, voffB); PG8_STAGE(PG8_SA(0, 1), cA + hstep, voffA);
        if (wr == 1) PG8_BAR;
        PG8_WAIT_V(4); PG8_BAR;
        PG8_STAGE(PG8_SB(1, 0), cB + kstep, voffB); PG8_STAGE(PG8_SA(1, 0), cA + kstep, voffA); PG8_STAGE(PG8_SB(1, 1), cB + hstep + kstep, voffB);
        PG8_WAIT_V(6); PG8_BAR;
    }
    for (;;) {
        const bool has_next = S.next(ui + 1, nxt);
        const char* nA = has_next ? (const char*)g.A + (size_t)nxt.pm * tstep + nxt.ko : cA; const char* nB = has_next ? (const char*)g.Bt + (size_t)nxt.pn * tstep + nxt.kob : cB;
        for (int t = 0; t < nt; t += 2) {
            const bool last = (t == nt - 2);
            const char* a1 = cA + (size_t)(t + 1) * kstep;
            const char* a2 = last ? nA : cA + (size_t)(t + 2) * kstep; const char* b2 = last ? nB : cB + (size_t)(t + 2) * kstep;
            const char* a3 = a2 + kstep; const char* b3 = b2 + kstep;
            if (last && has_next) S.a_ready(nxt);
            if constexpr (SP2) {
            PG8_LDB(B0, 0, 0); PG8_LDB(B1, 0, 1); PG8_SCHED; PG8_LDA(At, 0, 0); PG8_STAGE(PG8_SA(1, 1), a1 + hstep, voffA);
            PG8_WAIT_V(8); PG8_WAIT_L(0); PG8_BAR; PG8_MMA(0, 0, At, B0); PG8_MMA(0, 1, At, B1); PG8_BAR; PG8_SCHED;
            PG8_LDA(At, 0, 1); PG8_STAGE(PG8_SB(0, 0), b2, voffB); PG8_STAGE(PG8_SB(0, 1), b2 + hstep, voffB); PG8_STAGE(PG8_SA(0, 0), a2, voffA);
            PG8_WAIT_V(8); PG8_WAIT_L(0); PG8_BAR; PG8_MMA(1, 0, At, B0); PG8_MMA(1, 1, At, B1); PG8_BAR; PG8_SCHED;
            PG8_LDB(B0, 1, 0); PG8_LDB(B1, 1, 1); PG8_SCHED; PG8_LDA(At, 1, 0); PG8_STAGE(PG8_SA(0, 1), a2 + hstep, voffA);
            PG8_WAIT_V(8); PG8_WAIT_L(0); PG8_BAR; PG8_MMA(0, 0, At, B0); PG8_MMA(0, 1, At, B1); PG8_BAR; PG8_SCHED;
            PG8_LDA(At, 1, 1); PG8_STAGE(PG8_SB(1, 0), b3, voffB); PG8_STAGE(PG8_SB(1, 1), b3 + hstep, voffB); PG8_STAGE(PG8_SA(1, 0), a3, voffA);
            PG8_WAIT_V(8); PG8_WAIT_L(0); PG8_BAR; PG8_MMA(1, 0, At, B0); PG8_MMA(1, 1, At, B1); PG8_BAR; PG8_SCHED;
            } else {
            PG8_LDB(B0, 0, 0); PG8_SCHED; PG8_LDA(At, 0, 0); PG8_STAGE(PG8_SA(1, 1), a1 + hstep, voffA);
            PG8_WAIT_L(8); PG8_BAR; PG8_WAIT_L(0); PG8_MMA(0, 0, At, B0); PG8_BAR; PG8_SCHED;
            PG8_LDB(B1, 0, 1); PG8_STAGE(PG8_SB(0, 0), b2, voffB);
            PG8_BAR; PG8_WAIT_L(0); PG8_MMA(0, 1, At, B1); PG8_BAR;
            PG8_LDA(At, 0, 1); PG8_STAGE(PG8_SA(0, 0), a2, voffA);
            PG8_BAR; PG8_WAIT_L(0); PG8_MMA(1, 0, At, B0); PG8_BAR; PG8_SCHED;
            PG8_STAGE(PG8_SB(0, 1), b2 + hstep, voffB);
            PG8_WAIT_V(6); PG8_BAR; PG8_MMA(1, 1, At, B1); PG8_BAR;
            PG8_LDB(B0, 1, 0); PG8_SCHED; PG8_LDA(At, 1, 0); PG8_STAGE(PG8_SA(0, 1), a2 + hstep, voffA);
            PG8_WAIT_L(8); PG8_BAR; PG8_WAIT_L(0); PG8_MMA(0, 0, At, B0); PG8_BAR; PG8_SCHED;
            PG8_LDB(B1, 1, 1); PG8_STAGE(PG8_SB(1, 0), b3, voffB);
            PG8_BAR; PG8_WAIT_L(0); PG8_MMA(0, 1, At, B1); PG8_BAR;
            PG8_LDA(At, 1, 1); PG8_STAGE(PG8_SA(1, 0), a3, voffA);
            PG8_BAR; PG8_WAIT_L(0); PG8_MMA(1, 0, At, B0); PG8_BAR; PG8_SCHED;
            PG8_STAGE(PG8_SB(1, 1), b3 + hstep, voffB);
            PG8_WAIT_V(6); PG8_BAR; PG8_MMA(1, 1, At, B1); PG8_BAR;
            }
        }
        if constexpr (ALIGN_EPI) { if (wr == 0) PG8_BAR; }
        if constexpr (!Epi::AFTER_DRAIN) { if (cur.chain) E.scale(acc, cur, wr, wc, fr, fq); else E(acc, cur, wr, wc, fr, fq); S.done(cur); }
        if (!has_next) break;
        if (!cur.chain)
#pragma unroll
        for (int a = 0; a < 2; ++a)
#pragma unroll
            for (int b = 0; b < 2; ++b)
#pragma unroll
                for (int m = 0; m < 4; ++m)
#pragma unroll
                    for (int n = 0; n < 2; ++n) acc[a][b][m][n] = (f32x4){0.f, 0.f, 0.f, 0.f};
        cur = nxt; cA = nA; cB = nB; ++ui;
        if constexpr (ALIGN_EPI) { if (wr == 1) PG8_BAR; }
    }
    PG8_WAIT_V(0);
    if constexpr (!ALIGN_EPI) { if (wr == 0) PG8_BAR; }
    PG8_BAR;
    if constexpr (Epi::AFTER_DRAIN) { E.fused(acc, cur, wr, wc, fr, fq, lds, wid, lane); S.done(cur); }
#undef PG8_SA
#undef PG8_SB
#undef PG8_STAGE
#undef PG8_LDA
#undef PG8_LDB
#undef PG8_MMA
#undef PG8_WAIT_V
#undef PG8_WAIT_L
#undef PG8_BAR
#undef PG8_SCHED
}
}
#ifndef PG8_SP2
#define PG8_SP2 true
#endif
#ifndef PG8_ALIGN
#define PG8_ALIGN true
#endif
namespace att {
typedef unsigned short bf16;
typedef short bf16x8 __attribute__((ext_vector_type(8)));
typedef short s16x4 __attribute__((ext_vector_type(4)));
typedef float f32x16 __attribute__((ext_vector_type(16)));
typedef float f32x4 __attribute__((ext_vector_type(4)));
typedef unsigned u32x4 __attribute__((ext_vector_type(4)));
constexpr int NW = 8, QBLK = 32, KVBLK = 64, QB = NW * QBLK, D = 128, PITCH = 1024;
constexpr int SHM_V = KVBLK * D * 2, SHM_K = KVBLK * D * 2;
constexpr int NBUF = 3;
constexpr int OFF_V = 0, OFF_K = NBUF * SHM_V, OFF_WS = OFF_K + NBUF * SHM_K, OFF_B = OFF_WS + NW * 64 * 4, LDS_BYTES = OFF_B + NBUF * 256;
constexpr float THR = 8.f;
#define KSWZ(row, colB) ((row) * 256 + ((colB) ^ (((row) & 7) << 4)))
#define SBAR() __builtin_amdgcn_sched_barrier(0)
__device__ __forceinline__ int v_st(int k, int c) { const int kk = (k & ~0xC) | ((k & 4) << 1) | ((k & 8) >> 1); return ((kk >> 3) * 4 + (c >> 5)) * 512 + ((kk & 7) * 32 + (c & 31)) * 2; }
__device__ __forceinline__ int v_rd_base(int lane) { return ((lane & 3) << 3) | (((lane >> 2) & 3) << 6) | (((lane >> 4) & 1) << 5) | (((lane >> 5) & 1) << 8); }
constexpr int v_rd_off(int d0, int ks, int half) { return d0 * 512 + ks * 4096 + half * 2048; }
__device__ __forceinline__ int crow(int r, int hi) { return (r & 3) + 8 * (r >> 2) + 4 * hi; }
__device__ __forceinline__ unsigned cvtpk(float lo, float hi) {
    unsigned r; asm volatile("v_cvt_pk_bf16_f32 %0, %1, %2" : "=v"(r) : "v"(lo), "v"(hi)); return r;
}
__device__ __forceinline__ bf16x8 load8(const bf16* p) { return *reinterpret_cast<const bf16x8*>(p); }
__device__ __forceinline__ void mask_tile(f32x16& p0, f32x16& p1, int dq, unsigned W) {
    const float NEG = -__builtin_inff();
#pragma unroll
    for (int r = 0; r < 16; ++r) {
        const int c = (r & 3) + 8 * (r >> 2);
        if ((unsigned)(dq - c) >= W) p0[r] = NEG;
        if ((unsigned)(dq - c - 32) >= W) p1[r] = NEG;
    }
}
template <int DQK>
__device__ __forceinline__ void partialSM(f32x16& p0, f32x16& p1, float& m_reg, float& mn, float& alpha) {
    constexpr float SCALE = DQK == 64 ? 0.125f : 0.08838834764831845f;
    float pmax;
    { float m0 = fmaxf(p0[0], p0[4]), m1 = fmaxf(p0[1], p0[5]), m2 = fmaxf(p0[2], p0[6]), m3 = fmaxf(p0[3], p0[7]);
#pragma unroll
      for (int r = 8; r < 16; r += 4) { m0 = fmaxf(m0, p0[r]); m1 = fmaxf(m1, p0[r + 1]); m2 = fmaxf(m2, p0[r + 2]); m3 = fmaxf(m3, p0[r + 3]); }
#pragma unroll
      for (int r = 0; r < 16; r += 4) { m0 = fmaxf(m0, p1[r]); m1 = fmaxf(m1, p1[r + 1]); m2 = fmaxf(m2, p1[r + 2]); m3 = fmaxf(m3, p1[r + 3]); }
      pmax = fmaxf(fmaxf(m0, m1), fmaxf(m2, m3)); }
    { auto rr = __builtin_amdgcn_permlane32_swap(__float_as_uint(pmax), __float_as_uint(pmax), false, false);
      pmax = fmaxf(__uint_as_float(rr[0]), __uint_as_float(rr[1])); }
    constexpr float C2 = 1.4426950408889634f * SCALE;
    if (__builtin_expect(__all((pmax - m_reg) * SCALE <= THR), 1)) { mn = m_reg; alpha = 1.f; }
    else { mn = fmaxf(m_reg, pmax); alpha = __builtin_amdgcn_exp2f((m_reg - mn) * C2); m_reg = mn; }
    const float mnL = -mn * C2;
    for (int r = 0; r < 16; ++r) p0[r] = fmaf(p0[r], C2, mnL); for (int r = 0; r < 16; ++r) p1[r] = fmaf(p1[r], C2, mnL);
    for (int r = 0; r < 16; ++r) p0[r] = __builtin_amdgcn_exp2f(p0[r]);
}
__device__ __forceinline__ void finishSM(f32x16& p0, f32x16& p1, float alpha, float& l_reg, bf16x8& pa0, bf16x8& pa1, bf16x8& pa2, bf16x8& pa3) {
    for (int r = 0; r < 16; ++r) p1[r] = __builtin_amdgcn_exp2f(p1[r]);
    float ps;
    { float s0 = p0[0] + p1[0], s1 = p0[1] + p1[1], s2 = p0[2] + p1[2], s3 = p0[3] + p1[3];
#pragma unroll
      for (int r = 4; r < 16; r += 4) { s0 += p0[r]; s1 += p0[r + 1]; s2 += p0[r + 2]; s3 += p0[r + 3]; s0 += p1[r]; s1 += p1[r + 1]; s2 += p1[r + 2]; s3 += p1[r + 3]; }
      ps = (s0 + s1) + (s2 + s3); }
    { auto rr = __builtin_amdgcn_permlane32_swap(__float_as_uint(ps), __float_as_uint(ps), false, false);
      ps = __uint_as_float(rr[0]) + __uint_as_float(rr[1]); }
    l_reg = l_reg * alpha + ps;
#define PK4(P, B_, OUT) do { unsigned a0 = cvtpk(P[B_+0], P[B_+1]), a1 = cvtpk(P[B_+2], P[B_+3]);                          \
        unsigned b0 = cvtpk(P[B_+4], P[B_+5]), b1 = cvtpk(P[B_+6], P[B_+7]);                                             \
        auto r0 = __builtin_amdgcn_permlane32_swap(a0, b0, false, false); auto r1 = __builtin_amdgcn_permlane32_swap(a1, b1, false, false); \
        u32x4 w = {r0[0], r1[0], r0[1], r1[1]}; OUT = *reinterpret_cast<bf16x8*>(&w); } while (0)
    PK4(p0, 0, pa0); PK4(p0, 8, pa1); PK4(p1, 0, pa2); PK4(p1, 8, pa3);
#undef PK4
}
template <int KB, int DQK>
__device__ __forceinline__ void qkt(f32x16& p0, f32x16& p1, const unsigned (&kaddr)[4], const char* B_lds, int r32, int hi, const bf16x8* qr, bool use_bias) {
    const char* bb = B_lds + KB * 256 + hi * 16;
    if (!use_bias) { p0 = f32x16{}; p1 = f32x16{}; } else
#pragma unroll
    for (int g = 0; g < 4; ++g) { const f32x4 t0 = *reinterpret_cast<const f32x4*>(bb + 32 * g), t1 = *reinterpret_cast<const f32x4*>(bb + 32 * g + 128);
        p0[4 * g] = t0[0]; p0[4 * g + 1] = t0[1]; p0[4 * g + 2] = t0[2]; p0[4 * g + 3] = t0[3];
        p1[4 * g] = t1[0]; p1[4 * g + 1] = t1[1]; p1[4 * g + 2] = t1[2]; p1[4 * g + 3] = t1[3]; }
#define KRD(dst, dd, off) asm volatile("ds_read_b128 %0, %1 offset:%2" : "=v"(dst) : "v"(kaddr[dd]), "i"(off) : "memory")
#define KGRP(S, g) do { KRD(S[0], (2 * (g)) & 3, KB * SHM_K + ((g) >> 1) * 128); KRD(S[1], (2 * (g)) & 3, KB * SHM_K + ((g) >> 1) * 128 + 32 * 256);                 \
                        KRD(S[2], (2 * (g) + 1) & 3, KB * SHM_K + ((g) >> 1) * 128); KRD(S[3], (2 * (g) + 1) & 3, KB * SHM_K + ((g) >> 1) * 128 + 32 * 256); } while (0)
#define KWAIT(N, S) do { asm volatile("s_waitcnt lgkmcnt(" #N ")" : "+v"(S[0]), "+v"(S[1]), "+v"(S[2]), "+v"(S[3]) :: "memory"); SBAR(); } while (0)
#define KMM(S, g) do { p0 = __builtin_amdgcn_mfma_f32_32x32x16_bf16(S[0], qr[2 * (g)], p0, 0, 0, 0); p1 = __builtin_amdgcn_mfma_f32_32x32x16_bf16(S[1], qr[2 * (g)], p1, 0, 0, 0);             \
                       p0 = __builtin_amdgcn_mfma_f32_32x32x16_bf16(S[2], qr[2 * (g) + 1], p0, 0, 0, 0); p1 = __builtin_amdgcn_mfma_f32_32x32x16_bf16(S[3], qr[2 * (g) + 1], p1, 0, 0, 0); SBAR(); } while (0)
    bf16x8 ka[4], kb[4];
    KGRP(ka, 0); KGRP(kb, 1);
    if constexpr (DQK == 128) {
        bf16x8 kc[4];
        KGRP(kc, 2);
        KWAIT(8, ka); KMM(ka, 0); KGRP(ka, 3);
        KWAIT(8, kb); KMM(kb, 1);
        KWAIT(4, kc); KMM(kc, 2);
        KWAIT(0, ka); KMM(ka, 3);
    } else {
        KWAIT(4, ka); KMM(ka, 0);
        KWAIT(0, kb); KMM(kb, 1);
    }
#undef KGRP
#undef KWAIT
#undef KMM
#undef KRD
}
template <int VB>
__device__ __forceinline__ void pv_tile(f32x16* o, int vb0, bf16x8 pa0, bf16x8 pa1, bf16x8 pa2, bf16x8 pa3) {
#define TRRD(dst, off) asm volatile("ds_read_b64_tr_b16 %0, %1 offset:%2" : "=&v"(dst) : "v"(vb0), "i"(off) : "memory")
#define PV_RD(S, d0) do { constexpr int b_ = VB * SHM_V + v_rd_off(d0, 0, 0);     \
        TRRD(S[0], b_); TRRD(S[1], b_ + 2048); TRRD(S[2], b_ + 4096); TRRD(S[3], b_ + 6144); TRRD(S[4], b_ + 8192); TRRD(S[5], b_ + 10240); TRRD(S[6], b_ + 12288); TRRD(S[7], b_ + 14336); } while (0)
#define PV_MM(S, d0) do {                                                                                                                   \
        o[d0] = __builtin_amdgcn_mfma_f32_32x32x16_bf16(pa0, (bf16x8){S[0][0], S[0][1], S[0][2], S[0][3], S[1][0], S[1][1], S[1][2], S[1][3]}, o[d0], 0, 0, 0);   \
        o[d0] = __builtin_amdgcn_mfma_f32_32x32x16_bf16(pa1, (bf16x8){S[2][0], S[2][1], S[2][2], S[2][3], S[3][0], S[3][1], S[3][2], S[3][3]}, o[d0], 0, 0, 0);   \
        o[d0] = __builtin_amdgcn_mfma_f32_32x32x16_bf16(pa2, (bf16x8){S[4][0], S[4][1], S[4][2], S[4][3], S[5][0], S[5][1], S[5][2], S[5][3]}, o[d0], 0, 0, 0);   \
        o[d0] = __builtin_amdgcn_mfma_f32_32x32x16_bf16(pa3, (bf16x8){S[6][0], S[6][1], S[6][2], S[6][3], S[7][0], S[7][1], S[7][2], S[7][3]}, o[d0], 0, 0, 0); } while (0)
#define PV_WAIT(N) do { asm volatile("s_waitcnt lgkmcnt(" #N ")" ::: "memory"); SBAR(); } while (0)
    s16x4 A[8], B[8];
    PV_RD(A, 0); PV_RD(B, 1);
    PV_WAIT(8); PV_MM(A, 0); SBAR();
    PV_RD(A, 2);
    PV_WAIT(8); PV_MM(B, 1); SBAR();
    PV_RD(B, 3);
    PV_WAIT(8); PV_MM(A, 2); SBAR();
    PV_WAIT(0); PV_MM(B, 3);
#undef PV_RD
#undef PV_MM
#undef PV_WAIT
#undef TRRD
}
struct BlockRef { const bf16* Q; const bf16* K; const bf16* V; const float* KB; bf16* O; int P0; int dqk; const float* qg; const float* rope; };
#define ROW(p, k0, rr) ((p) + (size_t)((k0) + (rr)) * PITCH + sc)
#define VMW() asm volatile("s_waitcnt vmcnt(0)" ::: "memory")
#define SLOAD_H(k0_) do { const int k0 = (ABL == 1) ? 0 : (k0_); st_v0 = load8(ROW(cur.V, k0, sr)); st_v1 = load8(ROW(cur.V, k0, 32 + sr));              \
                         if (sc < DQK) { st_k0 = load8(ROW(cur.K, k0, sr)); st_k1 = load8(ROW(cur.K, k0, 32 + sr)); }    \
                         if (tid < 64) st_b = cur.KB[(k0) + tid]; } while (0)
#define SWRITE_H(bf) do { *(bf16x8*)(V_lds + (bf) * SHM_V + vst0) = st_v0; *(bf16x8*)(V_lds + (bf) * SHM_V + vst1) = st_v1; \
                         if (sc < DQK) { *(bf16x8*)(K_lds + (bf) * SHM_K + kws) = st_k0; *(bf16x8*)(K_lds + (bf) * SHM_K + kws + 32 * 256) = st_k1; } \
                         if (tid < 64) *(float*)(B_lds + (bf) * 256 + tid * 4) = st_b; } while (0)
template <int DQK, int ABL>
__device__ __forceinline__ void block(const BlockRef& cur, int skv, char* lds) {
    int tid = threadIdx.x; asm volatile("" : "+v"(tid));
    const int wid = __builtin_amdgcn_readfirstlane(tid >> 6), lane = tid & 63, r32 = lane & 31, hi = lane >> 5;
    constexpr unsigned W = 1u << 30;
    int j_hi = (cur.P0 + QB - 1) / KVBLK + 1; if (j_hi > skv / KVBLK) j_hi = skv / KVBLK;
    const int NT = j_hi;
    const int qlo = cur.P0 + wid * QBLK, qm = qlo + r32 - 4 * hi;
    char* V_lds = lds + OFF_V; char* K_lds = lds + OFF_K; char* B_lds = lds + OFF_B;
    float* ws = (float*)(lds + OFF_WS) + wid * 64; float* li_l = ws, * al_l = ws + 32;
    float m_reg = -1e30f, l_reg = 0; f32x16 o[4] = {};
    const int sr = tid >> 4, sc = (tid & 15) * 8, vst0 = v_st(sr, sc), vst1 = v_st(32 + sr, sc), kws = KSWZ(sr, sc * 2);
    const int vb0 = (int)(uintptr_t)V_lds + v_rd_base(lane);
    unsigned kaddr[4];
#pragma unroll
    for (int dd = 0; dd < 4; ++dd) kaddr[dd] = (unsigned)(uintptr_t)K_lds + KSWZ(r32, (dd * 16 + hi * 8) * 2);
    bf16x8 qr[DQK / 16];
    {
        float qf[DQK / 16][8]; float ss = 0.f;
#pragma unroll
        for (int d0 = 0; d0 < DQK / 16; ++d0) { const u32x4 w = __builtin_bit_cast(u32x4, load8(cur.Q + (size_t)(wid * QBLK + r32) * PITCH + d0 * 16 + hi * 8));
#pragma unroll
            for (int i = 0; i < 4; ++i) { qf[d0][2 * i] = __uint_as_float(w[i] << 16); qf[d0][2 * i + 1] = __uint_as_float(w[i] & 0xffff0000u); }
#pragma unroll
            for (int i = 0; i < 8; ++i) ss += qf[d0][i] * qf[d0][i]; }
        { auto rr = __builtin_amdgcn_permlane32_swap(__float_as_uint(ss), __float_as_uint(ss), false, false); ss = __uint_as_float(rr[0]) + __uint_as_float(rr[1]); }
        const float rn = 1.f / sqrtf(ss * (1.f / DQK) + 1e-6f);
#pragma unroll
        for (int d0 = 0; d0 < DQK / 16; ++d0) { const f32x4 g0 = *(const f32x4*)(cur.qg + d0 * 16 + hi * 8), g1 = *(const f32x4*)(cur.qg + d0 * 16 + hi * 8 + 4);
#pragma unroll
            for (int i = 0; i < 4; ++i) { qf[d0][i] *= rn * g0[i]; qf[d0][4 + i] *= rn * g1[i]; } }
        if (DQK == 64) { const float* tb = cur.rope + (size_t)(cur.P0 - 48 + wid * QBLK + r32) * 16;
#pragma unroll
            for (int i = 0; i < 8; ++i) { const float mine = qf[0][i]; auto rr = __builtin_amdgcn_permlane32_swap(__float_as_uint(mine), __float_as_uint(mine), false, false);
                const float other = __uint_as_float(hi ? rr[0] : rr[1]); const float c = tb[2 * i], sn = tb[2 * i + 1];
                qf[0][i] = hi ? (mine * c + other * sn) : (mine * c - other * sn); } }
#pragma unroll
        for (int d0 = 0; d0 < DQK / 16; ++d0) { u32x4 w = {cvtpk(qf[d0][0], qf[d0][1]), cvtpk(qf[d0][2], qf[d0][3]), cvtpk(qf[d0][4], qf[d0][5]), cvtpk(qf[d0][6], qf[d0][7])}; qr[d0] = __builtin_bit_cast(bf16x8, w); }
    }
    bf16x8 st_v0, st_v1, st_k0, st_k1; float st_b;
    SLOAD_H(0); VMW(); SWRITE_H(0);
    if (NT > 1) { SLOAD_H(KVBLK); VMW(); SWRITE_H(1); }
    __syncthreads();
    if (wid >= 4) __builtin_amdgcn_s_barrier();
#define RESC(a) do { if (__any((a) < 1.f)) { if (hi == 0) al_l[r32] = (a); asm volatile("s_waitcnt lgkmcnt(0)" ::: "memory");              \
                     for (int d_ = 0; d_ < 4; ++d_) for (int r = 0; r < 16; ++r) o[d_][r] *= al_l[crow(r, hi)]; } } while (0)
#define BAR() do { asm volatile("s_waitcnt lgkmcnt(0)" ::: "memory"); __builtin_amdgcn_s_barrier(); asm volatile("" ::: "memory"); } while (0)
#define KEEP4(a, b, c, d) asm volatile("" :: "v"(a), "v"(b), "v"(c), "v"(d))
#define TILE(t, BUF) do { f32x16 p0, p1; float mn, al; bf16x8 pa0, pa1, pa2, pa3;                                             \
        if (ABL != 6 && ABL < 7) { if ((t) + 2 < NT) { SLOAD_H(((t) + 2) * KVBLK); } }                                          \
        SBAR();                                                                                                               \
        if (ABL == 4 || ABL == 9 || ABL >= 10) { p0 = f32x16{}; p1 = f32x16{}; asm volatile("" : "+v"(p0), "+v"(p1)); }                                 \
        else qkt<BUF, DQK>(p0, p1, kaddr, B_lds, r32, hi, qr, DQK == 128 || (t) == 0);     \
        { const int kb_ = (t) * KVBLK; if (kb_ + KVBLK - 1 > qlo) mask_tile(p0, p1, qm - kb_, W); }                            \
        if (ABL != 5 && ABL < 7) BAR();                                                                                        \
        if (ABL == 2 || ABL >= 7) { al = 1.f; l_reg += p0[0];                                                                  \
            { u32x4 w0 = {cvtpk(p0[0], p0[1]), cvtpk(p0[2], p0[3]), cvtpk(p0[4], p0[5]), cvtpk(p0[6], p0[7])}; pa0 = *reinterpret_cast<bf16x8*>(&w0);    \
              u32x4 w1 = {cvtpk(p0[8], p0[9]), cvtpk(p0[10], p0[11]), cvtpk(p0[12], p0[13]), cvtpk(p0[14], p0[15])}; pa1 = *reinterpret_cast<bf16x8*>(&w1); \
              u32x4 w2 = {cvtpk(p1[0], p1[1]), cvtpk(p1[2], p1[3]), cvtpk(p1[4], p1[5]), cvtpk(p1[6], p1[7])}; pa2 = *reinterpret_cast<bf16x8*>(&w2);    \
              u32x4 w3 = {cvtpk(p1[8], p1[9]), cvtpk(p1[10], p1[11]), cvtpk(p1[12], p1[13]), cvtpk(p1[14], p1[15])}; pa3 = *reinterpret_cast<bf16x8*>(&w3); } } \
        else { partialSM<DQK>(p0, p1, m_reg, mn, al); RESC(al);                                                               \
               finishSM(p0, p1, al, l_reg, pa0, pa1, pa2, pa3); }                                                              \
        SBAR();                                                                                                               \
        if (ABL == 3 || ABL == 8 || ABL >= 10) { KEEP4(pa0, pa1, pa2, pa3); } else pv_tile<BUF>(o, vb0, pa0, pa1, pa2, pa3);                              \
        if (ABL != 6 && ABL < 7) { if ((t) + 2 < NT) { VMW(); SWRITE_H(((BUF) + 2) % 3); } }                                   \
        if (ABL != 5 && ABL < 7) BAR(); } while (0)
    for (int t = 0; t < (ABL == 11 ? 0 : NT); t += 3) {
        TILE(t, 0);
        if (t + 1 < NT) TILE(t + 1, 1);
        if (t + 2 < NT) TILE(t + 2, 2);
    }
    if (wid < 4) __builtin_amdgcn_s_barrier();
    if (hi == 0) li_l[r32] = l_reg; asm volatile("s_waitcnt lgkmcnt(0)" ::: "memory");
    float rli[16];
#pragma unroll
    for (int r = 0; r < 16; ++r) rli[r] = __builtin_amdgcn_rcpf(li_l[crow(r, hi)]);
    bf16* Ow = cur.O + (size_t)(wid * QBLK) * PITCH;
    {
        unsigned short* stg = (unsigned short*)(lds + OFF_V + wid * 8192);
#pragma unroll
        for (int r = 0; r < 16; ++r) { const int orow = crow(r, hi);
#pragma unroll
            for (int d0 = 0; d0 < 4; ++d0) stg[orow * 128 + d0 * 32 + r32] = (unsigned short)cvtpk(o[d0][r] * rli[r], 0.f); }
        asm volatile("s_waitcnt lgkmcnt(0)" ::: "memory");
#pragma unroll
        for (int i = 0; i < 8; ++i) { const int row = i * 4 + (lane >> 4), ch = lane & 15;
            const u32x4 v = *(const u32x4*)(stg + row * 128 + ch * 8); *(u32x4*)(Ow + (size_t)row * PITCH + ch * 8) = v;
            if (i & 1) asm volatile("" ::: "memory"); } }
    __syncthreads();
#undef RESC
#undef BAR
#undef TILE
}
#undef ROW
#undef VMW
#undef SLOAD_H
#undef SWRITE_H
#undef KSWZ
#undef SBAR
}
constexpr int NWAVES = 8;
#ifndef MK_N_LAUNCHES
#define MK_N_LAUNCHES 1
#endif
constexpr int N_PHASES = 11;
constexpr int N_LAUNCHES = MK_N_LAUNCHES;
static_assert(N_LAUNCHES == 1 || N_LAUNCHES == N_PHASES, "MK_N_LAUNCHES is 1 or 11");

constexpr int BATCH = 2, SEQ = 4096, DM = 2048, NMETA = 16, MREAL = BATCH * SEQ;
constexpr int LSEQ = NMETA + SEQ;
constexpr int LP = 4160, PADF = 48;
constexpr int M1 = 8192;
constexpr int N1 = 10240;
constexpr int WIN_LD = 10248;
constexpr int NEXP = 16384, PEER_H = 8, PEER_K = 16, EROW = 1536;
constexpr float EPS = 1e-6f;

constexpr size_t MiB = 1u << 20;
constexpr size_t WS_CTL = 0, CTL_ZERO_BYTES = 32768;
constexpr size_t WS_WIN = 2 * MiB, WS_WBD = 42 * MiB, WS_WBF = 46 * MiB, WS_WOUT = 50 * MiB, WS_WPQ = 58 * MiB;
constexpr size_t WS_EU = 62 * MiB, WS_EV = 94 * MiB;
constexpr size_t WS_SU = 126 * MiB, WS_SV = 126 * MiB + 65536;
constexpr size_t WS_XN = 190 * MiB;
constexpr size_t WS_H2N = 190 * MiB;
constexpr size_t WS_DQ = 223 * MiB, WS_DK = 239 * MiB, WS_DV = 256 * MiB, WS_FQ = 273 * MiB, WS_FK = 289 * MiB, WS_FV = 306 * MiB;
constexpr size_t WS_GA = 323 * MiB, WS_GB = 355 * MiB;
constexpr size_t WS_O1 = 387 * MiB, WS_O2 = 403 * MiB, WS_OF = 419 * MiB;
constexpr size_t WS_OD = 435 * MiB;
constexpr size_t WS_T = 223 * MiB;
constexpr size_t WS_MG = 289 * MiB;
constexpr size_t WS_QP = 323 * MiB;
constexpr size_t WS_RS = 396 * MiB;
constexpr size_t WS_PART = WS_QP;
constexpr size_t WS_IDX = 387 * MiB, WS_GATE = 391 * MiB;
constexpr size_t WS_SSQ = 395 * MiB;
constexpr size_t WS_LOGF = 451 * MiB;
constexpr size_t WS_KBIAS = 452 * MiB;
constexpr size_t WS_SKH = 451 * MiB + 512 * 1024, WS_SKL = 452 * MiB + 512 * 1024;
constexpr size_t WS_ROPE = 453 * MiB;
constexpr size_t WS_END = 454 * MiB;
static_assert(WS_T + (size_t)MREAL * DM * 4 <= WS_FK && WS_MG + (size_t)MREAL * DM * 2 <= WS_GA && WS_XN + (size_t)M1 * DM * 2 <= WS_DQ, "d_ws map");
static_assert(WS_DK + (size_t)BATCH * LP * 1024 * 2 <= WS_DV && WS_FV + (size_t)BATCH * LP * 1024 * 2 <= WS_GA, "d_ws map");

constexpr int CW_TMO = 0, CW_CODE = 1;
constexpr int CW_BAR = 4096;
constexpr int RING_OFF = 0, RING_BYTES = 131072;
constexpr int LDSCTL_OFF = 143360, MISC_OFF = LDSCTL_OFF + 320;
constexpr int LDS_BYTES = 147456;
#define GAS __attribute__((address_space(1)))
#define LAS __attribute__((address_space(3)))
typedef unsigned short bf16;
typedef unsigned v4u __attribute__((ext_vector_type(4)));
typedef float f32x4 __attribute__((ext_vector_type(4)));
typedef short bf16x8 __attribute__((ext_vector_type(8)));
typedef GAS unsigned gu32;
typedef GAS unsigned long long gu64;
#define RLX_AGENT __ATOMIC_RELAXED, __HIP_MEMORY_SCOPE_AGENT
#define LDS_WAIT() asm volatile("s_waitcnt lgkmcnt(0)" ::: "memory")
#define VM_WAIT() asm volatile("s_waitcnt vmcnt(0)" ::: "memory")
__device__ __forceinline__ unsigned long long rt() { return __builtin_amdgcn_s_memrealtime(); }
__device__ __forceinline__ unsigned f2bf(float f) { unsigned u = __builtin_bit_cast(unsigned, f); return (u + 0x7fffu + ((u >> 16) & 1u)) >> 16; }
__device__ __forceinline__ unsigned pk2(float lo, float hi) { return f2bf(lo) | (f2bf(hi) << 16); }
#define XB_TMO      128
#define XB_XCNT(j)  (256  + 64 * (j))
#define XB_XSUB(j)  (1280 + 64 * (j))
#define XB_XGEN(j)  (2304 + 64 * (j))
#define XB_TOP      3328
#define XB_TOPGEN   3392
#define XCD_BAR_WORDS 3456
#define XB_SPIN_CAP (1u << 18)

__device__ __forceinline__ unsigned xb_ld(unsigned* p)              { return __hip_atomic_load(p, __ATOMIC_RELAXED, __HIP_MEMORY_SCOPE_AGENT); }
__device__ __forceinline__ unsigned xb_add(unsigned* p, unsigned v) { return __hip_atomic_fetch_add(p, v, __ATOMIC_RELAXED, __HIP_MEMORY_SCOPE_AGENT); }
__device__ __forceinline__ unsigned xb_xcc_id() { return (unsigned)__builtin_amdgcn_s_getreg((3 << 11) | 20) & 0xFu; }
#define XB_SPIN(cond, bar) do { unsigned _sp = 0; while (cond) { __builtin_amdgcn_s_sleep(1); \
    if ((++_sp & 255u) == 0u) { if (xb_ld(&(bar)[XB_TMO])) break; if (_sp > XB_SPIN_CAP) { atomicAdd(&(bar)[XB_TMO], 1u); break; } } } } while (0)

struct XcdBarrier {
    unsigned* bar; unsigned x;
    volatile LAS unsigned* st;
};

__device__ __forceinline__ XcdBarrier xcd_barrier_post(unsigned* bar, volatile LAS unsigned* st) {
    XcdBarrier b; b.bar = bar; b.x = xb_xcc_id(); b.st = st;
    if (threadIdx.x == 0) (void)xb_add(&bar[XB_XCNT(b.x)], 1u);
    return b;
}
__device__ __forceinline__ void xcd_barrier_complete(unsigned* bar, unsigned x, unsigned& nloc, unsigned& nx) {
    const unsigned G = gridDim.x * gridDim.y * gridDim.z;
    unsigned sum, cnt, mine, sp = 0u;
    for (;;) {
        sum = 0u; cnt = 0u; mine = 0u;
#pragma unroll
        for (unsigned j = 0; j < 16; ++j) { const unsigned c = xb_ld(&bar[XB_XCNT(j)]); sum += c; cnt += (c > 0u) ? 1u : 0u; mine = (j == x) ? c : mine; }
        if (sum == G) break;
        __builtin_amdgcn_s_sleep(1);
        if ((++sp & 255u) == 0u) { if (xb_ld(&bar[XB_TMO])) break; if (sp > XB_SPIN_CAP) { atomicAdd(&bar[XB_TMO], 1u); break; } }
    }
    nloc = mine > 0u ? mine : 1u; nx = cnt > 0u ? cnt : 1u;
}

__device__ __forceinline__ void xcd_barrier(const XcdBarrier& b) {
    asm volatile("s_waitcnt vmcnt(0)" ::: "memory");
    __syncthreads();
    if (threadIdx.x == 0) {
        unsigned* bar = b.bar;
        __builtin_amdgcn_s_waitcnt(0);
        unsigned nloc = b.st[0], nx = b.st[1];
        if (nloc == 0u) { xcd_barrier_complete(bar, b.x, nloc, nx); b.st[0] = nloc; b.st[1] = nx; }
        const unsigned old = xb_add(&bar[XB_XSUB(b.x)], 1u);
        const unsigned gen = old / nloc;
        if (old + 1u == (gen + 1u) * nloc) {
            __builtin_amdgcn_fence(__ATOMIC_RELEASE, "agent");
            asm volatile("s_waitcnt vmcnt(0)" ::: "memory");
            const unsigned og = xb_add(&bar[XB_TOP], 1u);
            const unsigned tg = og / nx;
            if (og + 1u == (tg + 1u) * nx) xb_add(&bar[XB_TOPGEN], 1u);
            else XB_SPIN(xb_ld(&bar[XB_TOPGEN]) == tg, bar);
            __builtin_amdgcn_fence(__ATOMIC_ACQUIRE, "agent");
            xb_add(&bar[XB_XGEN(b.x)], 1u);
            asm volatile("s_waitcnt vmcnt(0)" ::: "memory");
        } else {
            XB_SPIN(xb_ld(&bar[XB_XGEN(b.x)]) == gen, bar);
            __builtin_amdgcn_fence(__ATOMIC_ACQUIRE, "agent");
            asm volatile("s_waitcnt vmcnt(0)" ::: "memory");
        }
    }
    __syncthreads();
}
__device__ __forceinline__ float wave_sum(float v) {
#pragma unroll
    for (int o = 1; o < 64; o <<= 1) v += __shfl_xor(v, o);
    return v;
}
struct Frame {
    LAS unsigned char* lds;
    volatile LAS unsigned* MISC;
    gu32* ctl;
    int tid, lane, wave;
    int vcu, G;
    int gw, NGW;
    const float* in[23];
    float* out;
    unsigned char* ws;
};
enum { I_X = 0, I_META, I_GMIX, I_WIN, I_BFORGET, I_BGATE, I_DQG, I_DKG, I_FQG, I_FKG, I_LQ1, I_LK1, I_LQ2, I_LK2, I_SUBLN, I_WBD, I_WBF, I_WOUT, I_GPEER, I_WPQ, I_SUBK, I_EU, I_EV };

__device__ __forceinline__ float bf2f(unsigned short b) { return __uint_as_float((unsigned)b << 16); }
__device__ __forceinline__ float bflo(unsigned w) { return __uint_as_float(w << 16); }
__device__ __forceinline__ float bfhi(unsigned w) { return __uint_as_float(w & 0xffff0000u); }
__device__ __forceinline__ float sigmoidf_(float x) { return 1.f / (1.f + __expf(-x)); }

__device__ __forceinline__ void p0_transpose_item2(const float* W, int ldw, int ncols, int K, bf16* WT, int row_off, LAS float* scr, int item, int lane) {
    const int nblk = ncols / 32, kb = item / nblk, nb = item % nblk, k0 = 64 * kb, n0 = 32 * nb;
#pragma unroll 8
    for (int i = 0; i < 32; ++i) { const int kk = 2 * i + (lane >> 5); scr[kk * 33 + (lane & 31)] = __builtin_nontemporal_load(W + (size_t)(k0 + kk) * ldw + n0 + (lane & 31)); }
    LDS_WAIT(); asm volatile("" ::: "memory");
    const int c = lane & 7;
#pragma unroll
    for (int j = 0; j < 4; ++j) { const int n = (lane >> 3) + 8 * j; const LAS float* s = scr + (8 * c) * 33 + n;
        v4u o; o.x = pk2(s[0 * 33], s[1 * 33]); o.y = pk2(s[2 * 33], s[3 * 33]); o.z = pk2(s[4 * 33], s[5 * 33]); o.w = pk2(s[6 * 33], s[7 * 33]);
        *(GAS v4u*)(WT + (size_t)(row_off + n0 + n) * K + k0 + 8 * c) = o; }
    LDS_WAIT(); asm volatile("" ::: "memory");
}

__device__ __forceinline__ void p0_prologue(Frame& F) {
    unsigned char* ws = F.ws;
    for (int rpa_ = 0; rpa_ < (((PH_REP_MASK) >> 12) & 1 ? 2 : 1); ++rpa_)
    {   LAS float* WF = (LAS float*)(F.lds + RING_OFF);
        const float* win = F.in[I_WIN];
        for (int i = F.tid; i < DM * 2; i += NWAVES * 64) { const int k = i >> 1, hh = (i & 1) * 4;
            const f32x4 v = *(const f32x4*)(win + (size_t)k * WIN_LD + 6144 + hh);
            WF[(hh + 0) * DM + k] = v.x; WF[(hh + 1) * DM + k] = v.y; WF[(hh + 2) * DM + k] = v.z; WF[(hh + 3) * DM + k] = v.w; }
        __syncthreads();
        bf16* XN = (bf16*)(ws + WS_XN); float* LOGF = (float*)(ws + WS_LOGF);
        const float* gmix = F.in[I_GMIX]; const float* bfg = F.in[I_BFORGET];
        constexpr int NROW = MREAL + NMETA;
#define P0A_SRC(m_) ((const GAS f32x4*)((m_) < MREAL ? F.in[I_X] + (size_t)(m_) * DM : F.in[I_META] + (size_t)((m_) - MREAL) * DM) + F.lane)
#define P0A_LOAD(V, m_) do { const GAS f32x4* xr_ = P0A_SRC(m_); _Pragma("unroll") for (int j = 0; j < 8; ++j) V[j] = __builtin_nontemporal_load(xr_ + 64 * j); } while (0)
#define P0A_ROW(V, m_) do { const int mrow = (m_);                                                                                        \
            GAS unsigned long long* o8 = (GAS unsigned long long*)(XN + (size_t)mrow * DM) + F.lane; float s2 = 0.f;                       \
            _Pragma("unroll") for (int j = 0; j < 8; ++j) s2 += (V[j].x * V[j].x + V[j].y * V[j].y) + (V[j].z * V[j].z + V[j].w * V[j].w);  \
            const float rstd = 1.f / sqrtf(wave_sum(s2) * (1.f / DM) + EPS);                                                           \
            float fl[8];                                                                                                               \
            _Pragma("unroll") for (int h = 0; h < 8; ++h) fl[h] = 0.f;                                                                 \
            _Pragma("unroll") for (int j = 0; j < 8; ++j) { const f32x4 g = *((const GAS f32x4*)gmix + 64 * j + F.lane);               \
                const f32x4 y = {V[j].x * rstd * g.x, V[j].y * rstd * g.y, V[j].z * rstd * g.z, V[j].w * rstd * g.w};                  \
                o8[64 * j] = (unsigned long long)pk2(y.x, y.y) | ((unsigned long long)pk2(y.z, y.w) << 32);                            \
                _Pragma("unroll") for (int h = 0; h < 8; ++h) { const f32x4 w = *(const LAS f32x4*)(WF + h * DM + 256 * j + 4 * F.lane); \
                    fl[h] += (y.x * w.x + y.y * w.y) + (y.z * w.z + y.w * w.w); }                                                      \
                asm volatile("" ::: "memory"); __builtin_amdgcn_sched_barrier(0); }     \
              \
            float a4[4]; { const bool up = (F.lane & 32) != 0;                                                                          \
              _Pragma("unroll") for (int i = 0; i < 4; ++i) { const float snd = up ? fl[i] : fl[i + 4]; const float kp = up ? fl[i + 4] : fl[i]; a4[i] = kp + __shfl_xor(snd, 32); } }   \
            float a2[2]; { const bool up = (F.lane & 16) != 0;                                                                          \
              _Pragma("unroll") for (int i = 0; i < 2; ++i) { const float snd = up ? a4[i] : a4[i + 2]; const float kp = up ? a4[i + 2] : a4[i]; a2[i] = kp + __shfl_xor(snd, 16); } }   \
            float a1; { const bool up = (F.lane & 8) != 0; const float snd = up ? a2[0] : a2[1]; const float kp = up ? a2[1] : a2[0]; a1 = kp + __shfl_xor(snd, 8); }                     \
            a1 += __shfl_xor(a1, 4); a1 += __shfl_xor(a1, 2); a1 += __shfl_xor(a1, 1);                                                 \
                                                       \
            if ((F.lane & 7) == 0) { const int h = ((F.lane >> 5) & 1) * 4 + ((F.lane >> 4) & 1) * 2 + ((F.lane >> 3) & 1);             \
                const float z = a1 + bfg[h];                                                                                           \
                const float lf = fminf(z, 0.f) - log1pf(__expf(-fabsf(z)));                                             \
                if (mrow < MREAL) { const int b = mrow >> 12, s = mrow & 4095; LOGF[((size_t)b * 8 + h) * LSEQ + NMETA + s] = lf; }            \
                else { const int t = mrow - MREAL; LOGF[((size_t)0 * 8 + h) * LSEQ + t] = lf; LOGF[((size_t)1 * 8 + h) * LSEQ + t] = lf; } } } while (0)
        f32x4 va[8], vb[8];
        int m = F.gw;
        if (m < NROW) P0A_LOAD(va, m);
#pragma unroll 1
        for (; m < NROW; m += 2 * F.NGW) {
            const int m1 = m + F.NGW, m2 = m + 2 * F.NGW;
            if (m1 < NROW) P0A_LOAD(vb, m1);
            P0A_ROW(va, m);
            if (m1 < NROW) { if (m2 < NROW) P0A_LOAD(va, m2); P0A_ROW(vb, m1); }
        }
#undef P0A_SRC
#undef P0A_LOAD
#undef P0A_ROW
        __syncthreads();
    }
    {   LAS unsigned short* XM = (LAS unsigned short*)(F.lds + RING_OFF);
        LAS float* PART = (LAS float*)(F.lds + RING_OFF + 66048);
        const float* gmix = F.in[I_GMIX]; const float* win = F.in[I_WIN];
        for (int rr = 0; rr < 2; ++rr) { const int r = 2 * F.wave + rr;
            const GAS f32x4* xr = (const GAS f32x4*)(F.in[I_META] + (size_t)r * DM) + F.lane;
            f32x4 v[8]; float s2 = 0.f;
#pragma unroll
            for (int j = 0; j < 8; ++j) { v[j] = xr[64 * j]; s2 += (v[j].x * v[j].x + v[j].y * v[j].y) + (v[j].z * v[j].z + v[j].w * v[j].w); }
            const float rstd = 1.f / sqrtf(wave_sum(s2) * (1.f / DM) + EPS);
#pragma unroll
            for (int j = 0; j < 8; ++j) { const f32x4 g = *((const GAS f32x4*)gmix + 64 * j + F.lane);
                *(LAS unsigned long long*)(XM + r * 2056 + 256 * j + 4 * F.lane) = (unsigned long long)pk2(v[j].x * rstd * g.x, v[j].y * rstd * g.y) | ((unsigned long long)pk2(v[j].z * rstd * g.z, v[j].w * rstd * g.w) << 32); } }
        __syncthreads();
        const int c = F.lane & 15, kk = F.lane >> 4;
        for (int task = F.vcu; task < 256; task += F.G) {
            const int n = task * 16 + c;
            const int wcol = n < 2048 ? 1024 + n : n + 2048;
            float acc[16];
#pragma unroll
            for (int r = 0; r < 16; ++r) acc[r] = 0.f;
            const LAS unsigned short* xp = XM + 256 * F.wave + kk; const float* wp = win + (size_t)(256 * F.wave + kk) * WIN_LD + wcol;
#pragma unroll 1
            for (int i0 = 0; i0 < 64; i0 += 16) {
                float wv[16];
#pragma unroll
                for (int i = 0; i < 16; ++i) wv[i] = wp[(size_t)(4 * (i0 + i)) * WIN_LD];
                const LAS unsigned short* xq = xp + 4 * i0;
#pragma unroll
                for (int i = 0; i < 16; ++i)
#pragma unroll
                    for (int r = 0; r < 16; ++r) acc[r] += bf2f(xq[r * 2056 + 4 * i]) * wv[i];
            }
#pragma unroll
            for (int r = 0; r < 16; ++r) { float s = acc[r]; s += __shfl_xor(s, 16); s += __shfl_xor(s, 32); if (kk == 0) PART[(F.wave * 16 + r) * 16 + c] = s; }
            __syncthreads();
            if (F.tid < 256) { const int r = F.tid >> 4, cc = F.tid & 15; float s = 0.f;
#pragma unroll
                for (int w = 0; w < 8; ++w) s += PART[(w * 16 + r) * 16 + cc];
                const int nn = task * 16 + cc; const int seg = nn >> 10, col = nn & 1023;
                bf16* base = (bf16*)(ws + (seg == 0 ? WS_DK : seg == 1 ? WS_DV : seg == 2 ? WS_FK : WS_FV));
                const bf16 hv = (bf16)f2bf(s);
                base[(size_t)(PADF + r) * 1024 + col] = hv; base[(size_t)(LP + PADF + r) * 1024 + col] = hv; }
            __syncthreads();
        }
    }
    for (int rpb_ = 0; rpb_ < (((PH_REP_MASK) >> 13) & 1 ? 2 : 1); ++rpb_)
    {   LAS float* scr = (LAS float*)(F.lds + RING_OFF + F.wave * 16384);
        const float* win = F.in[I_WIN];
        constexpr int I_A = (DM / 64) * (6144 / 32), I_G = (DM / 64) * (2048 / 32), I_BD = (1024 / 64) * (DM / 32), I_O = (DM / 64) * (DM / 32), I_P = (DM / 64) * (1024 / 32);
        constexpr int NITEMS = I_A + 2 * I_G + 2 * I_BD + I_O + I_P;
        bf16* WIN = (bf16*)(ws + WS_WIN);
        for (int it = F.gw; it < NITEMS; it += F.NGW) {
            int r = it;
            if (r < I_A) {
                const int nblk = 6144 / 32, kb = r / nblk, nb = r % nblk; const int seg = nb >> 5; int sb = nb;
                if (seg == 1 || seg == 4) { const int pb = nb & 7; sb = (nb & ~7) + 2 * (pb & 3) + (pb >> 2); }
                p0_transpose_item2(win + 32 * sb, WIN_LD, 32, DM, WIN, 32 * nb, scr, kb, F.lane); continue; } r -= I_A;
            if (r < I_G) { p0_transpose_item2(win + 6152, WIN_LD, 2048, DM, WIN, 6144, scr, r, F.lane); continue; } r -= I_G;
            if (r < I_G) { p0_transpose_item2(win + 8200, WIN_LD, 2048, DM, WIN, 8192, scr, r, F.lane); continue; } r -= I_G;
            if (r < I_BD) { p0_transpose_item2(F.in[I_WBD], DM, DM, 1024, (bf16*)(ws + WS_WBD), 0, scr, r, F.lane); continue; } r -= I_BD;
            if (r < I_BD) { p0_transpose_item2(F.in[I_WBF], DM, DM, 1024, (bf16*)(ws + WS_WBF), 0, scr, r, F.lane); continue; } r -= I_BD;
            if (r < I_O) { p0_transpose_item2(F.in[I_WOUT], DM, DM, DM, (bf16*)(ws + WS_WOUT), 0, scr, r, F.lane); continue; } r -= I_O;
            p0_transpose_item2(F.in[I_WPQ], 1024, 1024, DM, (bf16*)(ws + WS_WPQ), 0, scr, r, F.lane);
        }
    }
    for (int rpc_ = 0; rpc_ < (((PH_REP_MASK) >> 14) & 1 ? 2 : 1); ++rpc_)
    {   typedef float f32x16 __attribute__((ext_vector_type(16))); typedef unsigned u32x6 __attribute__((ext_vector_type(6)));
        for (int r = F.gw; r < 2 * NEXP; r += F.NGW) {
            const int tsel = r >= NEXP, e = r - tsel * NEXP;
            const GAS f32x4* src = (const GAS f32x4*)(F.in[tsel ? I_EV : I_EU] + (size_t)e * DM);
            f32x4 v[8]; float amax = 0.f;
#pragma unroll
            for (int j = 0; j < 8; ++j) { v[j] = __builtin_nontemporal_load(src + 64 * j + F.lane);
                amax = fmaxf(amax, fmaxf(fmaxf(fabsf(v[j].x), fabsf(v[j].y)), fmaxf(fabsf(v[j].z), fabsf(v[j].w)))); }
#pragma unroll
            for (int o = 1; o < 64; o <<= 1) amax = fmaxf(amax, __shfl_xor(amax, o));
            {   const float s4 = amax > 0.f ? 6.f / amax : 1.f; v4u q;
#define PK4(J) ({ unsigned w_ = 0u; \
                    w_ = __builtin_amdgcn_cvt_scalef32_pk_fp4_f32(w_, v[2 * (J)].x * s4, v[2 * (J)].y * s4, 1.0f, 0); w_ = __builtin_amdgcn_cvt_scalef32_pk_fp4_f32(w_, v[2 * (J)].z * s4, v[2 * (J)].w * s4, 1.0f, 1); \
                    w_ = __builtin_amdgcn_cvt_scalef32_pk_fp4_f32(w_, v[2 * (J) + 1].x * s4, v[2 * (J) + 1].y * s4, 1.0f, 2); w_ = __builtin_amdgcn_cvt_scalef32_pk_fp4_f32(w_, v[2 * (J) + 1].z * s4, v[2 * (J) + 1].w * s4, 1.0f, 3); w_; })
                q.x = PK4(0); q.y = PK4(1); q.z = PK4(2); q.w = PK4(3);
#undef PK4
                if (tsel) *(GAS v4u*)(ws + WS_EV + (size_t)e * 1024 + 16 * F.lane) = q;
                else {
                    GAS unsigned short* up = (GAS unsigned short*)(ws + WS_EU + (size_t)e * 128) + F.lane; constexpr size_t SL = (size_t)NEXP * 64;
                    up[0] = (unsigned short)q.x; up[SL] = (unsigned short)(q.x >> 16); up[2 * SL] = (unsigned short)q.y; up[3 * SL] = (unsigned short)(q.y >> 16);
                    up[4 * SL] = (unsigned short)q.z; up[5 * SL] = (unsigned short)(q.z >> 16); up[6 * SL] = (unsigned short)q.w; up[7 * SL] = (unsigned short)(q.w >> 16); }
            }
            if (F.lane == 0) ((float*)(ws + (tsel ? WS_SV : WS_SU)))[e] = amax > 0.f ? amax / 6.f : 1.f;
        }
    }
    {   const size_t gt = (size_t)F.vcu * (NWAVES * 64) + F.tid, GT = (size_t)F.G * NWAVES * 64;
        constexpr size_t per = (size_t)PADF * 1024 * 2 / 16;
        for (size_t c = gt; c < 8 * per; c += GT) { const int a = (int)(c / per), off = (int)(c % per); const int arr = a >> 1, b = a & 1;
            const size_t base = arr == 0 ? WS_DK : arr == 1 ? WS_DV : arr == 2 ? WS_FK : WS_FV;
            ((GAS v4u*)(ws + base + (size_t)b * LP * 1024 * 2))[off] = (v4u){0u, 0u, 0u, 0u}; }
        { const float* sk = F.in[I_SUBK]; bf16* skh = (bf16*)(ws + WS_SKH); bf16* skl = (bf16*)(ws + WS_SKL);
          for (size_t i = gt; i < (size_t)8 * 2 * 128 * 64; i += GT) { const float v = sk[i]; const unsigned hb = f2bf(v); skh[i] = (bf16)hb; skl[i] = (bf16)f2bf(v - __uint_as_float(hb << 16)); } }
        { float* rt = (float*)(ws + WS_ROPE);
          const float inv[8] = {1.0f, 0.1939227432012558f, 0.03760603070259094f, 0.007292664609849453f, 0.0014142135623842478f, 0.00027424818836152554f, 5.318296098266728e-05f, 1.0313386155758053e-05f};
          for (size_t i = gt; i < (size_t)LSEQ * 8; i += GT) { const int fi = (int)(i & 7); float iv = inv[0];
#pragma unroll
              for (int q = 1; q < 8; ++q) iv = fi == q ? inv[q] : iv;
              const float ang = (float)(i >> 3) * iv; rt[2 * i] = cosf(ang); rt[2 * i + 1] = sinf(ang); } }
        float* KBD = (float*)(ws + WS_KBIAS) + (size_t)16 * LP;
        for (size_t p = gt; p < LP; p += GT) KBD[p] = p < PADF ? -__builtin_inff() : 0.f;
    }
}
using pg8::Unit;
__device__ __forceinline__ v4u pack8bf(const f32x4& a, const f32x4& b) { v4u w; w.x = pg8::cvt_pk_bf16(a[0], a[1]); w.y = pg8::cvt_pk_bf16(a[2], a[3]); w.z = pg8::cvt_pk_bf16(b[0], b[1]); w.w = pg8::cvt_pk_bf16(b[2], b[3]); return w; }
struct Epi1 {
    static constexpr bool PERM = true, AFTER_DRAIN = false;
    unsigned char* ws; LAS float* xch; const float* dkg; const float* fkg;
    __device__ __forceinline__ void scale(f32x4 (&)[2][2][4][2], const Unit&, int, int, int, int) const {}
    __device__ __forceinline__ void operator()(const f32x4 (&acc)[2][2][4][2], const Unit& u, int wr, int wc, int fr, int fq) const {
        using pg8::HALF;
        asm volatile("" : "+v"(fr), "+v"(fq));
        const int ncol = u.pn * 256;
        if (ncol >= 1024 && ncol < 2048) {
            bf16* base = (bf16*)(ws + WS_DK) + (ncol - 1024) + 64 * wc + 8 * fq; const float* rope = (const float*)(ws + WS_ROPE);
#pragma unroll
            for (int ai = 0; ai < 2; ++ai)
#pragma unroll
                for (int m = 0; m < 4; ++m) { const int mrow = u.pm * 256 + ai * HALF + wr * 64 + m * 16 + fr;
                    f32x4 y[2][2]; float ss = 0.f;
#pragma unroll
                    for (int bj = 0; bj < 2; ++bj)
#pragma unroll
                        for (int n = 0; n < 2; ++n) { y[bj][n] = acc[ai][bj][m][n]; ss += (y[bj][n][0] * y[bj][n][0] + y[bj][n][1] * y[bj][n][1]) + (y[bj][n][2] * y[bj][n][2] + y[bj][n][3] * y[bj][n][3]); }
                    ss += __shfl_xor(ss, 16); ss += __shfl_xor(ss, 32);
                    const float r = 1.f / sqrtf(ss * (1.f / 64.f) + EPS);
#pragma unroll
                    for (int bj = 0; bj < 2; ++bj)
#pragma unroll
                        for (int n = 0; n < 2; ++n) { const f32x4 g = *(const f32x4*)(dkg + 32 * bj + 8 * fq + 4 * n); y[bj][n] = y[bj][n] * r * g; }
                    const float* tb = rope + (size_t)(NMETA + (mrow & 4095)) * 16;
#pragma unroll
                    for (int n = 0; n < 2; ++n)
#pragma unroll
                        for (int i = 0; i < 4; ++i) { const float mine = y[0][n][i], other = __shfl_xor(mine, 16); const float c = tb[2 * (4 * n + i)], sn = tb[2 * (4 * n + i) + 1];
                            y[0][n][i] = fq == 0 ? (mine * c - other * sn) : (fq == 1 ? (mine * c + other * sn) : mine); }
                    bf16* rowp = base + (size_t)(mrow + 64 + 64 * (mrow >> 12)) * 1024;
                    *(GAS v4u*)(rowp) = pack8bf(y[0][0], y[0][1]); *(GAS v4u*)(rowp + 32) = pack8bf(y[1][0], y[1][1]); }
        } else if (ncol >= 4096 && ncol < 5120) {
            bf16* base = (bf16*)(ws + WS_FK) + (ncol - 4096) + 64 * wc + 8 * fq;
#pragma unroll
            for (int ai = 0; ai < 2; ++ai)
#pragma unroll
                for (int m = 0; m < 4; ++m) { const int rt = ai * HALF + wr * 64 + m * 16 + fr; float ss = 0.f;
#pragma unroll
                    for (int bj = 0; bj < 2; ++bj)
#pragma unroll
                        for (int n = 0; n < 2; ++n) { const f32x4 v = acc[ai][bj][m][n]; ss += (v[0] * v[0] + v[1] * v[1]) + (v[2] * v[2] + v[3] * v[3]); }
                    ss += __shfl_xor(ss, 16); ss += __shfl_xor(ss, 32);
                    if (fq == 0) xch[rt * 4 + wc] = ss; }
            asm volatile("s_waitcnt lgkmcnt(0)" ::: "memory"); __builtin_amdgcn_s_barrier(); asm volatile("" ::: "memory");
#pragma unroll
            for (int ai = 0; ai < 2; ++ai)
#pragma unroll
                for (int m = 0; m < 4; ++m) { const int rt = ai * HALF + wr * 64 + m * 16 + fr; const int mrow = u.pm * 256 + rt;
                    const float r = 1.f / sqrtf((xch[rt * 4 + wc] + xch[rt * 4 + (wc ^ 1)]) * (1.f / 128.f) + EPS);
                    bf16* rowp = base + (size_t)(mrow + 64 + 64 * (mrow >> 12)) * 1024;
#pragma unroll
                    for (int bj = 0; bj < 2; ++bj) { const float* gg = fkg + 64 * (wc & 1) + 32 * bj + 8 * fq; const f32x4 g0 = *(const f32x4*)gg, g1 = *(const f32x4*)(gg + 4);
                        *(GAS v4u*)(rowp + 32 * bj) = pack8bf(acc[ai][bj][m][0] * r * g0, acc[ai][bj][m][1] * r * g1); } }
        } else {
            bf16* base; int ldc, colt, kind;
            if (ncol < 6144) { const int seg = ncol >> 10; colt = ncol & 1023; ldc = 1024;
                base = (bf16*)(ws + (seg == 0 ? WS_DQ : seg == 2 ? WS_DV : seg == 3 ? WS_FQ : WS_FV)); kind = (seg == 2 || seg == 5) ? 1 : 0; }
            else if (ncol < 8192) { base = (bf16*)(ws + WS_GA); colt = ncol - 6144; ldc = 2048; kind = 0; }
            else { base = (bf16*)(ws + WS_GB); colt = ncol - 8192; ldc = 2048; kind = 0; }
#pragma unroll
            for (int ai = 0; ai < 2; ++ai)
#pragma unroll
                for (int m = 0; m < 4; ++m) { const int mrow = u.pm * 256 + ai * HALF + wr * 64 + m * 16 + fr; const size_t row = kind ? (size_t)(mrow + 64 + 64 * (mrow >> 12)) : (size_t)mrow;
#pragma unroll
                    for (int bj = 0; bj < 2; ++bj) *(GAS v4u*)(base + row * ldc + colt + bj * HALF + wc * 32 + 8 * fq) = pack8bf(acc[ai][bj][m][0], acc[ai][bj][m][1]); }
        }
    }
};
struct F_Gemm2a {
    const bf16* G; const float* bg; bf16* MG;
    __device__ __forceinline__ bool begin(const Unit&) { return true; }
    __device__ __forceinline__ void row_begin() {}
    __device__ __forceinline__ void scale_chunk(const Unit&, int, int, f32x4&, f32x4&) const {}
    __device__ __forceinline__ void row_end(const Unit&, int, int, int) {}
    __device__ __forceinline__ void chunk(const Unit& u, int rt, int ct, const f32x4& v0, const f32x4& v1) const {
        const size_t row = (size_t)u.pm * 256 + rt; const int col = u.pn * 256 + ct;
        const v4u g = *(const GAS v4u*)(G + row * DM + col); const f32x4 b0 = *(const f32x4*)(bg + col), b1 = *(const f32x4*)(bg + col + 4);
        f32x4 o0, o1;
        o0[0] = sigmoidf_(bflo(g.x) + b0[0]) * v0[0]; o0[1] = sigmoidf_(bfhi(g.x) + b0[1]) * v0[1]; o0[2] = sigmoidf_(bflo(g.y) + b0[2]) * v0[2]; o0[3] = sigmoidf_(bfhi(g.y) + b0[3]) * v0[3];
        o1[0] = sigmoidf_(bflo(g.z) + b1[0]) * v1[0]; o1[1] = sigmoidf_(bfhi(g.z) + b1[1]) * v1[1]; o1[2] = sigmoidf_(bflo(g.w) + b1[2]) * v1[2]; o1[3] = sigmoidf_(bfhi(g.w) + b1[3]) * v1[3];
        *(GAS v4u*)(MG + row * DM + col) = pack8bf(o0, o1);
    }
};
struct F_Gemm2b {
    const bf16* G; const float* bg; bf16* MG;
    __device__ __forceinline__ bool begin(const Unit&) { return true; }
    __device__ __forceinline__ void row_begin() {}
    __device__ __forceinline__ void scale_chunk(const Unit&, int, int, f32x4&, f32x4&) const {}
    __device__ __forceinline__ void row_end(const Unit&, int, int, int) {}
    __device__ __forceinline__ void chunk(const Unit& u, int rt, int ct, const f32x4& v0, const f32x4& v1) const {
        const size_t row = (size_t)u.pm * 256 + rt; const int col = u.pn * 256 + ct;
        const v4u g = *(const GAS v4u*)(G + row * DM + col); const f32x4 b0 = *(const f32x4*)(bg + col), b1 = *(const f32x4*)(bg + col + 4);
        const v4u t = *(const GAS v4u*)(MG + row * DM + col);
        f32x4 o0, o1;
        o0[0] = bflo(t.x) + sigmoidf_(bflo(g.x) + b0[0]) * v0[0]; o0[1] = bfhi(t.x) + sigmoidf_(bfhi(g.x) + b0[1]) * v0[1]; o0[2] = bflo(t.y) + sigmoidf_(bflo(g.y) + b0[2]) * v0[2]; o0[3] = bfhi(t.y) + sigmoidf_(bfhi(g.y) + b0[3]) * v0[3];
        o1[0] = bflo(t.z) + sigmoidf_(bflo(g.z) + b1[0]) * v1[0]; o1[1] = bfhi(t.z) + sigmoidf_(bfhi(g.z) + b1[1]) * v1[1]; o1[2] = bflo(t.w) + sigmoidf_(bflo(g.w) + b1[2]) * v1[2]; o1[3] = bfhi(t.w) + sigmoidf_(bfhi(g.w) + b1[3]) * v1[3];
        *(GAS v4u*)(MG + row * DM + col) = pack8bf(o0, o1);
    }
};
struct F_Gemm2 {
    const bf16* GA; const bf16* GB; const float* bg; bf16* MG;
    __device__ __forceinline__ bool begin(const Unit&) { return true; }
    __device__ __forceinline__ void row_begin() {}
    __device__ __forceinline__ void row_end(const Unit&, int, int, int) {}
    __device__ __forceinline__ void scale_chunk(const Unit& u, int rt, int ct, f32x4& v0, f32x4& v1) const {
        const size_t row = (size_t)u.pm * 256 + rt; const int col = u.pn * 256 + ct;
        const v4u ga = *(const GAS v4u*)(GA + row * DM + col), gb = *(const GAS v4u*)(GB + row * DM + col);
        const f32x4 a0 = *(const f32x4*)(bg + col), a1 = *(const f32x4*)(bg + col + 4), b0 = *(const f32x4*)(bg + DM + col), b1 = *(const f32x4*)(bg + DM + col + 4);
#define RT(GAW, GBW, HI, AB, BB) ((1.f + __expf(-((HI ? bfhi(GBW) : bflo(GBW)) + (BB)))) / (1.f + __expf(-((HI ? bfhi(GAW) : bflo(GAW)) + (AB)))))
        v0[0] *= RT(ga.x, gb.x, 0, a0[0], b0[0]); v0[1] *= RT(ga.x, gb.x, 1, a0[1], b0[1]); v0[2] *= RT(ga.y, gb.y, 0, a0[2], b0[2]); v0[3] *= RT(ga.y, gb.y, 1, a0[3], b0[3]);
        v1[0] *= RT(ga.z, gb.z, 0, a1[0], b1[0]); v1[1] *= RT(ga.z, gb.z, 1, a1[1], b1[1]); v1[2] *= RT(ga.w, gb.w, 0, a1[2], b1[2]); v1[3] *= RT(ga.w, gb.w, 1, a1[3], b1[3]);
#undef RT
    }
    __device__ __forceinline__ void chunk(const Unit& u, int rt, int ct, const f32x4& v0, const f32x4& v1) const {
        const size_t row = (size_t)u.pm * 256 + rt; const int col = u.pn * 256 + ct;
        const v4u g = *(const GAS v4u*)(GB + row * DM + col); const f32x4 b0 = *(const f32x4*)(bg + DM + col), b1 = *(const f32x4*)(bg + DM + col + 4);
        f32x4 o0, o1;
        o0[0] = sigmoidf_(bflo(g.x) + b0[0]) * v0[0]; o0[1] = sigmoidf_(bfhi(g.x) + b0[1]) * v0[1]; o0[2] = sigmoidf_(bflo(g.y) + b0[2]) * v0[2]; o0[3] = sigmoidf_(bfhi(g.y) + b0[3]) * v0[3];
        o1[0] = sigmoidf_(bflo(g.z) + b1[0]) * v1[0]; o1[1] = sigmoidf_(bfhi(g.z) + b1[1]) * v1[1]; o1[2] = sigmoidf_(bflo(g.w) + b1[2]) * v1[2]; o1[3] = sigmoidf_(bfhi(g.w) + b1[3]) * v1[3];
        *(GAS v4u*)(MG + row * DM + col) = pack8bf(o0, o1);
    }
};
struct Pair2Order {
    pg8::StaticOrder S; int dA, dB;
    __device__ void init(int M, int N, int G_, int c_, int dA_, int dB_) { S.init(M, N, G_, c_); dA = dA_; dB = dB_; }
    __device__ bool next(int i, Unit& u) const { if (!S.next(i >> 1, u)) return false; const int br = i & 1; u.ko = br ? dA : 0; u.kob = br ? dB : 0; u.chain = br ? 0 : 1; return true; }
    __device__ __forceinline__ void a_ready(const Unit&) const {}
    __device__ __forceinline__ void done(const Unit&) const {}
};
struct F_Gemm3 {
    const float* X; float* O; const float* gp; bf16* HG; float* SSQ; float ss;
    __device__ __forceinline__ bool begin(const Unit&) { return true; }
    __device__ __forceinline__ void row_begin() { ss = 0.f; }
    __device__ __forceinline__ void scale_chunk(const Unit&, int, int, f32x4&, f32x4&) const {}
    __device__ __forceinline__ void chunk(const Unit& u, int rt, int ct, const f32x4& v0, const f32x4& v1) {
        const int col = u.pn * 256 + ct; const size_t off = ((size_t)u.pm * 256 + rt) * DM + col;
        const f32x4 x0 = *(const GAS f32x4*)(X + off), x1 = *(const GAS f32x4*)(X + off + 4);
        const f32x4 o0 = x0 + v0, o1 = x1 + v1;
        *(GAS f32x4*)(O + off) = o0; *(GAS f32x4*)(O + off + 4) = o1;
        ss += (o0[0] * o0[0] + o0[1] * o0[1]) + (o0[2] * o0[2] + o0[3] * o0[3]) + (o1[0] * o1[0] + o1[1] * o1[1]) + (o1[2] * o1[2] + o1[3] * o1[3]);
        const f32x4 g0 = *(const f32x4*)(gp + col), g1 = *(const f32x4*)(gp + col + 4);
        *(GAS v4u*)(HG + off) = pack8bf(o0 * g0, o1 * g1);
    }
    __device__ __forceinline__ void row_end(const Unit& u, int rt, int wc, int fq) {
        float s = ss; s += __shfl_xor(s, 16); s += __shfl_xor(s, 32);
        if (fq == 0) SSQ[((size_t)u.pm * 256 + rt) * 32 + u.pn * 4 + wc] = s;
    }
};
struct F_Gemm4 {
    float* Q;
    __device__ __forceinline__ bool begin(const Unit&) { return true; }
    __device__ __forceinline__ void row_begin() {}
    __device__ __forceinline__ void scale_chunk(const Unit&, int, int, f32x4&, f32x4&) const {}
    __device__ __forceinline__ void row_end(const Unit&, int, int, int) {}
    __device__ __forceinline__ void chunk(const Unit& u, int rt, int ct, const f32x4& v0, const f32x4& v1) const {
        const size_t off = (u.ko ? (size_t)MREAL * 1024 : 0) + ((size_t)u.pm * 256 + rt) * 1024 + u.pn * 256 + ct;
        *(GAS f32x4*)(Q + off) = v0; *(GAS f32x4*)(Q + off + 4) = v1;
    }
};
struct SplitK2Order {
    pg8::StaticOrder S;
    __device__ void init(int M, int N, int G_, int c_) { S.init(M, 2 * N, G_, c_); }
    __device__ bool next(int i, Unit& u) const { if (!S.next(i, u)) return false; u.ko = (u.pn >> 2) * 2048; u.kob = u.ko; u.pn &= 3; return true; }
    __device__ __forceinline__ void a_ready(const Unit&) const {}
    __device__ __forceinline__ void done(const Unit&) const {}
};

__device__ __forceinline__ void p2_norm_row(bf16* rowp, const float* gain, int grp  , bool rope, const float* ropetab  , int lane) {
    const v4u w0 = *(const GAS v4u*)(rowp + 16 * lane), w1 = *(const GAS v4u*)(rowp + 16 * lane + 8);
    float x[16];
    x[0] = bflo(w0.x); x[1] = bfhi(w0.x); x[2] = bflo(w0.y); x[3] = bfhi(w0.y); x[4] = bflo(w0.z); x[5] = bfhi(w0.z); x[6] = bflo(w0.w); x[7] = bfhi(w0.w);
    x[8] = bflo(w1.x); x[9] = bfhi(w1.x); x[10] = bflo(w1.y); x[11] = bfhi(w1.y); x[12] = bflo(w1.z); x[13] = bfhi(w1.z); x[14] = bflo(w1.w); x[15] = bfhi(w1.w);
    float ss = 0.f;
#pragma unroll
    for (int i = 0; i < 16; ++i) ss += x[i] * x[i];
    ss += __shfl_xor(ss, 1); ss += __shfl_xor(ss, 2); if (grp == 128) ss += __shfl_xor(ss, 4);
    const float r = 1.f / sqrtf(ss / (float)grp + EPS);
    const int d0 = (16 * lane) & (grp - 1);
#pragma unroll
    for (int i = 0; i < 16; i += 4) { const f32x4 g = *(const f32x4*)(gain + d0 + i); x[i] = x[i] * r * g[0]; x[i + 1] = x[i + 1] * r * g[1]; x[i + 2] = x[i + 2] * r * g[2]; x[i + 3] = x[i + 3] * r * g[3]; }
    if (rope && (lane & 3) == 0) {
#pragma unroll
        for (int i = 0; i < 8; ++i) { const float c = ropetab[2 * i], s = ropetab[2 * i + 1]; const float a = x[i], b = x[i + 8]; x[i] = a * c - b * s; x[i + 8] = b * c + a * s; }
    }
    v4u o0, o1;
    o0.x = pk2(x[0], x[1]); o0.y = pk2(x[2], x[3]); o0.z = pk2(x[4], x[5]); o0.w = pk2(x[6], x[7]); o1.x = pk2(x[8], x[9]); o1.y = pk2(x[10], x[11]); o1.z = pk2(x[12], x[13]); o1.w = pk2(x[14], x[15]);
    *(GAS v4u*)(rowp + 16 * lane) = o0; *(GAS v4u*)(rowp + 16 * lane + 8) = o1;
}
__device__ __forceinline__ void p1_tail(Frame& F) {
    unsigned char* ws = F.ws;
    if (F.gw < 16) {
        const float* lf = (const float*)(ws + WS_LOGF) + (size_t)F.gw * LSEQ; float* kb = (float*)(ws + WS_KBIAS) + (size_t)F.gw * LP;
        float carry = 0.f;
#pragma unroll 1
        for (int c0 = 0; c0 < LSEQ; c0 += 512) {
            float x[8];
#pragma unroll
            for (int u = 0; u < 8; ++u) { const int t = c0 + 64 * u + F.lane; x[u] = t < LSEQ ? lf[t] : 0.f; }
#pragma unroll
            for (int u = 0; u < 8; ++u) { float incl = x[u];
#pragma unroll
                for (int o = 1; o < 64; o <<= 1) { const float n = __shfl_up(incl, o); if (F.lane >= o) incl += n; }
                incl += carry; const int t = c0 + 64 * u + F.lane; if (t < LSEQ) kb[PADF + t] = -incl * 11.313708498984761f;
                carry = __shfl(incl, 63); }
        }
        if (F.lane < PADF) kb[F.lane] = -__builtin_inff();
    }
    { const int rtask = F.gw - 16;
      if (rtask >= 0 && rtask < 64) { const int arr = rtask >> 5, b = (rtask >> 4) & 1, t = rtask & 15;
          if (arr == 0) p2_norm_row((bf16*)(ws + WS_DK) + ((size_t)b * LP + PADF + t) * 1024, F.in[I_DKG], 64, true, (const float*)(ws + WS_ROPE) + (size_t)t * 16, F.lane);
          else p2_norm_row((bf16*)(ws + WS_FK) + ((size_t)b * LP + PADF + t) * 1024, F.in[I_FKG], 128, false, nullptr, F.lane); } }
}

__device__ const unsigned char ATT_TAB[32][4] = {
{0,95,69,112},{16,79,85,112},{32,94,70,112},{22,78,81,112},{4,36,77,112},{15,38,35,112},{55,93,65,112},{63,33,87,112},{61,6,21,112},{47,20,84,112},{13,42,1,112},{54,92,83,112},{41,18,75,112},{43,17,90,112},{62,7,19,112},{39,51,76,112},{45,71,82,112},{30,8,50,112},{46,40,2,112},{31,9,48,112},{28,53,86,112},{56,3,91,112},{10,57,37,112},{44,23,5,112},{29,73,64,112},{14,58,80,112},{12,11,49,112},{26,34,74,112},{60,72,66,112},{59,25,52,112},{89,88,67,112},{27,24,68,112}};
__device__ __forceinline__ att::BlockRef att_ref(unsigned char* ws, int x, int code, const float* qg64, const float* qg128) {
    const int hl = code >> 4, j = code & 15; att::BlockRef r; r.rope = (const float*)(ws + WS_ROPE);
    if (hl < 4) { const int dp = 2 * x + (hl >> 1), b = dp >> 3, h = dp & 7, i = hl & 1;
        r.Q = (const bf16*)(ws + WS_DQ) + ((size_t)b * SEQ + 256 * j) * 1024 + h * 128 + i * 64;
        r.K = (const bf16*)(ws + WS_DK) + (size_t)b * LP * 1024 + h * 128 + i * 64;
        r.V = (const bf16*)(ws + WS_DV) + (size_t)b * LP * 1024 + h * 128;
        r.KB = (const float*)(ws + WS_KBIAS) + (size_t)16 * LP;
        r.O = (bf16*)(ws + (i ? WS_O2 : WS_O1)) + ((size_t)b * SEQ + 256 * j) * 1024 + h * 128; r.dqk = 64; r.qg = qg64; }
    else { const int fh = 2 * x + (hl - 4), b = fh >> 3, h = fh & 7;
        r.Q = (const bf16*)(ws + WS_FQ) + ((size_t)b * SEQ + 256 * j) * 1024 + h * 128;
        r.K = (const bf16*)(ws + WS_FK) + (size_t)b * LP * 1024 + h * 128;
        r.V = (const bf16*)(ws + WS_FV) + (size_t)b * LP * 1024 + h * 128;
        r.KB = (const float*)(ws + WS_KBIAS) + (size_t)fh * LP;
        r.O = (bf16*)(ws + WS_OF) + ((size_t)b * SEQ + 256 * j) * 1024 + h * 128; r.dqk = 128; r.qg = qg128; }
    r.P0 = 64 + 256 * j; return r;
}
template <int ABL>
__device__ __forceinline__ void p3_attention(Frame& F, char* lds) {
    for (int v = F.vcu; v < 256; v += F.G) {
        const int x = v >> 5, slot = v & 31;
        int n = 0; while (n < 4 && ATT_TAB[slot][n] != 112) ++n;
        if (n == 0) continue;
        for (int i = 0; i < n; ++i) {
            att::BlockRef cur = att_ref(F.ws, x, ATT_TAB[slot][i], F.in[I_DQG], F.in[I_FQG]);
            if (ABL != 0) cur.O = (bf16*)(F.ws + WS_XN) + (cur.O - (bf16*)(F.ws + (cur.dqk == 64 ? WS_O1 : WS_OF)) ) % ((size_t)MREAL * 1024);
            if (cur.dqk == 64) att::block<64, ABL>(cur, LP, lds); else att::block<128, ABL>(cur, LP, lds);
        }
    }
}
__device__ __forceinline__ float diff_lambda(Frame& F) {
    const float a = F.in[I_LQ1][F.lane] * F.in[I_LK1][F.lane], b = F.in[I_LQ2][F.lane] * F.in[I_LK2][F.lane];
    return __expf(wave_sum(a)) - __expf(wave_sum(b)) + 0.2f;
}
__device__ __forceinline__ void p4_combine(Frame& F) {
    const float lam = diff_lambda(F);
    const bf16* O1 = (const bf16*)(F.ws + WS_O1); const bf16* O2 = (const bf16*)(F.ws + WS_O2); bf16* OD = (bf16*)(F.ws + WS_OD);
    const float* g = F.in[I_SUBLN];
    const int d0 = (16 * F.lane) & 127;
    for (int m = F.gw; m < MREAL; m += F.NGW) {
        const size_t off = (size_t)m * 1024 + 16 * F.lane;
        const v4u a0 = *(const GAS v4u*)(O1 + off), a1 = *(const GAS v4u*)(O1 + off + 8), b0 = *(const GAS v4u*)(O2 + off), b1 = *(const GAS v4u*)(O2 + off + 8);
        float x[16];
        x[0] = bflo(a0.x) - lam * bflo(b0.x); x[1] = bfhi(a0.x) - lam * bfhi(b0.x); x[2] = bflo(a0.y) - lam * bflo(b0.y); x[3] = bfhi(a0.y) - lam * bfhi(b0.y);
        x[4] = bflo(a0.z) - lam * bflo(b0.z); x[5] = bfhi(a0.z) - lam * bfhi(b0.z); x[6] = bflo(a0.w) - lam * bflo(b0.w); x[7] = bfhi(a0.w) - lam * bfhi(b0.w);
        x[8] = bflo(a1.x) - lam * bflo(b1.x); x[9] = bfhi(a1.x) - lam * bfhi(b1.x); x[10] = bflo(a1.y) - lam * bflo(b1.y); x[11] = bfhi(a1.y) - lam * bfhi(b1.y);
        x[12] = bflo(a1.z) - lam * bflo(b1.z); x[13] = bfhi(a1.z) - lam * bfhi(b1.z); x[14] = bflo(a1.w) - lam * bflo(b1.w); x[15] = bfhi(a1.w) - lam * bfhi(b1.w);
        float ss = 0.f;
#pragma unroll
        for (int i = 0; i < 16; ++i) ss += x[i] * x[i];
        ss += __shfl_xor(ss, 1); ss += __shfl_xor(ss, 2); ss += __shfl_xor(ss, 4);
        const float r = 0.8f / sqrtf(ss * (1.f / 128.f) + EPS);
#pragma unroll
        for (int i = 0; i < 16; i += 4) { const f32x4 gg = *(const f32x4*)(g + d0 + i); x[i] *= r * gg[0]; x[i + 1] *= r * gg[1]; x[i + 2] *= r * gg[2]; x[i + 3] *= r * gg[3]; }
        v4u o0, o1;
        o0.x = pk2(x[0], x[1]); o0.y = pk2(x[2], x[3]); o0.z = pk2(x[4], x[5]); o0.w = pk2(x[6], x[7]); o1.x = pk2(x[8], x[9]); o1.y = pk2(x[10], x[11]); o1.z = pk2(x[12], x[13]); o1.w = pk2(x[14], x[15]);
        *(GAS v4u*)(OD + off) = o0; *(GAS v4u*)(OD + off + 8) = o1;
    }
}
__device__ __forceinline__ unsigned f2ord(float f) { const unsigned u = __float_as_uint(f); return u ^ ((unsigned)((int)u >> 31) | 0x80000000u); }
__device__ __forceinline__ float ord2f(unsigned k) { const unsigned m = (unsigned)((int)(~k) >> 31) | 0x80000000u; return __uint_as_float(k ^ m); }
__device__ __forceinline__ void sort16_desc(unsigned (&a)[16]) {
#pragma unroll
    for (int k = 2; k <= 16; k <<= 1)
#pragma unroll
        for (int j = k >> 1; j > 0; j >>= 1)
#pragma unroll
            for (int i = 0; i < 16; ++i) { const int l = i ^ j; if (l > i) { const bool desc = (i & k) == 0; const unsigned hi_ = max(a[i], a[l]), lo_ = min(a[i], a[l]); a[i] = desc ? hi_ : lo_; a[l] = desc ? lo_ : hi_; } }
}
__device__ __forceinline__ void merge_top16(unsigned (&a)[16], const unsigned (&b)[16]) {
#pragma unroll
    for (int i = 0; i < 16; ++i) a[i] = max(a[i], b[15 - i]);
#pragma unroll
    for (int j = 8; j > 0; j >>= 1)
#pragma unroll
        for (int i = 0; i < 16; ++i) { const int l = i ^ j; if (l > i) { const unsigned hi_ = max(a[i], a[l]), lo_ = min(a[i], a[l]); a[i] = hi_; a[l] = lo_; } }
}
__device__ __forceinline__ void p9_route(Frame& F) {
    typedef float f32x16 __attribute__((ext_vector_type(16)));
    const float* QP0 = (const float*)(F.ws + WS_QP); const float* QP1 = QP0 + (size_t)MREAL * 1024; const float* SSQ = (const float*)(F.ws + WS_SSQ);
    const bf16* SKH = (const bf16*)(F.ws + WS_SKH); const bf16* SKL = (const bf16*)(F.ws + WS_SKL);
    int* IDX = (int*)(F.ws + WS_IDX); float* GATE = (float*)(F.ws + WS_GATE);
    LAS int* XI = (LAS int*)(F.lds + RING_OFF) + F.wave * (64 * 33);
    const int r32 = F.lane & 31, hi = F.lane >> 5;
    for (int task = F.gw; task < PEER_H * (MREAL / 32); task += F.NGW) {
        const int h = task & 7, tok = (task >> 3) * 32 + r32;
        float rs;
        { const GAS f32x4* sp = (const GAS f32x4*)(SSQ + (size_t)tok * 32); f32x4 t = sp[0];
#pragma unroll
          for (int i = 1; i < 8; ++i) t += sp[i];
          rs = 1.f / sqrtf(((t[0] + t[1]) + (t[2] + t[3])) * (1.f / DM) + EPS); }
        if (h == 0 && hi == 0) ((float*)(F.ws + WS_RS))[tok] = rs;
        unsigned T[2][16];
#pragma unroll
        for (int c = 0; c < 2; ++c) {
            f32x16 acc[4];
#pragma unroll
            for (int kb = 0; kb < 4; ++kb) acc[kb] = f32x16{};
            const size_t qoff = (size_t)tok * 1024 + h * 128 + c * 64 + 8 * hi;
            const size_t koff = ((size_t)(h * 2 + c) * 128 + r32) * 64 + 8 * hi;
#pragma unroll
            for (int ks = 0; ks < 4; ++ks) {
                bf16x8 qh, ql;
                { const GAS f32x4* a0 = (const GAS f32x4*)(QP0 + qoff + 16 * ks); const GAS f32x4* a1 = (const GAS f32x4*)(QP1 + qoff + 16 * ks);
                  const f32x4 q0 = (a0[0] + a1[0]) * rs, q1 = (a0[1] + a1[1]) * rs;
                  const v4u hw = pack8bf(q0, q1);
                  f32x4 l0, l1;
                  l0[0] = q0[0] - bflo(hw.x); l0[1] = q0[1] - bfhi(hw.x); l0[2] = q0[2] - bflo(hw.y); l0[3] = q0[3] - bfhi(hw.y);
                  l1[0] = q1[0] - bflo(hw.z); l1[1] = q1[1] - bfhi(hw.z); l1[2] = q1[2] - bflo(hw.w); l1[3] = q1[3] - bfhi(hw.w);
                  const v4u lw = pack8bf(l0, l1);
                  qh = __builtin_bit_cast(bf16x8, hw); ql = __builtin_bit_cast(bf16x8, lw); }
#pragma unroll
                for (int kb = 0; kb < 4; ++kb) {
                    const bf16x8 kh = *(const GAS bf16x8*)(SKH + koff + (size_t)kb * 32 * 64 + 16 * ks), kl = *(const GAS bf16x8*)(SKL + koff + (size_t)kb * 32 * 64 + 16 * ks);
                    acc[kb] = __builtin_amdgcn_mfma_f32_32x32x16_bf16(kh, qh, acc[kb], 0, 0, 0);
                    acc[kb] = __builtin_amdgcn_mfma_f32_32x32x16_bf16(kh, ql, acc[kb], 0, 0, 0);
                    acc[kb] = __builtin_amdgcn_mfma_f32_32x32x16_bf16(kl, qh, acc[kb], 0, 0, 0);
                }
                __builtin_amdgcn_sched_barrier(0);
            }
            unsigned G[4][16];
#pragma unroll
            for (int kb = 0; kb < 4; ++kb) {
#pragma unroll
                for (int r = 0; r < 16; ++r) { const int n = 32 * kb + (r & 3) + 8 * (r >> 2) + 4 * hi; G[kb][r] = (f2ord(acc[kb][r]) & ~0x7Fu) | (unsigned)(127 - n); }
                sort16_desc(G[kb]); }
            merge_top16(G[0], G[1]); merge_top16(G[2], G[3]); merge_top16(G[0], G[2]);
            unsigned P[16];
#pragma unroll
            for (int j = 0; j < 16; ++j) { auto rr = __builtin_amdgcn_permlane32_swap(G[0][j], G[0][j], false, false); P[j] = hi ? rr[0] : rr[1]; }
            merge_top16(G[0], P);
            unsigned (&L)[16] = G[0];
#pragma unroll
            for (int j = 0; j < 16; ++j) T[c][j] = L[j];
        }
        float v1[16], v2[16];
#pragma unroll
        for (int j = 0; j < 16; ++j) { v1[j] = ord2f(T[0][j] & ~0x7Fu); v2[j] = ord2f(T[1][j] & ~0x7Fu);
            XI[F.lane * 33 + j] = 127 - (int)(T[0][j] & 0x7Fu); XI[F.lane * 33 + 16 + j] = 127 - (int)(T[1][j] & 0x7Fu); }
        unsigned Bst[16], C1[16], C2[16], C3[16];
#pragma unroll
        for (int j = 0; j < 16; ++j) { Bst[j] = (f2ord(v1[0] + v2[j]) & ~0xFFu) | (unsigned)(255 - j); C1[j] = 0u; C2[j] = 0u; C3[j] = 0u; }
        { int cnt = 0;
#pragma unroll
          for (int a = 1; a < 16; ++a)
#pragma unroll
            for (int b = 0; b < 16; ++b) if ((a + 1) * (b + 1) <= 16) { const unsigned key = (f2ord(v1[a] + v2[b]) & ~0xFFu) | (unsigned)(255 - (a * 16 + b));
                if (cnt < 16) C1[cnt] = key; else if (cnt < 32) C2[cnt - 16] = key; else C3[cnt - 32] = key; ++cnt; } }
        sort16_desc(C1); sort16_desc(C2); sort16_desc(C3);
        merge_top16(Bst, C1); merge_top16(C2, C3); merge_top16(Bst, C2);
        float e[16], sum = 0.f; const float top = ord2f(Bst[0] & ~0xFFu);
#pragma unroll
        for (int j = 0; j < 16; ++j) { e[j] = __expf(ord2f(Bst[j] & ~0xFFu) - top); sum += e[j]; }
        const float rsum = 1.f / sum;
        LDS_WAIT();
        if (hi == 0) {
            GAS int* io = (GAS int*)(IDX + (size_t)tok * 128 + h * 16); GAS float* go = (GAS float*)(GATE + (size_t)tok * 128 + h * 16);
#pragma unroll
            for (int j = 0; j < 16; ++j) { const int ab = 255 - (int)(Bst[j] & 0xFFu); const int i1 = XI[F.lane * 33 + (ab >> 4)], i2 = XI[F.lane * 33 + 16 + (ab & 15)];
                io[j] = i1 * 128 + i2; go[j] = e[j] * rsum; }
        }
        LDS_WAIT();
    }
}
typedef float f32x2 __attribute__((ext_vector_type(2)));
typedef float f32x32 __attribute__((ext_vector_type(32)));
typedef unsigned u32x6 __attribute__((ext_vector_type(6)));
typedef unsigned u32x16 __attribute__((ext_vector_type(16)));
typedef __bf16 bf16x32_t __attribute__((ext_vector_type(32)));
typedef __bf16 bf16x2_t __attribute__((ext_vector_type(2)));
__device__ __forceinline__ float gelu1(float v) {
    const float av = fabsf(v), t = __builtin_amdgcn_rcpf(av * 0.2316418882f + 1.0f);
    float q = t * 0.5307027145f + (-0.7265760135f); q = q * t + 0.7107068705f; q = q * t + (-0.142248368f); q = q * t + 0.127414796f; q = q * t;
    const float e = __builtin_amdgcn_exp2f((v * v) * (-0.72134752044f));
    const float m = v * (q * e);
    return v < 0.f ? m : v - m;
}

__device__ __forceinline__ float dot32(const float* hf, const v4u& r) {
    float s0 = 0.f, s1 = 0.f;
#define D8(W, T) { const f32x2 a_ = __builtin_amdgcn_cvt_scalef32_pk_f32_fp4((W), 1.0f, 0), b_ = __builtin_amdgcn_cvt_scalef32_pk_f32_fp4((W), 1.0f, 1), \
                               c_ = __builtin_amdgcn_cvt_scalef32_pk_f32_fp4((W), 1.0f, 2), d_ = __builtin_amdgcn_cvt_scalef32_pk_f32_fp4((W), 1.0f, 3); \
                   s0 += hf[T] * a_.x; s1 += hf[T + 1] * a_.y; s0 += hf[T + 2] * b_.x; s1 += hf[T + 3] * b_.y; s0 += hf[T + 4] * c_.x; s1 += hf[T + 5] * c_.y; s0 += hf[T + 6] * d_.x; s1 += hf[T + 7] * d_.y; }
    D8(r.x, 0) D8(r.y, 8) D8(r.z, 16) D8(r.w, 24)
#undef D8
    return s0 + s1;
}
__device__ __forceinline__ void axpy32(float* acc, float w, const v4u& r) {
#define A8(W, T) { const f32x2 a_ = __builtin_amdgcn_cvt_scalef32_pk_f32_fp4((W), 1.0f, 0), b_ = __builtin_amdgcn_cvt_scalef32_pk_f32_fp4((W), 1.0f, 1), \
                               c_ = __builtin_amdgcn_cvt_scalef32_pk_f32_fp4((W), 1.0f, 2), d_ = __builtin_amdgcn_cvt_scalef32_pk_f32_fp4((W), 1.0f, 3); \
                   acc[T] += w * a_.x; acc[T + 1] += w * a_.y; acc[T + 2] += w * b_.x; acc[T + 3] += w * b_.y; acc[T + 4] += w * c_.x; acc[T + 5] += w * c_.y; acc[T + 6] += w * d_.x; acc[T + 7] += w * d_.y; }
    A8(r.x, 0) A8(r.y, 8) A8(r.z, 16) A8(r.w, 24)
#undef A8
}
__device__ __forceinline__ void p10a_udots(Frame& F) {
    typedef int i32x8 __attribute__((ext_vector_type(8)));
    typedef float f32x16 __attribute__((ext_vector_type(16)));
    const bf16* H2N = (const bf16*)(F.ws + WS_H2N); const int* IDX = (const int*)(F.ws + WS_IDX);
    const unsigned char* EU = F.ws + WS_EU; float* PART = (float*)(F.ws + WS_PART);
    LAS unsigned char* wl = F.lds + F.wave * 6144;
    const int l8 = F.lane >> 3, p8 = F.lane & 7;
    const int r32 = F.lane & 31, half = F.lane >> 5;
    int t0, tend, tstep;
    if (F.G % 8 == 0) { const int per = F.G / 8, x = F.vcu / per; t0 = x * MREAL + (F.vcu % per) * NWAVES + F.wave; tend = (x + 1) * MREAL; tstep = per * NWAVES; }
    else { t0 = F.gw; tend = 8 * MREAL; tstep = F.NGW; }
    int zv = 0; asm volatile("" : "+v"(zv));
    const float* RS = (const float*)(F.ws + WS_RS) + zv;
#define PA_CL(T) ((T) < tlast ? (T) : tlast)
#define PA_IDX(I, T) do { const int tk_ = (T) & (MREAL - 1); const GAS v4u* ip_ = (const GAS v4u*)(IDX + (size_t)tk_ * 128 + l8 * 16);     \
        _Pragma("unroll") for (int c_ = 0; c_ < 4; ++c_) { const v4u v_ = ip_[c_]; I[4 * c_] = (int)v_.x; I[4 * c_ + 1] = (int)v_.y; I[4 * c_ + 2] = (int)v_.z; I[4 * c_ + 3] = (int)v_.w; } } while (0)
#define PA_LN(A, I, RB, T) do { const int xs_ = (T) >> 13; _Pragma("unroll") for (int g_ = 0; g_ < 4; ++g_) A[RB][g_] = *(const GAS v4u*)(EU + (size_t)xs_ * ((size_t)NEXP * 128) + (size_t)(unsigned)I[4 * (RB) + g_] * 128 + p8 * 16); } while (0)
#define PA_H(HW, RSV, T) do { const int tk_ = (T) & (MREAL - 1), xs_ = (T) >> 13; HW = *(const GAS unsigned long long*)(H2N + (size_t)tk_ * DM + xs_ * 256 + 4 * F.lane); RSV = RS[tk_]; } while (0)
#define PA_W(AC, RB) do { _Pragma("unroll") for (int g_ = 0; g_ < 4; ++g_) *(LAS v4u*)(wl + 1536 + (8 * g_ + l8) * 144 + p8 * 16) = AC[RB][g_]; asm volatile("" ::: "memory"); } while (0)
#define PA_R(AR) do { _Pragma("unroll") for (int s_ = 0; s_ < 4; ++s_) AR[s_] = *(const LAS v4u*)(wl + 1536 + r32 * 144 + half * 64 + s_ * 16); asm volatile("" ::: "memory"); } while (0)
#define PA_M(AR, ACC) do { _Pragma("unroll") for (int i_ = 0; i_ < 16; ++i_) ACC[i_] = 0.f; \
        _Pragma("unroll") for (int s_ = 0; s_ < 4; ++s_) { const i32x8 a_ = (i32x8){(int)AR[s_].x, (int)AR[s_].y, (int)AR[s_].z, (int)AR[s_].w, 0, 0, 0, 0}; \
            ACC = __builtin_amdgcn_mfma_scale_f32_32x32x64_f8f6f4(a_, B_[s_], ACC, 4, 0, 0, 0x7F7F7F7F, 0, 0x7F7F7F7F); } \
        asm volatile("" : "+v"(ACC)); } while (0)
#define PA_D(RB, ACC) do { if (r32 < 2) { LAS f32x4* dp_ = (LAS f32x4*)(wl + 512 + r32 * 512 + ((RB) * 32 + 4 * half) * 4); \
        _Pragma("unroll") for (int g_ = 0; g_ < 4; ++g_) dp_[2 * g_] = (f32x4){ACC[4 * g_], ACC[4 * g_ + 1], ACC[4 * g_ + 2], ACC[4 * g_ + 3]}; } } while (0)
#define PA_SB() __builtin_amdgcn_sched_barrier(0)
#define PA_TASK(AC, AN, I1, I2, HWC, RSC, HWN, RSN, T) do { \
        const int tn_ = PA_CL((T) + tstep), tn2_ = PA_CL((T) + 2 * tstep); \
        PA_H(HWN, RSN, tn_); PA_IDX(I2, tn2_); \
        {   const float x0 = bflo((unsigned)HWC) * RSC, x1 = bfhi((unsigned)HWC) * RSC, x2 = bflo((unsigned)(HWC >> 32)) * RSC, x3 = bfhi((unsigned)(HWC >> 32)) * RSC; \
            int hi_ = 0; hi_ = __builtin_amdgcn_cvt_pk_fp8_f32(x0, x1, hi_, false); hi_ = __builtin_amdgcn_cvt_pk_fp8_f32(x2, x3, hi_, true); \
            const f32x2 b0_ = __builtin_amdgcn_cvt_pk_f32_fp8(hi_, false), b1_ = __builtin_amdgcn_cvt_pk_f32_fp8(hi_, true); \
            int lo_ = 0; lo_ = __builtin_amdgcn_cvt_pk_fp8_f32((x0 - b0_.x) * 16.f, (x1 - b0_.y) * 16.f, lo_, false); lo_ = __builtin_amdgcn_cvt_pk_fp8_f32((x2 - b1_.x) * 16.f, (x3 - b1_.y) * 16.f, lo_, true); \
              \
            LAS int* bp_ = (LAS int*)(wl + ((((F.lane >> 2) & 1) * 4 + ((F.lane >> 3) & 3)) * 64 + (F.lane >> 5) * 16 + 4 * (F.lane & 3))); bp_[0] = hi_; bp_[8] = lo_; } \
        asm volatile("" ::: "memory"); \
        i32x8 B_[4]; \
        _Pragma("unroll") for (int s_ = 0; s_ < 4; ++s_) { const LAS v4u* q_ = (const LAS v4u*)(wl + (half * 4 + s_) * 64 + (r32 & 1) * 32); const v4u c0_ = q_[0], c1_ = q_[1]; \
            B_[s_] = (i32x8){(int)c0_.x, (int)c0_.y, (int)c0_.z, (int)c0_.w, (int)c1_.x, (int)c1_.y, (int)c1_.z, (int)c1_.w}; } \
        asm volatile("" ::: "memory"); \
        v4u ar0_[4], ar1_[4]; f32x16 ac0_, ac1_; \
        PA_LN(AN, I1, 0, tn_); PA_W(AC, 0); PA_R(ar0_); PA_SB(); \
        PA_LN(AN, I1, 1, tn_); PA_W(AC, 1); PA_R(ar1_); PA_SB(); \
        PA_M(ar0_, ac0_); PA_SB(); \
        PA_LN(AN, I1, 2, tn_); PA_W(AC, 2); PA_R(ar0_); PA_SB(); \
        PA_M(ar1_, ac1_); PA_SB(); \
        PA_D(0, ac0_); PA_SB(); \
        PA_LN(AN, I1, 3, tn_); PA_W(AC, 3); PA_R(ar1_); PA_SB(); \
        PA_M(ar0_, ac0_); PA_SB(); \
        PA_D(1, ac1_); PA_SB(); \
        PA_M(ar1_, ac1_); PA_SB(); \
        PA_D(2, ac0_); PA_D(3, ac1_); \
        asm volatile("" ::: "memory"); \
        {   const LAS f32x2* rp_ = (const LAS f32x2*)(wl + 512) + F.lane; const f32x2 h_ = rp_[0], l_ = rp_[64]; \
            *(GAS f32x2*)(PART + ((size_t)((T) >> 13) * MREAL + ((T) & (MREAL - 1))) * 128 + 2 * F.lane) = (f32x2){h_.x + l_.x * 0.0625f, h_.y + l_.y * 0.0625f}; } \
        asm volatile("" ::: "memory"); \
    } while (0)
    if (t0 < tend) {
        const int tlast = t0 + ((tend - 1 - t0) / tstep) * tstep;
        v4u A0[4][4], A1[4][4]; int I0[16], I1[16]; unsigned long long HW0, HW1; float RS0, RS1;
        PA_IDX(I0, t0); PA_H(HW0, RS0, t0);
        { const int t1_ = PA_CL(t0 + tstep); PA_IDX(I1, t1_); }
        PA_LN(A0, I0, 0, t0); PA_LN(A0, I0, 1, t0); PA_LN(A0, I0, 2, t0); PA_LN(A0, I0, 3, t0);
#pragma unroll 1
        for (int t = t0; t < tend; t += 2 * tstep) {
            PA_TASK(A0, A1, I1, I0, HW0, RS0, HW1, RS1, t);
            { const int tb_ = PA_CL(t + tstep); PA_TASK(A1, A0, I0, I1, HW1, RS1, HW0, RS0, tb_); }
        }
    }
#undef PA_LN
#undef PA_W
#undef PA_R
#undef PA_M
#undef PA_D
#undef PA_SB
#undef PA_CL
#undef PA_IDX
#undef PA_H
#undef PA_TASK
}

__device__ __forceinline__ void axpy32p(f32x2* acc2, float w, const v4u& r) {
    const f32x2 w2 = {w, w};
#define A8P(W, T) { const f32x2 a_ = __builtin_amdgcn_cvt_scalef32_pk_f32_fp4((W), 1.0f, 0), b_ = __builtin_amdgcn_cvt_scalef32_pk_f32_fp4((W), 1.0f, 1), \
                                c_ = __builtin_amdgcn_cvt_scalef32_pk_f32_fp4((W), 1.0f, 2), d_ = __builtin_amdgcn_cvt_scalef32_pk_f32_fp4((W), 1.0f, 3); \
                    acc2[T] = __builtin_elementwise_fma(w2, a_, acc2[T]); acc2[T + 1] = __builtin_elementwise_fma(w2, b_, acc2[T + 1]); acc2[T + 2] = __builtin_elementwise_fma(w2, c_, acc2[T + 2]); acc2[T + 3] = __builtin_elementwise_fma(w2, d_, acc2[T + 3]); }
    A8P(r.x, 0) A8P(r.y, 4) A8P(r.z, 8) A8P(r.w, 12)
#undef A8P
}
__device__ __forceinline__ void p10_experts(Frame& F, float* dst) {
    const int* IDX = (const int*)(F.ws + WS_IDX); const float* GATE = (const float*)(F.ws + WS_GATE);
    const unsigned char* EV = F.ws + WS_EV; const float* PART = (const float*)(F.ws + WS_PART);
    const float* SU = (const float*)(F.ws + WS_SU); const float* SV = (const float*)(F.ws + WS_SV);
    for (int tok = F.gw; tok < MREAL; tok += F.NGW) {
        const int e0 = IDX[(size_t)tok * 128 + F.lane], e1 = IDX[(size_t)tok * 128 + 64 + F.lane];
        float d0 = 0.f, d1 = 0.f;
        const int pk = ((F.lane >> 2) & 3) * 32 + 8 * (F.lane & 3) + (F.lane >> 4);
#pragma unroll
        for (int x = 0; x < 8; ++x) { const float* pp = PART + ((size_t)x * MREAL + tok) * 128; d0 += pp[pk]; d1 += pp[pk + 4]; }
        const float w0 = GATE[(size_t)tok * 128 + F.lane] * SV[e0] * gelu1(d0 * SU[e0]), w1 = GATE[(size_t)tok * 128 + 64 + F.lane] * SV[e1] * gelu1(d1 * SU[e1]);
        f32x2 acc2[16];
#pragma unroll
        for (int i = 0; i < 16; ++i) acc2[i] = (f32x2){0.f, 0.f};
#define EIDX(k) __builtin_amdgcn_readlane((k) < 64 ? e0 : e1, (k) & 63)
#define WK(k) __int_as_float(__builtin_amdgcn_readlane(__float_as_int((k) < 64 ? w0 : w1), (k) & 63))
#define LOADV(R, k0) do { _Pragma("unroll") for (int i_ = 0; i_ < 4; ++i_) R[i_] = *(const GAS v4u*)(EV + (size_t)EIDX((k0) + i_) * 1024 + 16 * F.lane); } while (0)
        v4u R0[4], R1[4], R2[4], R3[4];
#define KCL(k) ((k) < 124 ? (k) : 124)
#define USEV(R, k0) do { _Pragma("unroll") for (int i_ = 0; i_ < 4; ++i_) { axpy32p(acc2, WK((k0) + i_), R[i_]); \
        asm volatile("" : "+v"(acc2[0]), "+v"(acc2[1]), "+v"(acc2[2]), "+v"(acc2[3]), "+v"(acc2[4]), "+v"(acc2[5]), "+v"(acc2[6]), "+v"(acc2[7]), "+v"(acc2[8]), "+v"(acc2[9]), "+v"(acc2[10]), "+v"(acc2[11]), "+v"(acc2[12]), "+v"(acc2[13]), "+v"(acc2[14]), "+v"(acc2[15])); \
        __builtin_amdgcn_sched_barrier(0); } } while (0)
        LOADV(R0, 0); LOADV(R1, 4); LOADV(R2, 8);
#pragma unroll 1
        for (int b = 0; b < 32; b += 4) {
            const int k0 = 4 * b;
            { const int kp = KCL(k0 + 12); LOADV(R3, kp); } __builtin_amdgcn_sched_barrier(0); USEV(R0, k0);
            { const int kp = KCL(k0 + 16); LOADV(R0, kp); } __builtin_amdgcn_sched_barrier(0); USEV(R1, k0 + 4);
            { const int kp = KCL(k0 + 20); LOADV(R1, kp); } __builtin_amdgcn_sched_barrier(0); USEV(R2, k0 + 8);
            { const int kp = KCL(k0 + 24); LOADV(R2, kp); } __builtin_amdgcn_sched_barrier(0); USEV(R3, k0 + 12);
        }
#undef KCL
#undef USEV
#undef EIDX
#undef WK
#undef LOADV
        { GAS f32x4* op = (GAS f32x4*)(F.out + (size_t)tok * DM) + F.lane; GAS f32x4* dp = (GAS f32x4*)(dst + (size_t)tok * DM) + F.lane;
#pragma unroll
          for (int j = 0; j < 8; ++j) { f32x4 a = op[64 * j];
              a[0] += acc2[2 * j].x; a[1] += acc2[2 * j].y; a[2] += acc2[2 * j + 1].x; a[3] += acc2[2 * j + 1].y; dp[64 * j] = a; } }
    }
}
struct Args { const float* in[23]; float* out; unsigned char* ws; int ph_lo, ph_hi, li, pad; };
__global__ void __launch_bounds__(NWAVES * 64, 2) mega_fwd(Args args) {
    extern __shared__ __attribute__((aligned(16))) unsigned char lds[];
    Frame F;
    F.lds = (LAS unsigned char*)lds;
    F.MISC = (volatile LAS unsigned*)(F.lds + MISC_OFF);
    F.tid = threadIdx.x; F.lane = F.tid & 63; F.wave = __builtin_amdgcn_readfirstlane(F.tid >> 6);
    F.G = gridDim.x; { const int bx = blockIdx.x; F.vcu = (F.G % 8 == 0) ? (bx % 8) * (F.G / 8) + bx / 8 : bx; }
    F.gw = F.vcu * NWAVES + F.wave; F.NGW = F.G * NWAVES;
#pragma unroll
    for (int i = 0; i < 23; ++i) F.in[i] = args.in[i];
    F.out = args.out; F.ws = args.ws;
    F.ctl = (gu32*)(args.ws + WS_CTL);
    for (int u = F.tid; u < (LDS_BYTES - LDSCTL_OFF) / 4; u += NWAVES * 64) ((LAS unsigned*)(F.lds + LDSCTL_OFF))[u] = 0u;
    __syncthreads();
    XcdBarrier bar; bar.bar = (unsigned*)(F.ctl + CW_BAR); bar.x = 0; bar.st = nullptr;
    if (N_LAUNCHES == 1) bar = xcd_barrier_post((unsigned*)(F.ctl + CW_BAR), F.MISC + 8);
#define GRID_BAR(seam) do { if (N_LAUNCHES != 1) { if (F.tid == 0) __hip_atomic_store(F.ctl + CW_TMO, 0xBADBA0u | (unsigned)(seam), RLX_AGENT); } else { xcd_barrier(bar); } } while (0)
    const int lo = args.ph_lo, hi = args.ph_hi;
#ifndef PH_MASK
#define PH_MASK 0x7ff
#endif
#define IN(k) ((((PH_MASK) >> (k)) & 1) && lo <= (k) && (k) < hi)
#define BOTH(k) (IN(k) && IN((k) + (((k) == 6 || (k) == 1) ? 2 : 1)))
#ifndef PH_REP_MASK
#define PH_REP_MASK 0
#endif
#define REPEAT(k) for (int rep_ = 0; rep_ < ((((PH_REP_MASK) >> (k)) & 1) ? 2 : 1); ++rep_)
    unsigned char* ws = args.ws;
    typedef pg8::bf16_t pb;
    if (IN(0)) { REPEAT(0) { p0_prologue(F); __syncthreads(); } if (BOTH(0)) GRID_BAR(0); }
    if (IN(1)) { REPEAT(1) {
        pg8::Gemm g{(const pb*)(ws + WS_XN), (const pb*)(ws + WS_WIN), M1, N1, DM, DM}; pg8::StaticOrder S; S.init(M1, N1, F.G, (int)blockIdx.x);
        Epi1 E{ws, (LAS float*)(F.lds + RING_BYTES), F.in[I_DKG], F.in[I_FKG]};
        pg8::gemm_phase<Epi1, pg8::StaticOrder, true, PG8_SP2>(F.lds + RING_OFF, g, S, E); }
        p1_tail(F);
        if (BOTH(1)) GRID_BAR(1);
    }
    if (IN(3)) { p3_attention<0>(F, (char*)lds + RING_OFF);
#if (PH_REP_MASK >> 3) & 1
        p3_attention<ATT_ABL>(F, (char*)lds + RING_OFF);
#endif
        if (BOTH(3)) GRID_BAR(3); }
    if (IN(4)) { REPEAT(4) { p4_combine(F); } if (BOTH(4)) GRID_BAR(4);
#if (PH_REP_MASK >> 11) & 1
        for (int xb_ = 0; xb_ < 10; ++xb_) GRID_BAR(4);
#endif
    }
    if (IN(5)) {
        { pg8::Gemm g{(const pb*)(ws + WS_OD), (const pb*)(ws + WS_WBD), MREAL, DM, 1024, 1024}; pg8::StaticOrder S; S.init(MREAL, DM, F.G, (int)blockIdx.x);
          pg8::EpiGen<F_Gemm2a> E{F_Gemm2a{(const bf16*)(ws + WS_GA), F.in[I_BGATE], (bf16*)(ws + WS_MG)}};
          pg8::gemm_phase<pg8::EpiGen<F_Gemm2a>, pg8::StaticOrder, PG8_ALIGN, PG8_SP2>(F.lds + RING_OFF, g, S, E); }
        { pg8::Gemm g{(const pb*)(ws + WS_OF), (const pb*)(ws + WS_WBF), MREAL, DM, 1024, 1024}; pg8::StaticOrder S; S.init(MREAL, DM, F.G, (int)blockIdx.x);
          pg8::EpiGen<F_Gemm2b> E{F_Gemm2b{(const bf16*)(ws + WS_GB), F.in[I_BGATE] + DM, (bf16*)(ws + WS_MG)}};
          pg8::gemm_phase<pg8::EpiGen<F_Gemm2b>, pg8::StaticOrder, PG8_ALIGN, PG8_SP2>(F.lds + RING_OFF, g, S, E); }
#if (PH_REP_MASK >> 5) & 1
        { pg8::Gemm g{(const pb*)(ws + WS_OD), (const pb*)(ws + WS_WBD), MREAL, DM, 1024, 1024}; pg8::StaticOrder S; S.init(MREAL, DM, F.G, (int)blockIdx.x);
          pg8::EpiGen<F_Gemm2a> E{F_Gemm2a{(const bf16*)(ws + WS_GA), F.in[I_BGATE], (bf16*)(ws + WS_MG)}};
          pg8::gemm_phase<pg8::EpiGen<F_Gemm2a>, pg8::StaticOrder, PG8_ALIGN, PG8_SP2>(F.lds + RING_OFF, g, S, E); }
        { pg8::Gemm g{(const pb*)(ws + WS_OF), (const pb*)(ws + WS_WBF), MREAL, DM, 1024, 1024}; pg8::StaticOrder S; S.init(MREAL, DM, F.G, (int)blockIdx.x);
          pg8::EpiGen<F_Gemm2b> E{F_Gemm2b{(const bf16*)(ws + WS_GB), F.in[I_BGATE] + DM, (bf16*)(ws + WS_MG)}};
          pg8::gemm_phase<pg8::EpiGen<F_Gemm2b>, pg8::StaticOrder, PG8_ALIGN, PG8_SP2>(F.lds + RING_OFF, g, S, E); }
#endif
        if (BOTH(5)) GRID_BAR(5);
    }
    if (IN(6)) {
        {
        pg8::Gemm g{(const pb*)(ws + WS_MG), (const pb*)(ws + WS_WOUT), MREAL, DM, DM, DM}; pg8::StaticOrder S; S.init(MREAL, DM, F.G, (int)blockIdx.x);
        pg8::EpiGen<F_Gemm3> E{F_Gemm3{F.in[I_X], F.out, F.in[I_GPEER], (bf16*)(ws + WS_H2N), (float*)(ws + WS_SSQ), 0.f}};
        pg8::gemm_phase<pg8::EpiGen<F_Gemm3>, pg8::StaticOrder, PG8_ALIGN, PG8_SP2>(F.lds + RING_OFF, g, S, E);
        }
#if (PH_REP_MASK >> 6) & 1
        {
        pg8::Gemm g{(const pb*)(ws + WS_MG), (const pb*)(ws + WS_WOUT), MREAL, DM, DM, DM}; pg8::StaticOrder S; S.init(MREAL, DM, F.G, (int)blockIdx.x);
        pg8::EpiGen<F_Gemm3> E{F_Gemm3{F.in[I_X], F.out, F.in[I_GPEER], (bf16*)(ws + WS_H2N), (float*)(ws + WS_SSQ), 0.f}};
        pg8::gemm_phase<pg8::EpiGen<F_Gemm3>, pg8::StaticOrder, PG8_ALIGN, PG8_SP2>(F.lds + RING_OFF, g, S, E);
        }
#endif
        if (BOTH(6)) GRID_BAR(6);
    }
    if (IN(8)) {
        {
        pg8::Gemm g{(const pb*)(ws + WS_H2N), (const pb*)(ws + WS_WPQ), MREAL, 1024, 1024, DM}; SplitK2Order S; S.init(MREAL, 1024, F.G, (int)blockIdx.x);
        pg8::EpiGen<F_Gemm4> E{F_Gemm4{(float*)(ws + WS_QP)}};
        pg8::gemm_phase<pg8::EpiGen<F_Gemm4>, SplitK2Order, PG8_ALIGN, PG8_SP2>(F.lds + RING_OFF, g, S, E);
        }
#if (PH_REP_MASK >> 8) & 1
        {
        pg8::Gemm g{(const pb*)(ws + WS_H2N), (const pb*)(ws + WS_WPQ), MREAL, 1024, 1024, DM}; SplitK2Order S; S.init(MREAL, 1024, F.G, (int)blockIdx.x);
        pg8::EpiGen<F_Gemm4> E{F_Gemm4{(float*)(ws + WS_QP)}};
        pg8::gemm_phase<pg8::EpiGen<F_Gemm4>, SplitK2Order, PG8_ALIGN, PG8_SP2>(F.lds + RING_OFF, g, S, E);
        }
#endif
        if (BOTH(8)) GRID_BAR(8);
    }
    if (IN(9)) { REPEAT(9) { p9_route(F); } if (BOTH(9)) GRID_BAR(9); }
    if (IN(10)) { for (int rp_ = 0; rp_ < ((((PH_REP_MASK) >> 12) & 1) ? 2 : 1); ++rp_) p10a_udots(F); GRID_BAR(10); REPEAT(10) { p10_experts(F, (rep_ == 0 && ((PH_REP_MASK >> 10) & 1)) ? (float*)(ws + WS_T) : F.out); } }
#undef IN
#undef BOTH
}

extern "C" void kernel_launch(void* const* d_in, const int* in_sizes, int n_in, void* d_out, int out_size, void* d_ws, size_t ws_size, hipStream_t stream) {
    static int grid = 0;
    if (grid == 0) {
        if (n_in != 23 || in_sizes[0] != MREAL * DM || out_size != MREAL * DM || ws_size < WS_END) {
            fprintf(stderr, "kernel_launch: built for 23 inputs, x/out of %d floats, >= %zu bytes of workspace; got n_in %d, in0 %d, out %d, ws %zu; nothing launched\n", MREAL * DM, (size_t)WS_END, n_in, n_in > 0 ? in_sizes[0] : -1, out_size, ws_size); grid = -1; return; }
        int dev = 0, cus = 0, per_cu = 0;
        if (hipGetDevice(&dev) != hipSuccess || hipDeviceGetAttribute(&cus, hipDeviceAttributeMultiprocessorCount, dev) != hipSuccess) { fprintf(stderr, "kernel_launch: device query failed\n"); grid = -1; return; }
        if (hipFuncSetAttribute((const void*)mega_fwd, hipFuncAttributeMaxDynamicSharedMemorySize, LDS_BYTES) != hipSuccess) { fprintf(stderr, "kernel_launch: hipFuncSetAttribute failed\n"); grid = -1; return; }
        if (hipOccupancyMaxActiveBlocksPerMultiprocessor(&per_cu, (const void*)mega_fwd, NWAVES * 64, LDS_BYTES) != hipSuccess || per_cu < 1) {
            fprintf(stderr, "kernel_launch: occupancy query reports %d workgroups per CU; nothing launched\n", per_cu); (void)hipGetLastError(); grid = -1; return; }
        grid = cus;
    }
    if (grid < 0) return;
    if (hipMemsetAsync((char*)d_ws + WS_CTL, 0, CTL_ZERO_BYTES, stream) != hipSuccess) { fprintf(stderr, "kernel_launch: hipMemsetAsync failed\n"); return; }
    Args a{};
    for (int i = 0; i < 23; ++i) a.in[i] = (const float*)d_in[i];
    a.out = (float*)d_out; a.ws = (unsigned char*)d_ws;
    for (int li = 0; li < N_LAUNCHES; ++li) {
        a.ph_lo = (N_LAUNCHES == 1) ? 0 : li; a.ph_hi = (N_LAUNCHES == 1) ? N_PHASES : li + 1; a.li = li;
        hipLaunchKernelGGL(mega_fwd, dim3(grid), dim3(NWAVES * 64), LDS_BYTES, stream, a);
        const hipError_t le = hipPeekAtLastError();
        if (le != hipSuccess) { fprintf(stderr, "kernel_launch: launch %d failed: %s\n", li, hipGetErrorName(le)); break; }
    }
}
```

```cpp
#include <hip/hip_runtime.h>
#include <cstdio>
#include <cstdint>
#include <cmath>
#define PH_REP_MASK 0x0
#define ATT_ABL 0
namespace pg8 {
#define PG8_LAS __attribute__((address_space(3)))
typedef unsigned short bf16_t;
typedef short bf16x8 __attribute__((ext_vector_type(8)));
typedef float f32x4 __attribute__((ext_vector_type(4)));
typedef unsigned u32x4 __attribute__((ext_vector_type(4)));
constexpr int BM = 256, BK = 64, HALF = 128, HTB = HALF * BK * 2  , STAGE_BYTES = 8 * HTB, NXCD = 8, WGM = 8;

__host__ __device__ __forceinline__ int lds_byte(int r, int c) { const int st = (r >> 4) * 2 + (c >> 5), rr = r & 15, cc = c & 31, ob = rr * 64 + cc * 2; return st * 1024 + (ob ^ (((ob >> 9) & 1) << 5)); }
__host__ __device__ __forceinline__ void stage_rc(int b, int& R, int& C) { const int st = b / 1024, sb = b % 1024, swz = sb ^ (((sb >> 9) & 1) << 5); R = (st >> 1) * 16 + swz / 64; C = (st & 1) * 32 + (swz % 64) / 2; }
__host__ __device__ __forceinline__ int perm32(int rho) { const int n = rho >> 4, i = rho & 15; return 8 * (i >> 2) + 4 * n + (i & 3); }

struct Unit { int pm, pn, ko, kob, chain; };
struct Gemm { const bf16_t* A; const bf16_t* Bt; int M, N, K, ld; };

struct StaticOrder {
    int nM, nN, nwg, G, c;
    __host__ __device__ void init(int M, int N, int G_, int c_) { nM = M / BM; nN = N / BM; nwg = nM * nN; G = G_; c = c_; }
    __host__ __device__ bool next(int i, Unit& u) const {
        const long L = (long)i * G + c; if (L >= nwg) return false;
        int wgid = (int)L; { const int q = nwg / NXCD, r = nwg % NXCD, xcd = wgid % NXCD, off = wgid / NXCD; wgid = (xcd < r ? xcd * (q + 1) : r * (q + 1) + (xcd - r) * q) + off; }
        const int nig = WGM * nN, gid = wgid / nig, fm = gid * WGM, gsz = (nM - fm) < WGM ? (nM - fm) : WGM;
        u.pm = fm + ((wgid % nig) % gsz); u.pn = (wgid % nig) / gsz; u.ko = 0; u.kob = 0; u.chain = 0; return true;
    }
    __device__ __forceinline__ void a_ready(const Unit&) const {}
    __device__ __forceinline__ void done(const Unit&) const {}
};
__device__ __forceinline__ unsigned cvt_pk_bf16(float lo, float hi) { unsigned r; asm volatile("v_cvt_pk_bf16_f32 %0, %1, %2" : "=v"(r) : "v"(lo), "v"(hi)); return r; }
typedef float f32x2 __attribute__((ext_vector_type(2)));
template <class F> struct EpiGen {
    static constexpr bool PERM = true, AFTER_DRAIN = false;
    F f;
    __device__ __forceinline__ void operator()(const f32x4 (&acc)[2][2][4][2], const Unit& u, int wr, int wc, int fr, int fq) const {
        F g = f; if (!g.begin(u)) return;
        asm volatile("" : "+v"(fr), "+v"(fq));
#pragma unroll
        for (int ai = 0; ai < 2; ++ai)
#pragma unroll
            for (int m = 0; m < 4; ++m) { const int rt = ai * HALF + wr * 64 + m * 16 + fr; g.row_begin();
#pragma unroll
                for (int bj = 0; bj < 2; ++bj) g.chunk(u, rt, bj * HALF + wc * 32 + 8 * fq, acc[ai][bj][m][0], acc[ai][bj][m][1]);
                g.row_end(u, rt, wc, fq); }
    }
    __device__ __forceinline__ void scale(f32x4 (&acc)[2][2][4][2], const Unit& u, int wr, int wc, int fr, int fq) const {
        F g = f;
        asm volatile("" : "+v"(fr), "+v"(fq));
#pragma unroll
        for (int ai = 0; ai < 2; ++ai)
#pragma unroll
            for (int m = 0; m < 4; ++m) { const int rt = ai * HALF + wr * 64 + m * 16 + fr;
#pragma unroll
                for (int bj = 0; bj < 2; ++bj) g.scale_chunk(u, rt, bj * HALF + wc * 32 + 8 * fq, acc[ai][bj][m][0], acc[ai][bj][m][1]);
                asm volatile("" ::: "memory"); __builtin_amdgcn_sched_barrier(0); }
    }
};
template <class Epi, class Sched, bool ALIGN_EPI = false, bool SP2 = false>
__device__ __forceinline__ void gemm_phase(PG8_LAS unsigned char* lds, const Gemm g, const Sched& S, const Epi& E) {
    const int tid = threadIdx.x, wid = __builtin_amdgcn_readfirstlane(tid >> 6), lane = tid & 63, wr = wid >> 2, wc = wid & 3, fr = lane & 15, fq = lane >> 4;
    const int K = g.K, nt = K / BK, LD = g.ld;
    unsigned voffA[2], voffB[2];
#pragma unroll
    for (int i = 0; i < 2; ++i) { int R, C; stage_rc(tid * 16 + i * 8192, R, C); const int Rb = Epi::PERM ? ((R & ~31) + perm32(R & 31)) : R;
        voffA[i] = (unsigned)(R * LD + C) * 2u; voffB[i] = (unsigned)(Rb * LD + C) * 2u; }
    const size_t kstep = (size_t)(BK * 2);
    const size_t hstep = (size_t)HALF * LD * 2;
    const size_t tstep = 2 * hstep;
    const unsigned ldsw = (unsigned)wid * 1024u;
    const int aoff = lds_byte(wr * 64 + fr, fq * 8), boff = lds_byte(wc * 32 + fr, fq * 8);
#define PG8_SA(b, h) (((b) * 2 + (h)) * HTB)
#define PG8_SB(b, h) ((4 + (b) * 2 + (h)) * HTB)
#define PG8_STAGE(bufoff, gbase, voff) do { _Pragma("unroll") for (int _i = 0; _i < 2; ++_i) \
        __builtin_amdgcn_global_load_lds((const unsigned*)((const char*)(gbase) + (voff)[_i]), (PG8_LAS unsigned*)(lds + (bufoff) + ldsw + _i * 8192), 16, 0, 0); } while (0)
#define PG8_LDA(dst, b, h) do { _Pragma("unroll") for (int m = 0; m < 4; ++m) _Pragma("unroll") for (int k = 0; k < 2; ++k) dst[m][k] = *(const PG8_LAS bf16x8*)(lds + PG8_SA(b, h) + aoff + m * 2048 + k * 1024); } while (0)
#define PG8_LDB(dst, b, h) do { _Pragma("unroll") for (int n = 0; n < 2; ++n) _Pragma("unroll") for (int k = 0; k < 2; ++k) dst[n][k] = *(const PG8_LAS bf16x8*)(lds + PG8_SB(b, h) + boff + n * 2048 + k * 1024); } while (0)
#define PG8_MMA(ai, bj, At, Bt) do { __builtin_amdgcn_s_setprio(1); _Pragma("unroll") for (int m = 0; m < 4; ++m) _Pragma("unroll") for (int n = 0; n < 2; ++n) _Pragma("unroll") for (int k = 0; k < 2; ++k) \
        acc[ai][bj][m][n] = __builtin_amdgcn_mfma_f32_16x16x32_bf16(Bt[n][k], At[m][k], acc[ai][bj][m][n], 0, 0, 0); __builtin_amdgcn_s_setprio(0); } while (0)
#define PG8_WAIT_V(n) asm volatile("s_waitcnt vmcnt(" #n ")" ::: "memory")
#define PG8_WAIT_L(n) asm volatile("s_waitcnt lgkmcnt(" #n ")" ::: "memory")
#define PG8_BAR __builtin_amdgcn_s_barrier()
#define PG8_SCHED __builtin_amdgcn_sched_barrier(0)
    Unit cur, nxt; int ui = 0;
    if (!S.next(0, cur)) return;
    f32x4 acc[2][2][4][2];
#pragma unroll
    for (int a = 0; a < 2; ++a)
#pragma unroll
        for (int b = 0; b < 2; ++b)
#pragma unroll
            for (int m = 0; m < 4; ++m)
#pragma unroll
                for (int n = 0; n < 2; ++n) acc[a][b][m][n] = (f32x4){0.f, 0.f, 0.f, 0.f};
    bf16x8 At[4][2], B0[2][2], B1[2][2];
    const char* cA = (const char*)g.A + (size_t)cur.pm * tstep + cur.ko; const char* cB = (const char*)g.Bt + (size_t)cur.pn * tstep + cur.kob;
    S.a_ready(cur);
    if constexpr (SP2) {
        PG8_STAGE(PG8_SB(0, 0), cB, voffB); PG8_STAGE(PG8_SB(0, 1), cB + hstep, voffB); PG8_STAGE(PG8_SA(0, 0), cA, voffA); PG8_STAGE(PG8_SA(0, 1), cA + hstep, voffA);
        if (wr == 1) PG8_BAR;
        PG8_WAIT_V(2); PG8_BAR;
        PG8_STAGE(PG8_SB(1, 0), cB + kstep, voffB); PG8_STAGE(PG8_SA(1, 0), cA + kstep, voffA); PG8_STAGE(PG8_SB(1, 1), cB + hstep + kstep, voffB);
        PG8_WAIT_V(6); PG8_BAR;
    } else {
        PG8_STAGE(PG8_SB(0, 0), cB, voffB); PG8_STAGE(PG8_SA(0, 0), cA, voffA); PG8_STAGE(PG8_SB(0, 1), cB + hstep, voffB); PG8_STAGE(PG8_SA(0, 1), cA + hstep, voffA);
        if (wr == 1) PG8_BAR;
        PG8_WAIT_V(4); PG8_BAR;
        PG8_STAGE(PG8_SB(1, 0), cB + kstep, voffB); PG8_STAGE(PG8_SA(1, 0), cA + kstep, voffA); PG8_STAGE(PG8_SB(1, 1), cB + hstep + kstep, voffB);
        PG8_WAIT_V(6); PG8_BAR;
    }
    for (;;) {
        const bool has_next = S.next(ui + 1, nxt);
        const char* nA = has_next ? (const char*)g.A + (size_t)nxt.pm * tstep + nxt.ko : cA; const char* nB = has_next ? (const char*)g.Bt + (size_t)nxt.pn * tstep + nxt.kob : cB;
        for (int t = 0; t < nt; t += 2) {
            const bool last = (t == nt - 2);
            const char* a1 = cA + (size_t)(t + 1) * kstep;
            const char* a2 = last ? nA : cA + (size_t)(t + 2) * kstep; const char* b2 = last ? nB : cB + (size_t)(t + 2) * kstep;
            const char* a3 = a2 + kstep; const char* b3 = b2 + kstep;
            if (last && has_next) S.a_ready(nxt);
            if constexpr (SP2) {
            PG8_LDB(B0, 0, 0); PG8_LDB(B1, 0, 1); PG8_SCHED; PG8_LDA(At, 0, 0); PG8_STAGE(PG8_SA(1, 1), a1 + hstep, voffA);
            PG8_WAIT_V(8); PG8_WAIT_L(0); PG8_BAR; PG8_MMA(0, 0, At, B0); PG8_MMA(0, 1, At, B1); PG8_BAR; PG8_SCHED;
            PG8_LDA(At, 0, 1); PG8_STAGE(PG8_SB(0, 0), b2, voffB); PG8_STAGE(PG8_SB(0, 1), b2 + hstep, voffB); PG8_STAGE(PG8_SA(0, 0), a2, voffA);
            PG8_WAIT_V(8); PG8_WAIT_L(0); PG8_BAR; PG8_MMA(1, 0, At, B0); PG8_MMA(1, 1, At, B1); PG8_BAR; PG8_SCHED;
            PG8_LDB(B0, 1, 0); PG8_LDB(B1, 1, 1); PG8_SCHED; PG8_LDA(At, 1, 0); PG8_STAGE(PG8_SA(0, 1), a2 + hstep, voffA);
            PG8_WAIT_V(8); PG8_WAIT_L(0); PG8_BAR; PG8_MMA(0, 0, At, B0); PG8_MMA(0, 1, At, B1); PG8_BAR; PG8_SCHED;
            PG8_LDA(At, 1, 1); PG8_STAGE(PG8_SB(1, 0), b3, voffB); PG8_STAGE(PG8_SB(1, 1), b3 + hstep, voffB); PG8_STAGE(PG8_SA(1, 0), a3, voffA);
            PG8_WAIT_V(8); PG8_WAIT_L(0); PG8_BAR; PG8_MMA(1, 0, At, B0); PG8_MMA(1, 1, At, B1); PG8_BAR; PG8_SCHED;
            } else {
            PG8_LDB(B0, 0, 0); PG8_SCHED; PG8_LDA(At, 0, 0); PG8_STAGE(PG8_SA(1, 1), a1 + hstep, voffA);
            PG8_WAIT_L(8); PG8_BAR; PG8_WAIT_L(0); PG8_MMA(0, 0, At, B0); PG8_BAR; PG8_SCHED;
            PG8_LDB(B1, 0, 1); PG8_STAGE(PG8_SB(0, 0), b2, voffB);
            PG8_BAR; PG8_WAIT_L(0); PG8_MMA(0, 1, At, B1); PG8_BAR;
            PG8_LDA(At, 0, 1); PG8_STAGE(PG8_SA(0, 0), a2, voffA);
            PG8_BAR; PG8_WAIT_L(0); PG8_MMA(1, 0, At, B0); PG8_BAR; PG8_SCHED;
            PG8_STAGE(PG8_SB(0, 1), b2 + hstep, voffB);
            PG8_WAIT_V(6); PG8_BAR; PG8_MMA(1, 1, At, B1); PG8_BAR;
            PG8_LDB(B0, 1, 0); PG8_SCHED; PG8_LDA(At, 1, 0); PG8_STAGE(PG8_SA(0, 1), a2 + hstep, voffA);
            PG8_WAIT_L(8); PG8_BAR; PG8_WAIT_L(0); PG8_MMA(0, 0, At, B0); PG8_BAR; PG8_SCHED;
            PG8_LDB(B1, 1, 1); PG8_STAGE(PG8_SB(1, 0), b3, voffB);
            PG8_BAR; PG8_WAIT_L(0); PG8_MMA(0, 1, At, B1); PG8_BAR;
            PG8_LDA(At, 1, 1); PG8_STAGE(PG8_SA(1, 0), a3, voffA);
            PG8_BAR; PG8_WAIT_L(0); PG8_MMA(1, 0, At, B0); PG8_BAR; PG8_SCHED;
            PG8_STAGE(PG8_SB(1, 1), b3 + hstep, voffB);
            PG8_WAIT_V(6); PG8_BAR; PG8_MMA(1, 1, At, B1); PG8_BAR;
            }
        }
        if constexpr (ALIGN_EPI) { if (wr == 0) PG8_BAR; }
        if constexpr (!Epi::AFTER_DRAIN) { if (cur.chain) E.scale(acc, cur, wr, wc, fr, fq); else E(acc, cur, wr, wc, fr, fq); S.done(cur); }
        if (!has_next) break;
        if (!cur.chain)
#pragma unroll
        for (int a = 0; a < 2; ++a)
#pragma unroll
            for (int b = 0; b < 2; ++b)
#pragma unroll
                for (int m = 0; m < 4; ++m)
#pragma unroll
                    for (int n = 0; n < 2; ++n) acc[a][b][m][n] = (f32x4){0.f, 0.f, 0.f, 0.f};
        cur = nxt; cA = nA; cB = nB; ++ui;
        if constexpr (ALIGN_EPI) { if (wr == 1) PG8_BAR; }
    }
    PG8_WAIT_V(0);
    if constexpr (!ALIGN_EPI) { if (wr == 0) PG8_BAR; }
    PG8_BAR;
    if constexpr (Epi::AFTER_DRAIN) { E.fused(acc, cur, wr, wc, fr, fq, lds, wid, lane); S.done(cur); }
#undef PG8_SA
#undef PG8_SB
#undef PG8_STAGE
#undef PG8_LDA
#undef PG8_LDB
#undef PG8_MMA
#undef PG8_WAIT_V
#undef PG8_WAIT_L
#undef PG8_BAR
#undef PG8_SCHED
}
}
#ifndef PG8_SP2
#define PG8_SP2 true
#endif
#ifndef PG8_ALIGN
#define PG8_ALIGN true
#endif
namespace att {
typedef unsigned short bf16;
typedef short bf16x8 __attribute__((ext_vector_type(8)));
typedef short s16x4 __attribute__((ext_vector_type(4)));
typedef float f32x16 __attribute__((ext_vector_type(16)));
typedef float f32x4 __attribute__((ext_vector_type(4)));
typedef unsigned u32x4 __attribute__((ext_vector_type(4)));
constexpr int NW = 8, QBLK = 32, KVBLK = 64, QB = NW * QBLK, D = 128, PITCH = 1024;
constexpr int SHM_V = KVBLK * D * 2, SHM_K = KVBLK * D * 2;
constexpr int NBUF = 3;
constexpr int OFF_V = 0, OFF_K = NBUF * SHM_V, OFF_WS = OFF_K + NBUF * SHM_K, OFF_B = OFF_WS + NW * 64 * 4, LDS_BYTES = OFF_B + NBUF * 256;
constexpr float THR = 8.f;
#define KSWZ(row, colB) ((row) * 256 + ((colB) ^ (((row) & 7) << 4)))
#define SBAR() __builtin_amdgcn_sched_barrier(0)
__device__ __forceinline__ int v_st(int k, int c) { const int kk = (k & ~0xC) | ((k & 4) << 1) | ((k & 8) >> 1); return ((kk >> 3) * 4 + (c >> 5)) * 512 + ((kk & 7) * 32 + (c & 31)) * 2; }
__device__ __forceinline__ int v_rd_base(int lane) { return ((lane & 3) << 3) | (((lane >> 2) & 3) << 6) | (((lane >> 4) & 1) << 5) | (((lane >> 5) & 1) << 8); }
constexpr int v_rd_off(int d0, int ks, int half) { return d0 * 512 + ks * 4096 + half * 2048; }
__device__ __forceinline__ int crow(int r, int hi) { return (r & 3) + 8 * (r >> 2) + 4 * hi; }
__device__ __forceinline__ unsigned cvtpk(float lo, float hi) {
    unsigned r; asm volatile("v_cvt_pk_bf16_f32 %0, %1, %2" : "=v"(r) : "v"(lo), "v"(hi)); return r;
}
__device__ __forceinline__ bf16x8 load8(const bf16* p) { return *reinterpret_cast<const bf16x8*>(p); }
__device__ __forceinline__ void mask_tile(f32x16& p0, f32x16& p1, int dq, unsigned W) {
    const float NEG = -__builtin_inff();
#pragma unroll
    for (int r = 0; r < 16; ++r) {
        const int c = (r & 3) + 8 * (r >> 2);
        if ((unsigned)(dq - c) >= W) p0[r] = NEG;
        if ((unsigned)(dq - c - 32) >= W) p1[r] = NEG;
    }
}
template <int DQK>
__device__ __forceinline__ void partialSM(f32x16& p0, f32x16& p1, float& m_reg, float& mn, float& alpha) {
    constexpr float SCALE = DQK == 64 ? 0.125f : 0.08838834764831845f;
    float pmax;
    { float m0 = fmaxf(p0[0], p0[4]), m1 = fmaxf(p0[1], p0[5]), m2 = fmaxf(p0[2], p0[6]), m3 = fmaxf(p0[3], p0[7]);
#pragma unroll
      for (int r = 8; r < 16; r += 4) { m0 = fmaxf(m0, p0[r]); m1 = fmaxf(m1, p0[r + 1]); m2 = fmaxf(m2, p0[r + 2]); m3 = fmaxf(m3, p0[r + 3]); }
#pragma unroll
      for (int r = 0; r < 16; r += 4) { m0 = fmaxf(m0, p1[r]); m1 = fmaxf(m1, p1[r + 1]); m2 = fmaxf(m2, p1[r + 2]); m3 = fmaxf(m3, p1[r + 3]); }
      pmax = fmaxf(fmaxf(m0, m1), fmaxf(m2, m3)); }
    { auto rr = __builtin_amdgcn_permlane32_swap(__float_as_uint(pmax), __float_as_uint(pmax), false, false);
      pmax = fmaxf(__uint_as_float(rr[0]), __uint_as_float(rr[1])); }
    constexpr float C2 = 1.4426950408889634f * SCALE;
    if (__builtin_expect(__all((pmax - m_reg) * SCALE <= THR), 1)) { mn = m_reg; alpha = 1.f; }
    else { mn = fmaxf(m_reg, pmax); alpha = __builtin_amdgcn_exp2f((m_reg - mn) * C2); m_reg = mn; }
    const float mnL = -mn * C2;
    for (int r = 0; r < 16; ++r) p0[r] = fmaf(p0[r], C2, mnL); for (int r = 0; r < 16; ++r) p1[r] = fmaf(p1[r], C2, mnL);
    for (int r = 0; r < 16; ++r) p0[r] = __builtin_amdgcn_exp2f(p0[r]);
}
__device__ __forceinline__ void finishSM(f32x16& p0, f32x16& p1, float alpha, float& l_reg, bf16x8& pa0, bf16x8& pa1, bf16x8& pa2, bf16x8& pa3) {
    for (int r = 0; r < 16; ++r) p1[r] = __builtin_amdgcn_exp2f(p1[r]);
    float ps;
    { float s0 = p0[0] + p1[0], s1 = p0[1] + p1[1], s2 = p0[2] + p1[2], s3 = p0[3] + p1[3];
#pragma unroll
      for (int r = 4; r < 16; r += 4) { s0 += p0[r]; s1 += p0[r + 1]; s2 += p0[r + 2]; s3 += p0[r + 3]; s0 += p1[r]; s1 += p1[r + 1]; s2 += p1[r + 2]; s3 += p1[r + 3]; }
      ps = (s0 + s1) + (s2 + s3); }
    { auto rr = __builtin_amdgcn_permlane32_swap(__float_as_uint(ps), __float_as_uint(ps), false, false);
      ps = __uint_as_float(rr[0]) + __uint_as_float(rr[1]); }
    l_reg = l_reg * alpha + ps;
#define PK4(P, B_, OUT) do { unsigned a0 = cvtpk(P[B_+0], P[B_+1]), a1 = cvtpk(P[B_+2], P[B_+3]);                          \
        unsigned b0 = cvtpk(P[B_+4], P[B_+5]), b1 = cvtpk(P[B_+6], P[B_+7]);                                             \
        auto r0 = __builtin_amdgcn_permlane32_swap(a0, b0, false, false); auto r1 = __builtin_amdgcn_permlane32_swap(a1, b1, false, false); \
        u32x4 w = {r0[0], r1[0], r0[1], r1[1]}; OUT = *reinterpret_cast<bf16x8*>(&w); } while (0)
    PK4(p0, 0, pa0); PK4(p0, 8, pa1); PK4(p1, 0, pa2); PK4(p1, 8, pa3);
#undef PK4
}
template <int KB, int DQK>
__device__ __forceinline__ void qkt(f32x16& p0, f32x16& p1, const unsigned (&kaddr)[4], const char* B_lds, int r32, int hi, const bf16x8* qr, bool use_bias) {
    const char* bb = B_lds + KB * 256 + hi * 16;
    if (!use_bias) { p0 = f32x16{}; p1 = f32x16{}; } else
#pragma unroll
    for (int g = 0; g < 4; ++g) { const f32x4 t0 = *reinterpret_cast<const f32x4*>(bb + 32 * g), t1 = *reinterpret_cast<const f32x4*>(bb + 32 * g + 128);
        p0[4 * g] = t0[0]; p0[4 * g + 1] = t0[1]; p0[4 * g + 2] = t0[2]; p0[4 * g + 3] = t0[3];
        p1[4 * g] = t1[0]; p1[4 * g + 1] = t1[1]; p1[4 * g + 2] = t1[2]; p1[4 * g + 3] = t1[3]; }
#define KRD(dst, dd, off) asm volatile("ds_read_b128 %0, %1 offset:%2" : "=v"(dst) : "v"(kaddr[dd]), "i"(off) : "memory")
#define KGRP(S, g) do { KRD(S[0], (2 * (g)) & 3, KB * SHM_K + ((g) >> 1) * 128); KRD(S[1], (2 * (g)) & 3, KB * SHM_K + ((g) >> 1) * 128 + 32 * 256);                 \
                        KRD(S[2], (2 * (g) + 1) & 3, KB * SHM_K + ((g) >> 1) * 128); KRD(S[3], (2 * (g) + 1) & 3, KB * SHM_K + ((g) >> 1) * 128 + 32 * 256); } while (0)
#define KWAIT(N, S) do { asm volatile("s_waitcnt lgkmcnt(" #N ")" : "+v"(S[0]), "+v"(S[1]), "+v"(S[2]), "+v"(S[3]) :: "memory"); SBAR(); } while (0)
#define KMM(S, g) do { p0 = __builtin_amdgcn_mfma_f32_32x32x16_bf16(S[0], qr[2 * (g)], p0, 0, 0, 0); p1 = __builtin_amdgcn_mfma_f32_32x32x16_bf16(S[1], qr[2 * (g)], p1, 0, 0, 0);             \
                       p0 = __builtin_amdgcn_mfma_f32_32x32x16_bf16(S[2], qr[2 * (g) + 1], p0, 0, 0, 0); p1 = __builtin_amdgcn_mfma_f32_32x32x16_bf16(S[3], qr[2 * (g) + 1], p1, 0, 0, 0); SBAR(); } while (0)
    bf16x8 ka[4], kb[4];
    KGRP(ka, 0); KGRP(kb, 1);
    if constexpr (DQK == 128) {
        bf16x8 kc[4];
        KGRP(kc, 2);
        KWAIT(8, ka); KMM(ka, 0); KGRP(ka, 3);
        KWAIT(8, kb); KMM(kb, 1);
        KWAIT(4, kc); KMM(kc, 2);
        KWAIT(0, ka); KMM(ka, 3);
    } else {
        KWAIT(4, ka); KMM(ka, 0);
        KWAIT(0, kb); KMM(kb, 1);
    }
#undef KGRP
#undef KWAIT
#undef KMM
#undef KRD
}
template <int VB>
__device__ __forceinline__ void pv_tile(f32x16* o, int vb0, bf16x8 pa0, bf16x8 pa1, bf16x8 pa2, bf16x8 pa3) {
#define TRRD(dst, off) asm volatile("ds_read_b64_tr_b16 %0, %1 offset:%2" : "=&v"(dst) : "v"(vb0), "i"(off) : "memory")
#define PV_RD(S, d0) do { constexpr int b_ = VB * SHM_V + v_rd_off(d0, 0, 0);     \
        TRRD(S[0], b_); TRRD(S[1], b_ + 2048); TRRD(S[2], b_ + 4096); TRRD(S[3], b_ + 6144); TRRD(S[4], b_ + 8192); TRRD(S[5], b_ + 10240); TRRD(S[6], b_ + 12288); TRRD(S[7], b_ + 14336); } while (0)
#define PV_MM(S, d0) do {                                                                                                                   \
        o[d0] = __builtin_amdgcn_mfma_f32_32x32x16_bf16(pa0, (bf16x8){S[0][0], S[0][1], S[0][2], S[0][3], S[1][0], S[1][1], S[1][2], S[1][3]}, o[d0], 0, 0, 0);   \
        o[d0] = __builtin_amdgcn_mfma_f32_32x32x16_bf16(pa1, (bf16x8){S[2][0], S[2][1], S[2][2], S[2][3], S[3][0], S[3][1], S[3][2], S[3][3]}, o[d0], 0, 0, 0);   \
        o[d0] = __builtin_amdgcn_mfma_f32_32x32x16_bf16(pa2, (bf16x8){S[4][0], S[4][1], S[4][2], S[4][3], S[5][0], S[5][1], S[5][2], S[5][3]}, o[d0], 0, 0, 0);   \
        o[d0] = __builtin_amdgcn_mfma_f32_32x32x16_bf16(pa3, (bf16x8){S[6][0], S[6][1], S[6][2], S[6][3], S[7][0], S[7][1], S[7][2], S[7][3]}, o[d0], 0, 0, 0); } while (0)
#define PV_WAIT(N) do { asm volatile("s_waitcnt lgkmcnt(" #N ")" ::: "memory"); SBAR(); } while (0)
    s16x4 A[8], B[8];
    PV_RD(A, 0); PV_RD(B, 1);
    PV_WAIT(8); PV_MM(A, 0); SBAR();
    PV_RD(A, 2);
    PV_WAIT(8); PV_MM(B, 1); SBAR();
    PV_RD(B, 3);
    PV_WAIT(8); PV_MM(A, 2); SBAR();
    PV_WAIT(0); PV_MM(B, 3);
#undef PV_RD
#undef PV_MM
#undef PV_WAIT
#undef TRRD
}
struct BlockRef { const bf16* Q; const bf16* K; const bf16* V; const float* KB; bf16* O; int P0; int dqk; const float* qg; const float* rope; };
#define ROW(p, k0, rr) ((p) + (size_t)((k0) + (rr)) * PITCH + sc)
#define VMW() asm volatile("s_waitcnt vmcnt(0)" ::: "memory")
#define SLOAD_H(k0_) do { const int k0 = (ABL == 1) ? 0 : (k0_); st_v0 = load8(ROW(cur.V, k0, sr)); st_v1 = load8(ROW(cur.V, k0, 32 + sr));              \
                         if (sc < DQK) { st_k0 = load8(ROW(cur.K, k0, sr)); st_k1 = load8(ROW(cur.K, k0, 32 + sr)); }    \
                         if (tid < 64) st_b = cur.KB[(k0) + tid]; } while (0)
#define SWRITE_H(bf) do { *(bf16x8*)(V_lds + (bf) * SHM_V + vst0) = st_v0; *(bf16x8*)(V_lds + (bf) * SHM_V + vst1) = st_v1; \
                         if (sc < DQK) { *(bf16x8*)(K_lds + (bf) * SHM_K + kws) = st_k0; *(bf16x8*)(K_lds + (bf) * SHM_K + kws + 32 * 256) = st_k1; } \
                         if (tid < 64) *(float*)(B_lds + (bf) * 256 + tid * 4) = st_b; } while (0)
template <int DQK, int ABL>
__device__ __forceinline__ void block(const BlockRef& cur, int skv, char* lds) {
    int tid = threadIdx.x; asm volatile("" : "+v"(tid));
    const int wid = __builtin_amdgcn_readfirstlane(tid >> 6), lane = tid & 63, r32 = lane & 31, hi = lane >> 5;
    constexpr unsigned W = 1u << 30;
    int j_hi = (cur.P0 + QB - 1) / KVBLK + 1; if (j_hi > skv / KVBLK) j_hi = skv / KVBLK;
    const int NT = j_hi;
    const int qlo = cur.P0 + wid * QBLK, qm = qlo + r32 - 4 * hi;
    char* V_lds = lds + OFF_V; char* K_lds = lds + OFF_K; char* B_lds = lds + OFF_B;
    float* ws = (float*)(lds + OFF_WS) + wid * 64; float* li_l = ws, * al_l = ws + 32;
    float m_reg = -1e30f, l_reg = 0; f32x16 o[4] = {};
    const int sr = tid >> 4, sc = (tid & 15) * 8, vst0 = v_st(sr, sc), vst1 = v_st(32 + sr, sc), kws = KSWZ(sr, sc * 2);
    const int vb0 = (int)(uintptr_t)V_lds + v_rd_base(lane);
    unsigned kaddr[4];
#pragma unroll
    for (int dd = 0; dd < 4; ++dd) kaddr[dd] = (unsigned)(uintptr_t)K_lds + KSWZ(r32, (dd * 16 + hi * 8) * 2);
    bf16x8 qr[DQK / 16];
    {
        float qf[DQK / 16][8]; float ss = 0.f;
#pragma unroll
        for (int d0 = 0; d0 < DQK / 16; ++d0) { const u32x4 w = __builtin_bit_cast(u32x4, load8(cur.Q + (size_t)(wid * QBLK + r32) * PITCH + d0 * 16 + hi * 8));
#pragma unroll
            for (int i = 0; i < 4; ++i) { qf[d0][2 * i] = __uint_as_float(w[i] << 16); qf[d0][2 * i + 1] = __uint_as_float(w[i] & 0xffff0000u); }
#pragma unroll
            for (int i = 0; i < 8; ++i) ss += qf[d0][i] * qf[d0][i]; }
        { auto rr = __builtin_amdgcn_permlane32_swap(__float_as_uint(ss), __float_as_uint(ss), false, false); ss = __uint_as_float(rr[0]) + __uint_as_float(rr[1]); }
        const float rn = 1.f / sqrtf(ss * (1.f / DQK) + 1e-6f);
#pragma unroll
        for (int d0 = 0; d0 < DQK / 16; ++d0) { const f32x4 g0 = *(const f32x4*)(cur.qg + d0 * 16 + hi * 8), g1 = *(const f32x4*)(cur.qg + d0 * 16 + hi * 8 + 4);
#pragma unroll
            for (int i = 0; i < 4; ++i) { qf[d0][i] *= rn * g0[i]; qf[d0][4 + i] *= rn * g1[i]; } }
        if (DQK == 64) { const float* tb = cur.rope + (size_t)(cur.P0 - 48 + wid * QBLK + r32) * 16;
#pragma unroll
            for (int i = 0; i < 8; ++i) { const float mine = qf[0][i]; auto rr = __builtin_amdgcn_permlane32_swap(__float_as_uint(mine), __float_as_uint(mine), false, false);
                const float other = __uint_as_float(hi ? rr[0] : rr[1]); const float c = tb[2 * i], sn = tb[2 * i + 1];
                qf[0][i] = hi ? (mine * c + other * sn) : (mine * c - other * sn); } }
#pragma unroll
        for (int d0 = 0; d0 < DQK / 16; ++d0) { u32x4 w = {cvtpk(qf[d0][0], qf[d0][1]), cvtpk(qf[d0][2], qf[d0][3]), cvtpk(qf[d0][4], qf[d0][5]), cvtpk(qf[d0][6], qf[d0][7])}; qr[d0] = __builtin_bit_cast(bf16x8, w); }
    }
    bf16x8 st_v0, st_v1, st_k0, st_k1; float st_b;
    SLOAD_H(0); VMW(); SWRITE_H(0);
    if (NT > 1) { SLOAD_H(KVBLK); VMW(); SWRITE_H(1); }
    __syncthreads();
    if (wid >= 4) __builtin_amdgcn_s_barrier();
#define RESC(a) do { if (__any((a) < 1.f)) { if (hi == 0) al_l[r32] = (a); asm volatile("s_waitcnt lgkmcnt(0)" ::: "memory");              \
                     for (int d_ = 0; d_ < 4; ++d_) for (int r = 0; r < 16; ++r) o[d_][r] *= al_l[crow(r, hi)]; } } while (0)
#define BAR() do { asm volatile("s_waitcnt lgkmcnt(0)" ::: "memory"); __builtin_amdgcn_s_barrier(); asm volatile("" ::: "memory"); } while (0)
#define KEEP4(a, b, c, d) asm volatile("" :: "v"(a), "v"(b), "v"(c), "v"(d))
#define TILE(t, BUF) do { f32x16 p0, p1; float mn, al; bf16x8 pa0, pa1, pa2, pa3;                                             \
        if (ABL != 6 && ABL < 7) { if ((t) + 2 < NT) { SLOAD_H(((t) + 2) * KVBLK); } }                                          \
        SBAR();                                                                                                               \
        if (ABL == 4 || ABL == 9 || ABL >= 10) { p0 = f32x16{}; p1 = f32x16{}; asm volatile("" : "+v"(p0), "+v"(p1)); }                                 \
        else qkt<BUF, DQK>(p0, p1, kaddr, B_lds, r32, hi, qr, DQK == 128 || (t) == 0);     \
        { const int kb_ = (t) * KVBLK; if (kb_ + KVBLK - 1 > qlo) mask_tile(p0, p1, qm - kb_, W); }                            \
        if (ABL != 5 && ABL < 7) BAR();                                                                                        \
        if (ABL == 2 || ABL >= 7) { al = 1.f; l_reg += p0[0];                                                                  \
            { u32x4 w0 = {cvtpk(p0[0], p0[1]), cvtpk(p0[2], p0[3]), cvtpk(p0[4], p0[5]), cvtpk(p0[6], p0[7])}; pa0 = *reinterpret_cast<bf16x8*>(&w0);    \
              u32x4 w1 = {cvtpk(p0[8], p0[9]), cvtpk(p0[10], p0[11]), cvtpk(p0[12], p0[13]), cvtpk(p0[14], p0[15])}; pa1 = *reinterpret_cast<bf16x8*>(&w1); \
              u32x4 w2 = {cvtpk(p1[0], p1[1]), cvtpk(p1[2], p1[3]), cvtpk(p1[4], p1[5]), cvtpk(p1[6], p1[7])}; pa2 = *reinterpret_cast<bf16x8*>(&w2);    \
              u32x4 w3 = {cvtpk(p1[8], p1[9]), cvtpk(p1[10], p1[11]), cvtpk(p1[12], p1[13]), cvtpk(p1[14], p1[15])}; pa3 = *reinterpret_cast<bf16x8*>(&w3); } } \
        else { partialSM<DQK>(p0, p1, m_reg, mn, al); RESC(al);                                                               \
               finishSM(p0, p1, al, l_reg, pa0, pa1, pa2, pa3); }                                                              \
        SBAR();                                                                                                               \
        if (ABL == 3 || ABL == 8 || ABL >= 10) { KEEP4(pa0, pa1, pa2, pa3); } else pv_tile<BUF>(o, vb0, pa0, pa1, pa2, pa3);                              \
        if (ABL != 6 && ABL < 7) { if ((t) + 2 < NT) { VMW(); SWRITE_H(((BUF) + 2) % 3); } }                                   \
        if (ABL != 5 && ABL < 7) BAR(); } while (0)
    for (int t = 0; t < (ABL == 11 ? 0 : NT); t += 3) {
        TILE(t, 0);
        if (t + 1 < NT) TILE(t + 1, 1);
        if (t + 2 < NT) TILE(t + 2, 2);
    }
    if (wid < 4) __builtin_amdgcn_s_barrier();
    if (hi == 0) li_l[r32] = l_reg; asm volatile("s_waitcnt lgkmcnt(0)" ::: "memory");
    float rli[16];
#pragma unroll
    for (int r = 0; r < 16; ++r) rli[r] = __builtin_amdgcn_rcpf(li_l[crow(r, hi)]);
    bf16* Ow = cur.O + (size_t)(wid * QBLK) * PITCH;
    {
        unsigned short* stg = (unsigned short*)(lds + OFF_V + wid * 8192);
#pragma unroll
        for (int r = 0; r < 16; ++r) { const int orow = crow(r, hi);
#pragma unroll
            for (int d0 = 0; d0 < 4; ++d0) stg[orow * 128 + d0 * 32 + r32] = (unsigned short)cvtpk(o[d0][r] * rli[r], 0.f); }
        asm volatile("s_waitcnt lgkmcnt(0)" ::: "memory");
#pragma unroll
        for (int i = 0; i < 8; ++i) { const int row = i * 4 + (lane >> 4), ch = lane & 15;
            const u32x4 v = *(const u32x4*)(stg + row * 128 + ch * 8); *(u32x4*)(Ow + (size_t)row * PITCH + ch * 8) = v;
            if (i & 1) asm volatile("" ::: "memory"); } }
    __syncthreads();
#undef RESC
#undef BAR
#undef TILE
}
#undef ROW
#undef VMW
#undef SLOAD_H
#undef SWRITE_H
#undef KSWZ
#undef SBAR
}
constexpr int NWAVES = 8;
#ifndef MK_N_LAUNCHES
#define MK_N_LAUNCHES 1
#endif
constexpr int N_PHASES = 11;
constexpr int N_LAUNCHES = MK_N_LAUNCHES;
static_assert(N_LAUNCHES == 1 || N_LAUNCHES == N_PHASES, "MK_N_LAUNCHES is 1 or 11");

constexpr int BATCH = 2, SEQ = 4096, DM = 2048, NMETA = 16, MREAL = BATCH * SEQ;
constexpr int LSEQ = NMETA + SEQ;
constexpr int LP = 4160, PADF = 48;
constexpr int M1 = 8192;
constexpr int N1 = 10240;
constexpr int WIN_LD = 10248;
constexpr int NEXP = 16384, PEER_H = 8, PEER_K = 16, EROW = 1536;
constexpr float EPS = 1e-6f;

constexpr size_t MiB = 1u << 20;
constexpr size_t WS_CTL = 0, CTL_ZERO_BYTES = 32768;
constexpr size_t WS_WIN = 2 * MiB, WS_WBD = 42 * MiB, WS_WBF = 46 * MiB, WS_WOUT = 50 * MiB, WS_WPQ = 58 * MiB;
constexpr size_t WS_EU = 62 * MiB, WS_EV = 94 * MiB;
constexpr size_t WS_SU = 126 * MiB, WS_SV = 126 * MiB + 65536;
constexpr size_t WS_XN = 190 * MiB;
constexpr size_t WS_H2N = 190 * MiB;
constexpr size_t WS_DQ = 223 * MiB, WS_DK = 239 * MiB, WS_DV = 256 * MiB, WS_FQ = 273 * MiB, WS_FK = 289 * MiB, WS_FV = 306 * MiB;
constexpr size_t WS_GA = 323 * MiB, WS_GB = 355 * MiB;
constexpr size_t WS_O1 = 387 * MiB, WS_O2 = 403 * MiB, WS_OF = 419 * MiB;
constexpr size_t WS_OD = 435 * MiB;
constexpr size_t WS_T = 223 * MiB;
constexpr size_t WS_MG = 289 * MiB;
constexpr size_t WS_QP = 323 * MiB;
constexpr size_t WS_RS = 396 * MiB;
constexpr size_t WS_PART = WS_QP;
constexpr size_t WS_IDX = 387 * MiB, WS_GATE = 391 * MiB;
constexpr size_t WS_SSQ = 395 * MiB;
constexpr size_t WS_LOGF = 451 * MiB;
constexpr size_t WS_KBIAS = 452 * MiB;
constexpr size_t WS_SKH = 451 * MiB + 512 * 1024, WS_SKL = 452 * MiB + 512 * 1024;
constexpr size_t WS_ROPE = 453 * MiB;
constexpr size_t WS_END = 454 * MiB;
static_assert(WS_T + (size_t)MREAL * DM * 4 <= WS_FK && WS_MG + (size_t)MREAL * DM * 2 <= WS_GA && WS_XN + (size_t)M1 * DM * 2 <= WS_DQ, "d_ws map");
static_assert(WS_DK + (size_t)BATCH * LP * 1024 * 2 <= WS_DV && WS_FV + (size_t)BATCH * LP * 1024 * 2 <= WS_GA, "d_ws map");

constexpr int CW_TMO = 0, CW_CODE = 1;
constexpr int CW_BAR = 4096;
constexpr int RING_OFF = 0, RING_BYTES = 131072;
constexpr int LDSCTL_OFF = 143360, MISC_OFF = LDSCTL_OFF + 320;
constexpr int LDS_BYTES = 147456;
#define GAS __attribute__((address_space(1)))
#define LAS __attribute__((address_space(3)))
typedef unsigned short bf16;
typedef unsigned v4u __attribute__((ext_vector_type(4)));
typedef float f32x4 __attribute__((ext_vector_type(4)));
typedef short bf16x8 __attribute__((ext_vector_type(8)));
typedef GAS unsigned gu32;
typedef GAS unsigned long long gu64;
#define RLX_AGENT __ATOMIC_RELAXED, __HIP_MEMORY_SCOPE_AGENT
#define LDS_WAIT() asm volatile("s_waitcnt lgkmcnt(0)" ::: "memory")
#define VM_WAIT() asm volatile("s_waitcnt vmcnt(0)" ::: "memory")
__device__ __forceinline__ unsigned long long rt() { return __builtin_amdgcn_s_memrealtime(); }
__device__ __forceinline__ unsigned f2bf(float f) { unsigned u = __builtin_bit_cast(unsigned, f); return (u + 0x7fffu + ((u >> 16) & 1u)) >> 16; }
__device__ __forceinline__ unsigned pk2(float lo, float hi) { return f2bf(lo) | (f2bf(hi) << 16); }
#define XB_TMO      128
#define XB_XCNT(j)  (256  + 64 * (j))
#define XB_XSUB(j)  (1280 + 64 * (j))
#define XB_XGEN(j)  (2304 + 64 * (j))
#define XB_TOP      3328
#define XB_TOPGEN   3392
#define XCD_BAR_WORDS 3456
#define XB_SPIN_CAP (1u << 18)

__device__ __forceinline__ unsigned xb_ld(unsigned* p)              { return __hip_atomic_load(p, __ATOMIC_RELAXED, __HIP_MEMORY_SCOPE_AGENT); }
__device__ __forceinline__ unsigned xb_add(unsigned* p, unsigned v) { return __hip_atomic_fetch_add(p, v, __ATOMIC_RELAXED, __HIP_MEMORY_SCOPE_AGENT); }
__device__ __forceinline__ unsigned xb_xcc_id() { return (unsigned)__builtin_amdgcn_s_getreg((3 << 11) | 20) & 0xFu; }
#define XB_SPIN(cond, bar) do { unsigned _sp = 0; while (cond) { __builtin_amdgcn_s_sleep(1); \
    if ((++_sp & 255u) == 0u) { if (xb_ld(&(bar)[XB_TMO])) break; if (_sp > XB_SPIN_CAP) { atomicAdd(&(bar)[XB_TMO], 1u); break; } } } } while (0)

struct XcdBarrier {
    unsigned* bar; unsigned x;
    volatile LAS unsigned* st;
};

__device__ __forceinline__ XcdBarrier xcd_barrier_post(unsigned* bar, volatile LAS unsigned* st) {
    XcdBarrier b; b.bar = bar; b.x = xb_xcc_id(); b.st = st;
    if (threadIdx.x == 0) (void)xb_add(&bar[XB_XCNT(b.x)], 1u);
    return b;
}
__device__ __forceinline__ void xcd_barrier_complete(unsigned* bar, unsigned x, unsigned& nloc, unsigned& nx) {
    const unsigned G = gridDim.x * gridDim.y * gridDim.z;
    unsigned sum, cnt, mine, sp = 0u;
    for (;;) {
        sum = 0u; cnt = 0u; mine = 0u;
#pragma unroll
        for (unsigned j = 0; j < 16; ++j) { const unsigned c = xb_ld(&bar[XB_XCNT(j)]); sum += c; cnt += (c > 0u) ? 1u : 0u; mine = (j == x) ? c : mine; }
        if (sum == G) break;
        __builtin_amdgcn_s_sleep(1);
        if ((++sp & 255u) == 0u) { if (xb_ld(&bar[XB_TMO])) break; if (sp > XB_SPIN_CAP) { atomicAdd(&bar[XB_TMO], 1u); break; } }
    }
    nloc = mine > 0u ? mine : 1u; nx = cnt > 0u ? cnt : 1u;
}

__device__ __forceinline__ void xcd_barrier(const XcdBarrier& b) {
    asm volatile("s_waitcnt vmcnt(0)" ::: "memory");
    __syncthreads();
    if (threadIdx.x == 0) {
        unsigned* bar = b.bar;
        __builtin_amdgcn_s_waitcnt(0);
        unsigned nloc = b.st[0], nx = b.st[1];
        if (nloc == 0u) { xcd_barrier_complete(bar, b.x, nloc, nx); b.st[0] = nloc; b.st[1] = nx; }
        const unsigned old = xb_add(&bar[XB_XSUB(b.x)], 1u);
        const unsigned gen = old / nloc;
        if (old + 1u == (gen + 1u) * nloc) {
            __builtin_amdgcn_fence(__ATOMIC_RELEASE, "agent");
            asm volatile("s_waitcnt vmcnt(0)" ::: "memory");
            const unsigned og = xb_add(&bar[XB_TOP], 1u);
            const unsigned tg = og / nx;
            if (og + 1u == (tg + 1u) * nx) xb_add(&bar[XB_TOPGEN], 1u);
            else XB_SPIN(xb_ld(&bar[XB_TOPGEN]) == tg, bar);
            __builtin_amdgcn_fence(__ATOMIC_ACQUIRE, "agent");
            xb_add(&bar[XB_XGEN(b.x)], 1u);
            asm volatile("s_waitcnt vmcnt(0)" ::: "memory");
        } else {
            XB_SPIN(xb_ld(&bar[XB_XGEN(b.x)]) == gen, bar);
            __builtin_amdgcn_fence(__ATOMIC_ACQUIRE, "agent");
            asm volatile("s_waitcnt vmcnt(0)" ::: "memory");
        }
    }
    __syncthreads();
}
__device__ __forceinline__ float wave_sum(float v) {
#pragma unroll
    for (int o = 1; o < 64; o <<= 1) v += __shfl_xor(v, o);
    return v;
}
struct Frame {
    LAS unsigned char* lds;
    volatile LAS unsigned* MISC;
    gu32* ctl;
    int tid, lane, wave;
    int vcu, G;
    int gw, NGW;
    const float* in[23];
    float* out;
    unsigned char* ws;
};
enum { I_X = 0, I_META, I_GMIX, I_WIN, I_BFORGET, I_BGATE, I_DQG, I_DKG, I_FQG, I_FKG, I_LQ1, I_LK1, I_LQ2, I_LK2, I_SUBLN, I_WBD, I_WBF, I_WOUT, I_GPEER, I_WPQ, I_SUBK, I_EU, I_EV };

__device__ __forceinline__ float bf2f(unsigned short b) { return __uint_as_float((unsigned)b << 16); }
__device__ __forceinline__ float bflo(unsigned w) { return __uint_as_float(w << 16); }
__device__ __forceinline__ float bfhi(unsigned w) { return __uint_as_float(w & 0xffff0000u); }
__device__ __forceinline__ float sigmoidf_(float x) { return 1.f / (1.f + __expf(-x)); }

__device__ __forceinline__ void p0_transpose_item2(const float* W, int ldw, int ncols, int K, bf16* WT, int row_off, LAS float* scr, int item, int lane) {
    const int nblk = ncols / 32, kb = item / nblk, nb = item % nblk, k0 = 64 * kb, n0 = 32 * nb;
#pragma unroll 8
    for (int i = 0; i < 32; ++i) { const int kk = 2 * i + (lane >> 5); scr[kk * 33 + (lane & 31)] = __builtin_nontemporal_load(W + (size_t)(k0 + kk) * ldw + n0 + (lane & 31)); }
    LDS_WAIT(); asm volatile("" ::: "memory");
    const int c = lane & 7;
#pragma unroll
    for (int j = 0; j < 4; ++j) { const int n = (lane >> 3) + 8 * j; const LAS float* s = scr + (8 * c) * 33 + n;
        v4u o; o.x = pk2(s[0 * 33], s[1 * 33]); o.y = pk2(s[2 * 33], s[3 * 33]); o.z = pk2(s[4 * 33], s[5 * 33]); o.w = pk2(s[6 * 33], s[7 * 33]);
        *(GAS v4u*)(WT + (size_t)(row_off + n0 + n) * K + k0 + 8 * c) = o; }
    LDS_WAIT(); asm volatile("" ::: "memory");
}

__device__ __forceinline__ void p0_prologue(Frame& F) {
    unsigned char* ws = F.ws;
    for (int rpa_ = 0; rpa_ < (((PH_REP_MASK) >> 12) & 1 ? 2 : 1); ++rpa_)
    {   LAS float* WF = (LAS float*)(F.lds + RING_OFF);
        const float* win = F.in[I_WIN];
        for (int i = F.tid; i < DM * 2; i += NWAVES * 64) { const int k = i >> 1, hh = (i & 1) * 4;
            const f32x4 v = *(const f32x4*)(win + (size_t)k * WIN_LD + 6144 + hh);
            WF[(hh + 0) * DM + k] = v.x; WF[(hh + 1) * DM + k] = v.y; WF[(hh + 2) * DM + k] = v.z; WF[(hh + 3) * DM + k] = v.w; }
        __syncthreads();
        bf16* XN = (bf16*)(ws + WS_XN); float* LOGF = (float*)(ws + WS_LOGF);
        const float* gmix = F.in[I_GMIX]; const float* bfg = F.in[I_BFORGET];
        constexpr int NROW = MREAL + NMETA;
#define P0A_SRC(m_) ((const GAS f32x4*)((m_) < MREAL ? F.in[I_X] + (size_t)(m_) * DM : F.in[I_META] + (size_t)((m_) - MREAL) * DM) + F.lane)
#define P0A_LOAD(V, m_) do { const GAS f32x4* xr_ = P0A_SRC(m_); _Pragma("unroll") for (int j = 0; j < 8; ++j) V[j] = __builtin_nontemporal_load(xr_ + 64 * j); } while (0)
#define P0A_ROW(V, m_) do { const int mrow = (m_);                                                                                        \
            GAS unsigned long long* o8 = (GAS unsigned long long*)(XN + (size_t)mrow * DM) + F.lane; float s2 = 0.f;                       \
            _Pragma("unroll") for (int j = 0; j < 8; ++j) s2 += (V[j].x * V[j].x + V[j].y * V[j].y) + (V[j].z * V[j].z + V[j].w * V[j].w);  \
            const float rstd = 1.f / sqrtf(wave_sum(s2) * (1.f / DM) + EPS);                                                           \
            float fl[8];                                                                                                               \
            _Pragma("unroll") for (int h = 0; h < 8; ++h) fl[h] = 0.f;                                                                 \
            _Pragma("unroll") for (int j = 0; j < 8; ++j) { const f32x4 g = *((const GAS f32x4*)gmix + 64 * j + F.lane);               \
                const f32x4 y = {V[j].x * rstd * g.x, V[j].y * rstd * g.y, V[j].z * rstd * g.z, V[j].w * rstd * g.w};                  \
                o8[64 * j] = (unsigned long long)pk2(y.x, y.y) | ((unsigned long long)pk2(y.z, y.w) << 32);                            \
                _Pragma("unroll") for (int h = 0; h < 8; ++h) { const f32x4 w = *(const LAS f32x4*)(WF + h * DM + 256 * j + 4 * F.lane); \
                    fl[h] += (y.x * w.x + y.y * w.y) + (y.z * w.z + y.w * w.w); }                                                      \
                asm volatile("" ::: "memory"); __builtin_amdgcn_sched_barrier(0); }     \
              \
            float a4[4]; { const bool up = (F.lane & 32) != 0;                                                                          \
              _Pragma("unroll") for (int i = 0; i < 4; ++i) { const float snd = up ? fl[i] : fl[i + 4]; const float kp = up ? fl[i + 4] : fl[i]; a4[i] = kp + __shfl_xor(snd, 32); } }   \
            float a2[2]; { const bool up = (F.lane & 16) != 0;                                                                          \
              _Pragma("unroll") for (int i = 0; i < 2; ++i) { const float snd = up ? a4[i] : a4[i + 2]; const float kp = up ? a4[i + 2] : a4[i]; a2[i] = kp + __shfl_xor(snd, 16); } }   \
            float a1; { const bool up = (F.lane & 8) != 0; const float snd = up ? a2[0] : a2[1]; const float kp = up ? a2[1] : a2[0]; a1 = kp + __shfl_xor(snd, 8); }                     \
            a1 += __shfl_xor(a1, 4); a1 += __shfl_xor(a1, 2); a1 += __shfl_xor(a1, 1);                                                 \
                                                       \
            if ((F.lane & 7) == 0) { const int h = ((F.lane >> 5) & 1) * 4 + ((F.lane >> 4) & 1) * 2 + ((F.lane >> 3) & 1);             \
                const float z = a1 + bfg[h];                                                                                           \
                const float lf = fminf(z, 0.f) - log1pf(__expf(-fabsf(z)));                                             \
                if (mrow < MREAL) { const int b = mrow >> 12, s = mrow & 4095; LOGF[((size_t)b * 8 + h) * LSEQ + NMETA + s] = lf; }            \
                else { const int t = mrow - MREAL; LOGF[((size_t)0 * 8 + h) * LSEQ + t] = lf; LOGF[((size_t)1 * 8 + h) * LSEQ + t] = lf; } } } while (0)
        f32x4 va[8], vb[8];
        int m = F.gw;
        if (m < NROW) P0A_LOAD(va, m);
#pragma unroll 1
        for (; m < NROW; m += 2 * F.NGW) {
            const int m1 = m + F.NGW, m2 = m + 2 * F.NGW;
            if (m1 < NROW) P0A_LOAD(vb, m1);
            P0A_ROW(va, m);
            if (m1 < NROW) { if (m2 < NROW) P0A_LOAD(va, m2); P0A_ROW(vb, m1); }
        }
#undef P0A_SRC
#undef P0A_LOAD
#undef P0A_ROW
        __syncthreads();
    }
    {   LAS unsigned short* XM = (LAS unsigned short*)(F.lds + RING_OFF);
        LAS float* PART = (LAS float*)(F.lds + RING_OFF + 66048);
        const float* gmix = F.in[I_GMIX]; const float* win = F.in[I_WIN];
        for (int rr = 0; rr < 2; ++rr) { const int r = 2 * F.wave + rr;
            const GAS f32x4* xr = (const GAS f32x4*)(F.in[I_META] + (size_t)r * DM) + F.lane;
            f32x4 v[8]; float s2 = 0.f;
#pragma unroll
            for (int j = 0; j < 8; ++j) { v[j] = xr[64 * j]; s2 += (v[j].x * v[j].x + v[j].y * v[j].y) + (v[j].z * v[j].z + v[j].w * v[j].w); }
            const float rstd = 1.f / sqrtf(wave_sum(s2) * (1.f / DM) + EPS);
#pragma unroll
            for (int j = 0; j < 8; ++j) { const f32x4 g = *((const GAS f32x4*)gmix + 64 * j + F.lane);
                *(LAS unsigned long long*)(XM + r * 2056 + 256 * j + 4 * F.lane) = (unsigned long long)pk2(v[j].x * rstd * g.x, v[j].y * rstd * g.y) | ((unsigned long long)pk2(v[j].z * rstd * g.z, v[j].w * rstd * g.w) << 32); } }
        __syncthreads();
        const int c = F.lane & 15, kk = F.lane >> 4;
        for (int task = F.vcu; task < 256; task += F.G) {
            const int n = task * 16 + c;
            const int wcol = n < 2048 ? 1024 + n : n + 2048;
            float acc[16];
#pragma unroll
            for (int r = 0; r < 16; ++r) acc[r] = 0.f;
            const LAS unsigned short* xp = XM + 256 * F.wave + kk; const float* wp = win + (size_t)(256 * F.wave + kk) * WIN_LD + wcol;
#pragma unroll 1
            for (int i0 = 0; i0 < 64; i0 += 16) {
                float wv[16];
#pragma unroll
                for (int i = 0; i < 16; ++i) wv[i] = wp[(size_t)(4 * (i0 + i)) * WIN_LD];
                const LAS unsigned short* xq = xp + 4 * i0;
#pragma unroll
                for (int i = 0; i < 16; ++i)
#pragma unroll
                    for (int r = 0; r < 16; ++r) acc[r] += bf2f(xq[r * 2056 + 4 * i]) * wv[i];
            }
#pragma unroll
            for (int r = 0; r < 16; ++r) { float s = acc[r]; s += __shfl_xor(s, 16); s += __shfl_xor(s, 32); if (kk == 0) PART[(F.wave * 16 + r) * 16 + c] = s; }
            __syncthreads();
            if (F.tid < 256) { const int r = F.tid >> 4, cc = F.tid & 15; float s = 0.f;
#pragma unroll
                for (int w = 0; w < 8; ++w) s += PART[(w * 16 + r) * 16 + cc];
                const int nn = task * 16 + cc; const int seg = nn >> 10, col = nn & 1023;
                bf16* base = (bf16*)(ws + (seg == 0 ? WS_DK : seg == 1 ? WS_DV : seg == 2 ? WS_FK : WS_FV));
                const bf16 hv = (bf16)f2bf(s);
                base[(size_t)(PADF + r) * 1024 + col] = hv; base[(size_t)(LP + PADF + r) * 1024 + col] = hv; }
            __syncthreads();
        }
    }
    for (int rpb_ = 0; rpb_ < (((PH_REP_MASK) >> 13) & 1 ? 2 : 1); ++rpb_)
    {   LAS float* scr = (LAS float*)(F.lds + RING_OFF + F.wave * 16384);
        const float* win = F.in[I_WIN];
        constexpr int I_A = (DM / 64) * (6144 / 32), I_G = (DM / 64) * (2048 / 32), I_BD = (1024 / 64) * (DM / 32), I_O = (DM / 64) * (DM / 32), I_P = (DM / 64) * (1024 / 32);
        constexpr int NITEMS = I_A + 2 * I_G + 2 * I_BD + I_O + I_P;
        bf16* WIN = (bf16*)(ws + WS_WIN);
        for (int it = F.gw; it < NITEMS; it += F.NGW) {
            int r = it;
            if (r < I_A) {
                const int nblk = 6144 / 32, kb = r / nblk, nb = r % nblk; const int seg = nb >> 5; int sb = nb;
                if (seg == 1 || seg == 4) { const int pb = nb & 7; sb = (nb & ~7) + 2 * (pb & 3) + (pb >> 2); }
                p0_transpose_item2(win + 32 * sb, WIN_LD, 32, DM, WIN, 32 * nb, scr, kb, F.lane); continue; } r -= I_A;
            if (r < I_G) { p0_transpose_item2(win + 6152, WIN_LD, 2048, DM, WIN, 6144, scr, r, F.lane); continue; } r -= I_G;
            if (r < I_G) { p0_transpose_item2(win + 8200, WIN_LD, 2048, DM, WIN, 8192, scr, r, F.lane); continue; } r -= I_G;
            if (r < I_BD) { p0_transpose_item2(F.in[I_WBD], DM, DM, 1024, (bf16*)(ws + WS_WBD), 0, scr, r, F.lane); continue; } r -= I_BD;
            if (r < I_BD) { p0_transpose_item2(F.in[I_WBF], DM, DM, 1024, (bf16*)(ws + WS_WBF), 0, scr, r, F.lane); continue; } r -= I_BD;
            if (r < I_O) { p0_transpose_item2(F.in[I_WOUT], DM, DM, DM, (bf16*)(ws + WS_WOUT), 0, scr, r, F.lane); continue; } r -= I_O;
            p0_transpose_item2(F.in[I_WPQ], 1024, 1024, DM, (bf16*)(ws + WS_WPQ), 0, scr, r, F.lane);
        }
    }
    for (int rpc_ = 0; rpc_ < (((PH_REP_MASK) >> 14) & 1 ? 2 : 1); ++rpc_)
    {   typedef float f32x16 __attribute__((ext_vector_type(16))); typedef unsigned u32x6 __attribute__((ext_vector_type(6)));
        for (int r = F.gw; r < 2 * NEXP; r += F.NGW) {
            const int tsel = r >= NEXP, e = r - tsel * NEXP;
            const GAS f32x4* src = (const GAS f32x4*)(F.in[tsel ? I_EV : I_EU] + (size_t)e * DM);
            f32x4 v[8]; float amax = 0.f;
#pragma unroll
            for (int j = 0; j < 8; ++j) { v[j] = __builtin_nontemporal_load(src + 64 * j + F.lane);
                amax = fmaxf(amax, fmaxf(fmaxf(fabsf(v[j].x), fabsf(v[j].y)), fmaxf(fabsf(v[j].z), fabsf(v[j].w)))); }
#pragma unroll
            for (int o = 1; o < 64; o <<= 1) amax = fmaxf(amax, __shfl_xor(amax, o));
            {   const float s4 = amax > 0.f ? 6.f / amax : 1.f; v4u q;
#define PK4(J) ({ unsigned w_ = 0u; \
                    w_ = __builtin_amdgcn_cvt_scalef32_pk_fp4_f32(w_, v[2 * (J)].x * s4, v[2 * (J)].y * s4, 1.0f, 0); w_ = __builtin_amdgcn_cvt_scalef32_pk_fp4_f32(w_, v[2 * (J)].z * s4, v[2 * (J)].w * s4, 1.0f, 1); \
                    w_ = __builtin_amdgcn_cvt_scalef32_pk_fp4_f32(w_, v[2 * (J) + 1].x * s4, v[2 * (J) + 1].y * s4, 1.0f, 2); w_ = __builtin_amdgcn_cvt_scalef32_pk_fp4_f32(w_, v[2 * (J) + 1].z * s4, v[2 * (J) + 1].w * s4, 1.0f, 3); w_; })
                q.x = PK4(0); q.y = PK4(1); q.z = PK4(2); q.w = PK4(3);
#undef PK4
                if (tsel) *(GAS v4u*)(ws + WS_EV + (size_t)e * 1024 + 16 * F.lane) = q;
                else {
                    GAS unsigned short* up = (GAS unsigned short*)(ws + WS_EU + (size_t)e * 128) + F.lane; constexpr size_t SL = (size_t)NEXP * 64;
                    up[0] = (unsigned short)q.x; up[SL] = (unsigned short)(q.x >> 16); up[2 * SL] = (unsigned short)q.y; up[3 * SL] = (unsigned short)(q.y >> 16);
                    up[4 * SL] = (unsigned short)q.z; up[5 * SL] = (unsigned short)(q.z >> 16); up[6 * SL] = (unsigned short)q.w; up[7 * SL] = (unsigned short)(q.w >> 16); }
            }
            if (F.lane == 0) ((float*)(ws + (tsel ? WS_SV : WS_SU)))[e] = amax > 0.f ? amax / 6.f : 1.f;
        }
    }
    {   const size_t gt = (size_t)F.vcu * (NWAVES * 64) + F.tid, GT = (size_t)F.G * NWAVES * 64;
        constexpr size_t per = (size_t)PADF * 1024 * 2 / 16;
        for (size_t c = gt; c < 8 * per; c += GT) { const int a = (int)(c / per), off = (int)(c % per); const int arr = a >> 1, b = a & 1;
            const size_t base = arr == 0 ? WS_DK : arr == 1 ? WS_DV : arr == 2 ? WS_FK : WS_FV;
            ((GAS v4u*)(ws + base + (size_t)b * LP * 1024 * 2))[off] = (v4u){0u, 0u, 0u, 0u}; }
        { const float* sk = F.in[I_SUBK]; bf16* skh = (bf16*)(ws + WS_SKH); bf16* skl = (bf16*)(ws + WS_SKL);
          for (size_t i = gt; i < (size_t)8 * 2 * 128 * 64; i += GT) { const float v = sk[i]; const unsigned hb = f2bf(v); skh[i] = (bf16)hb; skl[i] = (bf16)f2bf(v - __uint_as_float(hb << 16)); } }
        { float* rt = (float*)(ws + WS_ROPE);
          const float inv[8] = {1.0f, 0.1939227432012558f, 0.03760603070259094f, 0.007292664609849453f, 0.0014142135623842478f, 0.00027424818836152554f, 5.318296098266728e-05f, 1.0313386155758053e-05f};
          for (size_t i = gt; i < (size_t)LSEQ * 8; i += GT) { const int fi = (int)(i & 7); float iv = inv[0];
#pragma unroll
              for (int q = 1; q < 8; ++q) iv = fi == q ? inv[q] : iv;
              const float ang = (float)(i >> 3) * iv; rt[2 * i] = cosf(ang); rt[2 * i + 1] = sinf(ang); } }
        float* KBD = (float*)(ws + WS_KBIAS) + (size_t)16 * LP;
        for (size_t p = gt; p < LP; p += GT) KBD[p] = p < PADF ? -__builtin_inff() : 0.f;
    }
}
using pg8::Unit;
__device__ __forceinline__ v4u pack8bf(const f32x4& a, const f32x4& b) { v4u w; w.x = pg8::cvt_pk_bf16(a[0], a[1]); w.y = pg8::cvt_pk_bf16(a[2], a[3]); w.z = pg8::cvt_pk_bf16(b[0], b[1]); w.w = pg8::cvt_pk_bf16(b[2], b[3]); return w; }
struct Epi1 {
    static constexpr bool PERM = true, AFTER_DRAIN = false;
    unsigned char* ws; LAS float* xch; const float* dkg; const float* fkg;
    __device__ __forceinline__ void scale(f32x4 (&)[2][2][4][2], const Unit&, int, int, int, int) const {}
    __device__ __forceinline__ void operator()(const f32x4 (&acc)[2][2][4][2], const Unit& u, int wr, int wc, int fr, int fq) const {
        using pg8::HALF;
        asm volatile("" : "+v"(fr), "+v"(fq));
        const int ncol = u.pn * 256;
        if (ncol >= 1024 && ncol < 2048) {
            bf16* base = (bf16*)(ws + WS_DK) + (ncol - 1024) + 64 * wc + 8 * fq; const float* rope = (const float*)(ws + WS_ROPE);
#pragma unroll
            for (int ai = 0; ai < 2; ++ai)
#pragma unroll
                for (int m = 0; m < 4; ++m) { const int mrow = u.pm * 256 + ai * HALF + wr * 64 + m * 16 + fr;
                    f32x4 y[2][2]; float ss = 0.f;
#pragma unroll
                    for (int bj = 0; bj < 2; ++bj)
#pragma unroll
                        for (int n = 0; n < 2; ++n) { y[bj][n] = acc[ai][bj][m][n]; ss += (y[bj][n][0] * y[bj][n][0] + y[bj][n][1] * y[bj][n][1]) + (y[bj][n][2] * y[bj][n][2] + y[bj][n][3] * y[bj][n][3]); }
                    ss += __shfl_xor(ss, 16); ss += __shfl_xor(ss, 32);
                    const float r = 1.f / sqrtf(ss * (1.f / 64.f) + EPS);
#pragma unroll
                    for (int bj = 0; bj < 2; ++bj)
#pragma unroll
                        for (int n = 0; n < 2; ++n) { const f32x4 g = *(const f32x4*)(dkg + 32 * bj + 8 * fq + 4 * n); y[bj][n] = y[bj][n] * r * g; }
                    const float* tb = rope + (size_t)(NMETA + (mrow & 4095)) * 16;
#pragma unroll
                    for (int n = 0; n < 2; ++n)
#pragma unroll
                        for (int i = 0; i < 4; ++i) { const float mine = y[0][n][i], other = __shfl_xor(mine, 16); const float c = tb[2 * (4 * n + i)], sn = tb[2 * (4 * n + i) + 1];
                            y[0][n][i] = fq == 0 ? (mine * c - other * sn) : (fq == 1 ? (mine * c + other * sn) : mine); }
                    bf16* rowp = base + (size_t)(mrow + 64 + 64 * (mrow >> 12)) * 1024;
                    *(GAS v4u*)(rowp) = pack8bf(y[0][0], y[0][1]); *(GAS v4u*)(rowp + 32) = pack8bf(y[1][0], y[1][1]); }
        } else if (ncol >= 4096 && ncol < 5120) {
            bf16* base = (bf16*)(ws + WS_FK) + (ncol - 4096) + 64 * wc + 8 * fq;
#pragma unroll
            for (int ai = 0; ai < 2; ++ai)
#pragma unroll
                for (int m = 0; m < 4; ++m) { const int rt = ai * HALF + wr * 64 + m * 16 + fr; float ss = 0.f;
#pragma unroll
                    for (int bj = 0; bj < 2; ++bj)
#pragma unroll
                        for (int n = 0; n < 2; ++n) { const f32x4 v = acc[ai][bj][m][n]; ss += (v[0] * v[0] + v[1] * v[1]) + (v[2] * v[2] + v[3] * v[3]); }
                    ss += __shfl_xor(ss, 16); ss += __shfl_xor(ss, 32);
                    if (fq == 0) xch[rt * 4 + wc] = ss; }
            asm volatile("s_waitcnt lgkmcnt(0)" ::: "memory"); __builtin_amdgcn_s_barrier(); asm volatile("" ::: "memory");
#pragma unroll
            for (int ai = 0; ai < 2; ++ai)
#pragma unroll
                for (int m = 0; m < 4; ++m) { const int rt = ai * HALF + wr * 64 + m * 16 + fr; const int mrow = u.pm * 256 + rt;
                    const float r = 1.f / sqrtf((xch[rt * 4 + wc] + xch[rt * 4 + (wc ^ 1)]) * (1.f / 128.f) + EPS);
                    bf16* rowp = base + (size_t)(mrow + 64 + 64 * (mrow >> 12)) * 1024;
#pragma unroll
                    for (int bj = 0; bj < 2; ++bj) { const float* gg = fkg + 64 * (wc & 1) + 32 * bj + 8 * fq; const f32x4 g0 = *(const f32x4*)gg, g1 = *(const f32x4*)(gg + 4);
                        *(GAS v4u*)(rowp + 32 * bj) = pack8bf(acc[ai][bj][m][0] * r * g0, acc[ai][bj][m][1] * r * g1); } }
        } else {
            bf16* base; int ldc, colt, kind;
            if (ncol < 6144) { const int seg = ncol >> 10; colt = ncol & 1023; ldc = 1024;
                base = (bf16*)(ws + (seg == 0 ? WS_DQ : seg == 2 ? WS_DV : seg == 3 ? WS_FQ : WS_FV)); kind = (seg == 2 || seg == 5) ? 1 : 0; }
            else if (ncol < 8192) { base = (bf16*)(ws + WS_GA); colt = ncol - 6144; ldc = 2048; kind = 0; }
            else { base = (bf16*)(ws + WS_GB); colt = ncol - 8192; ldc = 2048; kind = 0; }
#pragma unroll
            for (int ai = 0; ai < 2; ++ai)
#pragma unroll
                for (int m = 0; m < 4; ++m) { const int mrow = u.pm * 256 + ai * HALF + wr * 64 + m * 16 + fr; const size_t row = kind ? (size_t)(mrow + 64 + 64 * (mrow >> 12)) : (size_t)mrow;
#pragma unroll
                    for (int bj = 0; bj < 2; ++bj) *(GAS v4u*)(base + row * ldc + colt + bj * HALF + wc * 32 + 8 * fq) = pack8bf(acc[ai][bj][m][0], acc[ai][bj][m][1]); }
        }
    }
};
struct F_Gemm2a {
    const bf16* G; const float* bg; bf16* MG;
    __device__ __forceinline__ bool begin(const Unit&) { return true; }
    __device__ __forceinline__ void row_begin() {}
    __device__ __forceinline__ void scale_chunk(const Unit&, int, int, f32x4&, f32x4&) const {}
    __device__ __forceinline__ void row_end(const Unit&, int, int, int) {}
    __device__ __forceinline__ void chunk(const Unit& u, int rt, int ct, const f32x4& v0, const f32x4& v1) const {
        const size_t row = (size_t)u.pm * 256 + rt; const int col = u.pn * 256 + ct;
        const v4u g = *(const GAS v4u*)(G + row * DM + col); const f32x4 b0 = *(const f32x4*)(bg + col), b1 = *(const f32x4*)(bg + col + 4);
        f32x4 o0, o1;
        o0[0] = sigmoidf_(bflo(g.x) + b0[0]) * v0[0]; o0[1] = sigmoidf_(bfhi(g.x) + b0[1]) * v0[1]; o0[2] = sigmoidf_(bflo(g.y) + b0[2]) * v0[2]; o0[3] = sigmoidf_(bfhi(g.y) + b0[3]) * v0[3];
        o1[0] = sigmoidf_(bflo(g.z) + b1[0]) * v1[0]; o1[1] = sigmoidf_(bfhi(g.z) + b1[1]) * v1[1]; o1[2] = sigmoidf_(bflo(g.w) + b1[2]) * v1[2]; o1[3] = sigmoidf_(bfhi(g.w) + b1[3]) * v1[3];
        *(GAS v4u*)(MG + row * DM + col) = pack8bf(o0, o1);
    }
};
struct F_Gemm2b {
    const bf16* G; const float* bg; bf16* MG;
    __device__ __forceinline__ bool begin(const Unit&) { return true; }
    __device__ __forceinline__ void row_begin() {}
    __device__ __forceinline__ void scale_chunk(const Unit&, int, int, f32x4&, f32x4&) const {}
    __device__ __forceinline__ void row_end(const Unit&, int, int, int) {}
    __device__ __forceinline__ void chunk(const Unit& u, int rt, int ct, const f32x4& v0, const f32x4& v1) const {
        const size_t row = (size_t)u.pm * 256 + rt; const int col = u.pn * 256 + ct;
        const v4u g = *(const GAS v4u*)(G + row * DM + col); const f32x4 b0 = *(const f32x4*)(bg + col), b1 = *(const f32x4*)(bg + col + 4);
        const v4u t = *(const GAS v4u*)(MG + row * DM + col);
        f32x4 o0, o1;
        o0[0] = bflo(t.x) + sigmoidf_(bflo(g.x) + b0[0]) * v0[0]; o0[1] = bfhi(t.x) + sigmoidf_(bfhi(g.x) + b0[1]) * v0[1]; o0[2] = bflo(t.y) + sigmoidf_(bflo(g.y) + b0[2]) * v0[2]; o0[3] = bfhi(t.y) + sigmoidf_(bfhi(g.y) + b0[3]) * v0[3];
        o1[0] = bflo(t.z) + sigmoidf_(bflo(g.z) + b1[0]) * v1[0]; o1[1] = bfhi(t.z) + sigmoidf_(bfhi(g.z) + b1[1]) * v1[1]; o1[2] = bflo(t.w) + sigmoidf_(bflo(g.w) + b1[2]) * v1[2]; o1[3] = bfhi(t.w) + sigmoidf_(bfhi(g.w) + b1[3]) * v1[3];
        *(GAS v4u*)(MG + row * DM + col) = pack8bf(o0, o1);
    }
};
struct F_Gemm2 {
    const bf16* GA; const bf16* GB; const float* bg; bf16* MG;
    __device__ __forceinline__ bool begin(const Unit&) { return true; }
    __device__ __forceinline__ void row_begin() {}
    __device__ __forceinline__ void row_end(const Unit&, int, int, int) {}
    __device__ __forceinline__ void scale_chunk(const Unit& u, int rt, int ct, f32x4& v0, f32x4& v1) const {
        const size_t row = (size_t)u.pm * 256 + rt; const int col = u.pn * 256 + ct;
        const v4u ga = *(const GAS v4u*)(GA + row * DM + col), gb = *(const GAS v4u*)(GB + row * DM + col);
        const f32x4 a0 = *(const f32x4*)(bg + col), a1 = *(const f32x4*)(bg + col + 4), b0 = *(const f32x4*)(bg + DM + col), b1 = *(const f32x4*)(bg + DM + col + 4);
#define RT(GAW, GBW, HI, AB, BB) ((1.f + __expf(-((HI ? bfhi(GBW) : bflo(GBW)) + (BB)))) / (1.f + __expf(-((HI ? bfhi(GAW) : bflo(GAW)) + (AB)))))
        v0[0] *= RT(ga.x, gb.x, 0, a0[0], b0[0]); v0[1] *= RT(ga.x, gb.x, 1, a0[1], b0[1]); v0[2] *= RT(ga.y, gb.y, 0, a0[2], b0[2]); v0[3] *= RT(ga.y, gb.y, 1, a0[3], b0[3]);
        v1[0] *= RT(ga.z, gb.z, 0, a1[0], b1[0]); v1[1] *= RT(ga.z, gb.z, 1, a1[1], b1[1]); v1[2] *= RT(ga.w, gb.w, 0, a1[2], b1[2]); v1[3] *= RT(ga.w, gb.w, 1, a1[3], b1[3]);
#undef RT
    }
    __device__ __forceinline__ void chunk(const Unit& u, int rt, int ct, const f32x4& v0, const f32x4& v1) const {
        const size_t row = (size_t)u.pm * 256 + rt; const int col = u.pn * 256 + ct;
        const v4u g = *(const GAS v4u*)(GB + row * DM + col); const f32x4 b0 = *(const f32x4*)(bg + DM + col), b1 = *(const f32x4*)(bg + DM + col + 4);
        f32x4 o0, o1;
        o0[0] = sigmoidf_(bflo(g.x) + b0[0]) * v0[0]; o0[1] = sigmoidf_(bfhi(g.x) + b0[1]) * v0[1]; o0[2] = sigmoidf_(bflo(g.y) + b0[2]) * v0[2]; o0[3] = sigmoidf_(bfhi(g.y) + b0[3]) * v0[3];
        o1[0] = sigmoidf_(bflo(g.z) + b1[0]) * v1[0]; o1[1] = sigmoidf_(bfhi(g.z) + b1[1]) * v1[1]; o1[2] = sigmoidf_(bflo(g.w) + b1[2]) * v1[2]; o1[3] = sigmoidf_(bfhi(g.w) + b1[3]) * v1[3];
        *(GAS v4u*)(MG + row * DM + col) = pack8bf(o0, o1);
    }
};
struct Pair2Order {
    pg8::StaticOrder S; int dA, dB;
    __device__ void init(int M, int N, int G_, int c_, int dA_, int dB_) { S.init(M, N, G_, c_); dA = dA_; dB = dB_; }
    __device__ bool next(int i, Unit& u) const { if (!S.next(i >> 1, u)) return false; const int br = i & 1; u.ko = br ? dA : 0; u.kob = br ? dB : 0; u.chain = br ? 0 : 1; return true; }
    __device__ __forceinline__ void a_ready(const Unit&) const {}
    __device__ __forceinline__ void done(const Unit&) const {}
};
struct F_Gemm3 {
    const float* X; float* O; const float* gp; bf16* HG; float* SSQ; float ss;
    __device__ __forceinline__ bool begin(const Unit&) { return true; }
    __device__ __forceinline__ void row_begin() { ss = 0.f; }
    __device__ __forceinline__ void scale_chunk(const Unit&, int, int, f32x4&, f32x4&) const {}
    __device__ __forceinline__ void chunk(const Unit& u, int rt, int ct, const f32x4& v0, const f32x4& v1) {
        const int col = u.pn * 256 + ct; const size_t off = ((size_t)u.pm * 256 + rt) * DM + col;
        const f32x4 x0 = *(const GAS f32x4*)(X + off), x1 = *(const GAS f32x4*)(X + off + 4);
        const f32x4 o0 = x0 + v0, o1 = x1 + v1;
        *(GAS f32x4*)(O + off) = o0; *(GAS f32x4*)(O + off + 4) = o1;
        ss += (o0[0] * o0[0] + o0[1] * o0[1]) + (o0[2] * o0[2] + o0[3] * o0[3]) + (o1[0] * o1[0] + o1[1] * o1[1]) + (o1[2] * o1[2] + o1[3] * o1[3]);
        const f32x4 g0 = *(const f32x4*)(gp + col), g1 = *(const f32x4*)(gp + col + 4);
        *(GAS v4u*)(HG + off) = pack8bf(o0 * g0, o1 * g1);
    }
    __device__ __forceinline__ void row_end(const Unit& u, int rt, int wc, int fq) {
        float s = ss; s += __shfl_xor(s, 16); s += __shfl_xor(s, 32);
        if (fq == 0) SSQ[((size_t)u.pm * 256 + rt) * 32 + u.pn * 4 + wc] = s;
    }
};
struct F_Gemm4 {
    float* Q;
    __device__ __forceinline__ bool begin(const Unit&) { return true; }
    __device__ __forceinline__ void row_begin() {}
    __device__ __forceinline__ void scale_chunk(const Unit&, int, int, f32x4&, f32x4&) const {}
    __device__ __forceinline__ void row_end(const Unit&, int, int, int) {}
    __device__ __forceinline__ void chunk(const Unit& u, int rt, int ct, const f32x4& v0, const f32x4& v1) const {
        const size_t off = (u.ko ? (size_t)MREAL * 1024 : 0) + ((size_t)u.pm * 256 + rt) * 1024 + u.pn * 256 + ct;
        *(GAS f32x4*)(Q + off) = v0; *(GAS f32x4*)(Q + off + 4) = v1;
    }
};
struct SplitK2Order {
    pg8::StaticOrder S;
    __device__ void init(int M, int N, int G_, int c_) { S.init(M, 2 * N, G_, c_); }
    __device__ bool next(int i, Unit& u) const { if (!S.next(i, u)) return false; u.ko = (u.pn >> 2) * 2048; u.kob = u.ko; u.pn &= 3; return true; }
    __device__ __forceinline__ void a_ready(const Unit&) const {}
    __device__ __forceinline__ void done(const Unit&) const {}
};

__device__ __forceinline__ void p2_norm_row(bf16* rowp, const float* gain, int grp  , bool rope, const float* ropetab  , int lane) {
    const v4u w0 = *(const GAS v4u*)(rowp + 16 * lane), w1 = *(const GAS v4u*)(rowp + 16 * lane + 8);
    float x[16];
    x[0] = bflo(w0.x); x[1] = bfhi(w0.x); x[2] = bflo(w0.y); x[3] = bfhi(w0.y); x[4] = bflo(w0.z); x[5] = bfhi(w0.z); x[6] = bflo(w0.w); x[7] = bfhi(w0.w);
    x[8] = bflo(w1.x); x[9] = bfhi(w1.x); x[10] = bflo(w1.y); x[11] = bfhi(w1.y); x[12] = bflo(w1.z); x[13] = bfhi(w1.z); x[14] = bflo(w1.w); x[15] = bfhi(w1.w);
    float ss = 0.f;
#pragma unroll
    for (int i = 0; i < 16; ++i) ss += x[i] * x[i];
    ss += __shfl_xor(ss, 1); ss += __shfl_xor(ss, 2); if (grp == 128) ss += __shfl_xor(ss, 4);
    const float r = 1.f / sqrtf(ss / (float)grp + EPS);
    const int d0 = (16 * lane) & (grp - 1);
#pragma unroll
    for (int i = 0; i < 16; i += 4) { const f32x4 g = *(const f32x4*)(gain + d0 + i); x[i] = x[i] * r * g[0]; x[i + 1] = x[i + 1] * r * g[1]; x[i + 2] = x[i + 2] * r * g[2]; x[i + 3] = x[i + 3] * r * g[3]; }
    if (rope && (lane & 3) == 0) {
#pragma unroll
        for (int i = 0; i < 8; ++i) { const float c = ropetab[2 * i], s = ropetab[2 * i + 1]; const float a = x[i], b = x[i + 8]; x[i] = a * c - b * s; x[i + 8] = b * c + a * s; }
    }
    v4u o0, o1;
    o0.x = pk2(x[0], x[1]); o0.y = pk2(x[2], x[3]); o0.z = pk2(x[4], x[5]); o0.w = pk2(x[6], x[7]); o1.x = pk2(x[8], x[9]); o1.y = pk2(x[10], x[11]); o1.z = pk2(x[12], x[13]); o1.w = pk2(x[14], x[15]);
    *(GAS v4u*)(rowp + 16 * lane) = o0; *(GAS v4u*)(rowp + 16 * lane + 8) = o1;
}
__device__ __forceinline__ void p1_tail(Frame& F) {
    unsigned char* ws = F.ws;
    if (F.gw < 16) {
        const float* lf = (const float*)(ws + WS_LOGF) + (size_t)F.gw * LSEQ; float* kb = (float*)(ws + WS_KBIAS) + (size_t)F.gw * LP;
        float carry = 0.f;
#pragma unroll 1
        for (int c0 = 0; c0 < LSEQ; c0 += 512) {
            float x[8];
#pragma unroll
            for (int u = 0; u < 8; ++u) { const int t = c0 + 64 * u + F.lane; x[u] = t < LSEQ ? lf[t] : 0.f; }
#pragma unroll
            for (int u = 0; u < 8; ++u) { float incl = x[u];
#pragma unroll
                for (int o = 1; o < 64; o <<= 1) { const float n = __shfl_up(incl, o); if (F.lane >= o) incl += n; }
                incl += carry; const int t = c0 + 64 * u + F.lane; if (t < LSEQ) kb[PADF + t] = -incl * 11.313708498984761f;
                carry = __shfl(incl, 63); }
        }
        if (F.lane < PADF) kb[F.lane] = -__builtin_inff();
    }
    { const int rtask = F.gw - 16;
      if (rtask >= 0 && rtask < 64) { const int arr = rtask >> 5, b = (rtask >> 4) & 1, t = rtask & 15;
          if (arr == 0) p2_norm_row((bf16*)(ws + WS_DK) + ((size_t)b * LP + PADF + t) * 1024, F.in[I_DKG], 64, true, (const float*)(ws + WS_ROPE) + (size_t)t * 16, F.lane);
          else p2_norm_row((bf16*)(ws + WS_FK) + ((size_t)b * LP + PADF + t) * 1024, F.in[I_FKG], 128, false, nullptr, F.lane); } }
}

__device__ const unsigned char ATT_TAB[32][4] = {
{0,95,69,112},{16,79,85,112},{32,94,70,112},{22,78,81,112},{4,36,77,112},{15,38,35,112},{55,93,65,112},{63,33,87,112},{61,6,21,112},{47,20,84,112},{13,42,1,112},{54,92,83,112},{41,18,75,112},{43,17,90,112},{62,7,19,112},{39,51,76,112},{45,71,82,112},{30,8,50,112},{46,40,2,112},{31,9,48,112},{28,53,86,112},{56,3,91,112},{10,57,37,112},{44,23,5,112},{29,73,64,112},{14,58,80,112},{12,11,49,112},{26,34,74,112},{60,72,66,112},{59,25,52,112},{89,88,67,112},{27,24,68,112}};
__device__ __forceinline__ att::BlockRef att_ref(unsigned char* ws, int x, int code, const float* qg64, const float* qg128) {
    const int hl = code >> 4, j = code & 15; att::BlockRef r; r.rope = (const float*)(ws + WS_ROPE);
    if (hl < 4) { const int dp = 2 * x + (hl >> 1), b = dp >> 3, h = dp & 7, i = hl & 1;
        r.Q = (const bf16*)(ws + WS_DQ) + ((size_t)b * SEQ + 256 * j) * 1024 + h * 128 + i * 64;
        r.K = (const bf16*)(ws + WS_DK) + (size_t)b * LP * 1024 + h * 128 + i * 64;
        r.V = (const bf16*)(ws + WS_DV) + (size_t)b * LP * 1024 + h * 128;
        r.KB = (const float*)(ws + WS_KBIAS) + (size_t)16 * LP;
        r.O = (bf16*)(ws + (i ? WS_O2 : WS_O1)) + ((size_t)b * SEQ + 256 * j) * 1024 + h * 128; r.dqk = 64; r.qg = qg64; }
    else { const int fh = 2 * x + (hl - 4), b = fh >> 3, h = fh & 7;
        r.Q = (const bf16*)(ws + WS_FQ) + ((size_t)b * SEQ + 256 * j) * 1024 + h * 128;
        r.K = (const bf16*)(ws + WS_FK) + (size_t)b * LP * 1024 + h * 128;
        r.V = (const bf16*)(ws + WS_FV) + (size_t)b * LP * 1024 + h * 128;
        r.KB = (const float*)(ws + WS_KBIAS) + (size_t)fh * LP;
        r.O = (bf16*)(ws + WS_OF) + ((size_t)b * SEQ + 256 * j) * 1024 + h * 128; r.dqk = 128; r.qg = qg128; }
    r.P0 = 64 + 256 * j; return r;
}
template <int ABL>
__device__ __forceinline__ void p3_attention(Frame& F, char* lds) {
    for (int v = F.vcu; v < 256; v += F.G) {
        const int x = v >> 5, slot = v & 31;
        int n = 0; while (n < 4 && ATT_TAB[slot][n] != 112) ++n;
        if (n == 0) continue;
        for (int i = 0; i < n; ++i) {
            att::BlockRef cur = att_ref(F.ws, x, ATT_TAB[slot][i], F.in[I_DQG], F.in[I_FQG]);
            if (ABL != 0) cur.O = (bf16*)(F.ws + WS_XN) + (cur.O - (bf16*)(F.ws + (cur.dqk == 64 ? WS_O1 : WS_OF)) ) % ((size_t)MREAL * 1024);
            if (cur.dqk == 64) att::block<64, ABL>(cur, LP, lds); else att::block<128, ABL>(cur, LP, lds);
        }
    }
}
__device__ __forceinline__ float diff_lambda(Frame& F) {
    const float a = F.in[I_LQ1][F.lane] * F.in[I_LK1][F.lane], b = F.in[I_LQ2][F.lane] * F.in[I_LK2][F.lane];
    return __expf(wave_sum(a)) - __expf(wave_sum(b)) + 0.2f;
}
__device__ __forceinline__ void p4_combine(Frame& F) {
    const float lam = diff_lambda(F);
    const bf16* O1 = (const bf16*)(F.ws + WS_O1); const bf16* O2 = (const bf16*)(F.ws + WS_O2); bf16* OD = (bf16*)(F.ws + WS_OD);
    const float* g = F.in[I_SUBLN];
    const int d0 = (16 * F.lane) & 127;
    for (int m = F.gw; m < MREAL; m += F.NGW) {
        const size_t off = (size_t)m * 1024 + 16 * F.lane;
        const v4u a0 = *(const GAS v4u*)(O1 + off), a1 = *(const GAS v4u*)(O1 + off + 8), b0 = *(const GAS v4u*)(O2 + off), b1 = *(const GAS v4u*)(O2 + off + 8);
        float x[16];
        x[0] = bflo(a0.x) - lam * bflo(b0.x); x[1] = bfhi(a0.x) - lam * bfhi(b0.x); x[2] = bflo(a0.y) - lam * bflo(b0.y); x[3] = bfhi(a0.y) - lam * bfhi(b0.y);
        x[4] = bflo(a0.z) - lam * bflo(b0.z); x[5] = bfhi(a0.z) - lam * bfhi(b0.z); x[6] = bflo(a0.w) - lam * bflo(b0.w); x[7] = bfhi(a0.w) - lam * bfhi(b0.w);
        x[8] = bflo(a1.x) - lam * bflo(b1.x); x[9] = bfhi(a1.x) - lam * bfhi(b1.x); x[10] = bflo(a1.y) - lam * bflo(b1.y); x[11] = bfhi(a1.y) - lam * bfhi(b1.y);
        x[12] = bflo(a1.z) - lam * bflo(b1.z); x[13] = bfhi(a1.z) - lam * bfhi(b1.z); x[14] = bflo(a1.w) - lam * bflo(b1.w); x[15] = bfhi(a1.w) - lam * bfhi(b1.w);
        float ss = 0.f;
#pragma unroll
        for (int i = 0; i < 16; ++i) ss += x[i] * x[i];
        ss += __shfl_xor(ss, 1); ss += __shfl_xor(ss, 2); ss += __shfl_xor(ss, 4);
        const float r = 0.8f / sqrtf(ss * (1.f / 128.f) + EPS);
#pragma unroll
        for (int i = 0; i < 16; i += 4) { const f32x4 gg = *(const f32x4*)(g + d0 + i); x[i] *= r * gg[0]; x[i + 1] *= r * gg[1]; x[i + 2] *= r * gg[2]; x[i + 3] *= r * gg[3]; }
        v4u o0, o1;
        o0.x = pk2(x[0], x[1]); o0.y = pk2(x[2], x[3]); o0.z = pk2(x[4], x[5]); o0.w = pk2(x[6], x[7]); o1.x = pk2(x[8], x[9]); o1.y = pk2(x[10], x[11]); o1.z = pk2(x[12], x[13]); o1.w = pk2(x[14], x[15]);
        *(GAS v4u*)(OD + off) = o0; *(GAS v4u*)(OD + off + 8) = o1;
    }
}
__device__ __forceinline__ unsigned f2ord(float f) { const unsigned u = __float_as_uint(f); return u ^ ((unsigned)((int)u >> 31) | 0x80000000u); }
__device__ __forceinline__ float ord2f(unsigned k) { const unsigned m = (unsigned)((int)(~k) >> 31) | 0x80000000u; return __uint_as_float(k ^ m); }
__device__ __forceinline__ void sort16_desc(unsigned (&a)[16]) {
#pragma unroll
    for (int k = 2; k <= 16; k <<= 1)
#pragma unroll
        for (int j = k >> 1; j > 0; j >>= 1)
#pragma unroll
            for (int i = 0; i < 16; ++i) { const int l = i ^ j; if (l > i) { const bool desc = (i & k) == 0; const unsigned hi_ = max(a[i], a[l]), lo_ = min(a[i], a[l]); a[i] = desc ? hi_ : lo_; a[l] = desc ? lo_ : hi_; } }
}
__device__ __forceinline__ void merge_top16(unsigned (&a)[16], const unsigned (&b)[16]) {
#pragma unroll
    for (int i = 0; i < 16; ++i) a[i] = max(a[i], b[15 - i]);
#pragma unroll
    for (int j = 8; j > 0; j >>= 1)
#pragma unroll
        for (int i = 0; i < 16; ++i) { const int l = i ^ j; if (l > i) { const unsigned hi_ = max(a[i], a[l]), lo_ = min(a[i], a[l]); a[i] = hi_; a[l] = lo_; } }
}
__device__ __forceinline__ void p9_route(Frame& F) {
    typedef float f32x16 __attribute__((ext_vector_type(16)));
    const float* QP0 = (const float*)(F.ws + WS_QP); const float* QP1 = QP0 + (size_t)MREAL * 1024; const float* SSQ = (const float*)(F.ws + WS_SSQ);
    const bf16* SKH = (const bf16*)(F.ws + WS_SKH); const bf16* SKL = (const bf16*)(F.ws + WS_SKL);
    int* IDX = (int*)(F.ws + WS_IDX); float* GATE = (float*)(F.ws + WS_GATE);
    LAS int* XI = (LAS int*)(F.lds + RING_OFF) + F.wave * (64 * 33);
    const int r32 = F.lane & 31, hi = F.lane >> 5;
    for (int task = F.gw; task < PEER_H * (MREAL / 32); task += F.NGW) {
        const int h = task & 7, tok = (task >> 3) * 32 + r32;
        float rs;
        { const GAS f32x4* sp = (const GAS f32x4*)(SSQ + (size_t)tok * 32); f32x4 t = sp[0];
#pragma unroll
          for (int i = 1; i < 8; ++i) t += sp[i];
          rs = 1.f / sqrtf(((t[0] + t[1]) + (t[2] + t[3])) * (1.f / DM) + EPS); }
        if (h == 0 && hi == 0) ((float*)(F.ws + WS_RS))[tok] = rs;
        unsigned T[2][16];
#pragma unroll
        for (int c = 0; c < 2; ++c) {
            f32x16 acc[4];
#pragma unroll
            for (int kb = 0; kb < 4; ++kb) acc[kb] = f32x16{};
            const size_t qoff = (size_t)tok * 1024 + h * 128 + c * 64 + 8 * hi;
            const size_t koff = ((size_t)(h * 2 + c) * 128 + r32) * 64 + 8 * hi;
#pragma unroll
            for (int ks = 0; ks < 4; ++ks) {
                bf16x8 qh, ql;
                { const GAS f32x4* a0 = (const GAS f32x4*)(QP0 + qoff + 16 * ks); const GAS f32x4* a1 = (const GAS f32x4*)(QP1 + qoff + 16 * ks);
                  const f32x4 q0 = (a0[0] + a1[0]) * rs, q1 = (a0[1] + a1[1]) * rs;
                  const v4u hw = pack8bf(q0, q1);
                  f32x4 l0, l1;
                  l0[0] = q0[0] - bflo(hw.x); l0[1] = q0[1] - bfhi(hw.x); l0[2] = q0[2] - bflo(hw.y); l0[3] = q0[3] - bfhi(hw.y);
                  l1[0] = q1[0] - bflo(hw.z); l1[1] = q1[1] - bfhi(hw.z); l1[2] = q1[2] - bflo(hw.w); l1[3] = q1[3] - bfhi(hw.w);
                  const v4u lw = pack8bf(l0, l1);
                  qh = __builtin_bit_cast(bf16x8, hw); ql = __builtin_bit_cast(bf16x8, lw); }
#pragma unroll
                for (int kb = 0; kb < 4; ++kb) {
                    const bf16x8 kh = *(const GAS bf16x8*)(SKH + koff + (size_t)kb * 32 * 64 + 16 * ks), kl = *(const GAS bf16x8*)(SKL + koff + (size_t)kb * 32 * 64 + 16 * ks);
                    acc[kb] = __builtin_amdgcn_mfma_f32_32x32x16_bf16(kh, qh, acc[kb], 0, 0, 0);
                    acc[kb] = __builtin_amdgcn_mfma_f32_32x32x16_bf16(kh, ql, acc[kb], 0, 0, 0);
                    acc[kb] = __builtin_amdgcn_mfma_f32_32x32x16_bf16(kl, qh, acc[kb], 0, 0, 0);
                }
                __builtin_amdgcn_sched_barrier(0);
            }
            unsigned G[4][16];
#pragma unroll
            for (int kb = 0; kb < 4; ++kb) {
#pragma unroll
                for (int r = 0; r < 16; ++r) { const int n = 32 * kb + (r & 3) + 8 * (r >> 2) + 4 * hi; G[kb][r] = (f2ord(acc[kb][r]) & ~0x7Fu) | (unsigned)(127 - n); }
                sort16_desc(G[kb]); }
            merge_top16(G[0], G[1]); merge_top16(G[2], G[3]); merge_top16(G[0], G[2]);
            unsigned P[16];
#pragma unroll
            for (int j = 0; j < 16; ++j) { auto rr = __builtin_amdgcn_permlane32_swap(G[0][j], G[0][j], false, false); P[j] = hi ? rr[0] : rr[1]; }
            merge_top16(G[0], P);
            unsigned (&L)[16] = G[0];
#pragma unroll
            for (int j = 0; j < 16; ++j) T[c][j] = L[j];
        }
        float v1[16], v2[16];
#pragma unroll
        for (int j = 0; j < 16; ++j) { v1[j] = ord2f(T[0][j] & ~0x7Fu); v2[j] = ord2f(T[1][j] & ~0x7Fu);
            XI[F.lane * 33 + j] = 127 - (int)(T[0][j] & 0x7Fu); XI[F.lane * 33 + 16 + j] = 127 - (int)(T[1][j] & 0x7Fu); }
        unsigned Bst[16], C1[16], C2[16], C3[16];
#pragma unroll
        for (int j = 0; j < 16; ++j) { Bst[j] = (f2ord(v1[0] + v2[j]) & ~0xFFu) | (unsigned)(255 - j); C1[j] = 0u; C2[j] = 0u; C3[j] = 0u; }
        { int cnt = 0;
#pragma unroll
          for (int a = 1; a < 16; ++a)
#pragma unroll
            for (int b = 0; b < 16; ++b) if ((a + 1) * (b + 1) <= 16) { const unsigned key = (f2ord(v1[a] + v2[b]) & ~0xFFu) | (unsigned)(255 - (a * 16 + b));
                if (cnt < 16) C1[cnt] = key; else if (cnt < 32) C2[cnt - 16] = key; else C3[cnt - 32] = key; ++cnt; } }
        sort16_desc(C1); sort16_desc(C2); sort16_desc(C3);
        merge_top16(Bst, C1); merge_top16(C2, C3); merge_top16(Bst, C2);
        float e[16], sum = 0.f; const float top = ord2f(Bst[0] & ~0xFFu);
#pragma unroll
        for (int j = 0; j < 16; ++j) { e[j] = __expf(ord2f(Bst[j] & ~0xFFu) - top); sum += e[j]; }
        const float rsum = 1.f / sum;
        LDS_WAIT();
        if (hi == 0) {
            GAS int* io = (GAS int*)(IDX + (size_t)tok * 128 + h * 16); GAS float* go = (GAS float*)(GATE + (size_t)tok * 128 + h * 16);
#pragma unroll
            for (int j = 0; j < 16; ++j) { const int ab = 255 - (int)(Bst[j] & 0xFFu); const int i1 = XI[F.lane * 33 + (ab >> 4)], i2 = XI[F.lane * 33 + 16 + (ab & 15)];
                io[j] = i1 * 128 + i2; go[j] = e[j] * rsum; }
        }
        LDS_WAIT();
    }
}
typedef float f32x2 __attribute__((ext_vector_type(2)));
typedef float f32x32 __attribute__((ext_vector_type(32)));
typedef unsigned u32x6 __attribute__((ext_vector_type(6)));
typedef unsigned u32x16 __attribute__((ext_vector_type(16)));
typedef __bf16 bf16x32_t __attribute__((ext_vector_type(32)));
typedef __bf16 bf16x2_t __attribute__((ext_vector_type(2)));
__device__ __forceinline__ float gelu1(float v) {
    const float av = fabsf(v), t = __builtin_amdgcn_rcpf(av * 0.2316418882f + 1.0f);
    float q = t * 0.5307027145f + (-0.7265760135f); q = q * t + 0.7107068705f; q = q * t + (-0.142248368f); q = q * t + 0.127414796f; q = q * t;
    const float e = __builtin_amdgcn_exp2f((v * v) * (-0.72134752044f));
    const float m = v * (q * e);
    return v < 0.f ? m : v - m;
}

__device__ __forceinline__ float dot32(const float* hf, const v4u& r) {
    float s0 = 0.f, s1 = 0.f;
#define D8(W, T) { const f32x2 a_ = __builtin_amdgcn_cvt_scalef32_pk_f32_fp4((W), 1.0f, 0), b_ = __builtin_amdgcn_cvt_scalef32_pk_f32_fp4((W), 1.0f, 1), \
                               c_ = __builtin_amdgcn_cvt_scalef32_pk_f32_fp4((W), 1.0f, 2), d_ = __builtin_amdgcn_cvt_scalef32_pk_f32_fp4((W), 1.0f, 3); \
                   s0 += hf[T] * a_.x; s1 += hf[T + 1] * a_.y; s0 += hf[T + 2] * b_.x; s1 += hf[T + 3] * b_.y; s0 += hf[T + 4] * c_.x; s1 += hf[T + 5] * c_.y; s0 += hf[T + 6] * d_.x; s1 += hf[T + 7] * d_.y; }
    D8(r.x, 0) D8(r.y, 8) D8(r.z, 16) D8(r.w, 24)
#undef D8
    return s0 + s1;
}
__device__ __forceinline__ void axpy32(float* acc, float w, const v4u& r) {
#define A8(W, T) { const f32x2 a_ = __builtin_amdgcn_cvt_scalef32_pk_f32_fp4((W), 1.0f, 0), b_ = __builtin_amdgcn_cvt_scalef32_pk_f32_fp4((W), 1.0f, 1), \
                               c_ = __builtin_amdgcn_cvt_scalef32_pk_f32_fp4((W), 1.0f, 2), d_ = __builtin_amdgcn_cvt_scalef32_pk_f32_fp4((W), 1.0f, 3); \
                   acc[T] += w * a_.x; acc[T + 1] += w * a_.y; acc[T + 2] += w * b_.x; acc[T + 3] += w * b_.y; acc[T + 4] += w * c_.x; acc[T + 5] += w * c_.y; acc[T + 6] += w * d_.x; acc[T + 7] += w * d_.y; }
    A8(r.x, 0) A8(r.y, 8) A8(r.z, 16) A8(r.w, 24)
#undef A8
}
__device__ __forceinline__ void p10a_udots(Frame& F) {
    typedef int i32x8 __attribute__((ext_vector_type(8)));
    typedef float f32x16 __attribute__((ext_vector_type(16)));
    const bf16* H2N = (const bf16*)(F.ws + WS_H2N); const int* IDX = (const int*)(F.ws + WS_IDX);
    const unsigned char* EU = F.ws + WS_EU; float* PART = (float*)(F.ws + WS_PART);
    LAS unsigned char* wl = F.lds + F.wave * 6144;
    const int l8 = F.lane >> 3, p8 = F.lane & 7;
    const int r32 = F.lane & 31, half = F.lane >> 5;
    int t0, tend, tstep;
    if (F.G % 8 == 0) { const int per = F.G / 8, x = F.vcu / per; t0 = x * MREAL + (F.vcu % per) * NWAVES + F.wave; tend = (x + 1) * MREAL; tstep = per * NWAVES; }
    else { t0 = F.gw; tend = 8 * MREAL; tstep = F.NGW; }
    int zv = 0; asm volatile("" : "+v"(zv));
    const float* RS = (const float*)(F.ws + WS_RS) + zv;
#define PA_CL(T) ((T) < tlast ? (T) : tlast)
#define PA_IDX(I, T) do { const int tk_ = (T) & (MREAL - 1); const GAS v4u* ip_ = (const GAS v4u*)(IDX + (size_t)tk_ * 128 + l8 * 16);     \
        _Pragma("unroll") for (int c_ = 0; c_ < 4; ++c_) { const v4u v_ = ip_[c_]; I[4 * c_] = (int)v_.x; I[4 * c_ + 1] = (int)v_.y; I[4 * c_ + 2] = (int)v_.z; I[4 * c_ + 3] = (int)v_.w; } } while (0)
#define PA_LN(A, I, RB, T) do { const int xs_ = (T) >> 13; _Pragma("unroll") for (int g_ = 0; g_ < 4; ++g_) A[RB][g_] = *(const GAS v4u*)(EU + (size_t)xs_ * ((size_t)NEXP * 128) + (size_t)(unsigned)I[4 * (RB) + g_] * 128 + p8 * 16); } while (0)
#define PA_H(HW, RSV, T) do { const int tk_ = (T) & (MREAL - 1), xs_ = (T) >> 13; HW = *(const GAS unsigned long long*)(H2N + (size_t)tk_ * DM + xs_ * 256 + 4 * F.lane); RSV = RS[tk_]; } while (0)
#define PA_W(AC, RB) do { _Pragma("unroll") for (int g_ = 0; g_ < 4; ++g_) *(LAS v4u*)(wl + 1536 + (8 * g_ + l8) * 144 + p8 * 16) = AC[RB][g_]; asm volatile("" ::: "memory"); } while (0)
#define PA_R(AR) do { _Pragma("unroll") for (int s_ = 0; s_ < 4; ++s_) AR[s_] = *(const LAS v4u*)(wl + 1536 + r32 * 144 + half * 64 + s_ * 16); asm volatile("" ::: "memory"); } while (0)
#define PA_M(AR, ACC) do { _Pragma("unroll") for (int i_ = 0; i_ < 16; ++i_) ACC[i_] = 0.f; \
        _Pragma("unroll") for (int s_ = 0; s_ < 4; ++s_) { const i32x8 a_ = (i32x8){(int)AR[s_].x, (int)AR[s_].y, (int)AR[s_].z, (int)AR[s_].w, 0, 0, 0, 0}; \
            ACC = __builtin_amdgcn_mfma_scale_f32_32x32x64_f8f6f4(a_, B_[s_], ACC, 4, 0, 0, 0x7F7F7F7F, 0, 0x7F7F7F7F); } \
        asm volatile("" : "+v"(ACC)); } while (0)
#define PA_D(RB, ACC) do { if (r32 < 2) { LAS f32x4* dp_ = (LAS f32x4*)(wl + 512 + r32 * 512 + ((RB) * 32 + 4 * half) * 4); \
        _Pragma("unroll") for (int g_ = 0; g_ < 4; ++g_) dp_[2 * g_] = (f32x4){ACC[4 * g_], ACC[4 * g_ + 1], ACC[4 * g_ + 2], ACC[4 * g_ + 3]}; } } while (0)
#define PA_SB() __builtin_amdgcn_sched_barrier(0)
#define PA_TASK(AC, AN, I1, I2, HWC, RSC, HWN, RSN, T) do { \
        const int tn_ = PA_CL((T) + tstep), tn2_ = PA_CL((T) + 2 * tstep); \
        PA_H(HWN, RSN, tn_); PA_IDX(I2, tn2_); \
        {   const float x0 = bflo((unsigned)HWC) * RSC, x1 = bfhi((unsigned)HWC) * RSC, x2 = bflo((unsigned)(HWC >> 32)) * RSC, x3 = bfhi((unsigned)(HWC >> 32)) * RSC; \
            int hi_ = 0; hi_ = __builtin_amdgcn_cvt_pk_fp8_f32(x0, x1, hi_, false); hi_ = __builtin_amdgcn_cvt_pk_fp8_f32(x2, x3, hi_, true); \
            const f32x2 b0_ = __builtin_amdgcn_cvt_pk_f32_fp8(hi_, false), b1_ = __builtin_amdgcn_cvt_pk_f32_fp8(hi_, true); \
            int lo_ = 0; lo_ = __builtin_amdgcn_cvt_pk_fp8_f32((x0 - b0_.x) * 16.f, (x1 - b0_.y) * 16.f, lo_, false); lo_ = __builtin_amdgcn_cvt_pk_fp8_f32((x2 - b1_.x) * 16.f, (x3 - b1_.y) * 16.f, lo_, true); \
              \
            LAS int* bp_ = (LAS int*)(wl + ((((F.lane >> 2) & 1) * 4 + ((F.lane >> 3) & 3)) * 64 + (F.lane >> 5) * 16 + 4 * (F.lane & 3))); bp_[0] = hi_; bp_[8] = lo_; } \
        asm volatile("" ::: "memory"); \
        i32x8 B_[4]; \
        _Pragma("unroll") for (int s_ = 0; s_ < 4; ++s_) { const LAS v4u* q_ = (const LAS v4u*)(wl + (half * 4 + s_) * 64 + (r32 & 1) * 32); const v4u c0_ = q_[0], c1_ = q_[1]; \
            B_[s_] = (i32x8){(int)c0_.x, (int)c0_.y, (int)c0_.z, (int)c0_.w, (int)c1_.x, (int)c1_.y, (int)c1_.z, (int)c1_.w}; } \
        asm volatile("" ::: "memory"); \
        v4u ar0_[4], ar1_[4]; f32x16 ac0_, ac1_; \
        PA_LN(AN, I1, 0, tn_); PA_W(AC, 0); PA_R(ar0_); PA_SB(); \
        PA_LN(AN, I1, 1, tn_); PA_W(AC, 1); PA_R(ar1_); PA_SB(); \
        PA_M(ar0_, ac0_); PA_SB(); \
        PA_LN(AN, I1, 2, tn_); PA_W(AC, 2); PA_R(ar0_); PA_SB(); \
        PA_M(ar1_, ac1_); PA_SB(); \
        PA_D(0, ac0_); PA_SB(); \
        PA_LN(AN, I1, 3, tn_); PA_W(AC, 3); PA_R(ar1_); PA_SB(); \
        PA_M(ar0_, ac0_); PA_SB(); \
        PA_D(1, ac1_); PA_SB(); \
        PA_M(ar1_, ac1_); PA_SB(); \
        PA_D(2, ac0_); PA_D(3, ac1_); \
        asm volatile("" ::: "memory"); \
        {   const LAS f32x2* rp_ = (const LAS f32x2*)(wl + 512) + F.lane; const f32x2 h_ = rp_[0], l_ = rp_[64]; \
            *(GAS f32x2*)(PART + ((size_t)((T) >> 13) * MREAL + ((T) & (MREAL - 1))) * 128 + 2 * F.lane) = (f32x2){h_.x + l_.x * 0.0625f, h_.y + l_.y * 0.0625f}; } \
        asm volatile("" ::: "memory"); \
    } while (0)
    if (t0 < tend) {
        const int tlast = t0 + ((tend - 1 - t0) / tstep) * tstep;
        v4u A0[4][4], A1[4][4]; int I0[16], I1[16]; unsigned long long HW0, HW1; float RS0, RS1;
        PA_IDX(I0, t0); PA_H(HW0, RS0, t0);
        { const int t1_ = PA_CL(t0 + tstep); PA_IDX(I1, t1_); }
        PA_LN(A0, I0, 0, t0); PA_LN(A0, I0, 1, t0); PA_LN(A0, I0, 2, t0); PA_LN(A0, I0, 3, t0);
#pragma unroll 1
        for (int t = t0; t < tend; t += 2 * tstep) {
            PA_TASK(A0, A1, I1, I0, HW0, RS0, HW1, RS1, t);
            { const int tb_ = PA_CL(t + tstep); PA_TASK(A1, A0, I0, I1, HW1, RS1, HW0, RS0, tb_); }
        }
    }
#undef PA_LN
#undef PA_W
#undef PA_R
#undef PA_M
#undef PA_D
#undef PA_SB
#undef PA_CL
#undef PA_IDX
#undef PA_H
#undef PA_TASK
}

__device__ __forceinline__ void p10_experts(Frame& F, float* dst) {
    const int* IDX = (const int*)(F.ws + WS_IDX); const float* GATE = (const float*)(F.ws + WS_GATE);
    const unsigned char* EV = F.ws + WS_EV; const float* PART = (const float*)(F.ws + WS_PART);
    const float* SU = (const float*)(F.ws + WS_SU); const float* SV = (const float*)(F.ws + WS_SV);
    for (int tok = F.gw; tok < MREAL; tok += F.NGW) {
        const int e0 = IDX[(size_t)tok * 128 + F.lane], e1 = IDX[(size_t)tok * 128 + 64 + F.lane];
        float d0 = 0.f, d1 = 0.f;
        const int pk = ((F.lane >> 2) & 3) * 32 + 8 * (F.lane & 3) + (F.lane >> 4);
#pragma unroll
        for (int x = 0; x < 8; ++x) { const float* pp = PART + ((size_t)x * MREAL + tok) * 128; d0 += pp[pk]; d1 += pp[pk + 4]; }
        const float w0 = GATE[(size_t)tok * 128 + F.lane] * SV[e0] * gelu1(d0 * SU[e0]), w1 = GATE[(size_t)tok * 128 + 64 + F.lane] * SV[e1] * gelu1(d1 * SU[e1]);
        float acc[32];
#pragma unroll
        for (int i = 0; i < 32; ++i) acc[i] = 0.f;
#define EIDX(k) __builtin_amdgcn_readlane((k) < 64 ? e0 : e1, (k) & 63)
#define WK(k) __int_as_float(__builtin_amdgcn_readlane(__float_as_int((k) < 64 ? w0 : w1), (k) & 63))
#define LOADV(R, k0) do { _Pragma("unroll") for (int i_ = 0; i_ < 4; ++i_) R[i_] = *(const GAS v4u*)(EV + (size_t)EIDX((k0) + i_) * 1024 + 16 * F.lane); } while (0)
        v4u Va[4], Vb[4];
        LOADV(Va, 0);
#pragma unroll 1
        for (int b = 0; b < 32; b += 2) {
            const int k0 = 4 * b;
            LOADV(Vb, k0 + 4);
            __builtin_amdgcn_sched_barrier(0);
#pragma unroll
            for (int i = 0; i < 4; ++i) { axpy32(acc, WK(k0 + i), Va[i]); __builtin_amdgcn_sched_barrier(0); }
            if (b + 2 < 32) LOADV(Va, k0 + 8);
            __builtin_amdgcn_sched_barrier(0);
#pragma unroll
            for (int i = 0; i < 4; ++i) { axpy32(acc, WK(k0 + 4 + i), Vb[i]); __builtin_amdgcn_sched_barrier(0); }
        }
#undef EIDX
#undef WK
#undef LOADV
        { GAS f32x4* op = (GAS f32x4*)(F.out + (size_t)tok * DM) + F.lane; GAS f32x4* dp = (GAS f32x4*)(dst + (size_t)tok * DM) + F.lane;
#pragma unroll
          for (int j = 0; j < 8; ++j) { f32x4 a = op[64 * j];
              a[0] += acc[4 * j]; a[1] += acc[4 * j + 1]; a[2] += acc[4 * j + 2]; a[3] += acc[4 * j + 3]; dp[64 * j] = a; } }
    }
}
struct Args { const float* in[23]; float* out; unsigned char* ws; int ph_lo, ph_hi, li, pad; };
__global__ void __launch_bounds__(NWAVES * 64, 2) mega_fwd(Args args) {
    extern __shared__ __attribute__((aligned(16))) unsigned char lds[];
    Frame F;
    F.lds = (LAS unsigned char*)lds;
    F.MISC = (volatile LAS unsigned*)(F.lds + MISC_OFF);
    F.tid = threadIdx.x; F.lane = F.tid & 63; F.wave = __builtin_amdgcn_readfirstlane(F.tid >> 6);
    F.G = gridDim.x; { const int bx = blockIdx.x; F.vcu = (F.G % 8 == 0) ? (bx % 8) * (F.G / 8) + bx / 8 : bx; }
    F.gw = F.vcu * NWAVES + F.wave; F.NGW = F.G * NWAVES;
#pragma unroll
    for (int i = 0; i < 23; ++i) F.in[i] = args.in[i];
    F.out = args.out; F.ws = args.ws;
    F.ctl = (gu32*)(args.ws + WS_CTL);
    for (int u = F.tid; u < (LDS_BYTES - LDSCTL_OFF) / 4; u += NWAVES * 64) ((LAS unsigned*)(F.lds + LDSCTL_OFF))[u] = 0u;
    __syncthreads();
    XcdBarrier bar; bar.bar = (unsigned*)(F.ctl + CW_BAR); bar.x = 0; bar.st = nullptr;
    if (N_LAUNCHES == 1) bar = xcd_barrier_post((unsigned*)(F.ctl + CW_BAR), F.MISC + 8);
#define GRID_BAR(seam) do { if (N_LAUNCHES != 1) { if (F.tid == 0) __hip_atomic_store(F.ctl + CW_TMO, 0xBADBA0u | (unsigned)(seam), RLX_AGENT); } else { xcd_barrier(bar); } } while (0)
    const int lo = args.ph_lo, hi = args.ph_hi;
#ifndef PH_MASK
#define PH_MASK 0x7ff
#endif
#define IN(k) ((((PH_MASK) >> (k)) & 1) && lo <= (k) && (k) < hi)
#define BOTH(k) (IN(k) && IN((k) + (((k) == 6 || (k) == 1) ? 2 : 1)))
#ifndef PH_REP_MASK
#define PH_REP_MASK 0
#endif
#define REPEAT(k) for (int rep_ = 0; rep_ < ((((PH_REP_MASK) >> (k)) & 1) ? 2 : 1); ++rep_)
    unsigned char* ws = args.ws;
    typedef pg8::bf16_t pb;
    if (IN(0)) { REPEAT(0) { p0_prologue(F); __syncthreads(); } if (BOTH(0)) GRID_BAR(0); }
    if (IN(1)) { REPEAT(1) {
        pg8::Gemm g{(const pb*)(ws + WS_XN), (const pb*)(ws + WS_WIN), M1, N1, DM, DM}; pg8::StaticOrder S; S.init(M1, N1, F.G, (int)blockIdx.x);
        Epi1 E{ws, (LAS float*)(F.lds + RING_BYTES), F.in[I_DKG], F.in[I_FKG]};
        pg8::gemm_phase<Epi1, pg8::StaticOrder, true, PG8_SP2>(F.lds + RING_OFF, g, S, E); }
        p1_tail(F);
        if (BOTH(1)) GRID_BAR(1);
    }
    if (IN(3)) { p3_attention<0>(F, (char*)lds + RING_OFF);
#if (PH_REP_MASK >> 3) & 1
        p3_attention<ATT_ABL>(F, (char*)lds + RING_OFF);
#endif
        if (BOTH(3)) GRID_BAR(3); }
    if (IN(4)) { REPEAT(4) { p4_combine(F); } if (BOTH(4)) GRID_BAR(4);
#if (PH_REP_MASK >> 11) & 1
        for (int xb_ = 0; xb_ < 10; ++xb_) GRID_BAR(4);
#endif
    }
    if (IN(5)) {
        { pg8::Gemm g{(const pb*)(ws + WS_OD), (const pb*)(ws + WS_WBD), MREAL, DM, 1024, 1024}; pg8::StaticOrder S; S.init(MREAL, DM, F.G, (int)blockIdx.x);
          pg8::EpiGen<F_Gemm2a> E{F_Gemm2a{(const bf16*)(ws + WS_GA), F.in[I_BGATE], (bf16*)(ws + WS_MG)}};
          pg8::gemm_phase<pg8::EpiGen<F_Gemm2a>, pg8::StaticOrder, PG8_ALIGN, PG8_SP2>(F.lds + RING_OFF, g, S, E); }
        { pg8::Gemm g{(const pb*)(ws + WS_OF), (const pb*)(ws + WS_WBF), MREAL, DM, 1024, 1024}; pg8::StaticOrder S; S.init(MREAL, DM, F.G, (int)blockIdx.x);
          pg8::EpiGen<F_Gemm2b> E{F_Gemm2b{(const bf16*)(ws + WS_GB), F.in[I_BGATE] + DM, (bf16*)(ws + WS_MG)}};
          pg8::gemm_phase<pg8::EpiGen<F_Gemm2b>, pg8::StaticOrder, PG8_ALIGN, PG8_SP2>(F.lds + RING_OFF, g, S, E); }
#if (PH_REP_MASK >> 5) & 1
        { pg8::Gemm g{(const pb*)(ws + WS_OD), (const pb*)(ws + WS_WBD), MREAL, DM, 1024, 1024}; pg8::StaticOrder S; S.init(MREAL, DM, F.G, (int)blockIdx.x);
          pg8::EpiGen<F_Gemm2a> E{F_Gemm2a{(const bf16*)(ws + WS_GA), F.in[I_BGATE], (bf16*)(ws + WS_MG)}};
          pg8::gemm_phase<pg8::EpiGen<F_Gemm2a>, pg8::StaticOrder, PG8_ALIGN, PG8_SP2>(F.lds + RING_OFF, g, S, E); }
        { pg8::Gemm g{(const pb*)(ws + WS_OF), (const pb*)(ws + WS_WBF), MREAL, DM, 1024, 1024}; pg8::StaticOrder S; S.init(MREAL, DM, F.G, (int)blockIdx.x);
          pg8::EpiGen<F_Gemm2b> E{F_Gemm2b{(const bf16*)(ws + WS_GB), F.in[I_BGATE] + DM, (bf16*)(ws + WS_MG)}};
          pg8::gemm_phase<pg8::EpiGen<F_Gemm2b>, pg8::StaticOrder, PG8_ALIGN, PG8_SP2>(F.lds + RING_OFF, g, S, E); }
#endif
        if (BOTH(5)) GRID_BAR(5);
    }
    if (IN(6)) {
        {
        pg8::Gemm g{(const pb*)(ws + WS_MG), (const pb*)(ws + WS_WOUT), MREAL, DM, DM, DM}; pg8::StaticOrder S; S.init(MREAL, DM, F.G, (int)blockIdx.x);
        pg8::EpiGen<F_Gemm3> E{F_Gemm3{F.in[I_X], F.out, F.in[I_GPEER], (bf16*)(ws + WS_H2N), (float*)(ws + WS_SSQ), 0.f}};
        pg8::gemm_phase<pg8::EpiGen<F_Gemm3>, pg8::StaticOrder, PG8_ALIGN, PG8_SP2>(F.lds + RING_OFF, g, S, E);
        }
#if (PH_REP_MASK >> 6) & 1
        {
        pg8::Gemm g{(const pb*)(ws + WS_MG), (const pb*)(ws + WS_WOUT), MREAL, DM, DM, DM}; pg8::StaticOrder S; S.init(MREAL, DM, F.G, (int)blockIdx.x);
        pg8::EpiGen<F_Gemm3> E{F_Gemm3{F.in[I_X], F.out, F.in[I_GPEER], (bf16*)(ws + WS_H2N), (float*)(ws + WS_SSQ), 0.f}};
        pg8::gemm_phase<pg8::EpiGen<F_Gemm3>, pg8::StaticOrder, PG8_ALIGN, PG8_SP2>(F.lds + RING_OFF, g, S, E);
        }
#endif
        if (BOTH(6)) GRID_BAR(6);
    }
    if (IN(8)) {
        {
        pg8::Gemm g{(const pb*)(ws + WS_H2N), (const pb*)(ws + WS_WPQ), MREAL, 1024, 1024, DM}; SplitK2Order S; S.init(MREAL, 1024, F.G, (int)blockIdx.x);
        pg8::EpiGen<F_Gemm4> E{F_Gemm4{(float*)(ws + WS_QP)}};
        pg8::gemm_phase<pg8::EpiGen<F_Gemm4>, SplitK2Order, PG8_ALIGN, PG8_SP2>(F.lds + RING_OFF, g, S, E);
        }
#if (PH_REP_MASK >> 8) & 1
        {
        pg8::Gemm g{(const pb*)(ws + WS_H2N), (const pb*)(ws + WS_WPQ), MREAL, 1024, 1024, DM}; SplitK2Order S; S.init(MREAL, 1024, F.G, (int)blockIdx.x);
        pg8::EpiGen<F_Gemm4> E{F_Gemm4{(float*)(ws + WS_QP)}};
        pg8::gemm_phase<pg8::EpiGen<F_Gemm4>, SplitK2Order, PG8_ALIGN, PG8_SP2>(F.lds + RING_OFF, g, S, E);
        }
#endif
        if (BOTH(8)) GRID_BAR(8);
    }
    if (IN(9)) { REPEAT(9) { p9_route(F); } if (BOTH(9)) GRID_BAR(9); }
    if (IN(10)) { for (int rp_ = 0; rp_ < ((((PH_REP_MASK) >> 12) & 1) ? 2 : 1); ++rp_) p10a_udots(F); GRID_BAR(10); REPEAT(10) { p10_experts(F, (rep_ == 0 && ((PH_REP_MASK >> 10) & 1)) ? (float*)(ws + WS_T) : F.out); } }
#undef IN
#undef BOTH
}

extern "C" void kernel_launch(void* const* d_in, const int* in_sizes, int n_in, void* d_out, int out_size, void* d_ws, size_t ws_size, hipStream_t stream) {
    static int grid = 0;
    if (grid == 0) {
        if (n_in != 23 || in_sizes[0] != MREAL * DM || out_size != MREAL * DM || ws_size < WS_END) {
            fprintf(stderr, "kernel_launch: built for 23 inputs, x/out of %d floats, >= %zu bytes of workspace; got n_in %d, in0 %d, out %d, ws %zu; nothing launched\n", MREAL * DM, (size_t)WS_END, n_in, n_in > 0 ? in_sizes[0] : -1, out_size, ws_size); grid = -1; return; }
        int dev = 0, cus = 0, per_cu = 0;
        if (hipGetDevice(&dev) != hipSuccess || hipDeviceGetAttribute(&cus, hipDeviceAttributeMultiprocessorCount, dev) != hipSuccess) { fprintf(stderr, "kernel_launch: device query failed\n"); grid = -1; return; }
        if (hipFuncSetAttribute((const void*)mega_fwd, hipFuncAttributeMaxDynamicSharedMemorySize, LDS_BYTES) != hipSuccess) { fprintf(stderr, "kernel_launch: hipFuncSetAttribute failed\n"); grid = -1; return; }
        if (hipOccupancyMaxActiveBlocksPerMultiprocessor(&per_cu, (const void*)mega_fwd, NWAVES * 64, LDS_BYTES) != hipSuccess || per_cu < 1) {
            fprintf(stderr, "kernel_launch: occupancy query reports %d workgroups per CU; nothing launched\n", per_cu); (void)hipGetLastError(); grid = -1; return; }
        grid = cus;
    }
    if (grid < 0) return;
    if (hipMemsetAsync((char*)d_ws + WS_CTL, 0, CTL_ZERO_BYTES, stream) != hipSuccess) { fprintf(stderr, "kernel_launch: hipMemsetAsync failed\n"); return; }
    Args a{};
    for (int i = 0; i < 23; ++i) a.in[i] = (const float*)d_in[i];
    a.out = (float*)d_out; a.ws = (unsigned char*)d_ws;
    for (int li = 0; li < N_LAUNCHES; ++li) {
        a.ph_lo = (N_LAUNCHES == 1) ? 0 : li; a.ph_hi = (N_LAUNCHES == 1) ? N_PHASES : li + 1; a.li = li;
        hipLaunchKernelGGL(mega_fwd, dim3(grid), dim3(NWAVES * 64), LDS_BYTES, stream, a);
        const hipError_t le = hipPeekAtLastError();
        if (le != hipSuccess) { fprintf(stderr, "kernel_launch: launch %d failed: %s\n", li, hipGetErrorName(le)); break; }
    }
}
```

```cpp
#include <hip/hip_runtime.h>
#include <cstdio>
#include <cstdint>
#include <cmath>
#define PH_REP_MASK 0x0
#define ATT_ABL 0
namespace pg8 {
#define PG8_LAS __attribute__((address_space(3)))
typedef unsigned short bf16_t;
typedef short bf16x8 __attribute__((ext_vector_type(8)));
typedef float f32x4 __attribute__((ext_vector_type(4)));
typedef unsigned u32x4 __attribute__((ext_vector_type(4)));
constexpr int BM = 256, BK = 64, HALF = 128, HTB = HALF * BK * 2  , STAGE_BYTES = 8 * HTB, NXCD = 8, WGM = 8;

__host__ __device__ __forceinline__ int lds_byte(int r, int c) { const int st = (r >> 4) * 2 + (c >> 5), rr = r & 15, cc = c & 31, ob = rr * 64 + cc * 2; return st * 1024 + (ob ^ (((ob >> 9) & 1) << 5)); }
__host__ __device__ __forceinline__ void stage_rc(int b, int& R, int& C) { const int st = b / 1024, sb = b % 1024, swz = sb ^ (((sb >> 9) & 1) << 5); R = (st >> 1) * 16 + swz / 64; C = (st & 1) * 32 + (swz % 64) / 2; }
__host__ __device__ __forceinline__ int perm32(int rho) { const int n = rho >> 4, i = rho & 15; return 8 * (i >> 2) + 4 * n + (i & 3); }

struct Unit { int pm, pn, ko, kob, chain; };
struct Gemm { const bf16_t* A; const bf16_t* Bt; int M, N, K, ld; };

struct StaticOrder {
    int nM, nN, nwg, G, c;
    __host__ __device__ void init(int M, int N, int G_, int c_) { nM = M / BM; nN = N / BM; nwg = nM * nN; G = G_; c = c_; }
    __host__ __device__ bool next(int i, Unit& u) const {
        const long L = (long)i * G + c; if (L >= nwg) return false;
        int wgid = (int)L; { const int q = nwg / NXCD, r = nwg % NXCD, xcd = wgid % NXCD, off = wgid / NXCD; wgid = (xcd < r ? xcd * (q + 1) : r * (q + 1) + (xcd - r) * q) + off; }
        const int nig = WGM * nN, gid = wgid / nig, fm = gid * WGM, gsz = (nM - fm) < WGM ? (nM - fm) : WGM;
        u.pm = fm + ((wgid % nig) % gsz); u.pn = (wgid % nig) / gsz; u.ko = 0; u.kob = 0; u.chain = 0; return true;
    }
    __device__ __forceinline__ void a_ready(const Unit&) const {}
    __device__ __forceinline__ void done(const Unit&) const {}
};
__device__ __forceinline__ unsigned cvt_pk_bf16(float lo, float hi) { unsigned r; asm volatile("v_cvt_pk_bf16_f32 %0, %1, %2" : "=v"(r) : "v"(lo), "v"(hi)); return r; }
typedef float f32x2 __attribute__((ext_vector_type(2)));
template <class F> struct EpiGen {
    static constexpr bool PERM = true, AFTER_DRAIN = false;
    F f;
    __device__ __forceinline__ void operator()(const f32x4 (&acc)[2][2][4][2], const Unit& u, int wr, int wc, int fr, int fq) const {
        F g = f; if (!g.begin(u)) return;
        asm volatile("" : "+v"(fr), "+v"(fq));
#pragma unroll
        for (int ai = 0; ai < 2; ++ai)
#pragma unroll
            for (int m = 0; m < 4; ++m) { const int rt = ai * HALF + wr * 64 + m * 16 + fr; g.row_begin();
#pragma unroll
                for (int bj = 0; bj < 2; ++bj) g.chunk(u, rt, bj * HALF + wc * 32 + 8 * fq, acc[ai][bj][m][0], acc[ai][bj][m][1]);
                g.row_end(u, rt, wc, fq); }
    }
    __device__ __forceinline__ void scale(f32x4 (&acc)[2][2][4][2], const Unit& u, int wr, int wc, int fr, int fq) const {
        F g = f;
        asm volatile("" : "+v"(fr), "+v"(fq));
#pragma unroll
        for (int ai = 0; ai < 2; ++ai)
#pragma unroll
            for (int m = 0; m < 4; ++m) { const int rt = ai * HALF + wr * 64 + m * 16 + fr;
#pragma unroll
                for (int bj = 0; bj < 2; ++bj) g.scale_chunk(u, rt, bj * HALF + wc * 32 + 8 * fq, acc[ai][bj][m][0], acc[ai][bj][m][1]);
                asm volatile("" ::: "memory"); __builtin_amdgcn_sched_barrier(0); }
    }
};
template <class Epi, class Sched, bool ALIGN_EPI = false, bool SP2 = false>
__device__ __forceinline__ void gemm_phase(PG8_LAS unsigned char* lds, const Gemm g, const Sched& S, const Epi& E) {
    const int tid = threadIdx.x, wid = __builtin_amdgcn_readfirstlane(tid >> 6), lane = tid & 63, wr = wid >> 2, wc = wid & 3, fr = lane & 15, fq = lane >> 4;
    const int K = g.K, nt = K / BK, LD = g.ld;
    unsigned voffA[2], voffB[2];
#pragma unroll
    for (int i = 0; i < 2; ++i) { int R, C; stage_rc(tid * 16 + i * 8192, R, C); const int Rb = Epi::PERM ? ((R & ~31) + perm32(R & 31)) : R;
        voffA[i] = (unsigned)(R * LD + C) * 2u; voffB[i] = (unsigned)(Rb * LD + C) * 2u; }
    const size_t kstep = (size_t)(BK * 2);
    const size_t hstep = (size_t)HALF * LD * 2;
    const size_t tstep = 2 * hstep;
    const unsigned ldsw = (unsigned)wid * 1024u;
    const int aoff = lds_byte(wr * 64 + fr, fq * 8), boff = lds_byte(wc * 32 + fr, fq * 8);
#define PG8_SA(b, h) (((b) * 2 + (h)) * HTB)
#define PG8_SB(b, h) ((4 + (b) * 2 + (h)) * HTB)
#define PG8_STAGE(bufoff, gbase, voff) do { _Pragma("unroll") for (int _i = 0; _i < 2; ++_i) \
        __builtin_amdgcn_global_load_lds((const unsigned*)((const char*)(gbase) + (voff)[_i]), (PG8_LAS unsigned*)(lds + (bufoff) + ldsw + _i * 8192), 16, 0, 0); } while (0)
#define PG8_LDA(dst, b, h) do { _Pragma("unroll") for (int m = 0; m < 4; ++m) _Pragma("unroll") for (int k = 0; k < 2; ++k) dst[m][k] = *(const PG8_LAS bf16x8*)(lds + PG8_SA(b, h) + aoff + m * 2048 + k * 1024); } while (0)
#define PG8_LDB(dst, b, h) do { _Pragma("unroll") for (int n = 0; n < 2; ++n) _Pragma("unroll") for (int k = 0; k < 2; ++k) dst[n][k] = *(const PG8_LAS bf16x8*)(lds + PG8_SB(b, h) + boff + n * 2048 + k * 1024); } while (0)
#define PG8_MMA(ai, bj, At, Bt) do { __builtin_amdgcn_s_setprio(1); _Pragma("unroll") for (int m = 0; m < 4; ++m) _Pragma("unroll") for (int n = 0; n < 2; ++n) _Pragma("unroll") for (int k = 0; k < 2; ++k) \
        acc[ai][bj][m][n] = __builtin_amdgcn_mfma_f32_16x16x32_bf16(Bt[n][k], At[m][k], acc[ai][bj][m][n], 0, 0, 0); __builtin_amdgcn_s_setprio(0); } while (0)
#define PG8_WAIT_V(n) asm volatile("s_waitcnt vmcnt(" #n ")" ::: "memory")
#define PG8_WAIT_L(n) asm volatile("s_waitcnt lgkmcnt(" #n ")" ::: "memory")
#define PG8_BAR __builtin_amdgcn_s_barrier()
#define PG8_SCHED __builtin_amdgcn_sched_barrier(0)
    Unit cur, nxt; int ui = 0;
    if (!S.next(0, cur)) return;
    f32x4 acc[2][2][4][2];
#pragma unroll
    for (int a = 0; a < 2; ++a)
#pragma unroll
        for (int b = 0; b < 2; ++b)
#pragma unroll
            for (int m = 0; m < 4; ++m)
#pragma unroll
                for (int n = 0; n < 2; ++n) acc[a][b][m][n] = (f32x4){0.f, 0.f, 0.f, 0.f};
    bf16x8 At[4][2], B0[2][2], B1[2][2];
    const char* cA = (const char*)g.A + (size_t)cur.pm * tstep + cur.ko; const char* cB = (const char*)g.Bt + (size_t)cur.pn * tstep + cur.kob;
    S.a_ready(cur);
    if constexpr (SP2) {
        PG8_STAGE(PG8_SB(0, 0), cB, voffB); PG8_STAGE(PG8_SB(0, 1), cB + hstep, voffB); PG8_STAGE(PG8_SA(0, 0), cA, voffA); PG8_STAGE(PG8_SA(0, 1), cA + hstep, voffA);
        if (wr == 1) PG8_BAR;
        PG8_WAIT_V(2); PG8_BAR;
        PG8_STAGE(PG8_SB(1, 0), cB + kstep, voffB); PG8_STAGE(PG8_SA(1, 0), cA + kstep, voffA); PG8_STAGE(PG8_SB(1, 1), cB + hstep + kstep, voffB);
        PG8_WAIT_V(6); PG8_BAR;
    } else {
        PG8_STAGE(PG8_SB(0, 0), cB, voffB); PG8_STAGE(PG8_SA(0, 0), cA, voffA); PG8_STAGE(PG8_SB(0, 1), cB + hstep, voffB); PG8_STAGE(PG8_SA(0, 1), cA + hstep, voffA);
        if (wr == 1) PG8_BAR;
        PG8_WAIT_V(4); PG8_BAR;
        PG8_STAGE(PG8_SB(1, 0), cB + kstep, voffB); PG8_STAGE(PG8_SA(1, 0), cA + kstep, voffA); PG8_STAGE(PG8_SB(1, 1), cB + hstep + kstep, voffB);
        PG8_WAIT_V(6); PG8_BAR;
    }
    for (;;) {
        const bool has_next = S.next(ui + 1, nxt);
        const char* nA = has_next ? (const char*)g.A + (size_t)nxt.pm * tstep + nxt.ko : cA; const char* nB = has_next ? (const char*)g.Bt + (size_t)nxt.pn * tstep + nxt.kob : cB;
        for (int t = 0; t < nt; t += 2) {
            const bool last = (t == nt - 2);
            const char* a1 = cA + (size_t)(t + 1) * kstep;
            const char* a2 = last ? nA : cA + (size_t)(t + 2) * kstep; const char* b2 = last ? nB : cB + (size_t)(t + 2) * kstep;
            const char* a3 = a2 + kstep; const char* b3 = b2 + kstep;
            if (last && has_next) S.a_ready(nxt);
            if constexpr (SP2) {
            PG8_LDB(B0, 0, 0); PG8_LDB(B1, 0, 1); PG8_SCHED; PG8_LDA(At, 0, 0); PG8_STAGE(PG8_SA(1, 1), a1 + hstep, voffA);
            PG8_WAIT_V(8); PG8_WAIT_L(0); PG8_BAR; PG8_MMA(0, 0, At, B0); PG8_MMA(0, 1, At, B1); PG8_BAR; PG8_SCHED;
            PG8_LDA(At, 0, 1); PG8_STAGE(PG8_SB(0, 0), b2, voffB); PG8_STAGE(PG8_SB(0, 1), b2 + hstep, voffB); PG8_STAGE(PG8_SA(0, 0), a2, voffA);
            PG8_WAIT_V(8); PG8_WAIT_L(0); PG8_BAR; PG8_MMA(1, 0, At, B0); PG8_MMA(1, 1, At, B1); PG8_BAR; PG8_SCHED;
            PG8_LDB(B0, 1, 0); PG8_LDB(B1, 1, 1); PG8_SCHED; PG8_LDA(At, 1, 0); PG8_STAGE(PG8_SA(0, 1), a2 + hstep, voffA);
            PG8_WAIT_V(8); PG8_WAIT_L(0); PG8_BAR; PG8_MMA(0, 0, At, B0); PG8_MMA(0, 1, At, B1); PG8_BAR; PG8_SCHED;
            PG8_LDA(At, 1, 1); PG8_STAGE(PG8_SB(1, 0), b3, voffB); PG8_STAGE(PG8_SB(1, 1), b3 + hstep, voffB); PG8_STAGE(PG8_SA(1, 0), a3, voffA);
            PG8_WAIT_V(8); PG8_WAIT_L(0); PG8_BAR; PG8_MMA(1, 0, At, B0); PG8_MMA(1, 1, At, B1); PG8_BAR; PG8_SCHED;
            } else {
            PG8_LDB(B0, 0, 0); PG8_SCHED; PG8_LDA(At, 0, 0); PG8_STAGE(PG8_SA(1, 1), a1 + hstep, voffA);
            PG8_WAIT_L(8); PG8_BAR; PG8_WAIT_L(0); PG8_MMA(0, 0, At, B0); PG8_BAR; PG8_SCHED;
            PG8_LDB(B1, 0, 1); PG8_STAGE(PG8_SB(0, 0), b2, voffB);
            PG8_BAR; PG8_WAIT_L(0); PG8_MMA(0, 1, At, B1); PG8_BAR;
            PG8_LDA(At, 0, 1); PG8_STAGE(PG8_SA(0, 0), a2, voffA);
            PG8_BAR; PG8_WAIT_L(0); PG8_MMA(1, 0, At, B0); PG8_BAR; PG8_SCHED;
            PG8_STAGE(PG8_SB(0, 1), b2 + hstep, voffB);
            PG8_WAIT_V(6); PG8_BAR; PG8_MMA(1, 1, At, B1); PG8_BAR;
            PG8_LDB(B0, 1, 0); PG8_SCHED; PG8_LDA(At, 1, 0); PG8_STAGE(PG8_SA(0, 1), a2 + hstep, voffA);
            PG8_WAIT_L(8); PG8_BAR; PG8_WAIT_L(0); PG8_MMA(0, 0, At, B0); PG8_BAR; PG8_SCHED;
            PG8_LDB(B1, 1, 1); PG8_STAGE(PG8_SB(1, 0), b3, voffB);
            PG8_BAR; PG8_WAIT_L(0); PG8_MMA(0, 1, At, B1); PG8_BAR;
            PG8_LDA(At, 1, 1); PG8_STAGE(PG8_SA(1, 0), a3, voffA);
            PG8_BAR; PG8_WAIT_L(0); PG8_MMA(1, 0, At, B0); PG8_BAR; PG8_SCHED;
            PG8_STAGE(PG8_SB(1, 1), b3 + hstep, voffB);
            PG8_WAIT_V(6); PG8_BAR; PG8_MMA(1, 1, At, B1); PG8_BAR;
            }
        }
        if constexpr (ALIGN_EPI) { if (wr == 0) PG8_BAR; }
        if constexpr (!Epi::AFTER_DRAIN) { if (cur.chain) E.scale(acc, cur, wr, wc, fr, fq); else E(acc, cur, wr, wc, fr, fq); S.done(cur); }
        if (!has_next) break;
        if (!cur.chain)
#pragma unroll
        for (int a = 0; a < 2; ++a)
#pragma unroll
            for (int b = 0; b < 2; ++b)
#pragma unroll
                for (int m = 0; m < 4; ++m)
#pragma unroll
                    for (int n = 0; n < 2; ++n) acc[a][b][m][n] = (f32x4){0.f, 0.f, 0.f, 0.f};
        cur = nxt; cA = nA; cB = nB; ++ui;
        if constexpr (ALIGN_EPI) { if (wr == 1) PG8_BAR; }
    }
    PG8_WAIT_V(0);
    if constexpr (!ALIGN_EPI) { if (wr == 0) PG8_BAR; }
    PG8_BAR;
    if constexpr (Epi::AFTER_DRAIN) { E.fused(acc, cur, wr, wc, fr, fq, lds, wid, lane); S.done(cur); }
#undef PG8_SA
#undef PG8_SB
#undef PG8_STAGE
#undef PG8_LDA
#undef PG8_LDB
#undef PG8_MMA
#undef PG8_WAIT_V
#undef PG8_WAIT_L
#undef PG8_BAR
#undef PG8_SCHED
}
}
#ifndef PG8_SP2
#define PG8_SP2 true
#endif
#ifndef PG8_ALIGN
#define PG8_ALIGN true
#endif
namespace att {
typedef unsigned short bf16;
typedef short bf16x8 __attribute__((ext_vector_type(8)));
typedef short s16x4 __attribute__((ext_vector_type(4)));
typedef float f32x16 __attribute__((ext_vector_type(16)));
typedef float f32x4 __attribute__((ext_vector_type(4)));
typedef unsigned u32x4 __attribute__((ext_vector_type(4)));
constexpr int NW = 8, QBLK = 32, KVBLK = 64, QB = NW * QBLK, D = 128, PITCH = 1024;
constexpr int SHM_V = KVBLK * D * 2, SHM_K = KVBLK * D * 2;
constexpr int NBUF = 3;
constexpr int OFF_V = 0, OFF_K = NBUF * SHM_V, OFF_WS = OFF_K + NBUF * SHM_K, OFF_B = OFF_WS + NW * 64 * 4, LDS_BYTES = OFF_B + NBUF * 256;
constexpr float THR = 8.f;
#define KSWZ(row, colB) ((row) * 256 + ((colB) ^ (((row) & 7) << 4)))
#define SBAR() __builtin_amdgcn_sched_barrier(0)
__device__ __forceinline__ int v_st(int k, int c) { const int kk = (k & ~0xC) | ((k & 4) << 1) | ((k & 8) >> 1); return ((kk >> 3) * 4 + (c >> 5)) * 512 + ((kk & 7) * 32 + (c & 31)) * 2; }
__device__ __forceinline__ int v_rd_base(int lane) { return ((lane & 3) << 3) | (((lane >> 2) & 3) << 6) | (((lane >> 4) & 1) << 5) | (((lane >> 5) & 1) << 8); }
constexpr int v_rd_off(int d0, int ks, int half) { return d0 * 512 + ks * 4096 + half * 2048; }
__device__ __forceinline__ int crow(int r, int hi) { return (r & 3) + 8 * (r >> 2) + 4 * hi; }
__device__ __forceinline__ unsigned cvtpk(float lo, float hi) {
    unsigned r; asm volatile("v_cvt_pk_bf16_f32 %0, %1, %2" : "=v"(r) : "v"(lo), "v"(hi)); return r;
}
__device__ __forceinline__ bf16x8 load8(const bf16* p) { return *reinterpret_cast<const bf16x8*>(p); }
__device__ __forceinline__ void mask_tile(f32x16& p0, f32x16& p1, int dq, unsigned W) {
    const float NEG = -__builtin_inff();
#pragma unroll
    for (int r = 0; r < 16; ++r) {
        const int c = (r & 3) + 8 * (r >> 2);
        if ((unsigned)(dq - c) >= W) p0[r] = NEG;
        if ((unsigned)(dq - c - 32) >= W) p1[r] = NEG;
    }
}
template <int DQK>
__device__ __forceinline__ void partialSM(f32x16& p0, f32x16& p1, float& m_reg, float& mn, float& alpha) {
    constexpr float SCALE = DQK == 64 ? 0.125f : 0.08838834764831845f;
    float pmax;
    { float m0 = fmaxf(p0[0], p0[4]), m1 = fmaxf(p0[1], p0[5]), m2 = fmaxf(p0[2], p0[6]), m3 = fmaxf(p0[3], p0[7]);
#pragma unroll
      for (int r = 8; r < 16; r += 4) { m0 = fmaxf(m0, p0[r]); m1 = fmaxf(m1, p0[r + 1]); m2 = fmaxf(m2, p0[r + 2]); m3 = fmaxf(m3, p0[r + 3]); }
#pragma unroll
      for (int r = 0; r < 16; r += 4) { m0 = fmaxf(m0, p1[r]); m1 = fmaxf(m1, p1[r + 1]); m2 = fmaxf(m2, p1[r + 2]); m3 = fmaxf(m3, p1[r + 3]); }
      pmax = fmaxf(fmaxf(m0, m1), fmaxf(m2, m3)); }
    { auto rr = __builtin_amdgcn_permlane32_swap(__float_as_uint(pmax), __float_as_uint(pmax), false, false);
      pmax = fmaxf(__uint_as_float(rr[0]), __uint_as_float(rr[1])); }
    constexpr float C2 = 1.4426950408889634f * SCALE;
    if (__builtin_expect(__all((pmax - m_reg) * SCALE <= THR), 1)) { mn = m_reg; alpha = 1.f; }
    else { mn = fmaxf(m_reg, pmax); alpha = __builtin_amdgcn_exp2f((m_reg - mn) * C2); m_reg = mn; }
    const float mnL = -mn * C2;
    for (int r = 0; r < 16; ++r) p0[r] = fmaf(p0[r], C2, mnL); for (int r = 0; r < 16; ++r) p1[r] = fmaf(p1[r], C2, mnL);
    for (int r = 0; r < 16; ++r) p0[r] = __builtin_amdgcn_exp2f(p0[r]);
}
__device__ __forceinline__ void finishSM(f32x16& p0, f32x16& p1, float alpha, float& l_reg, bf16x8& pa0, bf16x8& pa1, bf16x8& pa2, bf16x8& pa3) {
    for (int r = 0; r < 16; ++r) p1[r] = __builtin_amdgcn_exp2f(p1[r]);
    float ps;
    { float s0 = p0[0] + p1[0], s1 = p0[1] + p1[1], s2 = p0[2] + p1[2], s3 = p0[3] + p1[3];
#pragma unroll
      for (int r = 4; r < 16; r += 4) { s0 += p0[r]; s1 += p0[r + 1]; s2 += p0[r + 2]; s3 += p0[r + 3]; s0 += p1[r]; s1 += p1[r + 1]; s2 += p1[r + 2]; s3 += p1[r + 3]; }
      ps = (s0 + s1) + (s2 + s3); }
    { auto rr = __builtin_amdgcn_permlane32_swap(__float_as_uint(ps), __float_as_uint(ps), false, false);
      ps = __uint_as_float(rr[0]) + __uint_as_float(rr[1]); }
    l_reg = l_reg * alpha + ps;
#define PK4(P, B_, OUT) do { unsigned a0 = cvtpk(P[B_+0], P[B_+1]), a1 = cvtpk(P[B_+2], P[B_+3]);                          \
        unsigned b0 = cvtpk(P[B_+4], P[B_+5]), b1 = cvtpk(P[B_+6], P[B_+7]);                                             \
        auto r0 = __builtin_amdgcn_permlane32_swap(a0, b0, false, false); auto r1 = __builtin_amdgcn_permlane32_swap(a1, b1, false, false); \
        u32x4 w = {r0[0], r1[0], r0[1], r1[1]}; OUT = *reinterpret_cast<bf16x8*>(&w); } while (0)
    PK4(p0, 0, pa0); PK4(p0, 8, pa1); PK4(p1, 0, pa2); PK4(p1, 8, pa3);
#undef PK4
}
__device__ __forceinline__ float rowmax32(const f32x16& p0, const f32x16& p1) {
    float m0 = fmaxf(p0[0], p0[4]), m1 = fmaxf(p0[1], p0[5]), m2 = fmaxf(p0[2], p0[6]), m3 = fmaxf(p0[3], p0[7]);
#pragma unroll
    for (int r = 8; r < 16; r += 4) { m0 = fmaxf(m0, p0[r]); m1 = fmaxf(m1, p0[r + 1]); m2 = fmaxf(m2, p0[r + 2]); m3 = fmaxf(m3, p0[r + 3]); }
#pragma unroll
    for (int r = 0; r < 16; r += 4) { m0 = fmaxf(m0, p1[r]); m1 = fmaxf(m1, p1[r + 1]); m2 = fmaxf(m2, p1[r + 2]); m3 = fmaxf(m3, p1[r + 3]); }
    float pmax = fmaxf(fmaxf(m0, m1), fmaxf(m2, m3));
    auto rr = __builtin_amdgcn_permlane32_swap(__float_as_uint(pmax), __float_as_uint(pmax), false, false);
    return fmaxf(__uint_as_float(rr[0]), __uint_as_float(rr[1]));
}
__device__ __forceinline__ void partialSM_first(f32x16& p0, f32x16& p1, float& m_reg, float& alpha, f32x16& negm) {
    const float mn = fmaxf(m_reg, rowmax32(p0, p1));
    alpha = __builtin_amdgcn_exp2f(m_reg - mn); m_reg = mn;
#pragma unroll
    for (int r = 0; r < 16; ++r) { p0[r] -= mn; p1[r] -= mn; negm[r] = -mn; }
#pragma unroll
    for (int r = 0; r < 16; ++r) p0[r] = __builtin_amdgcn_exp2f(p0[r]);
}
__device__ __forceinline__ void partialSM_shift(f32x16& p0, f32x16& p1, float& m_reg, float& alpha, f32x16& negm) {
    const float pmax = rowmax32(p0, p1);
    if (__builtin_expect(__all(pmax <= THR * 1.4426950408889634f), 1)) alpha = 1.f;
    else { const float d = fmaxf(pmax, 0.f); alpha = __builtin_amdgcn_exp2f(-d); m_reg += d;
#pragma unroll
           for (int r = 0; r < 16; ++r) { p0[r] -= d; p1[r] -= d; negm[r] = -m_reg; } }
#pragma unroll
    for (int r = 0; r < 16; ++r) p0[r] = __builtin_amdgcn_exp2f(p0[r]);
}
template <int KB, int DQK>
__device__ __forceinline__ void qkt(f32x16& p0, f32x16& p1, const unsigned (&kaddr)[4], const char* B_lds, int r32, int hi, const bf16x8* qr, bool use_bias, const f32x16& cinit) {
    const char* bb = B_lds + KB * 256 + hi * 16;
    if (!use_bias) { p0 = cinit; p1 = cinit; } else
#pragma unroll
    for (int g = 0; g < 4; ++g) { const f32x4 t0 = *reinterpret_cast<const f32x4*>(bb + 32 * g), t1 = *reinterpret_cast<const f32x4*>(bb + 32 * g + 128);
        p0[4 * g] = t0[0]; p0[4 * g + 1] = t0[1]; p0[4 * g + 2] = t0[2]; p0[4 * g + 3] = t0[3];
        p1[4 * g] = t1[0]; p1[4 * g + 1] = t1[1]; p1[4 * g + 2] = t1[2]; p1[4 * g + 3] = t1[3]; }
#define KRD(dst, dd, off) asm volatile("ds_read_b128 %0, %1 offset:%2" : "=v"(dst) : "v"(kaddr[dd]), "i"(off) : "memory")
#define KGRP(S, g) do { KRD(S[0], (2 * (g)) & 3, KB * SHM_K + ((g) >> 1) * 128); KRD(S[1], (2 * (g)) & 3, KB * SHM_K + ((g) >> 1) * 128 + 32 * 256);                 \
                        KRD(S[2], (2 * (g) + 1) & 3, KB * SHM_K + ((g) >> 1) * 128); KRD(S[3], (2 * (g) + 1) & 3, KB * SHM_K + ((g) >> 1) * 128 + 32 * 256); } while (0)
#define KWAIT(N, S) do { asm volatile("s_waitcnt lgkmcnt(" #N ")" : "+v"(S[0]), "+v"(S[1]), "+v"(S[2]), "+v"(S[3]) :: "memory"); SBAR(); } while (0)
#define KMM(S, g) do { p0 = __builtin_amdgcn_mfma_f32_32x32x16_bf16(S[0], qr[2 * (g)], p0, 0, 0, 0); p1 = __builtin_amdgcn_mfma_f32_32x32x16_bf16(S[1], qr[2 * (g)], p1, 0, 0, 0);             \
                       p0 = __builtin_amdgcn_mfma_f32_32x32x16_bf16(S[2], qr[2 * (g) + 1], p0, 0, 0, 0); p1 = __builtin_amdgcn_mfma_f32_32x32x16_bf16(S[3], qr[2 * (g) + 1], p1, 0, 0, 0); SBAR(); } while (0)
    bf16x8 ka[4], kb[4];
    KGRP(ka, 0); KGRP(kb, 1);
    if constexpr (DQK == 128) {
        bf16x8 kc[4];
        KGRP(kc, 2);
        KWAIT(8, ka); KMM(ka, 0); KGRP(ka, 3);
        KWAIT(8, kb); KMM(kb, 1);
        KWAIT(4, kc); KMM(kc, 2);
        KWAIT(0, ka); KMM(ka, 3);
    } else {
        KWAIT(4, ka); KMM(ka, 0);
        KWAIT(0, kb); KMM(kb, 1);
    }
#undef KGRP
#undef KWAIT
#undef KMM
#undef KRD
}
template <int VB>
__device__ __forceinline__ void pv_tile(f32x16* o, int vb0, bf16x8 pa0, bf16x8 pa1, bf16x8 pa2, bf16x8 pa3) {
#define TRRD(dst, off) asm volatile("ds_read_b64_tr_b16 %0, %1 offset:%2" : "=&v"(dst) : "v"(vb0), "i"(off) : "memory")
#define PV_RD(S, d0) do { constexpr int b_ = VB * SHM_V + v_rd_off(d0, 0, 0);     \
        TRRD(S[0], b_); TRRD(S[1], b_ + 2048); TRRD(S[2], b_ + 4096); TRRD(S[3], b_ + 6144); TRRD(S[4], b_ + 8192); TRRD(S[5], b_ + 10240); TRRD(S[6], b_ + 12288); TRRD(S[7], b_ + 14336); } while (0)
#define PV_MM(S, d0) do {                                                                                                                   \
        o[d0] = __builtin_amdgcn_mfma_f32_32x32x16_bf16(pa0, (bf16x8){S[0][0], S[0][1], S[0][2], S[0][3], S[1][0], S[1][1], S[1][2], S[1][3]}, o[d0], 0, 0, 0);   \
        o[d0] = __builtin_amdgcn_mfma_f32_32x32x16_bf16(pa1, (bf16x8){S[2][0], S[2][1], S[2][2], S[2][3], S[3][0], S[3][1], S[3][2], S[3][3]}, o[d0], 0, 0, 0);   \
        o[d0] = __builtin_amdgcn_mfma_f32_32x32x16_bf16(pa2, (bf16x8){S[4][0], S[4][1], S[4][2], S[4][3], S[5][0], S[5][1], S[5][2], S[5][3]}, o[d0], 0, 0, 0);   \
        o[d0] = __builtin_amdgcn_mfma_f32_32x32x16_bf16(pa3, (bf16x8){S[6][0], S[6][1], S[6][2], S[6][3], S[7][0], S[7][1], S[7][2], S[7][3]}, o[d0], 0, 0, 0); } while (0)
#define PV_WAIT(N) do { asm volatile("s_waitcnt lgkmcnt(" #N ")" ::: "memory"); SBAR(); } while (0)
    s16x4 A[8], B[8];
    PV_RD(A, 0); PV_RD(B, 1);
    PV_WAIT(8); PV_MM(A, 0); SBAR();
    PV_RD(A, 2);
    PV_WAIT(8); PV_MM(B, 1); SBAR();
    PV_RD(B, 3);
    PV_WAIT(8); PV_MM(A, 2); SBAR();
    PV_WAIT(0); PV_MM(B, 3);
#undef PV_RD
#undef PV_MM
#undef PV_WAIT
#undef TRRD
}
struct BlockRef { const bf16* Q; const bf16* K; const bf16* V; const float* KB; bf16* O; int P0; int dqk; const float* qg; const float* rope; };
#define ROW(p, k0, rr) ((p) + (size_t)((k0) + (rr)) * PITCH + sc)
#define VMW() asm volatile("s_waitcnt vmcnt(0)" ::: "memory")
#define SLOAD_H(k0_) do { const int k0 = (ABL == 1) ? 0 : (k0_); st_v0 = load8(ROW(cur.V, k0, sr)); st_v1 = load8(ROW(cur.V, k0, 32 + sr));              \
                         if (sc < DQK) { st_k0 = load8(ROW(cur.K, k0, sr)); st_k1 = load8(ROW(cur.K, k0, 32 + sr)); }    \
                         if (tid < 64) st_b = cur.KB[(k0) + tid]; } while (0)
#define SWRITE_H(bf) do { *(bf16x8*)(V_lds + (bf) * SHM_V + vst0) = st_v0; *(bf16x8*)(V_lds + (bf) * SHM_V + vst1) = st_v1; \
                         if (sc < DQK) { *(bf16x8*)(K_lds + (bf) * SHM_K + kws) = st_k0; *(bf16x8*)(K_lds + (bf) * SHM_K + kws + 32 * 256) = st_k1; } \
                         if (tid < 64) *(float*)(B_lds + (bf) * 256 + tid * 4) = st_b; } while (0)
template <int DQK, int ABL>
__device__ __forceinline__ void block(const BlockRef& cur, int skv, char* lds) {
    int tid = threadIdx.x; asm volatile("" : "+v"(tid));
    const int wid = __builtin_amdgcn_readfirstlane(tid >> 6), lane = tid & 63, r32 = lane & 31, hi = lane >> 5;
    constexpr unsigned W = 1u << 30;
    int j_hi = (cur.P0 + QB - 1) / KVBLK + 1; if (j_hi > skv / KVBLK) j_hi = skv / KVBLK;
    const int NT = j_hi;
    const int qlo = cur.P0 + wid * QBLK, qm = qlo + r32 - 4 * hi;
    char* V_lds = lds + OFF_V; char* K_lds = lds + OFF_K; char* B_lds = lds + OFF_B;
    float* ws = (float*)(lds + OFF_WS) + wid * 64; float* li_l = ws, * al_l = ws + 32;
    float m_reg = -1e30f, l_reg = 0; f32x16 o[4] = {}; f32x16 negm = {};
    const int sr = tid >> 4, sc = (tid & 15) * 8, vst0 = v_st(sr, sc), vst1 = v_st(32 + sr, sc), kws = KSWZ(sr, sc * 2);
    const int vb0 = (int)(uintptr_t)V_lds + v_rd_base(lane);
    unsigned kaddr[4];
#pragma unroll
    for (int dd = 0; dd < 4; ++dd) kaddr[dd] = (unsigned)(uintptr_t)K_lds + KSWZ(r32, (dd * 16 + hi * 8) * 2);
    bf16x8 qr[DQK / 16];
    {
        float qf[DQK / 16][8]; float ss = 0.f;
#pragma unroll
        for (int d0 = 0; d0 < DQK / 16; ++d0) { const u32x4 w = __builtin_bit_cast(u32x4, load8(cur.Q + (size_t)(wid * QBLK + r32) * PITCH + d0 * 16 + hi * 8));
#pragma unroll
            for (int i = 0; i < 4; ++i) { qf[d0][2 * i] = __uint_as_float(w[i] << 16); qf[d0][2 * i + 1] = __uint_as_float(w[i] & 0xffff0000u); }
#pragma unroll
            for (int i = 0; i < 8; ++i) ss += qf[d0][i] * qf[d0][i]; }
        { auto rr = __builtin_amdgcn_permlane32_swap(__float_as_uint(ss), __float_as_uint(ss), false, false); ss = __uint_as_float(rr[0]) + __uint_as_float(rr[1]); }
        const float rn = (DQK == 64 ? 0.125f * 1.4426950408889634f : 1.f) / sqrtf(ss * (1.f / DQK) + 1e-6f);
#pragma unroll
        for (int d0 = 0; d0 < DQK / 16; ++d0) { const f32x4 g0 = *(const f32x4*)(cur.qg + d0 * 16 + hi * 8), g1 = *(const f32x4*)(cur.qg + d0 * 16 + hi * 8 + 4);
#pragma unroll
            for (int i = 0; i < 4; ++i) { qf[d0][i] *= rn * g0[i]; qf[d0][4 + i] *= rn * g1[i]; } }
        if (DQK == 64) { const float* tb = cur.rope + (size_t)(cur.P0 - 48 + wid * QBLK + r32) * 16;
#pragma unroll
            for (int i = 0; i < 8; ++i) { const float mine = qf[0][i]; auto rr = __builtin_amdgcn_permlane32_swap(__float_as_uint(mine), __float_as_uint(mine), false, false);
                const float other = __uint_as_float(hi ? rr[0] : rr[1]); const float c = tb[2 * i], sn = tb[2 * i + 1];
                qf[0][i] = hi ? (mine * c + other * sn) : (mine * c - other * sn); } }
#pragma unroll
        for (int d0 = 0; d0 < DQK / 16; ++d0) { u32x4 w = {cvtpk(qf[d0][0], qf[d0][1]), cvtpk(qf[d0][2], qf[d0][3]), cvtpk(qf[d0][4], qf[d0][5]), cvtpk(qf[d0][6], qf[d0][7])}; qr[d0] = __builtin_bit_cast(bf16x8, w); }
    }
    bf16x8 st_v0, st_v1, st_k0, st_k1; float st_b;
    SLOAD_H(0); VMW(); SWRITE_H(0);
    if (NT > 1) { SLOAD_H(KVBLK); VMW(); SWRITE_H(1); }
    __syncthreads();
    if (wid >= 4) __builtin_amdgcn_s_barrier();
#define RESC(a) do { if (__any((a) < 1.f)) { if (hi == 0) al_l[r32] = (a); asm volatile("s_waitcnt lgkmcnt(0)" ::: "memory");              \
                     for (int d_ = 0; d_ < 4; ++d_) for (int r = 0; r < 16; ++r) o[d_][r] *= al_l[crow(r, hi)]; } } while (0)
#define BAR() do { asm volatile("s_waitcnt lgkmcnt(0)" ::: "memory"); __builtin_amdgcn_s_barrier(); asm volatile("" ::: "memory"); } while (0)
#define KEEP4(a, b, c, d) asm volatile("" :: "v"(a), "v"(b), "v"(c), "v"(d))
#define TILE(t, BUF) do { f32x16 p0, p1; float mn, al; bf16x8 pa0, pa1, pa2, pa3;                                             \
        if (ABL != 6 && ABL < 7) { if ((t) + 2 < NT) { SLOAD_H(((t) + 2) * KVBLK); } }                                          \
        SBAR();                                                                                                               \
        if (ABL == 4 || ABL == 9 || ABL >= 10) { p0 = f32x16{}; p1 = f32x16{}; asm volatile("" : "+v"(p0), "+v"(p1)); }                                 \
        else qkt<BUF, DQK>(p0, p1, kaddr, B_lds, r32, hi, qr, DQK == 128 || (t) == 0, negm);     \
        { const int kb_ = (t) * KVBLK; if (kb_ + KVBLK - 1 > qlo) mask_tile(p0, p1, qm - kb_, W); }                            \
        if (ABL != 5 && ABL < 7) BAR();                                                                                        \
        if (ABL == 2 || ABL >= 7) { al = 1.f; l_reg += p0[0];                                                                  \
            { u32x4 w0 = {cvtpk(p0[0], p0[1]), cvtpk(p0[2], p0[3]), cvtpk(p0[4], p0[5]), cvtpk(p0[6], p0[7])}; pa0 = *reinterpret_cast<bf16x8*>(&w0);    \
              u32x4 w1 = {cvtpk(p0[8], p0[9]), cvtpk(p0[10], p0[11]), cvtpk(p0[12], p0[13]), cvtpk(p0[14], p0[15])}; pa1 = *reinterpret_cast<bf16x8*>(&w1); \
              u32x4 w2 = {cvtpk(p1[0], p1[1]), cvtpk(p1[2], p1[3]), cvtpk(p1[4], p1[5]), cvtpk(p1[6], p1[7])}; pa2 = *reinterpret_cast<bf16x8*>(&w2);    \
              u32x4 w3 = {cvtpk(p1[8], p1[9]), cvtpk(p1[10], p1[11]), cvtpk(p1[12], p1[13]), cvtpk(p1[14], p1[15])}; pa3 = *reinterpret_cast<bf16x8*>(&w3); } } \
        else { if constexpr (DQK == 64) { if ((t) == 0) partialSM_first(p0, p1, m_reg, al, negm); else partialSM_shift(p0, p1, m_reg, al, negm); (void)mn; } \
               else partialSM<DQK>(p0, p1, m_reg, mn, al);                                                                 \
               RESC(al);                                                                                                      \
               finishSM(p0, p1, al, l_reg, pa0, pa1, pa2, pa3); }                                                              \
        SBAR();                                                                                                               \
        if (ABL == 3 || ABL == 8 || ABL >= 10) { KEEP4(pa0, pa1, pa2, pa3); } else pv_tile<BUF>(o, vb0, pa0, pa1, pa2, pa3);                              \
        if (ABL != 6 && ABL < 7) { if ((t) + 2 < NT) { VMW(); SWRITE_H(((BUF) + 2) % 3); } }                                   \
        if (ABL != 5 && ABL < 7) BAR(); } while (0)
    for (int t = 0; t < (ABL == 11 ? 0 : NT); t += 3) {
        TILE(t, 0);
        if (t + 1 < NT) TILE(t + 1, 1);
        if (t + 2 < NT) TILE(t + 2, 2);
    }
    if (wid < 4) __builtin_amdgcn_s_barrier();
    if (hi == 0) li_l[r32] = l_reg; asm volatile("s_waitcnt lgkmcnt(0)" ::: "memory");
    float rli[16];
#pragma unroll
    for (int r = 0; r < 16; ++r) rli[r] = __builtin_amdgcn_rcpf(li_l[crow(r, hi)]);
    bf16* Ow = cur.O + (size_t)(wid * QBLK) * PITCH;
    {
        unsigned short* stg = (unsigned short*)(lds + OFF_V + wid * 8192);
#pragma unroll
        for (int r = 0; r < 16; ++r) { const int orow = crow(r, hi);
#pragma unroll
            for (int d0 = 0; d0 < 4; ++d0) stg[orow * 128 + d0 * 32 + r32] = (unsigned short)cvtpk(o[d0][r] * rli[r], 0.f); }
        asm volatile("s_waitcnt lgkmcnt(0)" ::: "memory");
#pragma unroll
        for (int i = 0; i < 8; ++i) { const int row = i * 4 + (lane >> 4), ch = lane & 15;
            const u32x4 v = *(const u32x4*)(stg + row * 128 + ch * 8); *(u32x4*)(Ow + (size_t)row * PITCH + ch * 8) = v;
            if (i & 1) asm volatile("" ::: "memory"); } }
    __syncthreads();
#undef RESC
#undef BAR
#undef TILE
}
#undef ROW
#undef VMW
#undef SLOAD_H
#undef SWRITE_H
#undef KSWZ
#undef SBAR
}
constexpr int NWAVES = 8;
#ifndef MK_N_LAUNCHES
#define MK_N_LAUNCHES 1
#endif
constexpr int N_PHASES = 11;
constexpr int N_LAUNCHES = MK_N_LAUNCHES;
static_assert(N_LAUNCHES == 1 || N_LAUNCHES == N_PHASES, "MK_N_LAUNCHES is 1 or 11");

constexpr int BATCH = 2, SEQ = 4096, DM = 2048, NMETA = 16, MREAL = BATCH * SEQ;
constexpr int LSEQ = NMETA + SEQ;
constexpr int LP = 4160, PADF = 48;
constexpr int M1 = 8192;
constexpr int N1 = 10240;
constexpr int WIN_LD = 10248;
constexpr int NEXP = 16384, PEER_H = 8, PEER_K = 16, EROW = 1536;
constexpr float EPS = 1e-6f;

constexpr size_t MiB = 1u << 20;
constexpr size_t WS_CTL = 0, CTL_ZERO_BYTES = 32768;
constexpr size_t WS_WIN = 2 * MiB, WS_WBD = 42 * MiB, WS_WBF = 46 * MiB, WS_WOUT = 50 * MiB, WS_WPQ = 58 * MiB;
constexpr size_t WS_EU = 62 * MiB, WS_EV = 94 * MiB;
constexpr size_t WS_SU = 126 * MiB, WS_SV = 126 * MiB + 65536;
constexpr size_t WS_XN = 190 * MiB;
constexpr size_t WS_H2N = 190 * MiB;
constexpr size_t WS_DQ = 223 * MiB, WS_DK = 239 * MiB, WS_DV = 256 * MiB, WS_FQ = 273 * MiB, WS_FK = 289 * MiB, WS_FV = 306 * MiB;
constexpr size_t WS_GA = 323 * MiB, WS_GB = 355 * MiB;
constexpr size_t WS_O1 = 387 * MiB, WS_O2 = 403 * MiB, WS_OF = 419 * MiB;
constexpr size_t WS_OD = 435 * MiB;
constexpr size_t WS_T = 223 * MiB;
constexpr size_t WS_MG = 289 * MiB;
constexpr size_t WS_QP = 323 * MiB;
constexpr size_t WS_RS = 396 * MiB;
constexpr size_t WS_PART = WS_QP;
constexpr size_t WS_IDX = 387 * MiB, WS_GATE = 391 * MiB;
constexpr size_t WS_SSQ = 395 * MiB;
constexpr size_t WS_LOGF = 451 * MiB;
constexpr size_t WS_KBIAS = 452 * MiB;
constexpr size_t WS_SKH = 451 * MiB + 512 * 1024, WS_SKL = 452 * MiB + 512 * 1024;
constexpr size_t WS_ROPE = 453 * MiB;
constexpr size_t WS_END = 454 * MiB;
static_assert(WS_T + (size_t)MREAL * DM * 4 <= WS_FK && WS_MG + (size_t)MREAL * DM * 2 <= WS_GA && WS_XN + (size_t)M1 * DM * 2 <= WS_DQ, "d_ws map");
static_assert(WS_DK + (size_t)BATCH * LP * 1024 * 2 <= WS_DV && WS_FV + (size_t)BATCH * LP * 1024 * 2 <= WS_GA, "d_ws map");

constexpr int CW_TMO = 0, CW_CODE = 1;
constexpr int CW_BAR = 4096;
constexpr int RING_OFF = 0, RING_BYTES = 131072;
constexpr int LDSCTL_OFF = 143360, MISC_OFF = LDSCTL_OFF + 320;
constexpr int LDS_BYTES = 147456;
#define GAS __attribute__((address_space(1)))
#define LAS __attribute__((address_space(3)))
typedef unsigned short bf16;
typedef unsigned v4u __attribute__((ext_vector_type(4)));
typedef float f32x4 __attribute__((ext_vector_type(4)));
typedef short bf16x8 __attribute__((ext_vector_type(8)));
typedef GAS unsigned gu32;
typedef GAS unsigned long long gu64;
#define RLX_AGENT __ATOMIC_RELAXED, __HIP_MEMORY_SCOPE_AGENT
#define LDS_WAIT() asm volatile("s_waitcnt lgkmcnt(0)" ::: "memory")
#define VM_WAIT() asm volatile("s_waitcnt vmcnt(0)" ::: "memory")
__device__ __forceinline__ unsigned long long rt() { return __builtin_amdgcn_s_memrealtime(); }
__device__ __forceinline__ unsigned f2bf(float f) { unsigned u = __builtin_bit_cast(unsigned, f); return (u + 0x7fffu + ((u >> 16) & 1u)) >> 16; }
__device__ __forceinline__ unsigned pk2(float lo, float hi) { return f2bf(lo) | (f2bf(hi) << 16); }
#define XB_TMO      128
#define XB_XCNT(j)  (256  + 64 * (j))
#define XB_XSUB(j)  (1280 + 64 * (j))
#define XB_XGEN(j)  (2304 + 64 * (j))
#define XB_TOP      3328
#define XB_TOPGEN   3392
#define XCD_BAR_WORDS 3456
#define XB_SPIN_CAP (1u << 18)

__device__ __forceinline__ unsigned xb_ld(unsigned* p)              { return __hip_atomic_load(p, __ATOMIC_RELAXED, __HIP_MEMORY_SCOPE_AGENT); }
__device__ __forceinline__ unsigned xb_add(unsigned* p, unsigned v) { return __hip_atomic_fetch_add(p, v, __ATOMIC_RELAXED, __HIP_MEMORY_SCOPE_AGENT); }
__device__ __forceinline__ unsigned xb_xcc_id() { return (unsigned)__builtin_amdgcn_s_getreg((3 << 11) | 20) & 0xFu; }
#define XB_SPIN(cond, bar) do { unsigned _sp = 0; while (cond) { __builtin_amdgcn_s_sleep(1); \
    if ((++_sp & 255u) == 0u) { if (xb_ld(&(bar)[XB_TMO])) break; if (_sp > XB_SPIN_CAP) { atomicAdd(&(bar)[XB_TMO], 1u); break; } } } } while (0)

struct XcdBarrier {
    unsigned* bar; unsigned x;
    volatile LAS unsigned* st;
};

__device__ __forceinline__ XcdBarrier xcd_barrier_post(unsigned* bar, volatile LAS unsigned* st) {
    XcdBarrier b; b.bar = bar; b.x = xb_xcc_id(); b.st = st;
    if (threadIdx.x == 0) (void)xb_add(&bar[XB_XCNT(b.x)], 1u);
    return b;
}
__device__ __forceinline__ void xcd_barrier_complete(unsigned* bar, unsigned x, unsigned& nloc, unsigned& nx) {
    const unsigned G = gridDim.x * gridDim.y * gridDim.z;
    unsigned sum, cnt, mine, sp = 0u;
    for (;;) {
        sum = 0u; cnt = 0u; mine = 0u;
#pragma unroll
        for (unsigned j = 0; j < 16; ++j) { const unsigned c = xb_ld(&bar[XB_XCNT(j)]); sum += c; cnt += (c > 0u) ? 1u : 0u; mine = (j == x) ? c : mine; }
        if (sum == G) break;
        __builtin_amdgcn_s_sleep(1);
        if ((++sp & 255u) == 0u) { if (xb_ld(&bar[XB_TMO])) break; if (sp > XB_SPIN_CAP) { atomicAdd(&bar[XB_TMO], 1u); break; } }
    }
    nloc = mine > 0u ? mine : 1u; nx = cnt > 0u ? cnt : 1u;
}

__device__ __forceinline__ void xcd_barrier(const XcdBarrier& b) {
    asm volatile("s_waitcnt vmcnt(0)" ::: "memory");
    __syncthreads();
    if (threadIdx.x == 0) {
        unsigned* bar = b.bar;
        __builtin_amdgcn_s_waitcnt(0);
        unsigned nloc = b.st[0], nx = b.st[1];
        if (nloc == 0u) { xcd_barrier_complete(bar, b.x, nloc, nx); b.st[0] = nloc; b.st[1] = nx; }
        const unsigned old = xb_add(&bar[XB_XSUB(b.x)], 1u);
        const unsigned gen = old / nloc;
        if (old + 1u == (gen + 1u) * nloc) {
            __builtin_amdgcn_fence(__ATOMIC_RELEASE, "agent");
            asm volatile("s_waitcnt vmcnt(0)" ::: "memory");
            const unsigned og = xb_add(&bar[XB_TOP], 1u);
            const unsigned tg = og / nx;
            if (og + 1u == (tg + 1u) * nx) xb_add(&bar[XB_TOPGEN], 1u);
            else XB_SPIN(xb_ld(&bar[XB_TOPGEN]) == tg, bar);
            __builtin_amdgcn_fence(__ATOMIC_ACQUIRE, "agent");
            xb_add(&bar[XB_XGEN(b.x)], 1u);
            asm volatile("s_waitcnt vmcnt(0)" ::: "memory");
        } else {
            XB_SPIN(xb_ld(&bar[XB_XGEN(b.x)]) == gen, bar);
            __builtin_amdgcn_fence(__ATOMIC_ACQUIRE, "agent");
            asm volatile("s_waitcnt vmcnt(0)" ::: "memory");
        }
    }
    __syncthreads();
}
__device__ __forceinline__ float wave_sum(float v) {
#pragma unroll
    for (int o = 1; o < 64; o <<= 1) v += __shfl_xor(v, o);
    return v;
}
struct Frame {
    LAS unsigned char* lds;
    volatile LAS unsigned* MISC;
    gu32* ctl;
    int tid, lane, wave;
    int vcu, G;
    int gw, NGW;
    const float* in[23];
    float* out;
    unsigned char* ws;
};
enum { I_X = 0, I_META, I_GMIX, I_WIN, I_BFORGET, I_BGATE, I_DQG, I_DKG, I_FQG, I_FKG, I_LQ1, I_LK1, I_LQ2, I_LK2, I_SUBLN, I_WBD, I_WBF, I_WOUT, I_GPEER, I_WPQ, I_SUBK, I_EU, I_EV };

__device__ __forceinline__ float bf2f(unsigned short b) { return __uint_as_float((unsigned)b << 16); }
__device__ __forceinline__ float bflo(unsigned w) { return __uint_as_float(w << 16); }
__device__ __forceinline__ float bfhi(unsigned w) { return __uint_as_float(w & 0xffff0000u); }
__device__ __forceinline__ float sigmoidf_(float x) { return 1.f / (1.f + __expf(-x)); }

__device__ __forceinline__ void p0_transpose_item2(const float* W, int ldw, int ncols, int K, bf16* WT, int row_off, LAS float* scr, int item, int lane) {
    const int nblk = ncols / 32, kb = item / nblk, nb = item % nblk, k0 = 64 * kb, n0 = 32 * nb;
#pragma unroll 8
    for (int i = 0; i < 32; ++i) { const int kk = 2 * i + (lane >> 5); scr[kk * 33 + (lane & 31)] = __builtin_nontemporal_load(W + (size_t)(k0 + kk) * ldw + n0 + (lane & 31)); }
    LDS_WAIT(); asm volatile("" ::: "memory");
    const int c = lane & 7;
#pragma unroll
    for (int j = 0; j < 4; ++j) { const int n = (lane >> 3) + 8 * j; const LAS float* s = scr + (8 * c) * 33 + n;
        v4u o; o.x = pk2(s[0 * 33], s[1 * 33]); o.y = pk2(s[2 * 33], s[3 * 33]); o.z = pk2(s[4 * 33], s[5 * 33]); o.w = pk2(s[6 * 33], s[7 * 33]);
        *(GAS v4u*)(WT + (size_t)(row_off + n0 + n) * K + k0 + 8 * c) = o; }
    LDS_WAIT(); asm volatile("" ::: "memory");
}

__device__ __forceinline__ void p0_prologue(Frame& F) {
    unsigned char* ws = F.ws;
    for (int rpa_ = 0; rpa_ < (((PH_REP_MASK) >> 12) & 1 ? 2 : 1); ++rpa_)
    {   LAS float* WF = (LAS float*)(F.lds + RING_OFF);
        const float* win = F.in[I_WIN];
        for (int i = F.tid; i < DM * 2; i += NWAVES * 64) { const int k = i >> 1, hh = (i & 1) * 4;
            const f32x4 v = *(const f32x4*)(win + (size_t)k * WIN_LD + 6144 + hh);
            WF[(hh + 0) * DM + k] = v.x; WF[(hh + 1) * DM + k] = v.y; WF[(hh + 2) * DM + k] = v.z; WF[(hh + 3) * DM + k] = v.w; }
        __syncthreads();
        bf16* XN = (bf16*)(ws + WS_XN); float* LOGF = (float*)(ws + WS_LOGF);
        const float* gmix = F.in[I_GMIX]; const float* bfg = F.in[I_BFORGET];
        constexpr int NROW = MREAL + NMETA;
#define P0A_SRC(m_) ((const GAS f32x4*)((m_) < MREAL ? F.in[I_X] + (size_t)(m_) * DM : F.in[I_META] + (size_t)((m_) - MREAL) * DM) + F.lane)
#define P0A_LOAD(V, m_) do { const GAS f32x4* xr_ = P0A_SRC(m_); _Pragma("unroll") for (int j = 0; j < 8; ++j) V[j] = __builtin_nontemporal_load(xr_ + 64 * j); } while (0)
#define P0A_ROW(V, m_) do { const int mrow = (m_);                                                                                        \
            GAS unsigned long long* o8 = (GAS unsigned long long*)(XN + (size_t)mrow * DM) + F.lane; float s2 = 0.f;                       \
            _Pragma("unroll") for (int j = 0; j < 8; ++j) s2 += (V[j].x * V[j].x + V[j].y * V[j].y) + (V[j].z * V[j].z + V[j].w * V[j].w);  \
            const float rstd = 1.f / sqrtf(wave_sum(s2) * (1.f / DM) + EPS);                                                           \
            float fl[8];                                                                                                               \
            _Pragma("unroll") for (int h = 0; h < 8; ++h) fl[h] = 0.f;                                                                 \
            _Pragma("unroll") for (int j = 0; j < 8; ++j) { const f32x4 g = *((const GAS f32x4*)gmix + 64 * j + F.lane);               \
                const f32x4 y = {V[j].x * rstd * g.x, V[j].y * rstd * g.y, V[j].z * rstd * g.z, V[j].w * rstd * g.w};                  \
                o8[64 * j] = (unsigned long long)pk2(y.x, y.y) | ((unsigned long long)pk2(y.z, y.w) << 32);                            \
                _Pragma("unroll") for (int h = 0; h < 8; ++h) { const f32x4 w = *(const LAS f32x4*)(WF + h * DM + 256 * j + 4 * F.lane); \
                    fl[h] += (y.x * w.x + y.y * w.y) + (y.z * w.z + y.w * w.w); }                                                      \
                asm volatile("" ::: "memory"); __builtin_amdgcn_sched_barrier(0); }     \
              \
            float a4[4]; { const bool up = (F.lane & 32) != 0;                                                                          \
              _Pragma("unroll") for (int i = 0; i < 4; ++i) { const float snd = up ? fl[i] : fl[i + 4]; const float kp = up ? fl[i + 4] : fl[i]; a4[i] = kp + __shfl_xor(snd, 32); } }   \
            float a2[2]; { const bool up = (F.lane & 16) != 0;                                                                          \
              _Pragma("unroll") for (int i = 0; i < 2; ++i) { const float snd = up ? a4[i] : a4[i + 2]; const float kp = up ? a4[i + 2] : a4[i]; a2[i] = kp + __shfl_xor(snd, 16); } }   \
            float a1; { const bool up = (F.lane & 8) != 0; const float snd = up ? a2[0] : a2[1]; const float kp = up ? a2[1] : a2[0]; a1 = kp + __shfl_xor(snd, 8); }                     \
            a1 += __shfl_xor(a1, 4); a1 += __shfl_xor(a1, 2); a1 += __shfl_xor(a1, 1);                                                 \
                                                       \
            if ((F.lane & 7) == 0) { const int h = ((F.lane >> 5) & 1) * 4 + ((F.lane >> 4) & 1) * 2 + ((F.lane >> 3) & 1);             \
                const float z = a1 + bfg[h];                                                                                           \
                const float lf = fminf(z, 0.f) - log1pf(__expf(-fabsf(z)));                                             \
                if (mrow < MREAL) { const int b = mrow >> 12, s = mrow & 4095; LOGF[((size_t)b * 8 + h) * LSEQ + NMETA + s] = lf; }            \
                else { const int t = mrow - MREAL; LOGF[((size_t)0 * 8 + h) * LSEQ + t] = lf; LOGF[((size_t)1 * 8 + h) * LSEQ + t] = lf; } } } while (0)
        f32x4 va[8], vb[8];
        int m = F.gw;
        if (m < NROW) P0A_LOAD(va, m);
#pragma unroll 1
        for (; m < NROW; m += 2 * F.NGW) {
            const int m1 = m + F.NGW, m2 = m + 2 * F.NGW;
            if (m1 < NROW) P0A_LOAD(vb, m1);
            P0A_ROW(va, m);
            if (m1 < NROW) { if (m2 < NROW) P0A_LOAD(va, m2); P0A_ROW(vb, m1); }
        }
#undef P0A_SRC
#undef P0A_LOAD
#undef P0A_ROW
        __syncthreads();
    }
    {   LAS unsigned short* XM = (LAS unsigned short*)(F.lds + RING_OFF);
        LAS float* PART = (LAS float*)(F.lds + RING_OFF + 66048);
        const float* gmix = F.in[I_GMIX]; const float* win = F.in[I_WIN];
        for (int rr = 0; rr < 2; ++rr) { const int r = 2 * F.wave + rr;
            const GAS f32x4* xr = (const GAS f32x4*)(F.in[I_META] + (size_t)r * DM) + F.lane;
            f32x4 v[8]; float s2 = 0.f;
#pragma unroll
            for (int j = 0; j < 8; ++j) { v[j] = xr[64 * j]; s2 += (v[j].x * v[j].x + v[j].y * v[j].y) + (v[j].z * v[j].z + v[j].w * v[j].w); }
            const float rstd = 1.f / sqrtf(wave_sum(s2) * (1.f / DM) + EPS);
#pragma unroll
            for (int j = 0; j < 8; ++j) { const f32x4 g = *((const GAS f32x4*)gmix + 64 * j + F.lane);
                *(LAS unsigned long long*)(XM + r * 2056 + 256 * j + 4 * F.lane) = (unsigned long long)pk2(v[j].x * rstd * g.x, v[j].y * rstd * g.y) | ((unsigned long long)pk2(v[j].z * rstd * g.z, v[j].w * rstd * g.w) << 32); } }
        __syncthreads();
        const int c = F.lane & 15, kk = F.lane >> 4;
        for (int task = F.vcu; task < 256; task += F.G) {
            const int n = task * 16 + c;
            const int wcol = n < 2048 ? 1024 + n : n + 2048;
            float acc[16];
#pragma unroll
            for (int r = 0; r < 16; ++r) acc[r] = 0.f;
            const LAS unsigned short* xp = XM + 256 * F.wave + kk; const float* wp = win + (size_t)(256 * F.wave + kk) * WIN_LD + wcol;
#pragma unroll 1
            for (int i0 = 0; i0 < 64; i0 += 16) {
                float wv[16];
#pragma unroll
                for (int i = 0; i < 16; ++i) wv[i] = wp[(size_t)(4 * (i0 + i)) * WIN_LD];
                const LAS unsigned short* xq = xp + 4 * i0;
#pragma unroll
                for (int i = 0; i < 16; ++i)
#pragma unroll
                    for (int r = 0; r < 16; ++r) acc[r] += bf2f(xq[r * 2056 + 4 * i]) * wv[i];
            }
#pragma unroll
            for (int r = 0; r < 16; ++r) { float s = acc[r]; s += __shfl_xor(s, 16); s += __shfl_xor(s, 32); if (kk == 0) PART[(F.wave * 16 + r) * 16 + c] = s; }
            __syncthreads();
            if (F.tid < 256) { const int r = F.tid >> 4, cc = F.tid & 15; float s = 0.f;
#pragma unroll
                for (int w = 0; w < 8; ++w) s += PART[(w * 16 + r) * 16 + cc];
                const int nn = task * 16 + cc; const int seg = nn >> 10, col = nn & 1023;
                bf16* base = (bf16*)(ws + (seg == 0 ? WS_DK : seg == 1 ? WS_DV : seg == 2 ? WS_FK : WS_FV));
                const bf16 hv = (bf16)f2bf(s);
                base[(size_t)(PADF + r) * 1024 + col] = hv; base[(size_t)(LP + PADF + r) * 1024 + col] = hv; }
            __syncthreads();
        }
    }
    for (int rpb_ = 0; rpb_ < (((PH_REP_MASK) >> 13) & 1 ? 2 : 1); ++rpb_)
    {   LAS float* scr = (LAS float*)(F.lds + RING_OFF + F.wave * 16384);
        const float* win = F.in[I_WIN];
        constexpr int I_A = (DM / 64) * (6144 / 32), I_G = (DM / 64) * (2048 / 32), I_BD = (1024 / 64) * (DM / 32), I_O = (DM / 64) * (DM / 32), I_P = (DM / 64) * (1024 / 32);
        constexpr int NITEMS = I_A + 2 * I_G + 2 * I_BD + I_O + I_P;
        bf16* WIN = (bf16*)(ws + WS_WIN);
        for (int it = F.gw; it < NITEMS; it += F.NGW) {
            int r = it;
            if (r < I_A) {
                const int nblk = 6144 / 32, kb = r / nblk, nb = r % nblk; const int seg = nb >> 5; int sb = nb;
                if (seg == 1 || seg == 4) { const int pb = nb & 7; sb = (nb & ~7) + 2 * (pb & 3) + (pb >> 2); }
                p0_transpose_item2(win + 32 * sb, WIN_LD, 32, DM, WIN, 32 * nb, scr, kb, F.lane); continue; } r -= I_A;
            if (r < I_G) { p0_transpose_item2(win + 6152, WIN_LD, 2048, DM, WIN, 6144, scr, r, F.lane); continue; } r -= I_G;
            if (r < I_G) { p0_transpose_item2(win + 8200, WIN_LD, 2048, DM, WIN, 8192, scr, r, F.lane); continue; } r -= I_G;
            if (r < I_BD) { p0_transpose_item2(F.in[I_WBD], DM, DM, 1024, (bf16*)(ws + WS_WBD), 0, scr, r, F.lane); continue; } r -= I_BD;
            if (r < I_BD) { p0_transpose_item2(F.in[I_WBF], DM, DM, 1024, (bf16*)(ws + WS_WBF), 0, scr, r, F.lane); continue; } r -= I_BD;
            if (r < I_O) { p0_transpose_item2(F.in[I_WOUT], DM, DM, DM, (bf16*)(ws + WS_WOUT), 0, scr, r, F.lane); continue; } r -= I_O;
            p0_transpose_item2(F.in[I_WPQ], 1024, 1024, DM, (bf16*)(ws + WS_WPQ), 0, scr, r, F.lane);
        }
    }
    for (int rpc_ = 0; rpc_ < (((PH_REP_MASK) >> 14) & 1 ? 2 : 1); ++rpc_)
    {   typedef float f32x16 __attribute__((ext_vector_type(16))); typedef unsigned u32x6 __attribute__((ext_vector_type(6)));
        for (int r = F.gw; r < 2 * NEXP; r += F.NGW) {
            const int tsel = r >= NEXP, e = r - tsel * NEXP;
            const GAS f32x4* src = (const GAS f32x4*)(F.in[tsel ? I_EV : I_EU] + (size_t)e * DM);
            f32x4 v[8]; float amax = 0.f;
#pragma unroll
            for (int j = 0; j < 8; ++j) { v[j] = __builtin_nontemporal_load(src + 64 * j + F.lane);
                amax = fmaxf(amax, fmaxf(fmaxf(fabsf(v[j].x), fabsf(v[j].y)), fmaxf(fabsf(v[j].z), fabsf(v[j].w)))); }
#pragma unroll
            for (int o = 1; o < 64; o <<= 1) amax = fmaxf(amax, __shfl_xor(amax, o));
            {   const float s4 = amax > 0.f ? 6.f / amax : 1.f; v4u q;
#define PK4(J) ({ unsigned w_ = 0u; \
                    w_ = __builtin_amdgcn_cvt_scalef32_pk_fp4_f32(w_, v[2 * (J)].x * s4, v[2 * (J)].y * s4, 1.0f, 0); w_ = __builtin_amdgcn_cvt_scalef32_pk_fp4_f32(w_, v[2 * (J)].z * s4, v[2 * (J)].w * s4, 1.0f, 1); \
                    w_ = __builtin_amdgcn_cvt_scalef32_pk_fp4_f32(w_, v[2 * (J) + 1].x * s4, v[2 * (J) + 1].y * s4, 1.0f, 2); w_ = __builtin_amdgcn_cvt_scalef32_pk_fp4_f32(w_, v[2 * (J) + 1].z * s4, v[2 * (J) + 1].w * s4, 1.0f, 3); w_; })
                q.x = PK4(0); q.y = PK4(1); q.z = PK4(2); q.w = PK4(3);
#undef PK4
                if (tsel) *(GAS v4u*)(ws + WS_EV + (size_t)e * 1024 + 16 * F.lane) = q;
                else {
                    GAS unsigned short* up = (GAS unsigned short*)(ws + WS_EU + (size_t)e * 128) + F.lane; constexpr size_t SL = (size_t)NEXP * 64;
                    up[0] = (unsigned short)q.x; up[SL] = (unsigned short)(q.x >> 16); up[2 * SL] = (unsigned short)q.y; up[3 * SL] = (unsigned short)(q.y >> 16);
                    up[4 * SL] = (unsigned short)q.z; up[5 * SL] = (unsigned short)(q.z >> 16); up[6 * SL] = (unsigned short)q.w; up[7 * SL] = (unsigned short)(q.w >> 16); }
            }
            if (F.lane == 0) ((float*)(ws + (tsel ? WS_SV : WS_SU)))[e] = amax > 0.f ? amax / 6.f : 1.f;
        }
    }
    {   const size_t gt = (size_t)F.vcu * (NWAVES * 64) + F.tid, GT = (size_t)F.G * NWAVES * 64;
        constexpr size_t per = (size_t)PADF * 1024 * 2 / 16;
        for (size_t c = gt; c < 8 * per; c += GT) { const int a = (int)(c / per), off = (int)(c % per); const int arr = a >> 1, b = a & 1;
            const size_t base = arr == 0 ? WS_DK : arr == 1 ? WS_DV : arr == 2 ? WS_FK : WS_FV;
            ((GAS v4u*)(ws + base + (size_t)b * LP * 1024 * 2))[off] = (v4u){0u, 0u, 0u, 0u}; }
        { const float* sk = F.in[I_SUBK]; bf16* skh = (bf16*)(ws + WS_SKH); bf16* skl = (bf16*)(ws + WS_SKL);
          for (size_t i = gt; i < (size_t)8 * 2 * 128 * 64; i += GT) { const float v = sk[i]; const unsigned hb = f2bf(v); skh[i] = (bf16)hb; skl[i] = (bf16)f2bf(v - __uint_as_float(hb << 16)); } }
        { float* rt = (float*)(ws + WS_ROPE);
          const float inv[8] = {1.0f, 0.1939227432012558f, 0.03760603070259094f, 0.007292664609849453f, 0.0014142135623842478f, 0.00027424818836152554f, 5.318296098266728e-05f, 1.0313386155758053e-05f};
          for (size_t i = gt; i < (size_t)LSEQ * 8; i += GT) { const int fi = (int)(i & 7); float iv = inv[0];
#pragma unroll
              for (int q = 1; q < 8; ++q) iv = fi == q ? inv[q] : iv;
              const float ang = (float)(i >> 3) * iv; rt[2 * i] = cosf(ang); rt[2 * i + 1] = sinf(ang); } }
        float* KBD = (float*)(ws + WS_KBIAS) + (size_t)16 * LP;
        for (size_t p = gt; p < LP; p += GT) KBD[p] = p < PADF ? -__builtin_inff() : 0.f;
    }
}
using pg8::Unit;
__device__ __forceinline__ v4u pack8bf(const f32x4& a, const f32x4& b) { v4u w; w.x = pg8::cvt_pk_bf16(a[0], a[1]); w.y = pg8::cvt_pk_bf16(a[2], a[3]); w.z = pg8::cvt_pk_bf16(b[0], b[1]); w.w = pg8::cvt_pk_bf16(b[2], b[3]); return w; }
struct Epi1 {
    static constexpr bool PERM = true, AFTER_DRAIN = false;
    unsigned char* ws; LAS float* xch; const float* dkg; const float* fkg;
    __device__ __forceinline__ void scale(f32x4 (&)[2][2][4][2], const Unit&, int, int, int, int) const {}
    __device__ __forceinline__ void operator()(const f32x4 (&acc)[2][2][4][2], const Unit& u, int wr, int wc, int fr, int fq) const {
        using pg8::HALF;
        asm volatile("" : "+v"(fr), "+v"(fq));
        const int ncol = u.pn * 256;
        if (ncol >= 1024 && ncol < 2048) {
            bf16* base = (bf16*)(ws + WS_DK) + (ncol - 1024) + 64 * wc + 8 * fq; const float* rope = (const float*)(ws + WS_ROPE);
#pragma unroll
            for (int ai = 0; ai < 2; ++ai)
#pragma unroll
                for (int m = 0; m < 4; ++m) { const int mrow = u.pm * 256 + ai * HALF + wr * 64 + m * 16 + fr;
                    f32x4 y[2][2]; float ss = 0.f;
#pragma unroll
                    for (int bj = 0; bj < 2; ++bj)
#pragma unroll
                        for (int n = 0; n < 2; ++n) { y[bj][n] = acc[ai][bj][m][n]; ss += (y[bj][n][0] * y[bj][n][0] + y[bj][n][1] * y[bj][n][1]) + (y[bj][n][2] * y[bj][n][2] + y[bj][n][3] * y[bj][n][3]); }
                    ss += __shfl_xor(ss, 16); ss += __shfl_xor(ss, 32);
                    const float r = 1.f / sqrtf(ss * (1.f / 64.f) + EPS);
#pragma unroll
                    for (int bj = 0; bj < 2; ++bj)
#pragma unroll
                        for (int n = 0; n < 2; ++n) { const f32x4 g = *(const f32x4*)(dkg + 32 * bj + 8 * fq + 4 * n); y[bj][n] = y[bj][n] * r * g; }
                    const float* tb = rope + (size_t)(NMETA + (mrow & 4095)) * 16;
#pragma unroll
                    for (int n = 0; n < 2; ++n)
#pragma unroll
                        for (int i = 0; i < 4; ++i) { const float mine = y[0][n][i], other = __shfl_xor(mine, 16); const float c = tb[2 * (4 * n + i)], sn = tb[2 * (4 * n + i) + 1];
                            y[0][n][i] = fq == 0 ? (mine * c - other * sn) : (fq == 1 ? (mine * c + other * sn) : mine); }
                    bf16* rowp = base + (size_t)(mrow + 64 + 64 * (mrow >> 12)) * 1024;
                    *(GAS v4u*)(rowp) = pack8bf(y[0][0], y[0][1]); *(GAS v4u*)(rowp + 32) = pack8bf(y[1][0], y[1][1]); }
        } else if (ncol >= 4096 && ncol < 5120) {
            bf16* base = (bf16*)(ws + WS_FK) + (ncol - 4096) + 64 * wc + 8 * fq;
#pragma unroll
            for (int ai = 0; ai < 2; ++ai)
#pragma unroll
                for (int m = 0; m < 4; ++m) { const int rt = ai * HALF + wr * 64 + m * 16 + fr; float ss = 0.f;
#pragma unroll
                    for (int bj = 0; bj < 2; ++bj)
#pragma unroll
                        for (int n = 0; n < 2; ++n) { const f32x4 v = acc[ai][bj][m][n]; ss += (v[0] * v[0] + v[1] * v[1]) + (v[2] * v[2] + v[3] * v[3]); }
                    ss += __shfl_xor(ss, 16); ss += __shfl_xor(ss, 32);
                    if (fq == 0) xch[rt * 4 + wc] = ss; }
            asm volatile("s_waitcnt lgkmcnt(0)" ::: "memory"); __builtin_amdgcn_s_barrier(); asm volatile("" ::: "memory");
#pragma unroll
            for (int ai = 0; ai < 2; ++ai)
#pragma unroll
                for (int m = 0; m < 4; ++m) { const int rt = ai * HALF + wr * 64 + m * 16 + fr; const int mrow = u.pm * 256 + rt;
                    const float r = 1.f / sqrtf((xch[rt * 4 + wc] + xch[rt * 4 + (wc ^ 1)]) * (1.f / 128.f) + EPS);
                    bf16* rowp = base + (size_t)(mrow + 64 + 64 * (mrow >> 12)) * 1024;
#pragma unroll
                    for (int bj = 0; bj < 2; ++bj) { const float* gg = fkg + 64 * (wc & 1) + 32 * bj + 8 * fq; const f32x4 g0 = *(const f32x4*)gg, g1 = *(const f32x4*)(gg + 4);
                        *(GAS v4u*)(rowp + 32 * bj) = pack8bf(acc[ai][bj][m][0] * r * g0, acc[ai][bj][m][1] * r * g1); } }
        } else {
            bf16* base; int ldc, colt, kind;
            if (ncol < 6144) { const int seg = ncol >> 10; colt = ncol & 1023; ldc = 1024;
                base = (bf16*)(ws + (seg == 0 ? WS_DQ : seg == 2 ? WS_DV : seg == 3 ? WS_FQ : WS_FV)); kind = (seg == 2 || seg == 5) ? 1 : 0; }
            else if (ncol < 8192) { base = (bf16*)(ws + WS_GA); colt = ncol - 6144; ldc = 2048; kind = 0; }
            else { base = (bf16*)(ws + WS_GB); colt = ncol - 8192; ldc = 2048; kind = 0; }
#pragma unroll
            for (int ai = 0; ai < 2; ++ai)
#pragma unroll
                for (int m = 0; m < 4; ++m) { const int mrow = u.pm * 256 + ai * HALF + wr * 64 + m * 16 + fr; const size_t row = kind ? (size_t)(mrow + 64 + 64 * (mrow >> 12)) : (size_t)mrow;
#pragma unroll
                    for (int bj = 0; bj < 2; ++bj) *(GAS v4u*)(base + row * ldc + colt + bj * HALF + wc * 32 + 8 * fq) = pack8bf(acc[ai][bj][m][0], acc[ai][bj][m][1]); }
        }
    }
};
struct F_Gemm2a {
    const bf16* G; const float* bg; bf16* MG;
    __device__ __forceinline__ bool begin(const Unit&) { return true; }
    __device__ __forceinline__ void row_begin() {}
    __device__ __forceinline__ void scale_chunk(const Unit&, int, int, f32x4&, f32x4&) const {}
    __device__ __forceinline__ void row_end(const Unit&, int, int, int) {}
    __device__ __forceinline__ void chunk(const Unit& u, int rt, int ct, const f32x4& v0, const f32x4& v1) const {
        const size_t row = (size_t)u.pm * 256 + rt; const int col = u.pn * 256 + ct;
        const v4u g = *(const GAS v4u*)(G + row * DM + col); const f32x4 b0 = *(const f32x4*)(bg + col), b1 = *(const f32x4*)(bg + col + 4);
        f32x4 o0, o1;
        o0[0] = sigmoidf_(bflo(g.x) + b0[0]) * v0[0]; o0[1] = sigmoidf_(bfhi(g.x) + b0[1]) * v0[1]; o0[2] = sigmoidf_(bflo(g.y) + b0[2]) * v0[2]; o0[3] = sigmoidf_(bfhi(g.y) + b0[3]) * v0[3];
        o1[0] = sigmoidf_(bflo(g.z) + b1[0]) * v1[0]; o1[1] = sigmoidf_(bfhi(g.z) + b1[1]) * v1[1]; o1[2] = sigmoidf_(bflo(g.w) + b1[2]) * v1[2]; o1[3] = sigmoidf_(bfhi(g.w) + b1[3]) * v1[3];
        *(GAS v4u*)(MG + row * DM + col) = pack8bf(o0, o1);
    }
};
struct F_Gemm2b {
    const bf16* G; const float* bg; bf16* MG;
    __device__ __forceinline__ bool begin(const Unit&) { return true; }
    __device__ __forceinline__ void row_begin() {}
    __device__ __forceinline__ void scale_chunk(const Unit&, int, int, f32x4&, f32x4&) const {}
    __device__ __forceinline__ void row_end(const Unit&, int, int, int) {}
    __device__ __forceinline__ void chunk(const Unit& u, int rt, int ct, const f32x4& v0, const f32x4& v1) const {
        const size_t row = (size_t)u.pm * 256 + rt; const int col = u.pn * 256 + ct;
        const v4u g = *(const GAS v4u*)(G + row * DM + col); const f32x4 b0 = *(const f32x4*)(bg + col), b1 = *(const f32x4*)(bg + col + 4);
        const v4u t = *(const GAS v4u*)(MG + row * DM + col);
        f32x4 o0, o1;
        o0[0] = bflo(t.x) + sigmoidf_(bflo(g.x) + b0[0]) * v0[0]; o0[1] = bfhi(t.x) + sigmoidf_(bfhi(g.x) + b0[1]) * v0[1]; o0[2] = bflo(t.y) + sigmoidf_(bflo(g.y) + b0[2]) * v0[2]; o0[3] = bfhi(t.y) + sigmoidf_(bfhi(g.y) + b0[3]) * v0[3];
        o1[0] = bflo(t.z) + sigmoidf_(bflo(g.z) + b1[0]) * v1[0]; o1[1] = bfhi(t.z) + sigmoidf_(bfhi(g.z) + b1[1]) * v1[1]; o1[2] = bflo(t.w) + sigmoidf_(bflo(g.w) + b1[2]) * v1[2]; o1[3] = bfhi(t.w) + sigmoidf_(bfhi(g.w) + b1[3]) * v1[3];
        *(GAS v4u*)(MG + row * DM + col) = pack8bf(o0, o1);
    }
};
struct F_Gemm2 {
    const bf16* GA; const bf16* GB; const float* bg; bf16* MG;
    __device__ __forceinline__ bool begin(const Unit&) { return true; }
    __device__ __forceinline__ void row_begin() {}
    __device__ __forceinline__ void row_end(const Unit&, int, int, int) {}
    __device__ __forceinline__ void scale_chunk(const Unit& u, int rt, int ct, f32x4& v0, f32x4& v1) const {
        const size_t row = (size_t)u.pm * 256 + rt; const int col = u.pn * 256 + ct;
        const v4u ga = *(const GAS v4u*)(GA + row * DM + col), gb = *(const GAS v4u*)(GB + row * DM + col);
        const f32x4 a0 = *(const f32x4*)(bg + col), a1 = *(const f32x4*)(bg + col + 4), b0 = *(const f32x4*)(bg + DM + col), b1 = *(const f32x4*)(bg + DM + col + 4);
#define RT(GAW, GBW, HI, AB, BB) ((1.f + __expf(-((HI ? bfhi(GBW) : bflo(GBW)) + (BB)))) / (1.f + __expf(-((HI ? bfhi(GAW) : bflo(GAW)) + (AB)))))
        v0[0] *= RT(ga.x, gb.x, 0, a0[0], b0[0]); v0[1] *= RT(ga.x, gb.x, 1, a0[1], b0[1]); v0[2] *= RT(ga.y, gb.y, 0, a0[2], b0[2]); v0[3] *= RT(ga.y, gb.y, 1, a0[3], b0[3]);
        v1[0] *= RT(ga.z, gb.z, 0, a1[0], b1[0]); v1[1] *= RT(ga.z, gb.z, 1, a1[1], b1[1]); v1[2] *= RT(ga.w, gb.w, 0, a1[2], b1[2]); v1[3] *= RT(ga.w, gb.w, 1, a1[3], b1[3]);
#undef RT
    }
    __device__ __forceinline__ void chunk(const Unit& u, int rt, int ct, const f32x4& v0, const f32x4& v1) const {
        const size_t row = (size_t)u.pm * 256 + rt; const int col = u.pn * 256 + ct;
        const v4u g = *(const GAS v4u*)(GB + row * DM + col); const f32x4 b0 = *(const f32x4*)(bg + DM + col), b1 = *(const f32x4*)(bg + DM + col + 4);
        f32x4 o0, o1;
        o0[0] = sigmoidf_(bflo(g.x) + b0[0]) * v0[0]; o0[1] = sigmoidf_(bfhi(g.x) + b0[1]) * v0[1]; o0[2] = sigmoidf_(bflo(g.y) + b0[2]) * v0[2]; o0[3] = sigmoidf_(bfhi(g.y) + b0[3]) * v0[3];
        o1[0] = sigmoidf_(bflo(g.z) + b1[0]) * v1[0]; o1[1] = sigmoidf_(bfhi(g.z) + b1[1]) * v1[1]; o1[2] = sigmoidf_(bflo(g.w) + b1[2]) * v1[2]; o1[3] = sigmoidf_(bfhi(g.w) + b1[3]) * v1[3];
        *(GAS v4u*)(MG + row * DM + col) = pack8bf(o0, o1);
    }
};
struct Pair2Order {
    pg8::StaticOrder S; int dA, dB;
    __device__ void init(int M, int N, int G_, int c_, int dA_, int dB_) { S.init(M, N, G_, c_); dA = dA_; dB = dB_; }
    __device__ bool next(int i, Unit& u) const { if (!S.next(i >> 1, u)) return false; const int br = i & 1; u.ko = br ? dA : 0; u.kob = br ? dB : 0; u.chain = br ? 0 : 1; return true; }
    __device__ __forceinline__ void a_ready(const Unit&) const {}
    __device__ __forceinline__ void done(const Unit&) const {}
};
struct F_Gemm3 {
    const float* X; float* O; const float* gp; bf16* HG; float* SSQ; float ss;
    __device__ __forceinline__ bool begin(const Unit&) { return true; }
    __device__ __forceinline__ void row_begin() { ss = 0.f; }
    __device__ __forceinline__ void scale_chunk(const Unit&, int, int, f32x4&, f32x4&) const {}
    __device__ __forceinline__ void chunk(const Unit& u, int rt, int ct, const f32x4& v0, const f32x4& v1) {
        const int col = u.pn * 256 + ct; const size_t off = ((size_t)u.pm * 256 + rt) * DM + col;
        const f32x4 x0 = *(const GAS f32x4*)(X + off), x1 = *(const GAS f32x4*)(X + off + 4);
        const f32x4 o0 = x0 + v0, o1 = x1 + v1;
        *(GAS f32x4*)(O + off) = o0; *(GAS f32x4*)(O + off + 4) = o1;
        ss += (o0[0] * o0[0] + o0[1] * o0[1]) + (o0[2] * o0[2] + o0[3] * o0[3]) + (o1[0] * o1[0] + o1[1] * o1[1]) + (o1[2] * o1[2] + o1[3] * o1[3]);
        const f32x4 g0 = *(const f32x4*)(gp + col), g1 = *(const f32x4*)(gp + col + 4);
        *(GAS v4u*)(HG + off) = pack8bf(o0 * g0, o1 * g1);
    }
    __device__ __forceinline__ void row_end(const Unit& u, int rt, int wc, int fq) {
        float s = ss; s += __shfl_xor(s, 16); s += __shfl_xor(s, 32);
        if (fq == 0) SSQ[((size_t)u.pm * 256 + rt) * 32 + u.pn * 4 + wc] = s;
    }
};
struct F_Gemm4 {
    float* Q;
    __device__ __forceinline__ bool begin(const Unit&) { return true; }
    __device__ __forceinline__ void row_begin() {}
    __device__ __forceinline__ void scale_chunk(const Unit&, int, int, f32x4&, f32x4&) const {}
    __device__ __forceinline__ void row_end(const Unit&, int, int, int) {}
    __device__ __forceinline__ void chunk(const Unit& u, int rt, int ct, const f32x4& v0, const f32x4& v1) const {
        const size_t off = (u.ko ? (size_t)MREAL * 1024 : 0) + ((size_t)u.pm * 256 + rt) * 1024 + u.pn * 256 + ct;
        *(GAS f32x4*)(Q + off) = v0; *(GAS f32x4*)(Q + off + 4) = v1;
    }
};
struct SplitK2Order {
    pg8::StaticOrder S;
    __device__ void init(int M, int N, int G_, int c_) { S.init(M, 2 * N, G_, c_); }
    __device__ bool next(int i, Unit& u) const { if (!S.next(i, u)) return false; u.ko = (u.pn >> 2) * 2048; u.kob = u.ko; u.pn &= 3; return true; }
    __device__ __forceinline__ void a_ready(const Unit&) const {}
    __device__ __forceinline__ void done(const Unit&) const {}
};

__device__ __forceinline__ void p2_norm_row(bf16* rowp, const float* gain, int grp  , bool rope, const float* ropetab  , int lane) {
    const v4u w0 = *(const GAS v4u*)(rowp + 16 * lane), w1 = *(const GAS v4u*)(rowp + 16 * lane + 8);
    float x[16];
    x[0] = bflo(w0.x); x[1] = bfhi(w0.x); x[2] = bflo(w0.y); x[3] = bfhi(w0.y); x[4] = bflo(w0.z); x[5] = bfhi(w0.z); x[6] = bflo(w0.w); x[7] = bfhi(w0.w);
    x[8] = bflo(w1.x); x[9] = bfhi(w1.x); x[10] = bflo(w1.y); x[11] = bfhi(w1.y); x[12] = bflo(w1.z); x[13] = bfhi(w1.z); x[14] = bflo(w1.w); x[15] = bfhi(w1.w);
    float ss = 0.f;
#pragma unroll
    for (int i = 0; i < 16; ++i) ss += x[i] * x[i];
    ss += __shfl_xor(ss, 1); ss += __shfl_xor(ss, 2); if (grp == 128) ss += __shfl_xor(ss, 4);
    const float r = 1.f / sqrtf(ss / (float)grp + EPS);
    const int d0 = (16 * lane) & (grp - 1);
#pragma unroll
    for (int i = 0; i < 16; i += 4) { const f32x4 g = *(const f32x4*)(gain + d0 + i); x[i] = x[i] * r * g[0]; x[i + 1] = x[i + 1] * r * g[1]; x[i + 2] = x[i + 2] * r * g[2]; x[i + 3] = x[i + 3] * r * g[3]; }
    if (rope && (lane & 3) == 0) {
#pragma unroll
        for (int i = 0; i < 8; ++i) { const float c = ropetab[2 * i], s = ropetab[2 * i + 1]; const float a = x[i], b = x[i + 8]; x[i] = a * c - b * s; x[i + 8] = b * c + a * s; }
    }
    v4u o0, o1;
    o0.x = pk2(x[0], x[1]); o0.y = pk2(x[2], x[3]); o0.z = pk2(x[4], x[5]); o0.w = pk2(x[6], x[7]); o1.x = pk2(x[8], x[9]); o1.y = pk2(x[10], x[11]); o1.z = pk2(x[12], x[13]); o1.w = pk2(x[14], x[15]);
    *(GAS v4u*)(rowp + 16 * lane) = o0; *(GAS v4u*)(rowp + 16 * lane + 8) = o1;
}
__device__ __forceinline__ void p1_tail(Frame& F) {
    unsigned char* ws = F.ws;
    if (F.gw < 16) {
        const float* lf = (const float*)(ws + WS_LOGF) + (size_t)F.gw * LSEQ; float* kb = (float*)(ws + WS_KBIAS) + (size_t)F.gw * LP;
        float carry = 0.f;
#pragma unroll 1
        for (int c0 = 0; c0 < LSEQ; c0 += 512) {
            float x[8];
#pragma unroll
            for (int u = 0; u < 8; ++u) { const int t = c0 + 64 * u + F.lane; x[u] = t < LSEQ ? lf[t] : 0.f; }
#pragma unroll
            for (int u = 0; u < 8; ++u) { float incl = x[u];
#pragma unroll
                for (int o = 1; o < 64; o <<= 1) { const float n = __shfl_up(incl, o); if (F.lane >= o) incl += n; }
                incl += carry; const int t = c0 + 64 * u + F.lane; if (t < LSEQ) kb[PADF + t] = -incl * 11.313708498984761f;
                carry = __shfl(incl, 63); }
        }
        if (F.lane < PADF) kb[F.lane] = -__builtin_inff();
    }
    { const int rtask = F.gw - 16;
      if (rtask >= 0 && rtask < 64) { const int arr = rtask >> 5, b = (rtask >> 4) & 1, t = rtask & 15;
          if (arr == 0) p2_norm_row((bf16*)(ws + WS_DK) + ((size_t)b * LP + PADF + t) * 1024, F.in[I_DKG], 64, true, (const float*)(ws + WS_ROPE) + (size_t)t * 16, F.lane);
          else p2_norm_row((bf16*)(ws + WS_FK) + ((size_t)b * LP + PADF + t) * 1024, F.in[I_FKG], 128, false, nullptr, F.lane); } }
}

__device__ const unsigned char ATT_TAB[32][4] = {
{0,95,69,112},{16,79,85,112},{32,94,70,112},{22,78,81,112},{4,36,77,112},{15,38,35,112},{55,93,65,112},{63,33,87,112},{61,6,21,112},{47,20,84,112},{13,42,1,112},{54,92,83,112},{41,18,75,112},{43,17,90,112},{62,7,19,112},{39,51,76,112},{45,71,82,112},{30,8,50,112},{46,40,2,112},{31,9,48,112},{28,53,86,112},{56,3,91,112},{10,57,37,112},{44,23,5,112},{29,73,64,112},{14,58,80,112},{12,11,49,112},{26,34,74,112},{60,72,66,112},{59,25,52,112},{89,88,67,112},{27,24,68,112}};
__device__ __forceinline__ att::BlockRef att_ref(unsigned char* ws, int x, int code, const float* qg64, const float* qg128) {
    const int hl = code >> 4, j = code & 15; att::BlockRef r; r.rope = (const float*)(ws + WS_ROPE);
    if (hl < 4) { const int dp = 2 * x + (hl >> 1), b = dp >> 3, h = dp & 7, i = hl & 1;
        r.Q = (const bf16*)(ws + WS_DQ) + ((size_t)b * SEQ + 256 * j) * 1024 + h * 128 + i * 64;
        r.K = (const bf16*)(ws + WS_DK) + (size_t)b * LP * 1024 + h * 128 + i * 64;
        r.V = (const bf16*)(ws + WS_DV) + (size_t)b * LP * 1024 + h * 128;
        r.KB = (const float*)(ws + WS_KBIAS) + (size_t)16 * LP;
        r.O = (bf16*)(ws + (i ? WS_O2 : WS_O1)) + ((size_t)b * SEQ + 256 * j) * 1024 + h * 128; r.dqk = 64; r.qg = qg64; }
    else { const int fh = 2 * x + (hl - 4), b = fh >> 3, h = fh & 7;
        r.Q = (const bf16*)(ws + WS_FQ) + ((size_t)b * SEQ + 256 * j) * 1024 + h * 128;
        r.K = (const bf16*)(ws + WS_FK) + (size_t)b * LP * 1024 + h * 128;
        r.V = (const bf16*)(ws + WS_FV) + (size_t)b * LP * 1024 + h * 128;
        r.KB = (const float*)(ws + WS_KBIAS) + (size_t)fh * LP;
        r.O = (bf16*)(ws + WS_OF) + ((size_t)b * SEQ + 256 * j) * 1024 + h * 128; r.dqk = 128; r.qg = qg128; }
    r.P0 = 64 + 256 * j; return r;
}
template <int ABL>
__device__ __forceinline__ void p3_attention(Frame& F, char* lds) {
    for (int v = F.vcu; v < 256; v += F.G) {
        const int x = v >> 5, slot = v & 31;
        int n = 0; while (n < 4 && ATT_TAB[slot][n] != 112) ++n;
        if (n == 0) continue;
        for (int i = 0; i < n; ++i) {
            att::BlockRef cur = att_ref(F.ws, x, ATT_TAB[slot][i], F.in[I_DQG], F.in[I_FQG]);
            if (ABL != 0) cur.O = (bf16*)(F.ws + WS_XN) + (cur.O - (bf16*)(F.ws + (cur.dqk == 64 ? WS_O1 : WS_OF)) ) % ((size_t)MREAL * 1024);
            if (cur.dqk == 64) att::block<64, ABL>(cur, LP, lds); else att::block<128, ABL>(cur, LP, lds);
        }
    }
}
__device__ __forceinline__ float diff_lambda(Frame& F) {
    const float a = F.in[I_LQ1][F.lane] * F.in[I_LK1][F.lane], b = F.in[I_LQ2][F.lane] * F.in[I_LK2][F.lane];
    return __expf(wave_sum(a)) - __expf(wave_sum(b)) + 0.2f;
}
__device__ __forceinline__ void p4_combine(Frame& F) {
    const float lam = diff_lambda(F);
    const bf16* O1 = (const bf16*)(F.ws + WS_O1); const bf16* O2 = (const bf16*)(F.ws + WS_O2); bf16* OD = (bf16*)(F.ws + WS_OD);
    const float* g = F.in[I_SUBLN];
    const int d0 = (16 * F.lane) & 127;
    for (int m = F.gw; m < MREAL; m += F.NGW) {
        const size_t off = (size_t)m * 1024 + 16 * F.lane;
        const v4u a0 = *(const GAS v4u*)(O1 + off), a1 = *(const GAS v4u*)(O1 + off + 8), b0 = *(const GAS v4u*)(O2 + off), b1 = *(const GAS v4u*)(O2 + off + 8);
        float x[16];
        x[0] = bflo(a0.x) - lam * bflo(b0.x); x[1] = bfhi(a0.x) - lam * bfhi(b0.x); x[2] = bflo(a0.y) - lam * bflo(b0.y); x[3] = bfhi(a0.y) - lam * bfhi(b0.y);
        x[4] = bflo(a0.z) - lam * bflo(b0.z); x[5] = bfhi(a0.z) - lam * bfhi(b0.z); x[6] = bflo(a0.w) - lam * bflo(b0.w); x[7] = bfhi(a0.w) - lam * bfhi(b0.w);
        x[8] = bflo(a1.x) - lam * bflo(b1.x); x[9] = bfhi(a1.x) - lam * bfhi(b1.x); x[10] = bflo(a1.y) - lam * bflo(b1.y); x[11] = bfhi(a1.y) - lam * bfhi(b1.y);
        x[12] = bflo(a1.z) - lam * bflo(b1.z); x[13] = bfhi(a1.z) - lam * bfhi(b1.z); x[14] = bflo(a1.w) - lam * bflo(b1.w); x[15] = bfhi(a1.w) - lam * bfhi(b1.w);
        float ss = 0.f;
#pragma unroll
        for (int i = 0; i < 16; ++i) ss += x[i] * x[i];
        ss += __shfl_xor(ss, 1); ss += __shfl_xor(ss, 2); ss += __shfl_xor(ss, 4);
        const float r = 0.8f / sqrtf(ss * (1.f / 128.f) + EPS);
#pragma unroll
        for (int i = 0; i < 16; i += 4) { const f32x4 gg = *(const f32x4*)(g + d0 + i); x[i] *= r * gg[0]; x[i + 1] *= r * gg[1]; x[i + 2] *= r * gg[2]; x[i + 3] *= r * gg[3]; }
        v4u o0, o1;
        o0.x = pk2(x[0], x[1]); o0.y = pk2(x[2], x[3]); o0.z = pk2(x[4], x[5]); o0.w = pk2(x[6], x[7]); o1.x = pk2(x[8], x[9]); o1.y = pk2(x[10], x[11]); o1.z = pk2(x[12], x[13]); o1.w = pk2(x[14], x[15]);
        *(GAS v4u*)(OD + off) = o0; *(GAS v4u*)(OD + off + 8) = o1;
    }
}
__device__ __forceinline__ unsigned f2ord(float f) { const unsigned u = __float_as_uint(f); return u ^ ((unsigned)((int)u >> 31) | 0x80000000u); }
__device__ __forceinline__ float ord2f(unsigned k) { const unsigned m = (unsigned)((int)(~k) >> 31) | 0x80000000u; return __uint_as_float(k ^ m); }
__device__ __forceinline__ void sort16_desc(unsigned (&a)[16]) {
#pragma unroll
    for (int k = 2; k <= 16; k <<= 1)
#pragma unroll
        for (int j = k >> 1; j > 0; j >>= 1)
#pragma unroll
            for (int i = 0; i < 16; ++i) { const int l = i ^ j; if (l > i) { const bool desc = (i & k) == 0; const unsigned hi_ = max(a[i], a[l]), lo_ = min(a[i], a[l]); a[i] = desc ? hi_ : lo_; a[l] = desc ? lo_ : hi_; } }
}
__device__ __forceinline__ void merge_top16(unsigned (&a)[16], const unsigned (&b)[16]) {
#pragma unroll
    for (int i = 0; i < 16; ++i) a[i] = max(a[i], b[15 - i]);
#pragma unroll
    for (int j = 8; j > 0; j >>= 1)
#pragma unroll
        for (int i = 0; i < 16; ++i) { const int l = i ^ j; if (l > i) { const unsigned hi_ = max(a[i], a[l]), lo_ = min(a[i], a[l]); a[i] = hi_; a[l] = lo_; } }
}
__device__ __forceinline__ void p9_route(Frame& F) {
    typedef float f32x16 __attribute__((ext_vector_type(16)));
    const float* QP0 = (const float*)(F.ws + WS_QP); const float* QP1 = QP0 + (size_t)MREAL * 1024; const float* SSQ = (const float*)(F.ws + WS_SSQ);
    const bf16* SKH = (const bf16*)(F.ws + WS_SKH); const bf16* SKL = (const bf16*)(F.ws + WS_SKL);
    int* IDX = (int*)(F.ws + WS_IDX); float* GATE = (float*)(F.ws + WS_GATE);
    LAS int* XI = (LAS int*)(F.lds + RING_OFF) + F.wave * (64 * 33);
    const int r32 = F.lane & 31, hi = F.lane >> 5;
    for (int task = F.gw; task < PEER_H * (MREAL / 32); task += F.NGW) {
        const int h = task & 7, tok = (task >> 3) * 32 + r32;
        float rs;
        { const GAS f32x4* sp = (const GAS f32x4*)(SSQ + (size_t)tok * 32); f32x4 t = sp[0];
#pragma unroll
          for (int i = 1; i < 8; ++i) t += sp[i];
          rs = 1.f / sqrtf(((t[0] + t[1]) + (t[2] + t[3])) * (1.f / DM) + EPS); }
        if (h == 0 && hi == 0) ((float*)(F.ws + WS_RS))[tok] = rs;
        unsigned T[2][16];
#pragma unroll
        for (int c = 0; c < 2; ++c) {
            f32x16 acc[4];
#pragma unroll
            for (int kb = 0; kb < 4; ++kb) acc[kb] = f32x16{};
            const size_t qoff = (size_t)tok * 1024 + h * 128 + c * 64 + 8 * hi;
            const size_t koff = ((size_t)(h * 2 + c) * 128 + r32) * 64 + 8 * hi;
#pragma unroll
            for (int ks = 0; ks < 4; ++ks) {
                bf16x8 qh, ql;
                { const GAS f32x4* a0 = (const GAS f32x4*)(QP0 + qoff + 16 * ks); const GAS f32x4* a1 = (const GAS f32x4*)(QP1 + qoff + 16 * ks);
                  const f32x4 q0 = (a0[0] + a1[0]) * rs, q1 = (a0[1] + a1[1]) * rs;
                  const v4u hw = pack8bf(q0, q1);
                  f32x4 l0, l1;
                  l0[0] = q0[0] - bflo(hw.x); l0[1] = q0[1] - bfhi(hw.x); l0[2] = q0[2] - bflo(hw.y); l0[3] = q0[3] - bfhi(hw.y);
                  l1[0] = q1[0] - bflo(hw.z); l1[1] = q1[1] - bfhi(hw.z); l1[2] = q1[2] - bflo(hw.w); l1[3] = q1[3] - bfhi(hw.w);
                  const v4u lw = pack8bf(l0, l1);
                  qh = __builtin_bit_cast(bf16x8, hw); ql = __builtin_bit_cast(bf16x8, lw); }
#pragma unroll
                for (int kb = 0; kb < 4; ++kb) {
                    const bf16x8 kh = *(const GAS bf16x8*)(SKH + koff + (size_t)kb * 32 * 64 + 16 * ks), kl = *(const GAS bf16x8*)(SKL + koff + (size_t)kb * 32 * 64 + 16 * ks);
                    acc[kb] = __builtin_amdgcn_mfma_f32_32x32x16_bf16(kh, qh, acc[kb], 0, 0, 0);
                    acc[kb] = __builtin_amdgcn_mfma_f32_32x32x16_bf16(kh, ql, acc[kb], 0, 0, 0);
                    acc[kb] = __builtin_amdgcn_mfma_f32_32x32x16_bf16(kl, qh, acc[kb], 0, 0, 0);
                }
                __builtin_amdgcn_sched_barrier(0);
            }
            unsigned G[4][16];
#pragma unroll
            for (int kb = 0; kb < 4; ++kb) {
#pragma unroll
                for (int r = 0; r < 16; ++r) { const int n = 32 * kb + (r & 3) + 8 * (r >> 2) + 4 * hi; G[kb][r] = (f2ord(acc[kb][r]) & ~0x7Fu) | (unsigned)(127 - n); }
                sort16_desc(G[kb]); }
            merge_top16(G[0], G[1]); merge_top16(G[2], G[3]); merge_top16(G[0], G[2]);
            unsigned P[16];
#pragma unroll
            for (int j = 0; j < 16; ++j) { auto rr = __builtin_amdgcn_permlane32_swap(G[0][j], G[0][j], false, false); P[j] = hi ? rr[0] : rr[1]; }
            merge_top16(G[0], P);
            unsigned (&L)[16] = G[0];
#pragma unroll
            for (int j = 0; j < 16; ++j) T[c][j] = L[j];
        }
        float v1[16], v2[16];
#pragma unroll
        for (int j = 0; j < 16; ++j) { v1[j] = ord2f(T[0][j] & ~0x7Fu); v2[j] = ord2f(T[1][j] & ~0x7Fu);
            XI[F.lane * 33 + j] = 127 - (int)(T[0][j] & 0x7Fu); XI[F.lane * 33 + 16 + j] = 127 - (int)(T[1][j] & 0x7Fu); }
        unsigned Bst[16], C1[16], C2[16], C3[16];
#pragma unroll
        for (int j = 0; j < 16; ++j) { Bst[j] = (f2ord(v1[0] + v2[j]) & ~0xFFu) | (unsigned)(255 - j); C1[j] = 0u; C2[j] = 0u; C3[j] = 0u; }
        { int cnt = 0;
#pragma unroll
          for (int a = 1; a < 16; ++a)
#pragma unroll
            for (int b = 0; b < 16; ++b) if ((a + 1) * (b + 1) <= 16) { const unsigned key = (f2ord(v1[a] + v2[b]) & ~0xFFu) | (unsigned)(255 - (a * 16 + b));
                if (cnt < 16) C1[cnt] = key; else if (cnt < 32) C2[cnt - 16] = key; else C3[cnt - 32] = key; ++cnt; } }
        sort16_desc(C1); sort16_desc(C2); sort16_desc(C3);
        merge_top16(Bst, C1); merge_top16(C2, C3); merge_top16(Bst, C2);
        float e[16], sum = 0.f; const float top = ord2f(Bst[0] & ~0xFFu);
#pragma unroll
        for (int j = 0; j < 16; ++j) { e[j] = __expf(ord2f(Bst[j] & ~0xFFu) - top); sum += e[j]; }
        const float rsum = 1.f / sum;
        LDS_WAIT();
        if (hi == 0) {
            GAS int* io = (GAS int*)(IDX + (size_t)tok * 128 + h * 16); GAS float* go = (GAS float*)(GATE + (size_t)tok * 128 + h * 16);
#pragma unroll
            for (int j = 0; j < 16; ++j) { const int ab = 255 - (int)(Bst[j] & 0xFFu); const int i1 = XI[F.lane * 33 + (ab >> 4)], i2 = XI[F.lane * 33 + 16 + (ab & 15)];
                io[j] = i1 * 128 + i2; go[j] = e[j] * rsum; }
        }
        LDS_WAIT();
    }
}
typedef float f32x2 __attribute__((ext_vector_type(2)));
typedef float f32x32 __attribute__((ext_vector_type(32)));
typedef unsigned u32x6 __attribute__((ext_vector_type(6)));
typedef unsigned u32x16 __attribute__((ext_vector_type(16)));
typedef __bf16 bf16x32_t __attribute__((ext_vector_type(32)));
typedef __bf16 bf16x2_t __attribute__((ext_vector_type(2)));
__device__ __forceinline__ float gelu1(float v) {
    const float av = fabsf(v), t = __builtin_amdgcn_rcpf(av * 0.2316418882f + 1.0f);
    float q = t * 0.5307027145f + (-0.7265760135f); q = q * t + 0.7107068705f; q = q * t + (-0.142248368f); q = q * t + 0.127414796f; q = q * t;
    const float e = __builtin_amdgcn_exp2f((v * v) * (-0.72134752044f));
    const float m = v * (q * e);
    return v < 0.f ? m : v - m;
}

__device__ __forceinline__ float dot32(const float* hf, const v4u& r) {
    float s0 = 0.f, s1 = 0.f;
#define D8(W, T) { const f32x2 a_ = __builtin_amdgcn_cvt_scalef32_pk_f32_fp4((W), 1.0f, 0), b_ = __builtin_amdgcn_cvt_scalef32_pk_f32_fp4((W), 1.0f, 1), \
                               c_ = __builtin_amdgcn_cvt_scalef32_pk_f32_fp4((W), 1.0f, 2), d_ = __builtin_amdgcn_cvt_scalef32_pk_f32_fp4((W), 1.0f, 3); \
                   s0 += hf[T] * a_.x; s1 += hf[T + 1] * a_.y; s0 += hf[T + 2] * b_.x; s1 += hf[T + 3] * b_.y; s0 += hf[T + 4] * c_.x; s1 += hf[T + 5] * c_.y; s0 += hf[T + 6] * d_.x; s1 += hf[T + 7] * d_.y; }
    D8(r.x, 0) D8(r.y, 8) D8(r.z, 16) D8(r.w, 24)
#undef D8
    return s0 + s1;
}
__device__ __forceinline__ void axpy32(float* acc, float w, const v4u& r) {
#define A8(W, T) { const f32x2 a_ = __builtin_amdgcn_cvt_scalef32_pk_f32_fp4((W), 1.0f, 0), b_ = __builtin_amdgcn_cvt_scalef32_pk_f32_fp4((W), 1.0f, 1), \
                               c_ = __builtin_amdgcn_cvt_scalef32_pk_f32_fp4((W), 1.0f, 2), d_ = __builtin_amdgcn_cvt_scalef32_pk_f32_fp4((W), 1.0f, 3); \
                   acc[T] += w * a_.x; acc[T + 1] += w * a_.y; acc[T + 2] += w * b_.x; acc[T + 3] += w * b_.y; acc[T + 4] += w * c_.x; acc[T + 5] += w * c_.y; acc[T + 6] += w * d_.x; acc[T + 7] += w * d_.y; }
    A8(r.x, 0) A8(r.y, 8) A8(r.z, 16) A8(r.w, 24)
#undef A8
}
__device__ __forceinline__ void p10a_udots(Frame& F) {
    typedef int i32x8 __attribute__((ext_vector_type(8)));
    typedef float f32x16 __attribute__((ext_vector_type(16)));
    const bf16* H2N = (const bf16*)(F.ws + WS_H2N); const int* IDX = (const int*)(F.ws + WS_IDX);
    const unsigned char* EU = F.ws + WS_EU; float* PART = (float*)(F.ws + WS_PART);
    LAS unsigned char* wl = F.lds + F.wave * 6144;
    const int l8 = F.lane >> 3, p8 = F.lane & 7;
    const int r32 = F.lane & 31, half = F.lane >> 5;
    int t0, tend, tstep;
    if (F.G % 8 == 0) { const int per = F.G / 8, x = F.vcu / per; t0 = x * MREAL + (F.vcu % per) * NWAVES + F.wave; tend = (x + 1) * MREAL; tstep = per * NWAVES; }
    else { t0 = F.gw; tend = 8 * MREAL; tstep = F.NGW; }
    int zv = 0; asm volatile("" : "+v"(zv));
    const float* RS = (const float*)(F.ws + WS_RS) + zv;
#define PA_CL(T) ((T) < tlast ? (T) : tlast)
#define PA_IDX(I, T) do { const int tk_ = (T) & (MREAL - 1); const GAS v4u* ip_ = (const GAS v4u*)(IDX + (size_t)tk_ * 128 + l8 * 16);     \
        _Pragma("unroll") for (int c_ = 0; c_ < 4; ++c_) { const v4u v_ = ip_[c_]; I[4 * c_] = (int)v_.x; I[4 * c_ + 1] = (int)v_.y; I[4 * c_ + 2] = (int)v_.z; I[4 * c_ + 3] = (int)v_.w; } } while (0)
#define PA_LN(A, I, RB, T) do { const int xs_ = (T) >> 13; _Pragma("unroll") for (int g_ = 0; g_ < 4; ++g_) A[RB][g_] = *(const GAS v4u*)(EU + (size_t)xs_ * ((size_t)NEXP * 128) + (size_t)(unsigned)I[4 * (RB) + g_] * 128 + p8 * 16); } while (0)
#define PA_H(HW, RSV, T) do { const int tk_ = (T) & (MREAL - 1), xs_ = (T) >> 13; HW = *(const GAS unsigned long long*)(H2N + (size_t)tk_ * DM + xs_ * 256 + 4 * F.lane); RSV = RS[tk_]; } while (0)
#define PA_W(AC, RB) do { _Pragma("unroll") for (int g_ = 0; g_ < 4; ++g_) *(LAS v4u*)(wl + 1536 + (8 * g_ + l8) * 144 + p8 * 16) = AC[RB][g_]; asm volatile("" ::: "memory"); } while (0)
#define PA_R(AR) do { _Pragma("unroll") for (int s_ = 0; s_ < 4; ++s_) AR[s_] = *(const LAS v4u*)(wl + 1536 + r32 * 144 + half * 64 + s_ * 16); asm volatile("" ::: "memory"); } while (0)
#define PA_M(AR, ACC) do { _Pragma("unroll") for (int i_ = 0; i_ < 16; ++i_) ACC[i_] = 0.f; \
        _Pragma("unroll") for (int s_ = 0; s_ < 4; ++s_) { const i32x8 a_ = (i32x8){(int)AR[s_].x, (int)AR[s_].y, (int)AR[s_].z, (int)AR[s_].w, 0, 0, 0, 0}; \
            ACC = __builtin_amdgcn_mfma_scale_f32_32x32x64_f8f6f4(a_, B_[s_], ACC, 4, 0, 0, 0x7F7F7F7F, 0, 0x7F7F7F7F); } \
        asm volatile("" : "+v"(ACC)); } while (0)
#define PA_D(RB, ACC) do { if (r32 < 2) { LAS f32x4* dp_ = (LAS f32x4*)(wl + 512 + r32 * 512 + ((RB) * 32 + 4 * half) * 4); \
        _Pragma("unroll") for (int g_ = 0; g_ < 4; ++g_) dp_[2 * g_] = (f32x4){ACC[4 * g_], ACC[4 * g_ + 1], ACC[4 * g_ + 2], ACC[4 * g_ + 3]}; } } while (0)
#define PA_SB() __builtin_amdgcn_sched_barrier(0)
#define PA_TASK(AC, AN, I1, I2, HWC, RSC, HWN, RSN, T) do { \
        const int tn_ = PA_CL((T) + tstep), tn2_ = PA_CL((T) + 2 * tstep); \
        PA_H(HWN, RSN, tn_); PA_IDX(I2, tn2_); \
        {   const float x0 = bflo((unsigned)HWC) * RSC, x1 = bfhi((unsigned)HWC) * RSC, x2 = bflo((unsigned)(HWC >> 32)) * RSC, x3 = bfhi((unsigned)(HWC >> 32)) * RSC; \
            int hi_ = 0; hi_ = __builtin_amdgcn_cvt_pk_fp8_f32(x0, x1, hi_, false); hi_ = __builtin_amdgcn_cvt_pk_fp8_f32(x2, x3, hi_, true); \
            const f32x2 b0_ = __builtin_amdgcn_cvt_pk_f32_fp8(hi_, false), b1_ = __builtin_amdgcn_cvt_pk_f32_fp8(hi_, true); \
            int lo_ = 0; lo_ = __builtin_amdgcn_cvt_pk_fp8_f32((x0 - b0_.x) * 16.f, (x1 - b0_.y) * 16.f, lo_, false); lo_ = __builtin_amdgcn_cvt_pk_fp8_f32((x2 - b1_.x) * 16.f, (x3 - b1_.y) * 16.f, lo_, true); \
              \
            LAS int* bp_ = (LAS int*)(wl + ((((F.lane >> 2) & 1) * 4 + ((F.lane >> 3) & 3)) * 64 + (F.lane >> 5) * 16 + 4 * (F.lane & 3))); bp_[0] = hi_; bp_[8] = lo_; } \
        asm volatile("" ::: "memory"); \
        i32x8 B_[4]; \
        _Pragma("unroll") for (int s_ = 0; s_ < 4; ++s_) { const LAS v4u* q_ = (const LAS v4u*)(wl + (half * 4 + s_) * 64 + (r32 & 1) * 32); const v4u c0_ = q_[0], c1_ = q_[1]; \
            B_[s_] = (i32x8){(int)c0_.x, (int)c0_.y, (int)c0_.z, (int)c0_.w, (int)c1_.x, (int)c1_.y, (int)c1_.z, (int)c1_.w}; } \
        asm volatile("" ::: "memory"); \
        v4u ar0_[4], ar1_[4]; f32x16 ac0_, ac1_; \
        PA_LN(AN, I1, 0, tn_); PA_W(AC, 0); PA_R(ar0_); PA_SB(); \
        PA_LN(AN, I1, 1, tn_); PA_W(AC, 1); PA_R(ar1_); PA_SB(); \
        PA_M(ar0_, ac0_); PA_SB(); \
        PA_LN(AN, I1, 2, tn_); PA_W(AC, 2); PA_R(ar0_); PA_SB(); \
        PA_M(ar1_, ac1_); PA_SB(); \
        PA_D(0, ac0_); PA_SB(); \
        PA_LN(AN, I1, 3, tn_); PA_W(AC, 3); PA_R(ar1_); PA_SB(); \
        PA_M(ar0_, ac0_); PA_SB(); \
        PA_D(1, ac1_); PA_SB(); \
        PA_M(ar1_, ac1_); PA_SB(); \
        PA_D(2, ac0_); PA_D(3, ac1_); \
        asm volatile("" ::: "memory"); \
        {   const LAS f32x2* rp_ = (const LAS f32x2*)(wl + 512) + F.lane; const f32x2 h_ = rp_[0], l_ = rp_[64]; \
            *(GAS f32x2*)(PART + ((size_t)((T) >> 13) * MREAL + ((T) & (MREAL - 1))) * 128 + 2 * F.lane) = (f32x2){h_.x + l_.x * 0.0625f, h_.y + l_.y * 0.0625f}; } \
        asm volatile("" ::: "memory"); \
    } while (0)
    if (t0 < tend) {
        const int tlast = t0 + ((tend - 1 - t0) / tstep) * tstep;
        v4u A0[4][4], A1[4][4]; int I0[16], I1[16]; unsigned long long HW0, HW1; float RS0, RS1;
        PA_IDX(I0, t0); PA_H(HW0, RS0, t0);
        { const int t1_ = PA_CL(t0 + tstep); PA_IDX(I1, t1_); }
        PA_LN(A0, I0, 0, t0); PA_LN(A0, I0, 1, t0); PA_LN(A0, I0, 2, t0); PA_LN(A0, I0, 3, t0);
#pragma unroll 1
        for (int t = t0; t < tend; t += 2 * tstep) {
            PA_TASK(A0, A1, I1, I0, HW0, RS0, HW1, RS1, t);
            { const int tb_ = PA_CL(t + tstep); PA_TASK(A1, A0, I0, I1, HW1, RS1, HW0, RS0, tb_); }
        }
    }
#undef PA_LN
#undef PA_W
#undef PA_R
#undef PA_M
#undef PA_D
#undef PA_SB
#undef PA_CL
#undef PA_IDX
#undef PA_H
#undef PA_TASK
}

__device__ __forceinline__ void p10_experts(Frame& F, float* dst) {
    const int* IDX = (const int*)(F.ws + WS_IDX); const float* GATE = (const float*)(F.ws + WS_GATE);
    const unsigned char* EV = F.ws + WS_EV; const float* PART = (const float*)(F.ws + WS_PART);
    const float* SU = (const float*)(F.ws + WS_SU); const float* SV = (const float*)(F.ws + WS_SV);
    for (int tok = F.gw; tok < MREAL; tok += F.NGW) {
        const int e0 = IDX[(size_t)tok * 128 + F.lane], e1 = IDX[(size_t)tok * 128 + 64 + F.lane];
        float d0 = 0.f, d1 = 0.f;
        const int pk = ((F.lane >> 2) & 3) * 32 + 8 * (F.lane & 3) + (F.lane >> 4);
#pragma unroll
        for (int x = 0; x < 8; ++x) { const float* pp = PART + ((size_t)x * MREAL + tok) * 128; d0 += pp[pk]; d1 += pp[pk + 4]; }
        const float w0 = GATE[(size_t)tok * 128 + F.lane] * SV[e0] * gelu1(d0 * SU[e0]), w1 = GATE[(size_t)tok * 128 + 64 + F.lane] * SV[e1] * gelu1(d1 * SU[e1]);
        float acc[32];
#pragma unroll
        for (int i = 0; i < 32; ++i) acc[i] = 0.f;
#define EIDX(k) __builtin_amdgcn_readlane((k) < 64 ? e0 : e1, (k) & 63)
#define WK(k) __int_as_float(__builtin_amdgcn_readlane(__float_as_int((k) < 64 ? w0 : w1), (k) & 63))
#define LOADV(R, k0) do { _Pragma("unroll") for (int i_ = 0; i_ < 4; ++i_) R[i_] = *(const GAS v4u*)(EV + (size_t)EIDX((k0) + i_) * 1024 + 16 * F.lane); } while (0)
        v4u Va[4], Vb[4];
        LOADV(Va, 0);
#pragma unroll 1
        for (int b = 0; b < 32; b += 2) {
            const int k0 = 4 * b;
            LOADV(Vb, k0 + 4);
            __builtin_amdgcn_sched_barrier(0);
#pragma unroll
            for (int i = 0; i < 4; ++i) { axpy32(acc, WK(k0 + i), Va[i]); __builtin_amdgcn_sched_barrier(0); }
            if (b + 2 < 32) LOADV(Va, k0 + 8);
            __builtin_amdgcn_sched_barrier(0);
#pragma unroll
            for (int i = 0; i < 4; ++i) { axpy32(acc, WK(k0 + 4 + i), Vb[i]); __builtin_amdgcn_sched_barrier(0); }
        }
#undef EIDX
#undef WK
#undef LOADV
        { GAS f32x4* op = (GAS f32x4*)(F.out + (size_t)tok * DM) + F.lane; GAS f32x4* dp = (GAS f32x4*)(dst + (size_t)tok * DM) + F.lane;
#pragma unroll
          for (int j = 0; j < 8; ++j) { f32x4 a = op[64 * j];
              a[0] += acc[4 * j]; a[1] += acc[4 * j + 1]; a[2] += acc[4 * j + 2]; a[3] += acc[4 * j + 3]; dp[64 * j] = a; } }
    }
}
struct Args { const float* in[23]; float* out; unsigned char* ws; int ph_lo, ph_hi, li, pad; };
__global__ void __launch_bounds__(NWAVES * 64, 2) mega_fwd(Args args) {
    extern __shared__ __attribute__((aligned(16))) unsigned char lds[];
    Frame F;
    F.lds = (LAS unsigned char*)lds;
    F.MISC = (volatile LAS unsigned*)(F.lds + MISC_OFF);
    F.tid = threadIdx.x; F.lane = F.tid & 63; F.wave = __builtin_amdgcn_readfirstlane(F.tid >> 6);
    F.G = gridDim.x; { const int bx = blockIdx.x; F.vcu = (F.G % 8 == 0) ? (bx % 8) * (F.G / 8) + bx / 8 : bx; }
    F.gw = F.vcu * NWAVES + F.wave; F.NGW = F.G * NWAVES;
#pragma unroll
    for (int i = 0; i < 23; ++i) F.in[i] = args.in[i];
    F.out = args.out; F.ws = args.ws;
    F.ctl = (gu32*)(args.ws + WS_CTL);
    for (int u = F.tid; u < (LDS_BYTES - LDSCTL_OFF) / 4; u += NWAVES * 64) ((LAS unsigned*)(F.lds + LDSCTL_OFF))[u] = 0u;
    __syncthreads();
    XcdBarrier bar; bar.bar = (unsigned*)(F.ctl + CW_BAR); bar.x = 0; bar.st = nullptr;
    if (N_LAUNCHES == 1) bar = xcd_barrier_post((unsigned*)(F.ctl + CW_BAR), F.MISC + 8);
#define GRID_BAR(seam) do { if (N_LAUNCHES != 1) { if (F.tid == 0) __hip_atomic_store(F.ctl + CW_TMO, 0xBADBA0u | (unsigned)(seam), RLX_AGENT); } else { xcd_barrier(bar); } } while (0)
    const int lo = args.ph_lo, hi = args.ph_hi;
#ifndef PH_MASK
#define PH_MASK 0x7ff
#endif
#define IN(k) ((((PH_MASK) >> (k)) & 1) && lo <= (k) && (k) < hi)
#define BOTH(k) (IN(k) && IN((k) + (((k) == 6 || (k) == 1) ? 2 : 1)))
#ifndef PH_REP_MASK
#define PH_REP_MASK 0
#endif
#define REPEAT(k) for (int rep_ = 0; rep_ < ((((PH_REP_MASK) >> (k)) & 1) ? 2 : 1); ++rep_)
    unsigned char* ws = args.ws;
    typedef pg8::bf16_t pb;
    if (IN(0)) { REPEAT(0) { p0_prologue(F); __syncthreads(); } if (BOTH(0)) GRID_BAR(0); }
    if (IN(1)) { REPEAT(1) {
        pg8::Gemm g{(const pb*)(ws + WS_XN), (const pb*)(ws + WS_WIN), M1, N1, DM, DM}; pg8::StaticOrder S; S.init(M1, N1, F.G, (int)blockIdx.x);
        Epi1 E{ws, (LAS float*)(F.lds + RING_BYTES), F.in[I_DKG], F.in[I_FKG]};
        pg8::gemm_phase<Epi1, pg8::StaticOrder, true, PG8_SP2>(F.lds + RING_OFF, g, S, E); }
        p1_tail(F);
        if (BOTH(1)) GRID_BAR(1);
    }
    if (IN(3)) { p3_attention<0>(F, (char*)lds + RING_OFF);
#if (PH_REP_MASK >> 3) & 1
        p3_attention<ATT_ABL>(F, (char*)lds + RING_OFF);
#endif
        if (BOTH(3)) GRID_BAR(3); }
    if (IN(4)) { REPEAT(4) { p4_combine(F); } if (BOTH(4)) GRID_BAR(4);
#if (PH_REP_MASK >> 11) & 1
        for (int xb_ = 0; xb_ < 10; ++xb_) GRID_BAR(4);
#endif
    }
    if (IN(5)) {
        { pg8::Gemm g{(const pb*)(ws + WS_OD), (const pb*)(ws + WS_WBD), MREAL, DM, 1024, 1024}; pg8::StaticOrder S; S.init(MREAL, DM, F.G, (int)blockIdx.x);
          pg8::EpiGen<F_Gemm2a> E{F_Gemm2a{(const bf16*)(ws + WS_GA), F.in[I_BGATE], (bf16*)(ws + WS_MG)}};
          pg8::gemm_phase<pg8::EpiGen<F_Gemm2a>, pg8::StaticOrder, PG8_ALIGN, PG8_SP2>(F.lds + RING_OFF, g, S, E); }
        { pg8::Gemm g{(const pb*)(ws + WS_OF), (const pb*)(ws + WS_WBF), MREAL, DM, 1024, 1024}; pg8::StaticOrder S; S.init(MREAL, DM, F.G, (int)blockIdx.x);
          pg8::EpiGen<F_Gemm2b> E{F_Gemm2b{(const bf16*)(ws + WS_GB), F.in[I_BGATE] + DM, (bf16*)(ws + WS_MG)}};
          pg8::gemm_phase<pg8::EpiGen<F_Gemm2b>, pg8::StaticOrder, PG8_ALIGN, PG8_SP2>(F.lds + RING_OFF, g, S, E); }
#if (PH_REP_MASK >> 5) & 1
        { pg8::Gemm g{(const pb*)(ws + WS_OD), (const pb*)(ws + WS_WBD), MREAL, DM, 1024, 1024}; pg8::StaticOrder S; S.init(MREAL, DM, F.G, (int)blockIdx.x);
          pg8::EpiGen<F_Gemm2a> E{F_Gemm2a{(const bf16*)(ws + WS_GA), F.in[I_BGATE], (bf16*)(ws + WS_MG)}};
          pg8::gemm_phase<pg8::EpiGen<F_Gemm2a>, pg8::StaticOrder, PG8_ALIGN, PG8_SP2>(F.lds + RING_OFF, g, S, E); }
        { pg8::Gemm g{(const pb*)(ws + WS_OF), (const pb*)(ws + WS_WBF), MREAL, DM, 1024, 1024}; pg8::StaticOrder S; S.init(MREAL, DM, F.G, (int)blockIdx.x);
          pg8::EpiGen<F_Gemm2b> E{F_Gemm2b{(const bf16*)(ws + WS_GB), F.in[I_BGATE] + DM, (bf16*)(ws + WS_MG)}};
          pg8::gemm_phase<pg8::EpiGen<F_Gemm2b>, pg8::StaticOrder, PG8_ALIGN, PG8_SP2>(F.lds + RING_OFF, g, S, E); }
#endif
        if (BOTH(5)) GRID_BAR(5);
    }
    if (IN(6)) {
        {
        pg8::Gemm g{(const pb*)(ws + WS_MG), (const pb*)(ws + WS_WOUT), MREAL, DM, DM, DM}; pg8::StaticOrder S; S.init(MREAL, DM, F.G, (int)blockIdx.x);
        pg8::EpiGen<F_Gemm3> E{F_Gemm3{F.in[I_X], F.out, F.in[I_GPEER], (bf16*)(ws + WS_H2N), (float*)(ws + WS_SSQ), 0.f}};
        pg8::gemm_phase<pg8::EpiGen<F_Gemm3>, pg8::StaticOrder, PG8_ALIGN, PG8_SP2>(F.lds + RING_OFF, g, S, E);
        }
#if (PH_REP_MASK >> 6) & 1
        {
        pg8::Gemm g{(const pb*)(ws + WS_MG), (const pb*)(ws + WS_WOUT), MREAL, DM, DM, DM}; pg8::StaticOrder S; S.init(MREAL, DM, F.G, (int)blockIdx.x);
        pg8::EpiGen<F_Gemm3> E{F_Gemm3{F.in[I_X], F.out, F.in[I_GPEER], (bf16*)(ws + WS_H2N), (float*)(ws + WS_SSQ), 0.f}};
        pg8::gemm_phase<pg8::EpiGen<F_Gemm3>, pg8::StaticOrder, PG8_ALIGN, PG8_SP2>(F.lds + RING_OFF, g, S, E);
        }
#endif
        if (BOTH(6)) GRID_BAR(6);
    }
    if (IN(8)) {
        {
        pg8::Gemm g{(const pb*)(ws + WS_H2N), (const pb*)(ws + WS_WPQ), MREAL, 1024, 1024, DM}; SplitK2Order S; S.init(MREAL, 1024, F.G, (int)blockIdx.x);
        pg8::EpiGen<F_Gemm4> E{F_Gemm4{(float*)(ws + WS_QP)}};
        pg8::gemm_phase<pg8::EpiGen<F_Gemm4>, SplitK2Order, PG8_ALIGN, PG8_SP2>(F.lds + RING_OFF, g, S, E);
        }
#if (PH_REP_MASK >> 8) & 1
        {
        pg8::Gemm g{(const pb*)(ws + WS_H2N), (const pb*)(ws + WS_WPQ), MREAL, 1024, 1024, DM}; SplitK2Order S; S.init(MREAL, 1024, F.G, (int)blockIdx.x);
        pg8::EpiGen<F_Gemm4> E{F_Gemm4{(float*)(ws + WS_QP)}};
        pg8::gemm_phase<pg8::EpiGen<F_Gemm4>, SplitK2Order, PG8_ALIGN, PG8_SP2>(F.lds + RING_OFF, g, S, E);
        }
#endif
        if (BOTH(8)) GRID_BAR(8);
    }
    if (IN(9)) { REPEAT(9) { p9_route(F); } if (BOTH(9)) GRID_BAR(9); }
    if (IN(10)) { for (int rp_ = 0; rp_ < ((((PH_REP_MASK) >> 12) & 1) ? 2 : 1); ++rp_) p10a_udots(F); GRID_BAR(10); REPEAT(10) { p10_experts(F, (rep_ == 0 && ((PH_REP_MASK >> 10) & 1)) ? (float*)(ws + WS_T) : F.out); } }
#undef IN
#undef BOTH
}

extern "C" void kernel_launch(void* const* d_in, const int* in_sizes, int n_in, void* d_out, int out_size, void* d_ws, size_t ws_size, hipStream_t stream) {
    static int grid = 0;
    if (grid == 0) {
        if (n_in != 23 || in_sizes[0] != MREAL * DM || out_size != MREAL * DM || ws_size < WS_END) {
            fprintf(stderr, "kernel_launch: built for 23 inputs, x/out of %d floats, >= %zu bytes of workspace; got n_in %d, in0 %d, out %d, ws %zu; nothing launched\n", MREAL * DM, (size_t)WS_END, n_in, n_in > 0 ? in_sizes[0] : -1, out_size, ws_size); grid = -1; return; }
        int dev = 0, cus = 0, per_cu = 0;
        if (hipGetDevice(&dev) != hipSuccess || hipDeviceGetAttribute(&cus, hipDeviceAttributeMultiprocessorCount, dev) != hipSuccess) { fprintf(stderr, "kernel_launch: device query failed\n"); grid = -1; return; }
        if (hipFuncSetAttribute((const void*)mega_fwd, hipFuncAttributeMaxDynamicSharedMemorySize, LDS_BYTES) != hipSuccess) { fprintf(stderr, "kernel_launch: hipFuncSetAttribute failed\n"); grid = -1; return; }
        if (hipOccupancyMaxActiveBlocksPerMultiprocessor(&per_cu, (const void*)mega_fwd, NWAVES * 64, LDS_BYTES) != hipSuccess || per_cu < 1) {
            fprintf(stderr, "kernel_launch: occupancy query reports %d workgroups per CU; nothing launched\n", per_cu); (void)hipGetLastError(); grid = -1; return; }
        grid = cus;
    }
    if (grid < 0) return;
    if (hipMemsetAsync((char*)d_ws + WS_CTL, 0, CTL_ZERO_BYTES, stream) != hipSuccess) { fprintf(stderr, "kernel_launch: hipMemsetAsync failed\n"); return; }
    Args a{};
    for (int i = 0; i < 23; ++i) a.in[i] = (const float*)d_in[i];
    a.out = (float*)d_out; a.ws = (unsigned char*)d_ws;
    for (int li = 0; li < N_LAUNCHES; ++li) {
        a.ph_lo = (N_LAUNCHES == 1) ? 0 : li; a.ph_hi = (N_LAUNCHES == 1) ? N_PHASES : li + 1; a.li = li;
        hipLaunchKernelGGL(mega_fwd, dim3(grid), dim3(NWAVES * 64), LDS_BYTES, stream, a);
        const hipError_t le = hipPeekAtLastError();
        if (le != hipSuccess) { fprintf(stderr, "kernel_launch: launch %d failed: %s\n", li, hipGetErrorName(le)); break; }
    }
}
```

```cpp
#include <hip/hip_runtime.h>
#include <cstdio>
#include <cstdint>
#include <cmath>
#define PH_REP_MASK 0x0
#define ATT_ABL 0
namespace pg8 {
#define PG8_LAS __attribute__((address_space(3)))
typedef unsigned short bf16_t;
typedef short bf16x8 __attribute__((ext_vector_type(8)));
typedef float f32x4 __attribute__((ext_vector_type(4)));
typedef unsigned u32x4 __attribute__((ext_vector_type(4)));
constexpr int BM = 256, BK = 64, HALF = 128, HTB = HALF * BK * 2  , STAGE_BYTES = 8 * HTB, NXCD = 8, WGM = 8;

__host__ __device__ __forceinline__ int lds_byte(int r, int c) { const int st = (r >> 4) * 2 + (c >> 5), rr = r & 15, cc = c & 31, ob = rr * 64 + cc * 2; return st * 1024 + (ob ^ (((ob >> 9) & 1) << 5)); }
__host__ __device__ __forceinline__ void stage_rc(int b, int& R, int& C) { const int st = b / 1024, sb = b % 1024, swz = sb ^ (((sb >> 9) & 1) << 5); R = (st >> 1) * 16 + swz / 64; C = (st & 1) * 32 + (swz % 64) / 2; }
__host__ __device__ __forceinline__ int perm32(int rho) { const int n = rho >> 4, i = rho & 15; return 8 * (i >> 2) + 4 * n + (i & 3); }

struct Unit { int pm, pn, ko, kob, chain; };
struct Gemm { const bf16_t* A; const bf16_t* Bt; int M, N, K, ld; };

struct StaticOrder {
    int nM, nN, nwg, G, c;
    __host__ __device__ void init(int M, int N, int G_, int c_) { nM = M / BM; nN = N / BM; nwg = nM * nN; G = G_; c = c_; }
    __host__ __device__ bool next(int i, Unit& u) const {
        const long L = (long)i * G + c; if (L >= nwg) return false;
        int wgid = (int)L; { const int q = nwg / NXCD, r = nwg % NXCD, xcd = wgid % NXCD, off = wgid / NXCD; wgid = (xcd < r ? xcd * (q + 1) : r * (q + 1) + (xcd - r) * q) + off; }
        const int nig = WGM * nN, gid = wgid / nig, fm = gid * WGM, gsz = (nM - fm) < WGM ? (nM - fm) : WGM;
        u.pm = fm + ((wgid % nig) % gsz); u.pn = (wgid % nig) / gsz; u.ko = 0; u.kob = 0; u.chain = 0; return true;
    }
    __device__ __forceinline__ void a_ready(const Unit&) const {}
    __device__ __forceinline__ void done(const Unit&) const {}
};
__device__ __forceinline__ unsigned cvt_pk_bf16(float lo, float hi) { unsigned r; asm volatile("v_cvt_pk_bf16_f32 %0, %1, %2" : "=v"(r) : "v"(lo), "v"(hi)); return r; }
typedef float f32x2 __attribute__((ext_vector_type(2)));
template <class F> struct EpiGen {
    static constexpr bool PERM = true, AFTER_DRAIN = false;
    F f;
    __device__ __forceinline__ void operator()(const f32x4 (&acc)[2][2][4][2], const Unit& u, int wr, int wc, int fr, int fq) const {
        F g = f; if (!g.begin(u)) return;
        asm volatile("" : "+v"(fr), "+v"(fq));
#pragma unroll
        for (int ai = 0; ai < 2; ++ai)
#pragma unroll
            for (int m = 0; m < 4; ++m) { const int rt = ai * HALF + wr * 64 + m * 16 + fr; g.row_begin();
#pragma unroll
                for (int bj = 0; bj < 2; ++bj) g.chunk(u, rt, bj * HALF + wc * 32 + 8 * fq, acc[ai][bj][m][0], acc[ai][bj][m][1]);
                g.row_end(u, rt, wc, fq); }
    }
    __device__ __forceinline__ void scale(f32x4 (&acc)[2][2][4][2], const Unit& u, int wr, int wc, int fr, int fq) const {
        F g = f;
        asm volatile("" : "+v"(fr), "+v"(fq));
#pragma unroll
        for (int ai = 0; ai < 2; ++ai)
#pragma unroll
            for (int m = 0; m < 4; ++m) { const int rt = ai * HALF + wr * 64 + m * 16 + fr;
#pragma unroll
                for (int bj = 0; bj < 2; ++bj) g.scale_chunk(u, rt, bj * HALF + wc * 32 + 8 * fq, acc[ai][bj][m][0], acc[ai][bj][m][1]);
                asm volatile("" ::: "memory"); __builtin_amdgcn_sched_barrier(0); }
    }
};
template <class Epi, class Sched, bool ALIGN_EPI = false, bool SP2 = false>
__device__ __forceinline__ void gemm_phase(PG8_LAS unsigned char* lds, const Gemm g, const Sched& S, const Epi& E) {
    const int tid = threadIdx.x, wid = __builtin_amdgcn_readfirstlane(tid >> 6), lane = tid & 63, wr = wid >> 2, wc = wid & 3, fr = lane & 15, fq = lane >> 4;
    const int K = g.K, nt = K / BK, LD = g.ld;
    unsigned voffA[2], voffB[2];
#pragma unroll
    for (int i = 0; i < 2; ++i) { int R, C; stage_rc(tid * 16 + i * 8192, R, C); const int Rb = Epi::PERM ? ((R & ~31) + perm32(R & 31)) : R;
        voffA[i] = (unsigned)(R * LD + C) * 2u; voffB[i] = (unsigned)(Rb * LD + C) * 2u; }
    const size_t kstep = (size_t)(BK * 2);
    const size_t hstep = (size_t)HALF * LD * 2;
    const size_t tstep = 2 * hstep;
    const unsigned ldsw = (unsigned)wid * 1024u;
    const int aoff = lds_byte(wr * 64 + fr, fq * 8), boff = lds_byte(wc * 32 + fr, fq * 8);
#define PG8_SA(b, h) (((b) * 2 + (h)) * HTB)
#define PG8_SB(b, h) ((4 + (b) * 2 + (h)) * HTB)
#define PG8_STAGE(bufoff, gbase, voff) do { _Pragma("unroll") for (int _i = 0; _i < 2; ++_i) \
        __builtin_amdgcn_global_load_lds((const unsigned*)((const char*)(gbase) + (voff)[_i]), (PG8_LAS unsigned*)(lds + (bufoff) + ldsw + _i * 8192), 16, 0, 0); } while (0)
#define PG8_LDA(dst, b, h) do { _Pragma("unroll") for (int m = 0; m < 4; ++m) _Pragma("unroll") for (int k = 0; k < 2; ++k) dst[m][k] = *(const PG8_LAS bf16x8*)(lds + PG8_SA(b, h) + aoff + m * 2048 + k * 1024); } while (0)
#define PG8_LDB(dst, b, h) do { _Pragma("unroll") for (int n = 0; n < 2; ++n) _Pragma("unroll") for (int k = 0; k < 2; ++k) dst[n][k] = *(const PG8_LAS bf16x8*)(lds + PG8_SB(b, h) + boff + n * 2048 + k * 1024); } while (0)
#define PG8_MMA(ai, bj, At, Bt) do { __builtin_amdgcn_s_setprio(1); _Pragma("unroll") for (int m = 0; m < 4; ++m) _Pragma("unroll") for (int n = 0; n < 2; ++n) _Pragma("unroll") for (int k = 0; k < 2; ++k) \
        acc[ai][bj][m][n] = __builtin_amdgcn_mfma_f32_16x16x32_bf16(Bt[n][k], At[m][k], acc[ai][bj][m][n], 0, 0, 0); __builtin_amdgcn_s_setprio(0); } while (0)
#define PG8_WAIT_V(n) asm volatile("s_waitcnt vmcnt(" #n ")" ::: "memory")
#define PG8_WAIT_L(n) asm volatile("s_waitcnt lgkmcnt(" #n ")" ::: "memory")
#define PG8_BAR __builtin_amdgcn_s_barrier()
#define PG8_SCHED __builtin_amdgcn_sched_barrier(0)
    Unit cur, nxt; int ui = 0;
    if (!S.next(0, cur)) return;
    f32x4 acc[2][2][4][2];
#pragma unroll
    for (int a = 0; a < 2; ++a)
#pragma unroll
        for (int b = 0; b < 2; ++b)
#pragma unroll
            for (int m = 0; m < 4; ++m)
#pragma unroll
                for (int n = 0; n < 2; ++n) acc[a][b][m][n] = (f32x4){0.f, 0.f, 0.f, 0.f};
    bf16x8 At[4][2], B0[2][2], B1[2][2];
    const char* cA = (const char*)g.A + (size_t)cur.pm * tstep + cur.ko; const char* cB = (const char*)g.Bt + (size_t)cur.pn * tstep + cur.kob;
    S.a_ready(cur);
    if constexpr (SP2) {
        PG8_STAGE(PG8_SB(0, 0), cB, voffB); PG8_STAGE(PG8_SB(0, 1), cB + hstep, voffB); PG8_STAGE(PG8_SA(0, 0), cA, voffA); PG8_STAGE(PG8_SA(0, 1), cA + hstep, voffA);
        if (wr == 1) PG8_BAR;
        PG8_WAIT_V(2); PG8_BAR;
        PG8_STAGE(PG8_SB(1, 0), cB + kstep, voffB); PG8_STAGE(PG8_SA(1, 0), cA + kstep, voffA); PG8_STAGE(PG8_SB(1, 1), cB + hstep + kstep, voffB);
        PG8_WAIT_V(6); PG8_BAR;
    } else {
        PG8_STAGE(PG8_SB(0, 0), cB, voffB); PG8_STAGE(PG8_SA(0, 0), cA, voffA); PG8_STAGE(PG8_SB(0, 1), cB + hstep, voffB); PG8_STAGE(PG8_SA(0, 1), cA + hstep, voffA);
        if (wr == 1) PG8_BAR;
        PG8_WAIT_V(4); PG8_BAR;
        PG8_STAGE(PG8_SB(1, 0), cB + kstep, voffB); PG8_STAGE(PG8_SA(1, 0), cA + kstep, voffA); PG8_STAGE(PG8_SB(1, 1), cB + hstep + kstep, voffB);
        PG8_WAIT_V(6); PG8_BAR;
    }
    for (;;) {
        const bool has_next = S.next(ui + 1, nxt);
        const char* nA = has_next ? (const char*)g.A + (size_t)nxt.pm * tstep + nxt.ko : cA; const char* nB = has_next ? (const char*)g.Bt + (size_t)nxt.pn * tstep + nxt.kob : cB;
        for (int t = 0; t < nt; t += 2) {
            const bool last = (t == nt - 2);
            const char* a1 = cA + (size_t)(t + 1) * kstep;
            const char* a2 = last ? nA : cA + (size_t)(t + 2) * kstep; const char* b2 = last ? nB : cB + (size_t)(t + 2) * kstep;
            const char* a3 = a2 + kstep; const char* b3 = b2 + kstep;
            if (last && has_next) S.a_ready(nxt);
            if constexpr (SP2) {
            PG8_LDB(B0, 0, 0); PG8_LDB(B1, 0, 1); PG8_SCHED; PG8_LDA(At, 0, 0); PG8_STAGE(PG8_SA(1, 1), a1 + hstep, voffA);
            PG8_WAIT_V(8); PG8_WAIT_L(0); PG8_BAR; PG8_MMA(0, 0, At, B0); PG8_MMA(0, 1, At, B1); PG8_BAR; PG8_SCHED;
            PG8_LDA(At, 0, 1); PG8_STAGE(PG8_SB(0, 0), b2, voffB); PG8_STAGE(PG8_SB(0, 1), b2 + hstep, voffB); PG8_STAGE(PG8_SA(0, 0), a2, voffA);
            PG8_WAIT_V(8); PG8_WAIT_L(0); PG8_BAR; PG8_MMA(1, 0, At, B0); PG8_MMA(1, 1, At, B1); PG8_BAR; PG8_SCHED;
            PG8_LDB(B0, 1, 0); PG8_LDB(B1, 1, 1); PG8_SCHED; PG8_LDA(At, 1, 0); PG8_STAGE(PG8_SA(0, 1), a2 + hstep, voffA);
            PG8_WAIT_V(8); PG8_WAIT_L(0); PG8_BAR; PG8_MMA(0, 0, At, B0); PG8_MMA(0, 1, At, B1); PG8_BAR; PG8_SCHED;
            PG8_LDA(At, 1, 1); PG8_STAGE(PG8_SB(1, 0), b3, voffB); PG8_STAGE(PG8_SB(1, 1), b3 + hstep, voffB); PG8_STAGE(PG8_SA(1, 0), a3, voffA);
            PG8_WAIT_V(8); PG8_WAIT_L(0); PG8_BAR; PG8_MMA(1, 0, At, B0); PG8_MMA(1, 1, At, B1); PG8_BAR; PG8_SCHED;
            } else {
            PG8_LDB(B0, 0, 0); PG8_SCHED; PG8_LDA(At, 0, 0); PG8_STAGE(PG8_SA(1, 1), a1 + hstep, voffA);
            PG8_WAIT_L(8); PG8_BAR; PG8_WAIT_L(0); PG8_MMA(0, 0, At, B0); PG8_BAR; PG8_SCHED;
            PG8_LDB(B1, 0, 1); PG8_STAGE(PG8_SB(0, 0), b2, voffB);
            PG8_BAR; PG8_WAIT_L(0); PG8_MMA(0, 1, At, B1); PG8_BAR;
            PG8_LDA(At, 0, 1); PG8_STAGE(PG8_SA(0, 0), a2, voffA);
            PG8_BAR; PG8_WAIT_L(0); PG8_MMA(1, 0, At, B0); PG8_BAR; PG8_SCHED;
            PG8_STAGE(PG8_SB(0, 1), b2 + hstep, voffB);
            PG8_WAIT_V(6); PG8_BAR; PG8_MMA(1, 1, At, B1); PG8_BAR;
            PG8_LDB(B0, 1, 0); PG8_SCHED; PG8_LDA(At, 1, 0); PG8_STAGE(PG8_SA(0, 1), a2 + hstep, voffA);
            PG8_WAIT_L(8); PG8_BAR; PG8_WAIT_L(0); PG8_MMA(0, 0, At, B0); PG8_BAR; PG8_SCHED;
            PG8_LDB(B1, 1, 1); PG8_STAGE(PG8_SB(1, 0), b3, voffB);
            PG8_BAR; PG8_WAIT_L(0); PG8_MMA(0, 1, At, B1); PG8_BAR;
            PG8_LDA(At, 1, 1); PG8_STAGE(PG8_SA(1, 0), a3, voffA);
            PG8_BAR; PG8_WAIT_L(0); PG8_MMA(1, 0, At, B0); PG8_BAR; PG8_SCHED;
            PG8_STAGE(PG8_SB(1, 1), b3 + hstep, voffB);
            PG8_WAIT_V(6); PG8_BAR; PG8_MMA(1, 1, At, B1); PG8_BAR;
            }
        }
        if constexpr (ALIGN_EPI) { if (wr == 0) PG8_BAR; }
        if constexpr (!Epi::AFTER_DRAIN) { if (cur.chain) E.scale(acc, cur, wr, wc, fr, fq); else E(acc, cur, wr, wc, fr, fq); S.done(cur); }
        if (!has_next) break;
        if (!cur.chain)
#pragma unroll
        for (int a = 0; a < 2; ++a)
#pragma unroll
            for (int b = 0; b < 2; ++b)
#pragma unroll
                for (int m = 0; m < 4; ++m)
#pragma unroll
                    for (int n = 0; n < 2; ++n) acc[a][b][m][n] = (f32x4){0.f, 0.f, 0.f, 0.f};
        cur = nxt; cA = nA; cB = nB; ++ui;
        if constexpr (ALIGN_EPI) { if (wr == 1) PG8_BAR; }
    }
    PG8_WAIT_V(0);
    if constexpr (!ALIGN_EPI) { if (wr == 0) PG8_BAR; }
    PG8_BAR;
    if constexpr (Epi::AFTER_DRAIN) { E.fused(acc, cur, wr, wc, fr, fq, lds, wid, lane); S.done(cur); }
#undef PG8_SA
#undef PG8_SB
#undef PG8_STAGE
#undef PG8_LDA
#undef PG8_LDB
#undef PG8_MMA
#undef PG8_WAIT_V
#undef PG8_WAIT_L
#undef PG8_BAR
#undef PG8_SCHED
}
}
#ifndef PG8_SP2
#define PG8_SP2 true
#endif
#ifndef PG8_ALIGN
#define PG8_ALIGN true
#endif
namespace att {
typedef unsigned short bf16;
typedef short bf16x8 __attribute__((ext_vector_type(8)));
typedef short s16x4 __attribute__((ext_vector_type(4)));
typedef float f32x16 __attribute__((ext_vector_type(16)));
typedef float f32x4 __attribute__((ext_vector_type(4)));
typedef unsigned u32x4 __attribute__((ext_vector_type(4)));
constexpr int NW = 8, QBLK = 32, KVBLK = 64, QB = NW * QBLK, D = 128, PITCH = 1024;
constexpr int SHM_V = KVBLK * D * 2, SHM_K = KVBLK * D * 2;
constexpr int NBUF = 3;
constexpr int OFF_V = 0, OFF_K = NBUF * SHM_V, OFF_WS = OFF_K + NBUF * SHM_K, OFF_B = OFF_WS + NW * 64 * 4, LDS_BYTES = OFF_B + NBUF * 256;
constexpr float THR = 8.f;
#define KSWZ(row, colB) ((row) * 256 + ((colB) ^ (((row) & 7) << 4)))
#define SBAR() __builtin_amdgcn_sched_barrier(0)
__device__ __forceinline__ int v_st(int k, int c) { const int kk = (k & ~0xC) | ((k & 4) << 1) | ((k & 8) >> 1); return ((kk >> 3) * 4 + (c >> 5)) * 512 + ((kk & 7) * 32 + (c & 31)) * 2; }
__device__ __forceinline__ int v_rd_base(int lane) { return ((lane & 3) << 3) | (((lane >> 2) & 3) << 6) | (((lane >> 4) & 1) << 5) | (((lane >> 5) & 1) << 8); }
constexpr int v_rd_off(int d0, int ks, int half) { return d0 * 512 + ks * 4096 + half * 2048; }
__device__ __forceinline__ int crow(int r, int hi) { return (r & 3) + 8 * (r >> 2) + 4 * hi; }
__device__ __forceinline__ unsigned cvtpk(float lo, float hi) {
    unsigned r; asm volatile("v_cvt_pk_bf16_f32 %0, %1, %2" : "=v"(r) : "v"(lo), "v"(hi)); return r;
}
__device__ __forceinline__ bf16x8 load8(const bf16* p) { return *reinterpret_cast<const bf16x8*>(p); }
__device__ __forceinline__ void mask_tile(f32x16& p0, f32x16& p1, int dq, unsigned W) {
    const float NEG = -__builtin_inff();
#pragma unroll
    for (int r = 0; r < 16; ++r) {
        const int c = (r & 3) + 8 * (r >> 2);
        if ((unsigned)(dq - c) >= W) p0[r] = NEG;
        if ((unsigned)(dq - c - 32) >= W) p1[r] = NEG;
    }
}
template <int DQK>
__device__ __forceinline__ void partialSM(f32x16& p0, f32x16& p1, float& m_reg, float& mn, float& alpha) {
    constexpr float SCALE = DQK == 64 ? 0.125f : 0.08838834764831845f;
    float pmax;
    { float m0 = fmaxf(p0[0], p0[4]), m1 = fmaxf(p0[1], p0[5]), m2 = fmaxf(p0[2], p0[6]), m3 = fmaxf(p0[3], p0[7]);
#pragma unroll
      for (int r = 8; r < 16; r += 4) { m0 = fmaxf(m0, p0[r]); m1 = fmaxf(m1, p0[r + 1]); m2 = fmaxf(m2, p0[r + 2]); m3 = fmaxf(m3, p0[r + 3]); }
#pragma unroll
      for (int r = 0; r < 16; r += 4) { m0 = fmaxf(m0, p1[r]); m1 = fmaxf(m1, p1[r + 1]); m2 = fmaxf(m2, p1[r + 2]); m3 = fmaxf(m3, p1[r + 3]); }
      pmax = fmaxf(fmaxf(m0, m1), fmaxf(m2, m3)); }
    { auto rr = __builtin_amdgcn_permlane32_swap(__float_as_uint(pmax), __float_as_uint(pmax), false, false);
      pmax = fmaxf(__uint_as_float(rr[0]), __uint_as_float(rr[1])); }
    constexpr float C2 = 1.4426950408889634f * SCALE;
    if (__builtin_expect(__all((pmax - m_reg) * SCALE <= THR), 1)) { mn = m_reg; alpha = 1.f; }
    else { mn = fmaxf(m_reg, pmax); alpha = __builtin_amdgcn_exp2f((m_reg - mn) * C2); m_reg = mn; }
    const float mnL = -mn * C2;
    for (int r = 0; r < 16; ++r) p0[r] = fmaf(p0[r], C2, mnL); for (int r = 0; r < 16; ++r) p1[r] = fmaf(p1[r], C2, mnL);
    for (int r = 0; r < 16; ++r) p0[r] = __builtin_amdgcn_exp2f(p0[r]);
}
__device__ __forceinline__ void finishSM(f32x16& p0, f32x16& p1, float alpha, float& l_reg, bf16x8& pa0, bf16x8& pa1, bf16x8& pa2, bf16x8& pa3) {
    for (int r = 0; r < 16; ++r) p1[r] = __builtin_amdgcn_exp2f(p1[r]);
    float ps;
    { float s0 = p0[0] + p1[0], s1 = p0[1] + p1[1], s2 = p0[2] + p1[2], s3 = p0[3] + p1[3];
#pragma unroll
      for (int r = 4; r < 16; r += 4) { s0 += p0[r]; s1 += p0[r + 1]; s2 += p0[r + 2]; s3 += p0[r + 3]; s0 += p1[r]; s1 += p1[r + 1]; s2 += p1[r + 2]; s3 += p1[r + 3]; }
      ps = (s0 + s1) + (s2 + s3); }
    { auto rr = __builtin_amdgcn_permlane32_swap(__float_as_uint(ps), __float_as_uint(ps), false, false);
      ps = __uint_as_float(rr[0]) + __uint_as_float(rr[1]); }
    l_reg = l_reg * alpha + ps;
#define PK4(P, B_, OUT) do { unsigned a0 = cvtpk(P[B_+0], P[B_+1]), a1 = cvtpk(P[B_+2], P[B_+3]);                          \
        unsigned b0 = cvtpk(P[B_+4], P[B_+5]), b1 = cvtpk(P[B_+6], P[B_+7]);                                             \
        auto r0 = __builtin_amdgcn_permlane32_swap(a0, b0, false, false); auto r1 = __builtin_amdgcn_permlane32_swap(a1, b1, false, false); \
        u32x4 w = {r0[0], r1[0], r0[1], r1[1]}; OUT = *reinterpret_cast<bf16x8*>(&w); } while (0)
    PK4(p0, 0, pa0); PK4(p0, 8, pa1); PK4(p1, 0, pa2); PK4(p1, 8, pa3);
#undef PK4
}
__device__ __forceinline__ float rowmax32(const f32x16& p0, const f32x16& p1) {
    float m0 = fmaxf(p0[0], p0[4]), m1 = fmaxf(p0[1], p0[5]), m2 = fmaxf(p0[2], p0[6]), m3 = fmaxf(p0[3], p0[7]);
#pragma unroll
    for (int r = 8; r < 16; r += 4) { m0 = fmaxf(m0, p0[r]); m1 = fmaxf(m1, p0[r + 1]); m2 = fmaxf(m2, p0[r + 2]); m3 = fmaxf(m3, p0[r + 3]); }
#pragma unroll
    for (int r = 0; r < 16; r += 4) { m0 = fmaxf(m0, p1[r]); m1 = fmaxf(m1, p1[r + 1]); m2 = fmaxf(m2, p1[r + 2]); m3 = fmaxf(m3, p1[r + 3]); }
    float pmax = fmaxf(fmaxf(m0, m1), fmaxf(m2, m3));
    auto rr = __builtin_amdgcn_permlane32_swap(__float_as_uint(pmax), __float_as_uint(pmax), false, false);
    return fmaxf(__uint_as_float(rr[0]), __uint_as_float(rr[1]));
}
__device__ __forceinline__ void partialSM_first(f32x16& p0, f32x16& p1, float& m_reg, float& alpha, f32x16& negm) {
    const float mn = fmaxf(m_reg, rowmax32(p0, p1));
    alpha = __builtin_amdgcn_exp2f(m_reg - mn); m_reg = mn;
#pragma unroll
    for (int r = 0; r < 16; ++r) { p0[r] -= mn; p1[r] -= mn; negm[r] = -mn; }
#pragma unroll
    for (int r = 0; r < 16; ++r) p0[r] = __builtin_amdgcn_exp2f(p0[r]);
}
__device__ __forceinline__ void partialSM_shift(f32x16& p0, f32x16& p1, float& m_reg, float& alpha, f32x16& negm) {
    const float pmax = rowmax32(p0, p1);
    if (__builtin_expect(__all(pmax <= THR * 1.4426950408889634f), 1)) alpha = 1.f;
    else { const float d = fmaxf(pmax, 0.f); alpha = __builtin_amdgcn_exp2f(-d); m_reg += d;
#pragma unroll
           for (int r = 0; r < 16; ++r) { p0[r] -= d; p1[r] -= d; negm[r] = -m_reg; } }
#pragma unroll
    for (int r = 0; r < 16; ++r) p0[r] = __builtin_amdgcn_exp2f(p0[r]);
}
template <int KB, int DQK>
__device__ __forceinline__ void qkt(f32x16& p0, f32x16& p1, const unsigned (&kaddr)[4], const char* B_lds, int r32, int hi, const bf16x8* qr, bool use_bias, const f32x16& cinit) {
    const char* bb = B_lds + KB * 256 + hi * 16;
    if (!use_bias) { p0 = cinit; p1 = cinit; } else
#pragma unroll
    for (int g = 0; g < 4; ++g) { const f32x4 t0 = *reinterpret_cast<const f32x4*>(bb + 32 * g), t1 = *reinterpret_cast<const f32x4*>(bb + 32 * g + 128);
        p0[4 * g] = t0[0]; p0[4 * g + 1] = t0[1]; p0[4 * g + 2] = t0[2]; p0[4 * g + 3] = t0[3];
        p1[4 * g] = t1[0]; p1[4 * g + 1] = t1[1]; p1[4 * g + 2] = t1[2]; p1[4 * g + 3] = t1[3]; }
#define KRD(dst, dd, off) asm volatile("ds_read_b128 %0, %1 offset:%2" : "=v"(dst) : "v"(kaddr[dd]), "i"(off) : "memory")
#define KGRP(S, g) do { KRD(S[0], (2 * (g)) & 3, KB * SHM_K + ((g) >> 1) * 128); KRD(S[1], (2 * (g)) & 3, KB * SHM_K + ((g) >> 1) * 128 + 32 * 256);                 \
                        KRD(S[2], (2 * (g) + 1) & 3, KB * SHM_K + ((g) >> 1) * 128); KRD(S[3], (2 * (g) + 1) & 3, KB * SHM_K + ((g) >> 1) * 128 + 32 * 256); } while (0)
#define KWAIT(N, S) do { asm volatile("s_waitcnt lgkmcnt(" #N ")" : "+v"(S[0]), "+v"(S[1]), "+v"(S[2]), "+v"(S[3]) :: "memory"); SBAR(); } while (0)
#define KMM(S, g) do { p0 = __builtin_amdgcn_mfma_f32_32x32x16_bf16(S[0], qr[2 * (g)], p0, 0, 0, 0); p1 = __builtin_amdgcn_mfma_f32_32x32x16_bf16(S[1], qr[2 * (g)], p1, 0, 0, 0);             \
                       p0 = __builtin_amdgcn_mfma_f32_32x32x16_bf16(S[2], qr[2 * (g) + 1], p0, 0, 0, 0); p1 = __builtin_amdgcn_mfma_f32_32x32x16_bf16(S[3], qr[2 * (g) + 1], p1, 0, 0, 0); SBAR(); } while (0)
    bf16x8 ka[4], kb[4];
    KGRP(ka, 0); KGRP(kb, 1);
    if constexpr (DQK == 128) {
        bf16x8 kc[4];
        KGRP(kc, 2);
        KWAIT(8, ka); KMM(ka, 0); KGRP(ka, 3);
        KWAIT(8, kb); KMM(kb, 1);
        KWAIT(4, kc); KMM(kc, 2);
        KWAIT(0, ka); KMM(ka, 3);
    } else {
        KWAIT(4, ka); KMM(ka, 0);
        KWAIT(0, kb); KMM(kb, 1);
    }
#undef KGRP
#undef KWAIT
#undef KMM
#undef KRD
}
template <int VB>
__device__ __forceinline__ void pv_tile(f32x16* o, int vb0, bf16x8 pa0, bf16x8 pa1, bf16x8 pa2, bf16x8 pa3) {
#define TRRD(dst, off) asm volatile("ds_read_b64_tr_b16 %0, %1 offset:%2" : "=&v"(dst) : "v"(vb0), "i"(off) : "memory")
#define PV_RD(S, d0) do { constexpr int b_ = VB * SHM_V + v_rd_off(d0, 0, 0);     \
        TRRD(S[0], b_); TRRD(S[1], b_ + 2048); TRRD(S[2], b_ + 4096); TRRD(S[3], b_ + 6144); TRRD(S[4], b_ + 8192); TRRD(S[5], b_ + 10240); TRRD(S[6], b_ + 12288); TRRD(S[7], b_ + 14336); } while (0)
#define PV_MM(S, d0) do {                                                                                                                   \
        o[d0] = __builtin_amdgcn_mfma_f32_32x32x16_bf16(pa0, (bf16x8){S[0][0], S[0][1], S[0][2], S[0][3], S[1][0], S[1][1], S[1][2], S[1][3]}, o[d0], 0, 0, 0);   \
        o[d0] = __builtin_amdgcn_mfma_f32_32x32x16_bf16(pa1, (bf16x8){S[2][0], S[2][1], S[2][2], S[2][3], S[3][0], S[3][1], S[3][2], S[3][3]}, o[d0], 0, 0, 0);   \
        o[d0] = __builtin_amdgcn_mfma_f32_32x32x16_bf16(pa2, (bf16x8){S[4][0], S[4][1], S[4][2], S[4][3], S[5][0], S[5][1], S[5][2], S[5][3]}, o[d0], 0, 0, 0);   \
        o[d0] = __builtin_amdgcn_mfma_f32_32x32x16_bf16(pa3, (bf16x8){S[6][0], S[6][1], S[6][2], S[6][3], S[7][0], S[7][1], S[7][2], S[7][3]}, o[d0], 0, 0, 0); } while (0)
#define PV_WAIT(N) do { asm volatile("s_waitcnt lgkmcnt(" #N ")" ::: "memory"); SBAR(); } while (0)
    s16x4 A[8], B[8];
    PV_RD(A, 0); PV_RD(B, 1);
    PV_WAIT(8); PV_MM(A, 0); SBAR();
    PV_RD(A, 2);
    PV_WAIT(8); PV_MM(B, 1); SBAR();
    PV_RD(B, 3);
    PV_WAIT(8); PV_MM(A, 2); SBAR();
    PV_WAIT(0); PV_MM(B, 3);
#undef PV_RD
#undef PV_MM
#undef PV_WAIT
#undef TRRD
}
struct BlockRef { const bf16* Q; const bf16* K; const bf16* V; const float* KB; bf16* O; int P0; int dqk; const float* qg; const float* rope; };
#define ROW(p, k0, rr) ((p) + (size_t)((k0) + (rr)) * PITCH + sc)
#define VMW() asm volatile("s_waitcnt vmcnt(0)" ::: "memory")
#define SLOAD_H(k0_) do { const int k0 = (ABL == 1) ? 0 : (k0_); st_v0 = load8(ROW(cur.V, k0, sr)); st_v1 = load8(ROW(cur.V, k0, 32 + sr));              \
                         if (sc < DQK) { st_k0 = load8(ROW(cur.K, k0, sr)); st_k1 = load8(ROW(cur.K, k0, 32 + sr)); }    \
                         if (tid < 64) st_b = cur.KB[(k0) + tid]; } while (0)
#define SWRITE_H(bf) do { *(bf16x8*)(V_lds + (bf) * SHM_V + vst0) = st_v0; *(bf16x8*)(V_lds + (bf) * SHM_V + vst1) = st_v1; \
                         if (sc < DQK) { *(bf16x8*)(K_lds + (bf) * SHM_K + kws) = st_k0; *(bf16x8*)(K_lds + (bf) * SHM_K + kws + 32 * 256) = st_k1; } \
                         if (tid < 64) *(float*)(B_lds + (bf) * 256 + tid * 4) = st_b; } while (0)
template <int DQK, int ABL>
__device__ __forceinline__ void block(const BlockRef& cur, int skv, char* lds) {
    int tid = threadIdx.x; asm volatile("" : "+v"(tid));
    const int wid = __builtin_amdgcn_readfirstlane(tid >> 6), lane = tid & 63, r32 = lane & 31, hi = lane >> 5;
    constexpr unsigned W = 1u << 30;
    int j_hi = (cur.P0 + QB - 1) / KVBLK + 1; if (j_hi > skv / KVBLK) j_hi = skv / KVBLK;
    const int NT = j_hi;
    const int qlo = cur.P0 + wid * QBLK, qm = qlo + r32 - 4 * hi;
    char* V_lds = lds + OFF_V; char* K_lds = lds + OFF_K; char* B_lds = lds + OFF_B;
    float* ws = (float*)(lds + OFF_WS) + wid * 64; float* li_l = ws, * al_l = ws + 32;
    float m_reg = -1e30f, l_reg = 0; f32x16 o[4] = {}; f32x16 negm = {};
    const int sr = tid >> 4, sc = (tid & 15) * 8, vst0 = v_st(sr, sc), vst1 = v_st(32 + sr, sc), kws = KSWZ(sr, sc * 2);
    const int vb0 = (int)(uintptr_t)V_lds + v_rd_base(lane);
    unsigned kaddr[4];
#pragma unroll
    for (int dd = 0; dd < 4; ++dd) kaddr[dd] = (unsigned)(uintptr_t)K_lds + KSWZ(r32, (dd * 16 + hi * 8) * 2);
    bf16x8 qr[DQK / 16];
    {
        float qf[DQK / 16][8]; float ss = 0.f;
#pragma unroll
        for (int d0 = 0; d0 < DQK / 16; ++d0) { const u32x4 w = __builtin_bit_cast(u32x4, load8(cur.Q + (size_t)(wid * QBLK + r32) * PITCH + d0 * 16 + hi * 8));
#pragma unroll
            for (int i = 0; i < 4; ++i) { qf[d0][2 * i] = __uint_as_float(w[i] << 16); qf[d0][2 * i + 1] = __uint_as_float(w[i] & 0xffff0000u); }
#pragma unroll
            for (int i = 0; i < 8; ++i) ss += qf[d0][i] * qf[d0][i]; }
        { auto rr = __builtin_amdgcn_permlane32_swap(__float_as_uint(ss), __float_as_uint(ss), false, false); ss = __uint_as_float(rr[0]) + __uint_as_float(rr[1]); }
        const float rn = (DQK == 64 ? 0.125f * 1.4426950408889634f : 1.f) / sqrtf(ss * (1.f / DQK) + 1e-6f);
#pragma unroll
        for (int d0 = 0; d0 < DQK / 16; ++d0) { const f32x4 g0 = *(const f32x4*)(cur.qg + d0 * 16 + hi * 8), g1 = *(const f32x4*)(cur.qg + d0 * 16 + hi * 8 + 4);
#pragma unroll
            for (int i = 0; i < 4; ++i) { qf[d0][i] *= rn * g0[i]; qf[d0][4 + i] *= rn * g1[i]; } }
        if (DQK == 64) { const float* tb = cur.rope + (size_t)(cur.P0 - 48 + wid * QBLK + r32) * 16;
#pragma unroll
            for (int i = 0; i < 8; ++i) { const float mine = qf[0][i]; auto rr = __builtin_amdgcn_permlane32_swap(__float_as_uint(mine), __float_as_uint(mine), false, false);
                const float other = __uint_as_float(hi ? rr[0] : rr[1]); const float c = tb[2 * i], sn = tb[2 * i + 1];
                qf[0][i] = hi ? (mine * c + other * sn) : (mine * c - other * sn); } }
#pragma unroll
        for (int d0 = 0; d0 < DQK / 16; ++d0) { u32x4 w = {cvtpk(qf[d0][0], qf[d0][1]), cvtpk(qf[d0][2], qf[d0][3]), cvtpk(qf[d0][4], qf[d0][5]), cvtpk(qf[d0][6], qf[d0][7])}; qr[d0] = __builtin_bit_cast(bf16x8, w); }
    }
    bf16x8 st_v0, st_v1, st_k0, st_k1; float st_b;
    SLOAD_H(0); VMW(); SWRITE_H(0);
    if (NT > 1) { SLOAD_H(KVBLK); VMW(); SWRITE_H(1); }
    __syncthreads();
    if (wid >= 4) __builtin_amdgcn_s_barrier();
#define RESC(a) do { if (__any((a) < 1.f)) { if (hi == 0) al_l[r32] = (a); asm volatile("s_waitcnt lgkmcnt(0)" ::: "memory");              \
                     for (int d_ = 0; d_ < 4; ++d_) for (int r = 0; r < 16; ++r) o[d_][r] *= al_l[crow(r, hi)]; } } while (0)
#define BAR() do { asm volatile("s_waitcnt lgkmcnt(0)" ::: "memory"); __builtin_amdgcn_s_barrier(); asm volatile("" ::: "memory"); } while (0)
#define KEEP4(a, b, c, d) asm volatile("" :: "v"(a), "v"(b), "v"(c), "v"(d))
#define TILE(t, BUF) do { f32x16 p0, p1; float mn, al; bf16x8 pa0, pa1, pa2, pa3;                                             \
        if (ABL != 6 && ABL < 7) { if ((t) + 2 < NT) { SLOAD_H(((t) + 2) * KVBLK); } }                                          \
        SBAR();                                                                                                               \
        if (ABL == 4 || ABL == 9 || ABL >= 10) { p0 = f32x16{}; p1 = f32x16{}; asm volatile("" : "+v"(p0), "+v"(p1)); }                                 \
        else qkt<BUF, DQK>(p0, p1, kaddr, B_lds, r32, hi, qr, DQK == 128 || (t) == 0, negm);     \
        { const int kb_ = (t) * KVBLK; if (kb_ + KVBLK - 1 > qlo) mask_tile(p0, p1, qm - kb_, W); }                            \
        if (ABL != 5 && ABL < 7) BAR();                                                                                        \
        if (ABL == 2 || ABL >= 7) { al = 1.f; l_reg += p0[0];                                                                  \
            { u32x4 w0 = {cvtpk(p0[0], p0[1]), cvtpk(p0[2], p0[3]), cvtpk(p0[4], p0[5]), cvtpk(p0[6], p0[7])}; pa0 = *reinterpret_cast<bf16x8*>(&w0);    \
              u32x4 w1 = {cvtpk(p0[8], p0[9]), cvtpk(p0[10], p0[11]), cvtpk(p0[12], p0[13]), cvtpk(p0[14], p0[15])}; pa1 = *reinterpret_cast<bf16x8*>(&w1); \
              u32x4 w2 = {cvtpk(p1[0], p1[1]), cvtpk(p1[2], p1[3]), cvtpk(p1[4], p1[5]), cvtpk(p1[6], p1[7])}; pa2 = *reinterpret_cast<bf16x8*>(&w2);    \
              u32x4 w3 = {cvtpk(p1[8], p1[9]), cvtpk(p1[10], p1[11]), cvtpk(p1[12], p1[13]), cvtpk(p1[14], p1[15])}; pa3 = *reinterpret_cast<bf16x8*>(&w3); } } \
        else { if constexpr (DQK == 64) { if ((t) == 0) partialSM_first(p0, p1, m_reg, al, negm); else partialSM_shift(p0, p1, m_reg, al, negm); (void)mn; } \
               else partialSM<DQK>(p0, p1, m_reg, mn, al);                                                                 \
               RESC(al);                                                                                                      \
               finishSM(p0, p1, al, l_reg, pa0, pa1, pa2, pa3); }                                                              \
        SBAR();                                                                                                               \
        if (ABL == 3 || ABL == 8 || ABL >= 10) { KEEP4(pa0, pa1, pa2, pa3); } else pv_tile<BUF>(o, vb0, pa0, pa1, pa2, pa3);                              \
        if (ABL != 6 && ABL < 7) { if ((t) + 2 < NT) { VMW(); SWRITE_H(((BUF) + 2) % 3); } }                                   \
        if (ABL != 5 && ABL < 7) BAR(); } while (0)
    for (int t = 0; t < (ABL == 11 ? 0 : NT); t += 3) {
        TILE(t, 0);
        if (t + 1 < NT) TILE(t + 1, 1);
        if (t + 2 < NT) TILE(t + 2, 2);
    }
    if (wid < 4) __builtin_amdgcn_s_barrier();
    if (hi == 0) li_l[r32] = l_reg; asm volatile("s_waitcnt lgkmcnt(0)" ::: "memory");
    float rli[16];
#pragma unroll
    for (int r = 0; r < 16; ++r) rli[r] = __builtin_amdgcn_rcpf(li_l[crow(r, hi)]);
    bf16* Ow = cur.O + (size_t)(wid * QBLK) * PITCH;
    {
        unsigned short* stg = (unsigned short*)(lds + OFF_V + wid * 8192);
#pragma unroll
        for (int r = 0; r < 16; ++r) { const int orow = crow(r, hi);
#pragma unroll
            for (int d0 = 0; d0 < 4; ++d0) stg[orow * 128 + d0 * 32 + r32] = (unsigned short)cvtpk(o[d0][r] * rli[r], 0.f); }
        asm volatile("s_waitcnt lgkmcnt(0)" ::: "memory");
#pragma unroll
        for (int i = 0; i < 8; ++i) { const int row = i * 4 + (lane >> 4), ch = lane & 15;
            const u32x4 v = *(const u32x4*)(stg + row * 128 + ch * 8); *(u32x4*)(Ow + (size_t)row * PITCH + ch * 8) = v;
            if (i & 1) asm volatile("" ::: "memory"); } }
    __syncthreads();
#undef RESC
#undef BAR
#undef TILE
}
#undef ROW
#undef VMW
#undef SLOAD_H
#undef SWRITE_H
#undef KSWZ
#undef SBAR
}
constexpr int NWAVES = 8;
#ifndef MK_N_LAUNCHES
#define MK_N_LAUNCHES 1
#endif
constexpr int N_PHASES = 11;
constexpr int N_LAUNCHES = MK_N_LAUNCHES;
static_assert(N_LAUNCHES == 1 || N_LAUNCHES == N_PHASES, "MK_N_LAUNCHES is 1 or 11");

constexpr int BATCH = 2, SEQ = 4096, DM = 2048, NMETA = 16, MREAL = BATCH * SEQ;
constexpr int LSEQ = NMETA + SEQ;
constexpr int LP = 4160, PADF = 48;
constexpr int M1 = 8192;
constexpr int N1 = 10240;
constexpr int WIN_LD = 10248;
constexpr int NEXP = 16384, PEER_H = 8, PEER_K = 16, EROW = 1536;
constexpr float EPS = 1e-6f;

constexpr size_t MiB = 1u << 20;
constexpr size_t WS_CTL = 0, CTL_ZERO_BYTES = 32768;
constexpr size_t WS_WIN = 2 * MiB, WS_WBD = 42 * MiB, WS_WBF = 46 * MiB, WS_WOUT = 50 * MiB, WS_WPQ = 58 * MiB;
constexpr size_t WS_EU = 62 * MiB, WS_EV = 94 * MiB;
constexpr size_t WS_SU = 126 * MiB, WS_SV = 126 * MiB + 65536;
constexpr size_t WS_XN = 190 * MiB;
constexpr size_t WS_H2N = 190 * MiB;
constexpr size_t WS_DQ = 223 * MiB, WS_DK = 239 * MiB, WS_DV = 256 * MiB, WS_FQ = 273 * MiB, WS_FK = 289 * MiB, WS_FV = 306 * MiB;
constexpr size_t WS_GA = 323 * MiB, WS_GB = 355 * MiB;
constexpr size_t WS_O1 = 387 * MiB, WS_O2 = 403 * MiB, WS_OF = 419 * MiB;
constexpr size_t WS_OD = 435 * MiB;
constexpr size_t WS_T = 223 * MiB;
constexpr size_t WS_MG = 289 * MiB;
constexpr size_t WS_QP = 323 * MiB;
constexpr size_t WS_RS = 396 * MiB;
constexpr size_t WS_PART = WS_QP;
constexpr size_t WS_IDX = 387 * MiB, WS_GATE = 391 * MiB;
constexpr size_t WS_SSQ = 395 * MiB;
constexpr size_t WS_LOGF = 451 * MiB;
constexpr size_t WS_KBIAS = 452 * MiB;
constexpr size_t WS_SKH = 451 * MiB + 512 * 1024, WS_SKL = 452 * MiB + 512 * 1024;
constexpr size_t WS_ROPE = 453 * MiB;
constexpr size_t WS_END = 454 * MiB;
static_assert(WS_T + (size_t)MREAL * DM * 4 <= WS_FK && WS_MG + (size_t)MREAL * DM * 2 <= WS_GA && WS_XN + (size_t)M1 * DM * 2 <= WS_DQ, "d_ws map");
static_assert(WS_DK + (size_t)BATCH * LP * 1024 * 2 <= WS_DV && WS_FV + (size_t)BATCH * LP * 1024 * 2 <= WS_GA, "d_ws map");

constexpr int CW_TMO = 0, CW_CODE = 1;
constexpr int CW_BAR = 4096;
constexpr int RING_OFF = 0, RING_BYTES = 131072;
constexpr int LDSCTL_OFF = 143360, MISC_OFF = LDSCTL_OFF + 320;
constexpr int LDS_BYTES = 147456;
#define GAS __attribute__((address_space(1)))
#define LAS __attribute__((address_space(3)))
typedef unsigned short bf16;
typedef unsigned v4u __attribute__((ext_vector_type(4)));
typedef float f32x4 __attribute__((ext_vector_type(4)));
typedef short bf16x8 __attribute__((ext_vector_type(8)));
typedef GAS unsigned gu32;
typedef GAS unsigned long long gu64;
#define RLX_AGENT __ATOMIC_RELAXED, __HIP_MEMORY_SCOPE_AGENT
#define LDS_WAIT() asm volatile("s_waitcnt lgkmcnt(0)" ::: "memory")
#define VM_WAIT() asm volatile("s_waitcnt vmcnt(0)" ::: "memory")
__device__ __forceinline__ unsigned long long rt() { return __builtin_amdgcn_s_memrealtime(); }
__device__ __forceinline__ unsigned f2bf(float f) { unsigned u = __builtin_bit_cast(unsigned, f); return (u + 0x7fffu + ((u >> 16) & 1u)) >> 16; }
__device__ __forceinline__ unsigned pk2(float lo, float hi) { return f2bf(lo) | (f2bf(hi) << 16); }
#define XB_TMO      128
#define XB_XCNT(j)  (256  + 64 * (j))
#define XB_XSUB(j)  (1280 + 64 * (j))
#define XB_XGEN(j)  (2304 + 64 * (j))
#define XB_TOP      3328
#define XB_TOPGEN   3392
#define XCD_BAR_WORDS 3456
#define XB_SPIN_CAP (1u << 18)

__device__ __forceinline__ unsigned xb_ld(unsigned* p)              { return __hip_atomic_load(p, __ATOMIC_RELAXED, __HIP_MEMORY_SCOPE_AGENT); }
__device__ __forceinline__ unsigned xb_add(unsigned* p, unsigned v) { return __hip_atomic_fetch_add(p, v, __ATOMIC_RELAXED, __HIP_MEMORY_SCOPE_AGENT); }
__device__ __forceinline__ unsigned xb_xcc_id() { return (unsigned)__builtin_amdgcn_s_getreg((3 << 11) | 20) & 0xFu; }
#define XB_SPIN(cond, bar) do { unsigned _sp = 0; while (cond) { __builtin_amdgcn_s_sleep(1); \
    if ((++_sp & 255u) == 0u) { if (xb_ld(&(bar)[XB_TMO])) break; if (_sp > XB_SPIN_CAP) { atomicAdd(&(bar)[XB_TMO], 1u); break; } } } } while (0)

struct XcdBarrier {
    unsigned* bar; unsigned x;
    volatile LAS unsigned* st;
};

__device__ __forceinline__ XcdBarrier xcd_barrier_post(unsigned* bar, volatile LAS unsigned* st) {
    XcdBarrier b; b.bar = bar; b.x = xb_xcc_id(); b.st = st;
    if (threadIdx.x == 0) (void)xb_add(&bar[XB_XCNT(b.x)], 1u);
    return b;
}
__device__ __forceinline__ void xcd_barrier_complete(unsigned* bar, unsigned x, unsigned& nloc, unsigned& nx) {
    const unsigned G = gridDim.x * gridDim.y * gridDim.z;
    unsigned sum, cnt, mine, sp = 0u;
    for (;;) {
        sum = 0u; cnt = 0u; mine = 0u;
#pragma unroll
        for (unsigned j = 0; j < 16; ++j) { const unsigned c = xb_ld(&bar[XB_XCNT(j)]); sum += c; cnt += (c > 0u) ? 1u : 0u; mine = (j == x) ? c : mine; }
        if (sum == G) break;
        __builtin_amdgcn_s_sleep(1);
        if ((++sp & 255u) == 0u) { if (xb_ld(&bar[XB_TMO])) break; if (sp > XB_SPIN_CAP) { atomicAdd(&bar[XB_TMO], 1u); break; } }
    }
    nloc = mine > 0u ? mine : 1u; nx = cnt > 0u ? cnt : 1u;
}

__device__ __forceinline__ void xcd_barrier(const XcdBarrier& b) {
    asm volatile("s_waitcnt vmcnt(0)" ::: "memory");
    __syncthreads();
    if (threadIdx.x == 0) {
        unsigned* bar = b.bar;
        __builtin_amdgcn_s_waitcnt(0);
        unsigned nloc = b.st[0], nx = b.st[1];
        if (nloc == 0u) { xcd_barrier_complete(bar, b.x, nloc, nx); b.st[0] = nloc; b.st[1] = nx; }
        const unsigned old = xb_add(&bar[XB_XSUB(b.x)], 1u);
        const unsigned gen = old / nloc;
        if (old + 1u == (gen + 1u) * nloc) {
            __builtin_amdgcn_fence(__ATOMIC_RELEASE, "agent");
            asm volatile("s_waitcnt vmcnt(0)" ::: "memory");
            const unsigned og = xb_add(&bar[XB_TOP], 1u);
            const unsigned tg = og / nx;
            if (og + 1u == (tg + 1u) * nx) xb_add(&bar[XB_TOPGEN], 1u);
            else XB_SPIN(xb_ld(&bar[XB_TOPGEN]) == tg, bar);
            __builtin_amdgcn_fence(__ATOMIC_ACQUIRE, "agent");
            xb_add(&bar[XB_XGEN(b.x)], 1u);
            asm volatile("s_waitcnt vmcnt(0)" ::: "memory");
        } else {
            XB_SPIN(xb_ld(&bar[XB_XGEN(b.x)]) == gen, bar);
            __builtin_amdgcn_fence(__ATOMIC_ACQUIRE, "agent");
            asm volatile("s_waitcnt vmcnt(0)" ::: "memory");
        }
    }
    __syncthreads();
}
__device__ __forceinline__ float wave_sum(float v) {
#pragma unroll
    for (int o = 1; o < 64; o <<= 1) v += __shfl_xor(v, o);
    return v;
}
struct Frame {
    LAS unsigned char* lds;
    volatile LAS unsigned* MISC;
    gu32* ctl;
    int tid, lane, wave;
    int vcu, G;
    int gw, NGW;
    const float* in[23];
    float* out;
    unsigned char* ws;
};
enum { I_X = 0, I_META, I_GMIX, I_WIN, I_BFORGET, I_BGATE, I_DQG, I_DKG, I_FQG, I_FKG, I_LQ1, I_LK1, I_LQ2, I_LK2, I_SUBLN, I_WBD, I_WBF, I_WOUT, I_GPEER, I_WPQ, I_SUBK, I_EU, I_EV };

__device__ __forceinline__ float bf2f(unsigned short b) { return __uint_as_float((unsigned)b << 16); }
__device__ __forceinline__ float bflo(unsigned w) { return __uint_as_float(w << 16); }
__device__ __forceinline__ float bfhi(unsigned w) { return __uint_as_float(w & 0xffff0000u); }
__device__ __forceinline__ float sigmoidf_(float x) { return 1.f / (1.f + __expf(-x)); }

__device__ __forceinline__ void p0_transpose_item2(const float* W, int ldw, int ncols, int K, bf16* WT, int row_off, LAS float* scr, int item, int lane) {
    const int nblk = ncols / 32, kb = item / nblk, nb = item % nblk, k0 = 64 * kb, n0 = 32 * nb;
#pragma unroll 8
    for (int i = 0; i < 32; ++i) { const int kk = 2 * i + (lane >> 5); scr[kk * 33 + (lane & 31)] = __builtin_nontemporal_load(W + (size_t)(k0 + kk) * ldw + n0 + (lane & 31)); }
    LDS_WAIT(); asm volatile("" ::: "memory");
    const int c = lane & 7;
#pragma unroll
    for (int j = 0; j < 4; ++j) { const int n = (lane >> 3) + 8 * j; const LAS float* s = scr + (8 * c) * 33 + n;
        v4u o; o.x = pk2(s[0 * 33], s[1 * 33]); o.y = pk2(s[2 * 33], s[3 * 33]); o.z = pk2(s[4 * 33], s[5 * 33]); o.w = pk2(s[6 * 33], s[7 * 33]);
        *(GAS v4u*)(WT + (size_t)(row_off + n0 + n) * K + k0 + 8 * c) = o; }
    LDS_WAIT(); asm volatile("" ::: "memory");
}

__device__ __forceinline__ void convert_expert_rows(Frame& F, int k0, int k1) {
    unsigned char* ws = F.ws;
#pragma unroll 1
    for (int kb = k0; kb < k1; kb += 4) {
        f32x4 v[4][8];
#pragma unroll
        for (int i = 0; i < 4; ++i) { int r = F.gw + (kb + i < k1 ? kb + i : k1 - 1) * F.NGW; if (r >= 2 * NEXP) r = 2 * NEXP - 1;
            const int tsel = r >= NEXP, e = r - tsel * NEXP; const GAS f32x4* src = (const GAS f32x4*)(F.in[tsel ? I_EV : I_EU] + (size_t)e * DM);
#pragma unroll
            for (int j = 0; j < 8; ++j) v[i][j] = __builtin_nontemporal_load(src + 64 * j + F.lane); }
#pragma unroll
        for (int i = 0; i < 4; ++i) { const int r = F.gw + (kb + i) * F.NGW; if (kb + i >= k1 || r >= 2 * NEXP) continue;
            const int tsel = r >= NEXP, e = r - tsel * NEXP;
            float amax = 0.f;
#pragma unroll
            for (int j = 0; j < 8; ++j) amax = fmaxf(amax, fmaxf(fmaxf(fabsf(v[i][j].x), fabsf(v[i][j].y)), fmaxf(fabsf(v[i][j].z), fabsf(v[i][j].w))));
#pragma unroll
            for (int o = 1; o < 64; o <<= 1) amax = fmaxf(amax, __shfl_xor(amax, o));
            const float s4 = amax > 0.f ? 6.f / amax : 1.f; v4u q;
#define PK4(J) ({ unsigned w_ = 0u; \
                    w_ = __builtin_amdgcn_cvt_scalef32_pk_fp4_f32(w_, v[i][2 * (J)].x * s4, v[i][2 * (J)].y * s4, 1.0f, 0); w_ = __builtin_amdgcn_cvt_scalef32_pk_fp4_f32(w_, v[i][2 * (J)].z * s4, v[i][2 * (J)].w * s4, 1.0f, 1); \
                    w_ = __builtin_amdgcn_cvt_scalef32_pk_fp4_f32(w_, v[i][2 * (J) + 1].x * s4, v[i][2 * (J) + 1].y * s4, 1.0f, 2); w_ = __builtin_amdgcn_cvt_scalef32_pk_fp4_f32(w_, v[i][2 * (J) + 1].z * s4, v[i][2 * (J) + 1].w * s4, 1.0f, 3); w_; })
            q.x = PK4(0); q.y = PK4(1); q.z = PK4(2); q.w = PK4(3);
#undef PK4
            if (tsel) *(GAS v4u*)(ws + WS_EV + (size_t)e * 1024 + 16 * F.lane) = q;
            else {
                GAS unsigned short* up = (GAS unsigned short*)(ws + WS_EU + (size_t)e * 128) + F.lane; constexpr size_t SL = (size_t)NEXP * 64;
                up[0] = (unsigned short)q.x; up[SL] = (unsigned short)(q.x >> 16); up[2 * SL] = (unsigned short)q.y; up[3 * SL] = (unsigned short)(q.y >> 16);
                up[4 * SL] = (unsigned short)q.z; up[5 * SL] = (unsigned short)(q.z >> 16); up[6 * SL] = (unsigned short)q.w; up[7 * SL] = (unsigned short)(q.w >> 16); }
            if (F.lane == 0) ((float*)(ws + (tsel ? WS_SV : WS_SU)))[e] = amax > 0.f ? amax / 6.f : 1.f;
        }
    }
}
__device__ __forceinline__ void p0_prologue(Frame& F) {
    unsigned char* ws = F.ws;
    for (int rpa_ = 0; rpa_ < (((PH_REP_MASK) >> 12) & 1 ? 2 : 1); ++rpa_)
    {   LAS float* WF = (LAS float*)(F.lds + RING_OFF);
        const float* win = F.in[I_WIN];
        for (int i = F.tid; i < DM * 2; i += NWAVES * 64) { const int k = i >> 1, hh = (i & 1) * 4;
            const f32x4 v = *(const f32x4*)(win + (size_t)k * WIN_LD + 6144 + hh);
            WF[(hh + 0) * DM + k] = v.x; WF[(hh + 1) * DM + k] = v.y; WF[(hh + 2) * DM + k] = v.z; WF[(hh + 3) * DM + k] = v.w; }
        __syncthreads();
        bf16* XN = (bf16*)(ws + WS_XN); float* LOGF = (float*)(ws + WS_LOGF);
        const float* gmix = F.in[I_GMIX]; const float* bfg = F.in[I_BFORGET];
        constexpr int NROW = MREAL + NMETA;
#define P0A_SRC(m_) ((const GAS f32x4*)((m_) < MREAL ? F.in[I_X] + (size_t)(m_) * DM : F.in[I_META] + (size_t)((m_) - MREAL) * DM) + F.lane)
#define P0A_LOAD(V, m_) do { const GAS f32x4* xr_ = P0A_SRC(m_); _Pragma("unroll") for (int j = 0; j < 8; ++j) V[j] = __builtin_nontemporal_load(xr_ + 64 * j); } while (0)
#define P0A_ROW(V, m_) do { const int mrow = (m_);                                                                                        \
            GAS unsigned long long* o8 = (GAS unsigned long long*)(XN + (size_t)mrow * DM) + F.lane; float s2 = 0.f;                       \
            _Pragma("unroll") for (int j = 0; j < 8; ++j) s2 += (V[j].x * V[j].x + V[j].y * V[j].y) + (V[j].z * V[j].z + V[j].w * V[j].w);  \
            const float rstd = 1.f / sqrtf(wave_sum(s2) * (1.f / DM) + EPS);                                                           \
            float fl[8];                                                                                                               \
            _Pragma("unroll") for (int h = 0; h < 8; ++h) fl[h] = 0.f;                                                                 \
            _Pragma("unroll") for (int j = 0; j < 8; ++j) { const f32x4 g = *((const GAS f32x4*)gmix + 64 * j + F.lane);               \
                const f32x4 y = {V[j].x * rstd * g.x, V[j].y * rstd * g.y, V[j].z * rstd * g.z, V[j].w * rstd * g.w};                  \
                o8[64 * j] = (unsigned long long)pk2(y.x, y.y) | ((unsigned long long)pk2(y.z, y.w) << 32);                            \
                _Pragma("unroll") for (int h = 0; h < 8; ++h) { const f32x4 w = *(const LAS f32x4*)(WF + h * DM + 256 * j + 4 * F.lane); \
                    fl[h] += (y.x * w.x + y.y * w.y) + (y.z * w.z + y.w * w.w); }                                                      \
                asm volatile("" ::: "memory"); __builtin_amdgcn_sched_barrier(0); }     \
              \
            float a4[4]; { const bool up = (F.lane & 32) != 0;                                                                          \
              _Pragma("unroll") for (int i = 0; i < 4; ++i) { const float snd = up ? fl[i] : fl[i + 4]; const float kp = up ? fl[i + 4] : fl[i]; a4[i] = kp + __shfl_xor(snd, 32); } }   \
            float a2[2]; { const bool up = (F.lane & 16) != 0;                                                                          \
              _Pragma("unroll") for (int i = 0; i < 2; ++i) { const float snd = up ? a4[i] : a4[i + 2]; const float kp = up ? a4[i + 2] : a4[i]; a2[i] = kp + __shfl_xor(snd, 16); } }   \
            float a1; { const bool up = (F.lane & 8) != 0; const float snd = up ? a2[0] : a2[1]; const float kp = up ? a2[1] : a2[0]; a1 = kp + __shfl_xor(snd, 8); }                     \
            a1 += __shfl_xor(a1, 4); a1 += __shfl_xor(a1, 2); a1 += __shfl_xor(a1, 1);                                                 \
                                                       \
            if ((F.lane & 7) == 0) { const int h = ((F.lane >> 5) & 1) * 4 + ((F.lane >> 4) & 1) * 2 + ((F.lane >> 3) & 1);             \
                const float z = a1 + bfg[h];                                                                                           \
                const float lf = fminf(z, 0.f) - log1pf(__expf(-fabsf(z)));                                             \
                if (mrow < MREAL) { const int b = mrow >> 12, s = mrow & 4095; LOGF[((size_t)b * 8 + h) * LSEQ + NMETA + s] = lf; }            \
                else { const int t = mrow - MREAL; LOGF[((size_t)0 * 8 + h) * LSEQ + t] = lf; LOGF[((size_t)1 * 8 + h) * LSEQ + t] = lf; } } } while (0)
        f32x4 va[8], vb[8];
        int m = F.gw;
        if (m < NROW) P0A_LOAD(va, m);
#pragma unroll 1
        for (; m < NROW; m += 2 * F.NGW) {
            const int m1 = m + F.NGW, m2 = m + 2 * F.NGW;
            if (m1 < NROW) P0A_LOAD(vb, m1);
            P0A_ROW(va, m);
            if (m1 < NROW) { if (m2 < NROW) P0A_LOAD(va, m2); P0A_ROW(vb, m1); }
        }
#undef P0A_SRC
#undef P0A_LOAD
#undef P0A_ROW
        __syncthreads();
    }
    {   LAS unsigned short* XM = (LAS unsigned short*)(F.lds + RING_OFF);
        LAS float* PART = (LAS float*)(F.lds + RING_OFF + 66048);
        const float* gmix = F.in[I_GMIX]; const float* win = F.in[I_WIN];
        for (int rr = 0; rr < 2; ++rr) { const int r = 2 * F.wave + rr;
            const GAS f32x4* xr = (const GAS f32x4*)(F.in[I_META] + (size_t)r * DM) + F.lane;
            f32x4 v[8]; float s2 = 0.f;
#pragma unroll
            for (int j = 0; j < 8; ++j) { v[j] = xr[64 * j]; s2 += (v[j].x * v[j].x + v[j].y * v[j].y) + (v[j].z * v[j].z + v[j].w * v[j].w); }
            const float rstd = 1.f / sqrtf(wave_sum(s2) * (1.f / DM) + EPS);
#pragma unroll
            for (int j = 0; j < 8; ++j) { const f32x4 g = *((const GAS f32x4*)gmix + 64 * j + F.lane);
                *(LAS unsigned long long*)(XM + r * 2056 + 256 * j + 4 * F.lane) = (unsigned long long)pk2(v[j].x * rstd * g.x, v[j].y * rstd * g.y) | ((unsigned long long)pk2(v[j].z * rstd * g.z, v[j].w * rstd * g.w) << 32); } }
        __syncthreads();
        const int c = F.lane & 15, kk = F.lane >> 4;
        for (int task = F.vcu; task < 256; task += F.G) {
            const int n = task * 16 + c;
            const int wcol = n < 2048 ? 1024 + n : n + 2048;
            float acc[16];
#pragma unroll
            for (int r = 0; r < 16; ++r) acc[r] = 0.f;
            const LAS unsigned short* xp = XM + 256 * F.wave + kk; const float* wp = win + (size_t)(256 * F.wave + kk) * WIN_LD + wcol;
#pragma unroll 1
            for (int i0 = 0; i0 < 64; i0 += 16) {
                float wv[16];
#pragma unroll
                for (int i = 0; i < 16; ++i) wv[i] = wp[(size_t)(4 * (i0 + i)) * WIN_LD];
                const LAS unsigned short* xq = xp + 4 * i0;
#pragma unroll
                for (int i = 0; i < 16; ++i)
#pragma unroll
                    for (int r = 0; r < 16; ++r) acc[r] += bf2f(xq[r * 2056 + 4 * i]) * wv[i];
            }
#pragma unroll
            for (int r = 0; r < 16; ++r) { float s = acc[r]; s += __shfl_xor(s, 16); s += __shfl_xor(s, 32); if (kk == 0) PART[(F.wave * 16 + r) * 16 + c] = s; }
            __syncthreads();
            if (F.tid < 256) { const int r = F.tid >> 4, cc = F.tid & 15; float s = 0.f;
#pragma unroll
                for (int w = 0; w < 8; ++w) s += PART[(w * 16 + r) * 16 + cc];
                const int nn = task * 16 + cc; const int seg = nn >> 10, col = nn & 1023;
                bf16* base = (bf16*)(ws + (seg == 0 ? WS_DK : seg == 1 ? WS_DV : seg == 2 ? WS_FK : WS_FV));
                const bf16 hv = (bf16)f2bf(s);
                base[(size_t)(PADF + r) * 1024 + col] = hv; base[(size_t)(LP + PADF + r) * 1024 + col] = hv; }
            __syncthreads();
        }
    }
    for (int rpb_ = 0; rpb_ < (((PH_REP_MASK) >> 13) & 1 ? 2 : 1); ++rpb_)
    {   LAS float* scr = (LAS float*)(F.lds + RING_OFF + F.wave * 16384);
        const float* win = F.in[I_WIN];
        constexpr int I_A = (DM / 64) * (6144 / 32), I_G = (DM / 64) * (2048 / 32), I_BD = (1024 / 64) * (DM / 32), I_O = (DM / 64) * (DM / 32), I_P = (DM / 64) * (1024 / 32);
        constexpr int NITEMS = I_A + 2 * I_G + 2 * I_BD + I_O + I_P;
        bf16* WIN = (bf16*)(ws + WS_WIN);
        for (int it = F.gw; it < NITEMS; it += F.NGW) {
            int r = it;
            if (r < I_A) {
                const int nblk = 6144 / 32, kb = r / nblk, nb = r % nblk; const int seg = nb >> 5; int sb = nb;
                if (seg == 1 || seg == 4) { const int pb = nb & 7; sb = (nb & ~7) + 2 * (pb & 3) + (pb >> 2); }
                p0_transpose_item2(win + 32 * sb, WIN_LD, 32, DM, WIN, 32 * nb, scr, kb, F.lane); continue; } r -= I_A;
            if (r < I_G) { p0_transpose_item2(win + 6152, WIN_LD, 2048, DM, WIN, 6144, scr, r, F.lane); continue; } r -= I_G;
            if (r < I_G) { p0_transpose_item2(win + 8200, WIN_LD, 2048, DM, WIN, 8192, scr, r, F.lane); continue; } r -= I_G;
            if (r < I_BD) { p0_transpose_item2(F.in[I_WBD], DM, DM, 1024, (bf16*)(ws + WS_WBD), 0, scr, r, F.lane); continue; } r -= I_BD;
            if (r < I_BD) { p0_transpose_item2(F.in[I_WBF], DM, DM, 1024, (bf16*)(ws + WS_WBF), 0, scr, r, F.lane); continue; } r -= I_BD;
            if (r < I_O) { p0_transpose_item2(F.in[I_WOUT], DM, DM, DM, (bf16*)(ws + WS_WOUT), 0, scr, r, F.lane); continue; } r -= I_O;
            p0_transpose_item2(F.in[I_WPQ], 1024, 1024, DM, (bf16*)(ws + WS_WPQ), 0, scr, r, F.lane);
        }
    }
    {   const size_t gt = (size_t)F.vcu * (NWAVES * 64) + F.tid, GT = (size_t)F.G * NWAVES * 64;
        constexpr size_t per = (size_t)PADF * 1024 * 2 / 16;
        for (size_t c = gt; c < 8 * per; c += GT) { const int a = (int)(c / per), off = (int)(c % per); const int arr = a >> 1, b = a & 1;
            const size_t base = arr == 0 ? WS_DK : arr == 1 ? WS_DV : arr == 2 ? WS_FK : WS_FV;
            ((GAS v4u*)(ws + base + (size_t)b * LP * 1024 * 2))[off] = (v4u){0u, 0u, 0u, 0u}; }
        { const float* sk = F.in[I_SUBK]; bf16* skh = (bf16*)(ws + WS_SKH); bf16* skl = (bf16*)(ws + WS_SKL);
          for (size_t i = gt; i < (size_t)8 * 2 * 128 * 64; i += GT) { const float v = sk[i]; const unsigned hb = f2bf(v); skh[i] = (bf16)hb; skl[i] = (bf16)f2bf(v - __uint_as_float(hb << 16)); } }
        { float* rt = (float*)(ws + WS_ROPE);
          const float inv[8] = {1.0f, 0.1939227432012558f, 0.03760603070259094f, 0.007292664609849453f, 0.0014142135623842478f, 0.00027424818836152554f, 5.318296098266728e-05f, 1.0313386155758053e-05f};
          for (size_t i = gt; i < (size_t)LSEQ * 8; i += GT) { const int fi = (int)(i & 7); float iv = inv[0];
#pragma unroll
              for (int q = 1; q < 8; ++q) iv = fi == q ? inv[q] : iv;
              const float ang = (float)(i >> 3) * iv; rt[2 * i] = cosf(ang); rt[2 * i + 1] = sinf(ang); } }
        float* KBD = (float*)(ws + WS_KBIAS) + (size_t)16 * LP;
        for (size_t p = gt; p < LP; p += GT) KBD[p] = p < PADF ? -__builtin_inff() : 0.f;
    }
}
using pg8::Unit;
__device__ __forceinline__ v4u pack8bf(const f32x4& a, const f32x4& b) { v4u w; w.x = pg8::cvt_pk_bf16(a[0], a[1]); w.y = pg8::cvt_pk_bf16(a[2], a[3]); w.z = pg8::cvt_pk_bf16(b[0], b[1]); w.w = pg8::cvt_pk_bf16(b[2], b[3]); return w; }
struct Epi1 {
    static constexpr bool PERM = true, AFTER_DRAIN = false;
    unsigned char* ws; LAS float* xch; const float* dkg; const float* fkg;
    __device__ __forceinline__ void scale(f32x4 (&)[2][2][4][2], const Unit&, int, int, int, int) const {}
    __device__ __forceinline__ void operator()(const f32x4 (&acc)[2][2][4][2], const Unit& u, int wr, int wc, int fr, int fq) const {
        using pg8::HALF;
        asm volatile("" : "+v"(fr), "+v"(fq));
        const int ncol = u.pn * 256;
        if (ncol >= 1024 && ncol < 2048) {
            bf16* base = (bf16*)(ws + WS_DK) + (ncol - 1024) + 64 * wc + 8 * fq; const float* rope = (const float*)(ws + WS_ROPE);
#pragma unroll
            for (int ai = 0; ai < 2; ++ai)
#pragma unroll
                for (int m = 0; m < 4; ++m) { const int mrow = u.pm * 256 + ai * HALF + wr * 64 + m * 16 + fr;
                    f32x4 y[2][2]; float ss = 0.f;
#pragma unroll
                    for (int bj = 0; bj < 2; ++bj)
#pragma unroll
                        for (int n = 0; n < 2; ++n) { y[bj][n] = acc[ai][bj][m][n]; ss += (y[bj][n][0] * y[bj][n][0] + y[bj][n][1] * y[bj][n][1]) + (y[bj][n][2] * y[bj][n][2] + y[bj][n][3] * y[bj][n][3]); }
                    ss += __shfl_xor(ss, 16); ss += __shfl_xor(ss, 32);
                    const float r = 1.f / sqrtf(ss * (1.f / 64.f) + EPS);
#pragma unroll
                    for (int bj = 0; bj < 2; ++bj)
#pragma unroll
                        for (int n = 0; n < 2; ++n) { const f32x4 g = *(const f32x4*)(dkg + 32 * bj + 8 * fq + 4 * n); y[bj][n] = y[bj][n] * r * g; }
                    const float* tb = rope + (size_t)(NMETA + (mrow & 4095)) * 16;
#pragma unroll
                    for (int n = 0; n < 2; ++n)
#pragma unroll
                        for (int i = 0; i < 4; ++i) { const float mine = y[0][n][i], other = __shfl_xor(mine, 16); const float c = tb[2 * (4 * n + i)], sn = tb[2 * (4 * n + i) + 1];
                            y[0][n][i] = fq == 0 ? (mine * c - other * sn) : (fq == 1 ? (mine * c + other * sn) : mine); }
                    bf16* rowp = base + (size_t)(mrow + 64 + 64 * (mrow >> 12)) * 1024;
                    *(GAS v4u*)(rowp) = pack8bf(y[0][0], y[0][1]); *(GAS v4u*)(rowp + 32) = pack8bf(y[1][0], y[1][1]); }
        } else if (ncol >= 4096 && ncol < 5120) {
            bf16* base = (bf16*)(ws + WS_FK) + (ncol - 4096) + 64 * wc + 8 * fq;
#pragma unroll
            for (int ai = 0; ai < 2; ++ai)
#pragma unroll
                for (int m = 0; m < 4; ++m) { const int rt = ai * HALF + wr * 64 + m * 16 + fr; float ss = 0.f;
#pragma unroll
                    for (int bj = 0; bj < 2; ++bj)
#pragma unroll
                        for (int n = 0; n < 2; ++n) { const f32x4 v = acc[ai][bj][m][n]; ss += (v[0] * v[0] + v[1] * v[1]) + (v[2] * v[2] + v[3] * v[3]); }
                    ss += __shfl_xor(ss, 16); ss += __shfl_xor(ss, 32);
                    if (fq == 0) xch[rt * 4 + wc] = ss; }
            asm volatile("s_waitcnt lgkmcnt(0)" ::: "memory"); __builtin_amdgcn_s_barrier(); asm volatile("" ::: "memory");
#pragma unroll
            for (int ai = 0; ai < 2; ++ai)
#pragma unroll
                for (int m = 0; m < 4; ++m) { const int rt = ai * HALF + wr * 64 + m * 16 + fr; const int mrow = u.pm * 256 + rt;
                    const float r = 1.f / sqrtf((xch[rt * 4 + wc] + xch[rt * 4 + (wc ^ 1)]) * (1.f / 128.f) + EPS);
                    bf16* rowp = base + (size_t)(mrow + 64 + 64 * (mrow >> 12)) * 1024;
#pragma unroll
                    for (int bj = 0; bj < 2; ++bj) { const float* gg = fkg + 64 * (wc & 1) + 32 * bj + 8 * fq; const f32x4 g0 = *(const f32x4*)gg, g1 = *(const f32x4*)(gg + 4);
                        *(GAS v4u*)(rowp + 32 * bj) = pack8bf(acc[ai][bj][m][0] * r * g0, acc[ai][bj][m][1] * r * g1); } }
        } else {
            bf16* base; int ldc, colt, kind;
            if (ncol < 6144) { const int seg = ncol >> 10; colt = ncol & 1023; ldc = 1024;
                base = (bf16*)(ws + (seg == 0 ? WS_DQ : seg == 2 ? WS_DV : seg == 3 ? WS_FQ : WS_FV)); kind = (seg == 2 || seg == 5) ? 1 : 0; }
            else if (ncol < 8192) { base = (bf16*)(ws + WS_GA); colt = ncol - 6144; ldc = 2048; kind = 0; }
            else { base = (bf16*)(ws + WS_GB); colt = ncol - 8192; ldc = 2048; kind = 0; }
#pragma unroll
            for (int ai = 0; ai < 2; ++ai)
#pragma unroll
                for (int m = 0; m < 4; ++m) { const int mrow = u.pm * 256 + ai * HALF + wr * 64 + m * 16 + fr; const size_t row = kind ? (size_t)(mrow + 64 + 64 * (mrow >> 12)) : (size_t)mrow;
#pragma unroll
                    for (int bj = 0; bj < 2; ++bj) *(GAS v4u*)(base + row * ldc + colt + bj * HALF + wc * 32 + 8 * fq) = pack8bf(acc[ai][bj][m][0], acc[ai][bj][m][1]); }
        }
    }
};
struct F_Gemm2a {
    const bf16* G; const float* bg; bf16* MG;
    __device__ __forceinline__ bool begin(const Unit&) { return true; }
    __device__ __forceinline__ void row_begin() {}
    __device__ __forceinline__ void scale_chunk(const Unit&, int, int, f32x4&, f32x4&) const {}
    __device__ __forceinline__ void row_end(const Unit&, int, int, int) {}
    __device__ __forceinline__ void chunk(const Unit& u, int rt, int ct, const f32x4& v0, const f32x4& v1) const {
        const size_t row = (size_t)u.pm * 256 + rt; const int col = u.pn * 256 + ct;
        const v4u g = *(const GAS v4u*)(G + row * DM + col); const f32x4 b0 = *(const f32x4*)(bg + col), b1 = *(const f32x4*)(bg + col + 4);
        f32x4 o0, o1;
        o0[0] = sigmoidf_(bflo(g.x) + b0[0]) * v0[0]; o0[1] = sigmoidf_(bfhi(g.x) + b0[1]) * v0[1]; o0[2] = sigmoidf_(bflo(g.y) + b0[2]) * v0[2]; o0[3] = sigmoidf_(bfhi(g.y) + b0[3]) * v0[3];
        o1[0] = sigmoidf_(bflo(g.z) + b1[0]) * v1[0]; o1[1] = sigmoidf_(bfhi(g.z) + b1[1]) * v1[1]; o1[2] = sigmoidf_(bflo(g.w) + b1[2]) * v1[2]; o1[3] = sigmoidf_(bfhi(g.w) + b1[3]) * v1[3];
        *(GAS v4u*)(MG + row * DM + col) = pack8bf(o0, o1);
    }
};
struct F_Gemm2b {
    const bf16* G; const float* bg; bf16* MG;
    __device__ __forceinline__ bool begin(const Unit&) { return true; }
    __device__ __forceinline__ void row_begin() {}
    __device__ __forceinline__ void scale_chunk(const Unit&, int, int, f32x4&, f32x4&) const {}
    __device__ __forceinline__ void row_end(const Unit&, int, int, int) {}
    __device__ __forceinline__ void chunk(const Unit& u, int rt, int ct, const f32x4& v0, const f32x4& v1) const {
        const size_t row = (size_t)u.pm * 256 + rt; const int col = u.pn * 256 + ct;
        const v4u g = *(const GAS v4u*)(G + row * DM + col); const f32x4 b0 = *(const f32x4*)(bg + col), b1 = *(const f32x4*)(bg + col + 4);
        const v4u t = *(const GAS v4u*)(MG + row * DM + col);
        f32x4 o0, o1;
        o0[0] = bflo(t.x) + sigmoidf_(bflo(g.x) + b0[0]) * v0[0]; o0[1] = bfhi(t.x) + sigmoidf_(bfhi(g.x) + b0[1]) * v0[1]; o0[2] = bflo(t.y) + sigmoidf_(bflo(g.y) + b0[2]) * v0[2]; o0[3] = bfhi(t.y) + sigmoidf_(bfhi(g.y) + b0[3]) * v0[3];
        o1[0] = bflo(t.z) + sigmoidf_(bflo(g.z) + b1[0]) * v1[0]; o1[1] = bfhi(t.z) + sigmoidf_(bfhi(g.z) + b1[1]) * v1[1]; o1[2] = bflo(t.w) + sigmoidf_(bflo(g.w) + b1[2]) * v1[2]; o1[3] = bfhi(t.w) + sigmoidf_(bfhi(g.w) + b1[3]) * v1[3];
        *(GAS v4u*)(MG + row * DM + col) = pack8bf(o0, o1);
    }
};
struct F_Gemm2 {
    const bf16* GA; const bf16* GB; const float* bg; bf16* MG;
    __device__ __forceinline__ bool begin(const Unit&) { return true; }
    __device__ __forceinline__ void row_begin() {}
    __device__ __forceinline__ void row_end(const Unit&, int, int, int) {}
    __device__ __forceinline__ void scale_chunk(const Unit& u, int rt, int ct, f32x4& v0, f32x4& v1) const {
        const size_t row = (size_t)u.pm * 256 + rt; const int col = u.pn * 256 + ct;
        const v4u ga = *(const GAS v4u*)(GA + row * DM + col), gb = *(const GAS v4u*)(GB + row * DM + col);
        const f32x4 a0 = *(const f32x4*)(bg + col), a1 = *(const f32x4*)(bg + col + 4), b0 = *(const f32x4*)(bg + DM + col), b1 = *(const f32x4*)(bg + DM + col + 4);
#define RT(GAW, GBW, HI, AB, BB) ((1.f + __expf(-((HI ? bfhi(GBW) : bflo(GBW)) + (BB)))) / (1.f + __expf(-((HI ? bfhi(GAW) : bflo(GAW)) + (AB)))))
        v0[0] *= RT(ga.x, gb.x, 0, a0[0], b0[0]); v0[1] *= RT(ga.x, gb.x, 1, a0[1], b0[1]); v0[2] *= RT(ga.y, gb.y, 0, a0[2], b0[2]); v0[3] *= RT(ga.y, gb.y, 1, a0[3], b0[3]);
        v1[0] *= RT(ga.z, gb.z, 0, a1[0], b1[0]); v1[1] *= RT(ga.z, gb.z, 1, a1[1], b1[1]); v1[2] *= RT(ga.w, gb.w, 0, a1[2], b1[2]); v1[3] *= RT(ga.w, gb.w, 1, a1[3], b1[3]);
#undef RT
    }
    __device__ __forceinline__ void chunk(const Unit& u, int rt, int ct, const f32x4& v0, const f32x4& v1) const {
        const size_t row = (size_t)u.pm * 256 + rt; const int col = u.pn * 256 + ct;
        const v4u g = *(const GAS v4u*)(GB + row * DM + col); const f32x4 b0 = *(const f32x4*)(bg + DM + col), b1 = *(const f32x4*)(bg + DM + col + 4);
        f32x4 o0, o1;
        o0[0] = sigmoidf_(bflo(g.x) + b0[0]) * v0[0]; o0[1] = sigmoidf_(bfhi(g.x) + b0[1]) * v0[1]; o0[2] = sigmoidf_(bflo(g.y) + b0[2]) * v0[2]; o0[3] = sigmoidf_(bfhi(g.y) + b0[3]) * v0[3];
        o1[0] = sigmoidf_(bflo(g.z) + b1[0]) * v1[0]; o1[1] = sigmoidf_(bfhi(g.z) + b1[1]) * v1[1]; o1[2] = sigmoidf_(bflo(g.w) + b1[2]) * v1[2]; o1[3] = sigmoidf_(bfhi(g.w) + b1[3]) * v1[3];
        *(GAS v4u*)(MG + row * DM + col) = pack8bf(o0, o1);
    }
};
struct Pair2Order {
    pg8::StaticOrder S; int dA, dB;
    __device__ void init(int M, int N, int G_, int c_, int dA_, int dB_) { S.init(M, N, G_, c_); dA = dA_; dB = dB_; }
    __device__ bool next(int i, Unit& u) const { if (!S.next(i >> 1, u)) return false; const int br = i & 1; u.ko = br ? dA : 0; u.kob = br ? dB : 0; u.chain = br ? 0 : 1; return true; }
    __device__ __forceinline__ void a_ready(const Unit&) const {}
    __device__ __forceinline__ void done(const Unit&) const {}
};
struct F_Gemm3 {
    const float* X; float* O; const float* gp; bf16* HG; float* SSQ; float ss;
    __device__ __forceinline__ bool begin(const Unit&) { return true; }
    __device__ __forceinline__ void row_begin() { ss = 0.f; }
    __device__ __forceinline__ void scale_chunk(const Unit&, int, int, f32x4&, f32x4&) const {}
    __device__ __forceinline__ void chunk(const Unit& u, int rt, int ct, const f32x4& v0, const f32x4& v1) {
        const int col = u.pn * 256 + ct; const size_t off = ((size_t)u.pm * 256 + rt) * DM + col;
        const f32x4 x0 = *(const GAS f32x4*)(X + off), x1 = *(const GAS f32x4*)(X + off + 4);
        const f32x4 o0 = x0 + v0, o1 = x1 + v1;
        *(GAS f32x4*)(O + off) = o0; *(GAS f32x4*)(O + off + 4) = o1;
        ss += (o0[0] * o0[0] + o0[1] * o0[1]) + (o0[2] * o0[2] + o0[3] * o0[3]) + (o1[0] * o1[0] + o1[1] * o1[1]) + (o1[2] * o1[2] + o1[3] * o1[3]);
        const f32x4 g0 = *(const f32x4*)(gp + col), g1 = *(const f32x4*)(gp + col + 4);
        *(GAS v4u*)(HG + off) = pack8bf(o0 * g0, o1 * g1);
    }
    __device__ __forceinline__ void row_end(const Unit& u, int rt, int wc, int fq) {
        float s = ss; s += __shfl_xor(s, 16); s += __shfl_xor(s, 32);
        if (fq == 0) SSQ[((size_t)u.pm * 256 + rt) * 32 + u.pn * 4 + wc] = s;
    }
};
struct F_Gemm4 {
    float* Q;
    __device__ __forceinline__ bool begin(const Unit&) { return true; }
    __device__ __forceinline__ void row_begin() {}
    __device__ __forceinline__ void scale_chunk(const Unit&, int, int, f32x4&, f32x4&) const {}
    __device__ __forceinline__ void row_end(const Unit&, int, int, int) {}
    __device__ __forceinline__ void chunk(const Unit& u, int rt, int ct, const f32x4& v0, const f32x4& v1) const {
        const size_t off = (u.ko ? (size_t)MREAL * 1024 : 0) + ((size_t)u.pm * 256 + rt) * 1024 + u.pn * 256 + ct;
        *(GAS f32x4*)(Q + off) = v0; *(GAS f32x4*)(Q + off + 4) = v1;
    }
};
struct SplitK2Order {
    pg8::StaticOrder S;
    __device__ void init(int M, int N, int G_, int c_) { S.init(M, 2 * N, G_, c_); }
    __device__ bool next(int i, Unit& u) const { if (!S.next(i, u)) return false; u.ko = (u.pn >> 2) * 2048; u.kob = u.ko; u.pn &= 3; return true; }
    __device__ __forceinline__ void a_ready(const Unit&) const {}
    __device__ __forceinline__ void done(const Unit&) const {}
};

__device__ __forceinline__ void p2_norm_row(bf16* rowp, const float* gain, int grp  , bool rope, const float* ropetab  , int lane) {
    const v4u w0 = *(const GAS v4u*)(rowp + 16 * lane), w1 = *(const GAS v4u*)(rowp + 16 * lane + 8);
    float x[16];
    x[0] = bflo(w0.x); x[1] = bfhi(w0.x); x[2] = bflo(w0.y); x[3] = bfhi(w0.y); x[4] = bflo(w0.z); x[5] = bfhi(w0.z); x[6] = bflo(w0.w); x[7] = bfhi(w0.w);
    x[8] = bflo(w1.x); x[9] = bfhi(w1.x); x[10] = bflo(w1.y); x[11] = bfhi(w1.y); x[12] = bflo(w1.z); x[13] = bfhi(w1.z); x[14] = bflo(w1.w); x[15] = bfhi(w1.w);
    float ss = 0.f;
#pragma unroll
    for (int i = 0; i < 16; ++i) ss += x[i] * x[i];
    ss += __shfl_xor(ss, 1); ss += __shfl_xor(ss, 2); if (grp == 128) ss += __shfl_xor(ss, 4);
    const float r = 1.f / sqrtf(ss / (float)grp + EPS);
    const int d0 = (16 * lane) & (grp - 1);
#pragma unroll
    for (int i = 0; i < 16; i += 4) { const f32x4 g = *(const f32x4*)(gain + d0 + i); x[i] = x[i] * r * g[0]; x[i + 1] = x[i + 1] * r * g[1]; x[i + 2] = x[i + 2] * r * g[2]; x[i + 3] = x[i + 3] * r * g[3]; }
    if (rope && (lane & 3) == 0) {
#pragma unroll
        for (int i = 0; i < 8; ++i) { const float c = ropetab[2 * i], s = ropetab[2 * i + 1]; const float a = x[i], b = x[i + 8]; x[i] = a * c - b * s; x[i + 8] = b * c + a * s; }
    }
    v4u o0, o1;
    o0.x = pk2(x[0], x[1]); o0.y = pk2(x[2], x[3]); o0.z = pk2(x[4], x[5]); o0.w = pk2(x[6], x[7]); o1.x = pk2(x[8], x[9]); o1.y = pk2(x[10], x[11]); o1.z = pk2(x[12], x[13]); o1.w = pk2(x[14], x[15]);
    *(GAS v4u*)(rowp + 16 * lane) = o0; *(GAS v4u*)(rowp + 16 * lane + 8) = o1;
}
__device__ __forceinline__ void p1_tail(Frame& F) {
    unsigned char* ws = F.ws;
    if (F.gw < 16) {
        const float* lf = (const float*)(ws + WS_LOGF) + (size_t)F.gw * LSEQ; float* kb = (float*)(ws + WS_KBIAS) + (size_t)F.gw * LP;
        float carry = 0.f;
#pragma unroll 1
        for (int c0 = 0; c0 < LSEQ; c0 += 512) {
            float x[8];
#pragma unroll
            for (int u = 0; u < 8; ++u) { const int t = c0 + 64 * u + F.lane; x[u] = t < LSEQ ? lf[t] : 0.f; }
#pragma unroll
            for (int u = 0; u < 8; ++u) { float incl = x[u];
#pragma unroll
                for (int o = 1; o < 64; o <<= 1) { const float n = __shfl_up(incl, o); if (F.lane >= o) incl += n; }
                incl += carry; const int t = c0 + 64 * u + F.lane; if (t < LSEQ) kb[PADF + t] = -incl * 11.313708498984761f;
                carry = __shfl(incl, 63); }
        }
        if (F.lane < PADF) kb[F.lane] = -__builtin_inff();
    }
    { const int rtask = F.gw - 16;
      if (rtask >= 0 && rtask < 64) { const int arr = rtask >> 5, b = (rtask >> 4) & 1, t = rtask & 15;
          if (arr == 0) p2_norm_row((bf16*)(ws + WS_DK) + ((size_t)b * LP + PADF + t) * 1024, F.in[I_DKG], 64, true, (const float*)(ws + WS_ROPE) + (size_t)t * 16, F.lane);
          else p2_norm_row((bf16*)(ws + WS_FK) + ((size_t)b * LP + PADF + t) * 1024, F.in[I_FKG], 128, false, nullptr, F.lane); } }
}

__device__ const unsigned char ATT_TAB[32][4] = {
{0,95,69,112},{16,79,85,112},{32,94,70,112},{22,78,81,112},{4,36,77,112},{15,38,35,112},{55,93,65,112},{63,33,87,112},{61,6,21,112},{47,20,84,112},{13,42,1,112},{54,92,83,112},{41,18,75,112},{43,17,90,112},{62,7,19,112},{39,51,76,112},{45,71,82,112},{30,8,50,112},{46,40,2,112},{31,9,48,112},{28,53,86,112},{56,3,91,112},{10,57,37,112},{44,23,5,112},{29,73,64,112},{14,58,80,112},{12,11,49,112},{26,34,74,112},{60,72,66,112},{59,25,52,112},{89,88,67,112},{27,24,68,112}};
__device__ __forceinline__ att::BlockRef att_ref(unsigned char* ws, int x, int code, const float* qg64, const float* qg128) {
    const int hl = code >> 4, j = code & 15; att::BlockRef r; r.rope = (const float*)(ws + WS_ROPE);
    if (hl < 4) { const int dp = 2 * x + (hl >> 1), b = dp >> 3, h = dp & 7, i = hl & 1;
        r.Q = (const bf16*)(ws + WS_DQ) + ((size_t)b * SEQ + 256 * j) * 1024 + h * 128 + i * 64;
        r.K = (const bf16*)(ws + WS_DK) + (size_t)b * LP * 1024 + h * 128 + i * 64;
        r.V = (const bf16*)(ws + WS_DV) + (size_t)b * LP * 1024 + h * 128;
        r.KB = (const float*)(ws + WS_KBIAS) + (size_t)16 * LP;
        r.O = (bf16*)(ws + (i ? WS_O2 : WS_O1)) + ((size_t)b * SEQ + 256 * j) * 1024 + h * 128; r.dqk = 64; r.qg = qg64; }
    else { const int fh = 2 * x + (hl - 4), b = fh >> 3, h = fh & 7;
        r.Q = (const bf16*)(ws + WS_FQ) + ((size_t)b * SEQ + 256 * j) * 1024 + h * 128;
        r.K = (const bf16*)(ws + WS_FK) + (size_t)b * LP * 1024 + h * 128;
        r.V = (const bf16*)(ws + WS_FV) + (size_t)b * LP * 1024 + h * 128;
        r.KB = (const float*)(ws + WS_KBIAS) + (size_t)fh * LP;
        r.O = (bf16*)(ws + WS_OF) + ((size_t)b * SEQ + 256 * j) * 1024 + h * 128; r.dqk = 128; r.qg = qg128; }
    r.P0 = 64 + 256 * j; return r;
}
template <int ABL>
__device__ __forceinline__ void p3_attention(Frame& F, char* lds) {
    for (int v = F.vcu; v < 256; v += F.G) {
        const int x = v >> 5, slot = v & 31;
        int n = 0; while (n < 4 && ATT_TAB[slot][n] != 112) ++n;
        if (ABL == 0 && v == F.vcu && n < 2) convert_expert_rows(F, 0, (2 * NEXP + F.NGW - 1) / F.NGW);
        if (n == 0) continue;
        for (int i = 0; i < n; ++i) {
            if (ABL == 0 && v == F.vcu && i > 0) {
                const int KT = (2 * NEXP + F.NGW - 1) / F.NGW, per = (KT + (n - 1) - 1) / (n - 1); const int ka = (i - 1) * per, kb2 = i * per < KT ? i * per : KT;
                if (ka < kb2) convert_expert_rows(F, ka, kb2); }
            att::BlockRef cur = att_ref(F.ws, x, ATT_TAB[slot][i], F.in[I_DQG], F.in[I_FQG]);
            if (ABL != 0) cur.O = (bf16*)(F.ws + WS_XN) + (cur.O - (bf16*)(F.ws + (cur.dqk == 64 ? WS_O1 : WS_OF)) ) % ((size_t)MREAL * 1024);
            if (cur.dqk == 64) att::block<64, ABL>(cur, LP, lds); else att::block<128, ABL>(cur, LP, lds);
        }
    }
}
__device__ __forceinline__ float diff_lambda(Frame& F) {
    const float a = F.in[I_LQ1][F.lane] * F.in[I_LK1][F.lane], b = F.in[I_LQ2][F.lane] * F.in[I_LK2][F.lane];
    return __expf(wave_sum(a)) - __expf(wave_sum(b)) + 0.2f;
}
__device__ __forceinline__ void p4_combine(Frame& F) {
    const float lam = diff_lambda(F);
    const bf16* O1 = (const bf16*)(F.ws + WS_O1); const bf16* O2 = (const bf16*)(F.ws + WS_O2); bf16* OD = (bf16*)(F.ws + WS_OD);
    const float* g = F.in[I_SUBLN];
    const int d0 = (16 * F.lane) & 127;
    for (int m = F.gw; m < MREAL; m += F.NGW) {
        const size_t off = (size_t)m * 1024 + 16 * F.lane;
        const v4u a0 = *(const GAS v4u*)(O1 + off), a1 = *(const GAS v4u*)(O1 + off + 8), b0 = *(const GAS v4u*)(O2 + off), b1 = *(const GAS v4u*)(O2 + off + 8);
        float x[16];
        x[0] = bflo(a0.x) - lam * bflo(b0.x); x[1] = bfhi(a0.x) - lam * bfhi(b0.x); x[2] = bflo(a0.y) - lam * bflo(b0.y); x[3] = bfhi(a0.y) - lam * bfhi(b0.y);
        x[4] = bflo(a0.z) - lam * bflo(b0.z); x[5] = bfhi(a0.z) - lam * bfhi(b0.z); x[6] = bflo(a0.w) - lam * bflo(b0.w); x[7] = bfhi(a0.w) - lam * bfhi(b0.w);
        x[8] = bflo(a1.x) - lam * bflo(b1.x); x[9] = bfhi(a1.x) - lam * bfhi(b1.x); x[10] = bflo(a1.y) - lam * bflo(b1.y); x[11] = bfhi(a1.y) - lam * bfhi(b1.y);
        x[12] = bflo(a1.z) - lam * bflo(b1.z); x[13] = bfhi(a1.z) - lam * bfhi(b1.z); x[14] = bflo(a1.w) - lam * bflo(b1.w); x[15] = bfhi(a1.w) - lam * bfhi(b1.w);
        float ss = 0.f;
#pragma unroll
        for (int i = 0; i < 16; ++i) ss += x[i] * x[i];
        ss += __shfl_xor(ss, 1); ss += __shfl_xor(ss, 2); ss += __shfl_xor(ss, 4);
        const float r = 0.8f / sqrtf(ss * (1.f / 128.f) + EPS);
#pragma unroll
        for (int i = 0; i < 16; i += 4) { const f32x4 gg = *(const f32x4*)(g + d0 + i); x[i] *= r * gg[0]; x[i + 1] *= r * gg[1]; x[i + 2] *= r * gg[2]; x[i + 3] *= r * gg[3]; }
        v4u o0, o1;
        o0.x = pk2(x[0], x[1]); o0.y = pk2(x[2], x[3]); o0.z = pk2(x[4], x[5]); o0.w = pk2(x[6], x[7]); o1.x = pk2(x[8], x[9]); o1.y = pk2(x[10], x[11]); o1.z = pk2(x[12], x[13]); o1.w = pk2(x[14], x[15]);
        *(GAS v4u*)(OD + off) = o0; *(GAS v4u*)(OD + off + 8) = o1;
    }
}
__device__ __forceinline__ unsigned f2ord(float f) { const unsigned u = __float_as_uint(f); return u ^ ((unsigned)((int)u >> 31) | 0x80000000u); }
__device__ __forceinline__ float ord2f(unsigned k) { const unsigned m = (unsigned)((int)(~k) >> 31) | 0x80000000u; return __uint_as_float(k ^ m); }
__device__ __forceinline__ void sort16_desc(unsigned (&a)[16]) {
#pragma unroll
    for (int k = 2; k <= 16; k <<= 1)
#pragma unroll
        for (int j = k >> 1; j > 0; j >>= 1)
#pragma unroll
            for (int i = 0; i < 16; ++i) { const int l = i ^ j; if (l > i) { const bool desc = (i & k) == 0; const unsigned hi_ = max(a[i], a[l]), lo_ = min(a[i], a[l]); a[i] = desc ? hi_ : lo_; a[l] = desc ? lo_ : hi_; } }
}
__device__ __forceinline__ void merge_top16(unsigned (&a)[16], const unsigned (&b)[16]) {
#pragma unroll
    for (int i = 0; i < 16; ++i) a[i] = max(a[i], b[15 - i]);
#pragma unroll
    for (int j = 8; j > 0; j >>= 1)
#pragma unroll
        for (int i = 0; i < 16; ++i) { const int l = i ^ j; if (l > i) { const unsigned hi_ = max(a[i], a[l]), lo_ = min(a[i], a[l]); a[i] = hi_; a[l] = lo_; } }
}
__device__ __forceinline__ void p9_route(Frame& F) {
    typedef float f32x16 __attribute__((ext_vector_type(16)));
    const float* QP0 = (const float*)(F.ws + WS_QP); const float* QP1 = QP0 + (size_t)MREAL * 1024; const float* SSQ = (const float*)(F.ws + WS_SSQ);
    const bf16* SKH = (const bf16*)(F.ws + WS_SKH); const bf16* SKL = (const bf16*)(F.ws + WS_SKL);
    int* IDX = (int*)(F.ws + WS_IDX); float* GATE = (float*)(F.ws + WS_GATE);
    LAS int* XI = (LAS int*)(F.lds + RING_OFF) + F.wave * (64 * 33);
    const int r32 = F.lane & 31, hi = F.lane >> 5;
    for (int task = F.gw; task < PEER_H * (MREAL / 32); task += F.NGW) {
        const int h = task & 7, tok = (task >> 3) * 32 + r32;
        float rs;
        { const GAS f32x4* sp = (const GAS f32x4*)(SSQ + (size_t)tok * 32); f32x4 t = sp[0];
#pragma unroll
          for (int i = 1; i < 8; ++i) t += sp[i];
          rs = 1.f / sqrtf(((t[0] + t[1]) + (t[2] + t[3])) * (1.f / DM) + EPS); }
        if (h == 0 && hi == 0) ((float*)(F.ws + WS_RS))[tok] = rs;
        unsigned T[2][16];
#pragma unroll
        for (int c = 0; c < 2; ++c) {
            f32x16 acc[4];
#pragma unroll
            for (int kb = 0; kb < 4; ++kb) acc[kb] = f32x16{};
            const size_t qoff = (size_t)tok * 1024 + h * 128 + c * 64 + 8 * hi;
            const size_t koff = ((size_t)(h * 2 + c) * 128 + r32) * 64 + 8 * hi;
#pragma unroll
            for (int ks = 0; ks < 4; ++ks) {
                bf16x8 qh, ql;
                { const GAS f32x4* a0 = (const GAS f32x4*)(QP0 + qoff + 16 * ks); const GAS f32x4* a1 = (const GAS f32x4*)(QP1 + qoff + 16 * ks);
                  const f32x4 q0 = (a0[0] + a1[0]) * rs, q1 = (a0[1] + a1[1]) * rs;
                  const v4u hw = pack8bf(q0, q1);
                  f32x4 l0, l1;
                  l0[0] = q0[0] - bflo(hw.x); l0[1] = q0[1] - bfhi(hw.x); l0[2] = q0[2] - bflo(hw.y); l0[3] = q0[3] - bfhi(hw.y);
                  l1[0] = q1[0] - bflo(hw.z); l1[1] = q1[1] - bfhi(hw.z); l1[2] = q1[2] - bflo(hw.w); l1[3] = q1[3] - bfhi(hw.w);
                  const v4u lw = pack8bf(l0, l1);
                  qh = __builtin_bit_cast(bf16x8, hw); ql = __builtin_bit_cast(bf16x8, lw); }
#pragma unroll
                for (int kb = 0; kb < 4; ++kb) {
                    const bf16x8 kh = *(const GAS bf16x8*)(SKH + koff + (size_t)kb * 32 * 64 + 16 * ks), kl = *(const GAS bf16x8*)(SKL + koff + (size_t)kb * 32 * 64 + 16 * ks);
                    acc[kb] = __builtin_amdgcn_mfma_f32_32x32x16_bf16(kh, qh, acc[kb], 0, 0, 0);
                    acc[kb] = __builtin_amdgcn_mfma_f32_32x32x16_bf16(kh, ql, acc[kb], 0, 0, 0);
                    acc[kb] = __builtin_amdgcn_mfma_f32_32x32x16_bf16(kl, qh, acc[kb], 0, 0, 0);
                }
                __builtin_amdgcn_sched_barrier(0);
            }
            unsigned G[4][16];
#pragma unroll
            for (int kb = 0; kb < 4; ++kb) {
#pragma unroll
                for (int r = 0; r < 16; ++r) { const int n = 32 * kb + (r & 3) + 8 * (r >> 2) + 4 * hi; G[kb][r] = (f2ord(acc[kb][r]) & ~0x7Fu) | (unsigned)(127 - n); }
                sort16_desc(G[kb]); }
            merge_top16(G[0], G[1]); merge_top16(G[2], G[3]); merge_top16(G[0], G[2]);
            unsigned P[16];
#pragma unroll
            for (int j = 0; j < 16; ++j) { auto rr = __builtin_amdgcn_permlane32_swap(G[0][j], G[0][j], false, false); P[j] = hi ? rr[0] : rr[1]; }
            merge_top16(G[0], P);
            unsigned (&L)[16] = G[0];
#pragma unroll
            for (int j = 0; j < 16; ++j) T[c][j] = L[j];
        }
        float v1[16], v2[16];
#pragma unroll
        for (int j = 0; j < 16; ++j) { v1[j] = ord2f(T[0][j] & ~0x7Fu); v2[j] = ord2f(T[1][j] & ~0x7Fu);
            XI[F.lane * 33 + j] = 127 - (int)(T[0][j] & 0x7Fu); XI[F.lane * 33 + 16 + j] = 127 - (int)(T[1][j] & 0x7Fu); }
        unsigned Bst[16], C1[16], C2[16], C3[16];
#pragma unroll
        for (int j = 0; j < 16; ++j) { Bst[j] = (f2ord(v1[0] + v2[j]) & ~0xFFu) | (unsigned)(255 - j); C1[j] = 0u; C2[j] = 0u; C3[j] = 0u; }
        { int cnt = 0;
#pragma unroll
          for (int a = 1; a < 16; ++a)
#pragma unroll
            for (int b = 0; b < 16; ++b) if ((a + 1) * (b + 1) <= 16) { const unsigned key = (f2ord(v1[a] + v2[b]) & ~0xFFu) | (unsigned)(255 - (a * 16 + b));
                if (cnt < 16) C1[cnt] = key; else if (cnt < 32) C2[cnt - 16] = key; else C3[cnt - 32] = key; ++cnt; } }
        sort16_desc(C1); sort16_desc(C2); sort16_desc(C3);
        merge_top16(Bst, C1); merge_top16(C2, C3); merge_top16(Bst, C2);
        float e[16], sum = 0.f; const float top = ord2f(Bst[0] & ~0xFFu);
#pragma unroll
        for (int j = 0; j < 16; ++j) { e[j] = __expf(ord2f(Bst[j] & ~0xFFu) - top); sum += e[j]; }
        const float rsum = 1.f / sum;
        LDS_WAIT();
        if (hi == 0) {
            GAS int* io = (GAS int*)(IDX + (size_t)tok * 128 + h * 16); GAS float* go = (GAS float*)(GATE + (size_t)tok * 128 + h * 16);
#pragma unroll
            for (int j = 0; j < 16; ++j) { const int ab = 255 - (int)(Bst[j] & 0xFFu); const int i1 = XI[F.lane * 33 + (ab >> 4)], i2 = XI[F.lane * 33 + 16 + (ab & 15)];
                io[j] = i1 * 128 + i2; go[j] = e[j] * rsum; }
        }
        LDS_WAIT();
    }
}
typedef float f32x2 __attribute__((ext_vector_type(2)));
typedef float f32x32 __attribute__((ext_vector_type(32)));
typedef unsigned u32x6 __attribute__((ext_vector_type(6)));
typedef unsigned u32x16 __attribute__((ext_vector_type(16)));
typedef __bf16 bf16x32_t __attribute__((ext_vector_type(32)));
typedef __bf16 bf16x2_t __attribute__((ext_vector_type(2)));
__device__ __forceinline__ float gelu1(float v) {
    const float av = fabsf(v), t = __builtin_amdgcn_rcpf(av * 0.2316418882f + 1.0f);
    float q = t * 0.5307027145f + (-0.7265760135f); q = q * t + 0.7107068705f; q = q * t + (-0.142248368f); q = q * t + 0.127414796f; q = q * t;
    const float e = __builtin_amdgcn_exp2f((v * v) * (-0.72134752044f));
    const float m = v * (q * e);
    return v < 0.f ? m : v - m;
}

__device__ __forceinline__ float dot32(const float* hf, const v4u& r) {
    float s0 = 0.f, s1 = 0.f;
#define D8(W, T) { const f32x2 a_ = __builtin_amdgcn_cvt_scalef32_pk_f32_fp4((W), 1.0f, 0), b_ = __builtin_amdgcn_cvt_scalef32_pk_f32_fp4((W), 1.0f, 1), \
                               c_ = __builtin_amdgcn_cvt_scalef32_pk_f32_fp4((W), 1.0f, 2), d_ = __builtin_amdgcn_cvt_scalef32_pk_f32_fp4((W), 1.0f, 3); \
                   s0 += hf[T] * a_.x; s1 += hf[T + 1] * a_.y; s0 += hf[T + 2] * b_.x; s1 += hf[T + 3] * b_.y; s0 += hf[T + 4] * c_.x; s1 += hf[T + 5] * c_.y; s0 += hf[T + 6] * d_.x; s1 += hf[T + 7] * d_.y; }
    D8(r.x, 0) D8(r.y, 8) D8(r.z, 16) D8(r.w, 24)
#undef D8
    return s0 + s1;
}
__device__ __forceinline__ void axpy32(float* acc, float w, const v4u& r) {
#define A8(W, T) { const f32x2 a_ = __builtin_amdgcn_cvt_scalef32_pk_f32_fp4((W), 1.0f, 0), b_ = __builtin_amdgcn_cvt_scalef32_pk_f32_fp4((W), 1.0f, 1), \
                               c_ = __builtin_amdgcn_cvt_scalef32_pk_f32_fp4((W), 1.0f, 2), d_ = __builtin_amdgcn_cvt_scalef32_pk_f32_fp4((W), 1.0f, 3); \
                   acc[T] += w * a_.x; acc[T + 1] += w * a_.y; acc[T + 2] += w * b_.x; acc[T + 3] += w * b_.y; acc[T + 4] += w * c_.x; acc[T + 5] += w * c_.y; acc[T + 6] += w * d_.x; acc[T + 7] += w * d_.y; }
    A8(r.x, 0) A8(r.y, 8) A8(r.z, 16) A8(r.w, 24)
#undef A8
}
__device__ __forceinline__ void p10a_udots(Frame& F) {
    typedef int i32x8 __attribute__((ext_vector_type(8)));
    typedef float f32x16 __attribute__((ext_vector_type(16)));
    const bf16* H2N = (const bf16*)(F.ws + WS_H2N); const int* IDX = (const int*)(F.ws + WS_IDX);
    const unsigned char* EU = F.ws + WS_EU; float* PART = (float*)(F.ws + WS_PART);
    LAS unsigned char* wl = F.lds + F.wave * 6144;
    const int l8 = F.lane >> 3, p8 = F.lane & 7;
    const int r32 = F.lane & 31, half = F.lane >> 5;
    int t0, tend, tstep;
    if (F.G % 8 == 0) { const int per = F.G / 8, x = F.vcu / per; t0 = x * MREAL + (F.vcu % per) * NWAVES + F.wave; tend = (x + 1) * MREAL; tstep = per * NWAVES; }
    else { t0 = F.gw; tend = 8 * MREAL; tstep = F.NGW; }
    int zv = 0; asm volatile("" : "+v"(zv));
    const float* RS = (const float*)(F.ws + WS_RS) + zv;
#define PA_CL(T) ((T) < tlast ? (T) : tlast)
#define PA_IDX(I, T) do { const int tk_ = (T) & (MREAL - 1); const GAS v4u* ip_ = (const GAS v4u*)(IDX + (size_t)tk_ * 128 + l8 * 16);     \
        _Pragma("unroll") for (int c_ = 0; c_ < 4; ++c_) { const v4u v_ = ip_[c_]; I[4 * c_] = (int)v_.x; I[4 * c_ + 1] = (int)v_.y; I[4 * c_ + 2] = (int)v_.z; I[4 * c_ + 3] = (int)v_.w; } } while (0)
#define PA_LN(A, I, RB, T) do { const int xs_ = (T) >> 13; _Pragma("unroll") for (int g_ = 0; g_ < 4; ++g_) A[RB][g_] = *(const GAS v4u*)(EU + (size_t)xs_ * ((size_t)NEXP * 128) + (size_t)(unsigned)I[4 * (RB) + g_] * 128 + p8 * 16); } while (0)
#define PA_H(HW, RSV, T) do { const int tk_ = (T) & (MREAL - 1), xs_ = (T) >> 13; HW = *(const GAS unsigned long long*)(H2N + (size_t)tk_ * DM + xs_ * 256 + 4 * F.lane); RSV = RS[tk_]; } while (0)
#define PA_W(AC, RB) do { _Pragma("unroll") for (int g_ = 0; g_ < 4; ++g_) *(LAS v4u*)(wl + 1536 + (8 * g_ + l8) * 144 + p8 * 16) = AC[RB][g_]; asm volatile("" ::: "memory"); } while (0)
#define PA_R(AR) do { _Pragma("unroll") for (int s_ = 0; s_ < 4; ++s_) AR[s_] = *(const LAS v4u*)(wl + 1536 + r32 * 144 + half * 64 + s_ * 16); asm volatile("" ::: "memory"); } while (0)
#define PA_M(AR, ACC) do { _Pragma("unroll") for (int i_ = 0; i_ < 16; ++i_) ACC[i_] = 0.f; \
        _Pragma("unroll") for (int s_ = 0; s_ < 4; ++s_) { const i32x8 a_ = (i32x8){(int)AR[s_].x, (int)AR[s_].y, (int)AR[s_].z, (int)AR[s_].w, 0, 0, 0, 0}; \
            ACC = __builtin_amdgcn_mfma_scale_f32_32x32x64_f8f6f4(a_, B_[s_], ACC, 4, 0, 0, 0x7F7F7F7F, 0, 0x7F7F7F7F); } \
        asm volatile("" : "+v"(ACC)); } while (0)
#define PA_D(RB, ACC) do { if (r32 < 2) { LAS f32x4* dp_ = (LAS f32x4*)(wl + 512 + r32 * 512 + ((RB) * 32 + 4 * half) * 4); \
        _Pragma("unroll") for (int g_ = 0; g_ < 4; ++g_) dp_[2 * g_] = (f32x4){ACC[4 * g_], ACC[4 * g_ + 1], ACC[4 * g_ + 2], ACC[4 * g_ + 3]}; } } while (0)
#define PA_SB() __builtin_amdgcn_sched_barrier(0)
#define PA_TASK(AC, AN, I1, I2, HWC, RSC, HWN, RSN, T) do { \
        const int tn_ = PA_CL((T) + tstep), tn2_ = PA_CL((T) + 2 * tstep); \
        PA_H(HWN, RSN, tn_); PA_IDX(I2, tn2_); \
        {   const float x0 = bflo((unsigned)HWC) * RSC, x1 = bfhi((unsigned)HWC) * RSC, x2 = bflo((unsigned)(HWC >> 32)) * RSC, x3 = bfhi((unsigned)(HWC >> 32)) * RSC; \
            int hi_ = 0; hi_ = __builtin_amdgcn_cvt_pk_fp8_f32(x0, x1, hi_, false); hi_ = __builtin_amdgcn_cvt_pk_fp8_f32(x2, x3, hi_, true); \
            const f32x2 b0_ = __builtin_amdgcn_cvt_pk_f32_fp8(hi_, false), b1_ = __builtin_amdgcn_cvt_pk_f32_fp8(hi_, true); \
            int lo_ = 0; lo_ = __builtin_amdgcn_cvt_pk_fp8_f32((x0 - b0_.x) * 16.f, (x1 - b0_.y) * 16.f, lo_, false); lo_ = __builtin_amdgcn_cvt_pk_fp8_f32((x2 - b1_.x) * 16.f, (x3 - b1_.y) * 16.f, lo_, true); \
              \
            LAS int* bp_ = (LAS int*)(wl + ((((F.lane >> 2) & 1) * 4 + ((F.lane >> 3) & 3)) * 64 + (F.lane >> 5) * 16 + 4 * (F.lane & 3))); bp_[0] = hi_; bp_[8] = lo_; } \
        asm volatile("" ::: "memory"); \
        i32x8 B_[4]; \
        _Pragma("unroll") for (int s_ = 0; s_ < 4; ++s_) { const LAS v4u* q_ = (const LAS v4u*)(wl + (half * 4 + s_) * 64 + (r32 & 1) * 32); const v4u c0_ = q_[0], c1_ = q_[1]; \
            B_[s_] = (i32x8){(int)c0_.x, (int)c0_.y, (int)c0_.z, (int)c0_.w, (int)c1_.x, (int)c1_.y, (int)c1_.z, (int)c1_.w}; } \
        asm volatile("" ::: "memory"); \
        v4u ar0_[4], ar1_[4]; f32x16 ac0_, ac1_; \
        PA_LN(AN, I1, 0, tn_); PA_W(AC, 0); PA_R(ar0_); PA_SB(); \
        PA_LN(AN, I1, 1, tn_); PA_W(AC, 1); PA_R(ar1_); PA_SB(); \
        PA_M(ar0_, ac0_); PA_SB(); \
        PA_LN(AN, I1, 2, tn_); PA_W(AC, 2); PA_R(ar0_); PA_SB(); \
        PA_M(ar1_, ac1_); PA_SB(); \
        PA_D(0, ac0_); PA_SB(); \
        PA_LN(AN, I1, 3, tn_); PA_W(AC, 3); PA_R(ar1_); PA_SB(); \
        PA_M(ar0_, ac0_); PA_SB(); \
        PA_D(1, ac1_); PA_SB(); \
        PA_M(ar1_, ac1_); PA_SB(); \
        PA_D(2, ac0_); PA_D(3, ac1_); \
        asm volatile("" ::: "memory"); \
        {   const LAS f32x2* rp_ = (const LAS f32x2*)(wl + 512) + F.lane; const f32x2 h_ = rp_[0], l_ = rp_[64]; \
            *(GAS f32x2*)(PART + ((size_t)((T) >> 13) * MREAL + ((T) & (MREAL - 1))) * 128 + 2 * F.lane) = (f32x2){h_.x + l_.x * 0.0625f, h_.y + l_.y * 0.0625f}; } \
        asm volatile("" ::: "memory"); \
    } while (0)
    if (t0 < tend) {
        const int tlast = t0 + ((tend - 1 - t0) / tstep) * tstep;
        v4u A0[4][4], A1[4][4]; int I0[16], I1[16]; unsigned long long HW0, HW1; float RS0, RS1;
        PA_IDX(I0, t0); PA_H(HW0, RS0, t0);
        { const int t1_ = PA_CL(t0 + tstep); PA_IDX(I1, t1_); }
        PA_LN(A0, I0, 0, t0); PA_LN(A0, I0, 1, t0); PA_LN(A0, I0, 2, t0); PA_LN(A0, I0, 3, t0);
#pragma unroll 1
        for (int t = t0; t < tend; t += 2 * tstep) {
            PA_TASK(A0, A1, I1, I0, HW0, RS0, HW1, RS1, t);
            { const int tb_ = PA_CL(t + tstep); PA_TASK(A1, A0, I0, I1, HW1, RS1, HW0, RS0, tb_); }
        }
    }
#undef PA_LN
#undef PA_W
#undef PA_R
#undef PA_M
#undef PA_D
#undef PA_SB
#undef PA_CL
#undef PA_IDX
#undef PA_H
#undef PA_TASK
}

__device__ __forceinline__ void p10_experts(Frame& F, float* dst) {
    const int* IDX = (const int*)(F.ws + WS_IDX); const float* GATE = (const float*)(F.ws + WS_GATE);
    const unsigned char* EV = F.ws + WS_EV; const float* PART = (const float*)(F.ws + WS_PART);
    const float* SU = (const float*)(F.ws + WS_SU); const float* SV = (const float*)(F.ws + WS_SV);
    for (int tok = F.gw; tok < MREAL; tok += F.NGW) {
        const int e0 = IDX[(size_t)tok * 128 + F.lane], e1 = IDX[(size_t)tok * 128 + 64 + F.lane];
        float d0 = 0.f, d1 = 0.f;
        const int pk = ((F.lane >> 2) & 3) * 32 + 8 * (F.lane & 3) + (F.lane >> 4);
#pragma unroll
        for (int x = 0; x < 8; ++x) { const float* pp = PART + ((size_t)x * MREAL + tok) * 128; d0 += pp[pk]; d1 += pp[pk + 4]; }
        const float w0 = GATE[(size_t)tok * 128 + F.lane] * SV[e0] * gelu1(d0 * SU[e0]), w1 = GATE[(size_t)tok * 128 + 64 + F.lane] * SV[e1] * gelu1(d1 * SU[e1]);
        float acc[32];
#pragma unroll
        for (int i = 0; i < 32; ++i) acc[i] = 0.f;
#define EIDX(k) __builtin_amdgcn_readlane((k) < 64 ? e0 : e1, (k) & 63)
#define WK(k) __int_as_float(__builtin_amdgcn_readlane(__float_as_int((k) < 64 ? w0 : w1), (k) & 63))
#define LOADV(R, k0) do { _Pragma("unroll") for (int i_ = 0; i_ < 4; ++i_) R[i_] = *(const GAS v4u*)(EV + (size_t)EIDX((k0) + i_) * 1024 + 16 * F.lane); } while (0)
        v4u Va[4], Vb[4];
        LOADV(Va, 0);
#pragma unroll 1
        for (int b = 0; b < 32; b += 2) {
            const int k0 = 4 * b;
            LOADV(Vb, k0 + 4);
            __builtin_amdgcn_sched_barrier(0);
#pragma unroll
            for (int i = 0; i < 4; ++i) { axpy32(acc, WK(k0 + i), Va[i]); __builtin_amdgcn_sched_barrier(0); }
            if (b + 2 < 32) LOADV(Va, k0 + 8);
            __builtin_amdgcn_sched_barrier(0);
#pragma unroll
            for (int i = 0; i < 4; ++i) { axpy32(acc, WK(k0 + 4 + i), Vb[i]); __builtin_amdgcn_sched_barrier(0); }
        }
#undef EIDX
#undef WK
#undef LOADV
        { GAS f32x4* op = (GAS f32x4*)(F.out + (size_t)tok * DM) + F.lane; GAS f32x4* dp = (GAS f32x4*)(dst + (size_t)tok * DM) + F.lane;
#pragma unroll
          for (int j = 0; j < 8; ++j) { f32x4 a = op[64 * j];
              a[0] += acc[4 * j]; a[1] += acc[4 * j + 1]; a[2] += acc[4 * j + 2]; a[3] += acc[4 * j + 3]; dp[64 * j] = a; } }
    }
}
struct Args { const float* in[23]; float* out; unsigned char* ws; int ph_lo, ph_hi, li, pad; };
__global__ void __launch_bounds__(NWAVES * 64, 2) mega_fwd(Args args) {
    extern __shared__ __attribute__((aligned(16))) unsigned char lds[];
    Frame F;
    F.lds = (LAS unsigned char*)lds;
    F.MISC = (volatile LAS unsigned*)(F.lds + MISC_OFF);
    F.tid = threadIdx.x; F.lane = F.tid & 63; F.wave = __builtin_amdgcn_readfirstlane(F.tid >> 6);
    F.G = gridDim.x; { const int bx = blockIdx.x; F.vcu = (F.G % 8 == 0) ? (bx % 8) * (F.G / 8) + bx / 8 : bx; }
    F.gw = F.vcu * NWAVES + F.wave; F.NGW = F.G * NWAVES;
#pragma unroll
    for (int i = 0; i < 23; ++i) F.in[i] = args.in[i];
    F.out = args.out; F.ws = args.ws;
    F.ctl = (gu32*)(args.ws + WS_CTL);
    for (int u = F.tid; u < (LDS_BYTES - LDSCTL_OFF) / 4; u += NWAVES * 64) ((LAS unsigned*)(F.lds + LDSCTL_OFF))[u] = 0u;
    __syncthreads();
    XcdBarrier bar; bar.bar = (unsigned*)(F.ctl + CW_BAR); bar.x = 0; bar.st = nullptr;
    if (N_LAUNCHES == 1) bar = xcd_barrier_post((unsigned*)(F.ctl + CW_BAR), F.MISC + 8);
#define GRID_BAR(seam) do { if (N_LAUNCHES != 1) { if (F.tid == 0) __hip_atomic_store(F.ctl + CW_TMO, 0xBADBA0u | (unsigned)(seam), RLX_AGENT); } else { xcd_barrier(bar); } } while (0)
    const int lo = args.ph_lo, hi = args.ph_hi;
#ifndef PH_MASK
#define PH_MASK 0x7ff
#endif
#define IN(k) ((((PH_MASK) >> (k)) & 1) && lo <= (k) && (k) < hi)
#define BOTH(k) (IN(k) && IN((k) + (((k) == 6 || (k) == 1) ? 2 : 1)))
#ifndef PH_REP_MASK
#define PH_REP_MASK 0
#endif
#define REPEAT(k) for (int rep_ = 0; rep_ < ((((PH_REP_MASK) >> (k)) & 1) ? 2 : 1); ++rep_)
    unsigned char* ws = args.ws;
    typedef pg8::bf16_t pb;
    if (IN(0)) { REPEAT(0) { p0_prologue(F); __syncthreads(); } if (BOTH(0)) GRID_BAR(0); }
    if (IN(1)) { REPEAT(1) {
        pg8::Gemm g{(const pb*)(ws + WS_XN), (const pb*)(ws + WS_WIN), M1, N1, DM, DM}; pg8::StaticOrder S; S.init(M1, N1, F.G, (int)blockIdx.x);
        Epi1 E{ws, (LAS float*)(F.lds + RING_BYTES), F.in[I_DKG], F.in[I_FKG]};
        pg8::gemm_phase<Epi1, pg8::StaticOrder, true, PG8_SP2>(F.lds + RING_OFF, g, S, E); }
        p1_tail(F);
        if (BOTH(1)) GRID_BAR(1);
    }
    if (IN(3)) { p3_attention<0>(F, (char*)lds + RING_OFF);
#if (PH_REP_MASK >> 3) & 1
        p3_attention<ATT_ABL>(F, (char*)lds + RING_OFF);
#endif
        if (BOTH(3)) GRID_BAR(3); }
    if (IN(4)) { REPEAT(4) { p4_combine(F); } if (BOTH(4)) GRID_BAR(4);
#if (PH_REP_MASK >> 11) & 1
        for (int xb_ = 0; xb_ < 10; ++xb_) GRID_BAR(4);
#endif
    }
    if (IN(5)) {
        { pg8::Gemm g{(const pb*)(ws + WS_OD), (const pb*)(ws + WS_WBD), MREAL, DM, 1024, 1024}; pg8::StaticOrder S; S.init(MREAL, DM, F.G, (int)blockIdx.x);
          pg8::EpiGen<F_Gemm2a> E{F_Gemm2a{(const bf16*)(ws + WS_GA), F.in[I_BGATE], (bf16*)(ws + WS_MG)}};
          pg8::gemm_phase<pg8::EpiGen<F_Gemm2a>, pg8::StaticOrder, PG8_ALIGN, PG8_SP2>(F.lds + RING_OFF, g, S, E); }
        { pg8::Gemm g{(const pb*)(ws + WS_OF), (const pb*)(ws + WS_WBF), MREAL, DM, 1024, 1024}; pg8::StaticOrder S; S.init(MREAL, DM, F.G, (int)blockIdx.x);
          pg8::EpiGen<F_Gemm2b> E{F_Gemm2b{(const bf16*)(ws + WS_GB), F.in[I_BGATE] + DM, (bf16*)(ws + WS_MG)}};
          pg8::gemm_phase<pg8::EpiGen<F_Gemm2b>, pg8::StaticOrder, PG8_ALIGN, PG8_SP2>(F.lds + RING_OFF, g, S, E); }
#if (PH_REP_MASK >> 5) & 1
        { pg8::Gemm g{(const pb*)(ws + WS_OD), (const pb*)(ws + WS_WBD), MREAL, DM, 1024, 1024}; pg8::StaticOrder S; S.init(MREAL, DM, F.G, (int)blockIdx.x);
          pg8::EpiGen<F_Gemm2a> E{F_Gemm2a{(const bf16*)(ws + WS_GA), F.in[I_BGATE], (bf16*)(ws + WS_MG)}};
          pg8::gemm_phase<pg8::EpiGen<F_Gemm2a>, pg8::StaticOrder, PG8_ALIGN, PG8_SP2>(F.lds + RING_OFF, g, S, E); }
        { pg8::Gemm g{(const pb*)(ws + WS_OF), (const pb*)(ws + WS_WBF), MREAL, DM, 1024, 1024}; pg8::StaticOrder S; S.init(MREAL, DM, F.G, (int)blockIdx.x);
          pg8::EpiGen<F_Gemm2b> E{F_Gemm2b{(const bf16*)(ws + WS_GB), F.in[I_BGATE] + DM, (bf16*)(ws + WS_MG)}};
          pg8::gemm_phase<pg8::EpiGen<F_Gemm2b>, pg8::StaticOrder, PG8_ALIGN, PG8_SP2>(F.lds + RING_OFF, g, S, E); }
#endif
        if (BOTH(5)) GRID_BAR(5);
    }
    if (IN(6)) {
        {
        pg8::Gemm g{(const pb*)(ws + WS_MG), (const pb*)(ws + WS_WOUT), MREAL, DM, DM, DM}; pg8::StaticOrder S; S.init(MREAL, DM, F.G, (int)blockIdx.x);
        pg8::EpiGen<F_Gemm3> E{F_Gemm3{F.in[I_X], F.out, F.in[I_GPEER], (bf16*)(ws + WS_H2N), (float*)(ws + WS_SSQ), 0.f}};
        pg8::gemm_phase<pg8::EpiGen<F_Gemm3>, pg8::StaticOrder, PG8_ALIGN, PG8_SP2>(F.lds + RING_OFF, g, S, E);
        }
#if (PH_REP_MASK >> 6) & 1
        {
        pg8::Gemm g{(const pb*)(ws + WS_MG), (const pb*)(ws + WS_WOUT), MREAL, DM, DM, DM}; pg8::StaticOrder S; S.init(MREAL, DM, F.G, (int)blockIdx.x);
        pg8::EpiGen<F_Gemm3> E{F_Gemm3{F.in[I_X], F.out, F.in[I_GPEER], (bf16*)(ws + WS_H2N), (float*)(ws + WS_SSQ), 0.f}};
        pg8::gemm_phase<pg8::EpiGen<F_Gemm3>, pg8::StaticOrder, PG8_ALIGN, PG8_SP2>(F.lds + RING_OFF, g, S, E);
        }
#endif
        if (BOTH(6)) GRID_BAR(6);
    }
    if (IN(8)) {
        {
        pg8::Gemm g{(const pb*)(ws + WS_H2N), (const pb*)(ws + WS_WPQ), MREAL, 1024, 1024, DM}; SplitK2Order S; S.init(MREAL, 1024, F.G, (int)blockIdx.x);
        pg8::EpiGen<F_Gemm4> E{F_Gemm4{(float*)(ws + WS_QP)}};
        pg8::gemm_phase<pg8::EpiGen<F_Gemm4>, SplitK2Order, PG8_ALIGN, PG8_SP2>(F.lds + RING_OFF, g, S, E);
        }
#if (PH_REP_MASK >> 8) & 1
        {
        pg8::Gemm g{(const pb*)(ws + WS_H2N), (const pb*)(ws + WS_WPQ), MREAL, 1024, 1024, DM}; SplitK2Order S; S.init(MREAL, 1024, F.G, (int)blockIdx.x);
        pg8::EpiGen<F_Gemm4> E{F_Gemm4{(float*)(ws + WS_QP)}};
        pg8::gemm_phase<pg8::EpiGen<F_Gemm4>, SplitK2Order, PG8_ALIGN, PG8_SP2>(F.lds + RING_OFF, g, S, E);
        }
#endif
        if (BOTH(8)) GRID_BAR(8);
    }
    if (IN(9)) { REPEAT(9) { p9_route(F); } if (BOTH(9)) GRID_BAR(9); }
    if (IN(10)) { for (int rp_ = 0; rp_ < ((((PH_REP_MASK) >> 12) & 1) ? 2 : 1); ++rp_) p10a_udots(F); GRID_BAR(10); REPEAT(10) { p10_experts(F, (rep_ == 0 && ((PH_REP_MASK >> 10) & 1)) ? (float*)(ws + WS_T) : F.out); } }
#undef IN
#undef BOTH
}

extern "C" void kernel_launch(void* const* d_in, const int* in_sizes, int n_in, void* d_out, int out_size, void* d_ws, size_t ws_size, hipStream_t stream) {
    static int grid = 0;
    if (grid == 0) {
        if (n_in != 23 || in_sizes[0] != MREAL * DM || out_size != MREAL * DM || ws_size < WS_END) {
            fprintf(stderr, "kernel_launch: built for 23 inputs, x/out of %d floats, >= %zu bytes of workspace; got n_in %d, in0 %d, out %d, ws %zu; nothing launched\n", MREAL * DM, (size_t)WS_END, n_in, n_in > 0 ? in_sizes[0] : -1, out_size, ws_size); grid = -1; return; }
        int dev = 0, cus = 0, per_cu = 0;
        if (hipGetDevice(&dev) != hipSuccess || hipDeviceGetAttribute(&cus, hipDeviceAttributeMultiprocessorCount, dev) != hipSuccess) { fprintf(stderr, "kernel_launch: device query failed\n"); grid = -1; return; }
        if (hipFuncSetAttribute((const void*)mega_fwd, hipFuncAttributeMaxDynamicSharedMemorySize, LDS_BYTES) != hipSuccess) { fprintf(stderr, "kernel_launch: hipFuncSetAttribute failed\n"); grid = -1; return; }
        if (hipOccupancyMaxActiveBlocksPerMultiprocessor(&per_cu, (const void*)mega_fwd, NWAVES * 64, LDS_BYTES) != hipSuccess || per_cu < 1) {
            fprintf(stderr, "kernel_launch: occupancy query reports %d workgroups per CU; nothing launched\n", per_cu); (void)hipGetLastError(); grid = -1; return; }
        grid = cus;
    }
    if (grid < 0) return;
    if (hipMemsetAsync((char*)d_ws + WS_CTL, 0, CTL_ZERO_BYTES, stream) != hipSuccess) { fprintf(stderr, "kernel_launch: hipMemsetAsync failed\n"); return; }
    Args a{};
    for (int i = 0; i < 23; ++i) a.in[i] = (const float*)d_in[i];
    a.out = (float*)d_out; a.ws = (unsigned char*)d_ws;
    for (int li = 0; li < N_LAUNCHES; ++li) {
        a.ph_lo = (N_LAUNCHES == 1) ? 0 : li; a.ph_hi = (N_LAUNCHES == 1) ? N_PHASES : li + 1; a.li = li;
        hipLaunchKernelGGL(mega_fwd, dim3(grid), dim3(NWAVES * 64), LDS_BYTES, stream, a);
        const hipError_t le = hipPeekAtLastError();
        if (le != hipSuccess) { fprintf(stderr, "kernel_launch: launch %d failed: %s\n", li, hipGetErrorName(le)); break; }
    }
}
```

```cpp
#include <hip/hip_runtime.h>
#include <cstdio>
#include <cstdint>
#include <cmath>
#define PH_REP_MASK 0x0
#define ATT_ABL 0
namespace pg8 {
#define PG8_LAS __attribute__((address_space(3)))
typedef unsigned short bf16_t;
typedef short bf16x8 __attribute__((ext_vector_type(8)));
typedef float f32x4 __attribute__((ext_vector_type(4)));
typedef unsigned u32x4 __attribute__((ext_vector_type(4)));
constexpr int BM = 256, BK = 64, HALF = 128, HTB = HALF * BK * 2  , STAGE_BYTES = 8 * HTB, NXCD = 8, WGM = 8;

__host__ __device__ __forceinline__ int lds_byte(int r, int c) { const int st = (r >> 4) * 2 + (c >> 5), rr = r & 15, cc = c & 31, ob = rr * 64 + cc * 2; return st * 1024 + (ob ^ (((ob >> 9) & 1) << 5)); }
__host__ __device__ __forceinline__ void stage_rc(int b, int& R, int& C) { const int st = b / 1024, sb = b % 1024, swz = sb ^ (((sb >> 9) & 1) << 5); R = (st >> 1) * 16 + swz / 64; C = (st & 1) * 32 + (swz % 64) / 2; }
__host__ __device__ __forceinline__ int perm32(int rho) { const int n = rho >> 4, i = rho & 15; return 8 * (i >> 2) + 4 * n + (i & 3); }

struct Unit { int pm, pn, ko, kob, chain; };
struct Gemm { const bf16_t* A; const bf16_t* Bt; int M, N, K, ld; };

struct StaticOrder {
    int nM, nN, nwg, G, c;
    __host__ __device__ void init(int M, int N, int G_, int c_) { nM = M / BM; nN = N / BM; nwg = nM * nN; G = G_; c = c_; }
    __host__ __device__ bool next(int i, Unit& u) const {
        const long L = (long)i * G + c; if (L >= nwg) return false;
        int wgid = (int)L; { const int q = nwg / NXCD, r = nwg % NXCD, xcd = wgid % NXCD, off = wgid / NXCD; wgid = (xcd < r ? xcd * (q + 1) : r * (q + 1) + (xcd - r) * q) + off; }
        const int nig = WGM * nN, gid = wgid / nig, fm = gid * WGM, gsz = (nM - fm) < WGM ? (nM - fm) : WGM;
        u.pm = fm + ((wgid % nig) % gsz); u.pn = (wgid % nig) / gsz; u.ko = 0; u.kob = 0; u.chain = 0; return true;
    }
    __device__ __forceinline__ void a_ready(const Unit&) const {}
    __device__ __forceinline__ void done(const Unit&) const {}
};
__device__ __forceinline__ unsigned cvt_pk_bf16(float lo, float hi) { unsigned r; asm volatile("v_cvt_pk_bf16_f32 %0, %1, %2" : "=v"(r) : "v"(lo), "v"(hi)); return r; }
typedef float f32x2 __attribute__((ext_vector_type(2)));
template <class F> struct EpiGen {
    static constexpr bool PERM = true, AFTER_DRAIN = false, HOSTS = false;
    F f;
    __device__ __forceinline__ void operator()(const f32x4 (&acc)[2][2][4][2], const Unit& u, int wr, int wc, int fr, int fq) const {
        F g = f; if (!g.begin(u)) return;
        asm volatile("" : "+v"(fr), "+v"(fq));
#pragma unroll
        for (int ai = 0; ai < 2; ++ai)
#pragma unroll
            for (int m = 0; m < 4; ++m) { const int rt = ai * HALF + wr * 64 + m * 16 + fr; g.row_begin();
#pragma unroll
                for (int bj = 0; bj < 2; ++bj) g.chunk(u, rt, bj * HALF + wc * 32 + 8 * fq, acc[ai][bj][m][0], acc[ai][bj][m][1]);
                g.row_end(u, rt, wc, fq); }
    }
    __device__ __forceinline__ void scale(f32x4 (&acc)[2][2][4][2], const Unit& u, int wr, int wc, int fr, int fq) const {
        F g = f;
        asm volatile("" : "+v"(fr), "+v"(fq));
#pragma unroll
        for (int ai = 0; ai < 2; ++ai)
#pragma unroll
            for (int m = 0; m < 4; ++m) { const int rt = ai * HALF + wr * 64 + m * 16 + fr;
#pragma unroll
                for (int bj = 0; bj < 2; ++bj) g.scale_chunk(u, rt, bj * HALF + wc * 32 + 8 * fq, acc[ai][bj][m][0], acc[ai][bj][m][1]);
                asm volatile("" ::: "memory"); __builtin_amdgcn_sched_barrier(0); }
    }
};
template <class Epi, class Sched, bool ALIGN_EPI = false, bool SP2 = false>
__device__ __forceinline__ void gemm_phase(PG8_LAS unsigned char* lds, const Gemm g, const Sched& S, const Epi& E) {
    const int tid = threadIdx.x, wid = __builtin_amdgcn_readfirstlane(tid >> 6), lane = tid & 63, wr = wid >> 2, wc = wid & 3, fr = lane & 15, fq = lane >> 4;
    const int K = g.K, nt = K / BK, LD = g.ld;
    unsigned voffA[2], voffB[2];
#pragma unroll
    for (int i = 0; i < 2; ++i) { int R, C; stage_rc(tid * 16 + i * 8192, R, C); const int Rb = Epi::PERM ? ((R & ~31) + perm32(R & 31)) : R;
        voffA[i] = (unsigned)(R * LD + C) * 2u; voffB[i] = (unsigned)(Rb * LD + C) * 2u; }
    const size_t kstep = (size_t)(BK * 2);
    const size_t hstep = (size_t)HALF * LD * 2;
    const size_t tstep = 2 * hstep;
    const unsigned ldsw = (unsigned)wid * 1024u;
    const int aoff = lds_byte(wr * 64 + fr, fq * 8), boff = lds_byte(wc * 32 + fr, fq * 8);
#define PG8_SA(b, h) (((b) * 2 + (h)) * HTB)
#define PG8_SB(b, h) ((4 + (b) * 2 + (h)) * HTB)
#define PG8_STAGE(bufoff, gbase, voff) do { _Pragma("unroll") for (int _i = 0; _i < 2; ++_i) \
        __builtin_amdgcn_global_load_lds((const unsigned*)((const char*)(gbase) + (voff)[_i]), (PG8_LAS unsigned*)(lds + (bufoff) + ldsw + _i * 8192), 16, 0, 0); } while (0)
#define PG8_LDA(dst, b, h) do { _Pragma("unroll") for (int m = 0; m < 4; ++m) _Pragma("unroll") for (int k = 0; k < 2; ++k) dst[m][k] = *(const PG8_LAS bf16x8*)(lds + PG8_SA(b, h) + aoff + m * 2048 + k * 1024); } while (0)
#define PG8_LDB(dst, b, h) do { _Pragma("unroll") for (int n = 0; n < 2; ++n) _Pragma("unroll") for (int k = 0; k < 2; ++k) dst[n][k] = *(const PG8_LAS bf16x8*)(lds + PG8_SB(b, h) + boff + n * 2048 + k * 1024); } while (0)
#define PG8_MMA(ai, bj, At, Bt) do { __builtin_amdgcn_s_setprio(1); _Pragma("unroll") for (int m = 0; m < 4; ++m) _Pragma("unroll") for (int n = 0; n < 2; ++n) _Pragma("unroll") for (int k = 0; k < 2; ++k) \
        acc[ai][bj][m][n] = __builtin_amdgcn_mfma_f32_16x16x32_bf16(Bt[n][k], At[m][k], acc[ai][bj][m][n], 0, 0, 0); __builtin_amdgcn_s_setprio(0); } while (0)
#define PG8_WAIT_V(n) asm volatile("s_waitcnt vmcnt(" #n ")" ::: "memory")
#define PG8_WAIT_L(n) asm volatile("s_waitcnt lgkmcnt(" #n ")" ::: "memory")
#define PG8_BAR __builtin_amdgcn_s_barrier()
#define PG8_SCHED __builtin_amdgcn_sched_barrier(0)
    Unit cur, nxt; int ui = 0;
    if (!S.next(0, cur)) return;
    f32x4 acc[2][2][4][2];
#pragma unroll
    for (int a = 0; a < 2; ++a)
#pragma unroll
        for (int b = 0; b < 2; ++b)
#pragma unroll
            for (int m = 0; m < 4; ++m)
#pragma unroll
                for (int n = 0; n < 2; ++n) acc[a][b][m][n] = (f32x4){0.f, 0.f, 0.f, 0.f};
    bf16x8 At[4][2], B0[2][2], B1[2][2];
    const char* cA = (const char*)g.A + (size_t)cur.pm * tstep + cur.ko; const char* cB = (const char*)g.Bt + (size_t)cur.pn * tstep + cur.kob;
    S.a_ready(cur);
    if constexpr (SP2) {
        PG8_STAGE(PG8_SB(0, 0), cB, voffB); PG8_STAGE(PG8_SB(0, 1), cB + hstep, voffB); PG8_STAGE(PG8_SA(0, 0), cA, voffA); PG8_STAGE(PG8_SA(0, 1), cA + hstep, voffA);
        if (wr == 1) PG8_BAR;
        PG8_WAIT_V(2); PG8_BAR;
        PG8_STAGE(PG8_SB(1, 0), cB + kstep, voffB); PG8_STAGE(PG8_SA(1, 0), cA + kstep, voffA); PG8_STAGE(PG8_SB(1, 1), cB + hstep + kstep, voffB);
        PG8_WAIT_V(6); PG8_BAR;
    } else {
        PG8_STAGE(PG8_SB(0, 0), cB, voffB); PG8_STAGE(PG8_SA(0, 0), cA, voffA); PG8_STAGE(PG8_SB(0, 1), cB + hstep, voffB); PG8_STAGE(PG8_SA(0, 1), cA + hstep, voffA);
        if (wr == 1) PG8_BAR;
        PG8_WAIT_V(4); PG8_BAR;
        PG8_STAGE(PG8_SB(1, 0), cB + kstep, voffB); PG8_STAGE(PG8_SA(1, 0), cA + kstep, voffA); PG8_STAGE(PG8_SB(1, 1), cB + hstep + kstep, voffB);
        PG8_WAIT_V(6); PG8_BAR;
    }
    for (;;) {
        const bool has_next = S.next(ui + 1, nxt);
        const char* nA = has_next ? (const char*)g.A + (size_t)nxt.pm * tstep + nxt.ko : cA; const char* nB = has_next ? (const char*)g.Bt + (size_t)nxt.pn * tstep + nxt.kob : cB;
        for (int t = 0; t < nt; t += 2) {
            const bool last = (t == nt - 2);
            const char* a1 = cA + (size_t)(t + 1) * kstep;
            const char* a2 = last ? nA : cA + (size_t)(t + 2) * kstep; const char* b2 = last ? nB : cB + (size_t)(t + 2) * kstep;
            const char* a3 = a2 + kstep; const char* b3 = b2 + kstep;
            if (last && has_next) S.a_ready(nxt);
            if constexpr (SP2) {
            PG8_LDB(B0, 0, 0); PG8_LDB(B1, 0, 1); PG8_SCHED; PG8_LDA(At, 0, 0); PG8_STAGE(PG8_SA(1, 1), a1 + hstep, voffA);
            PG8_WAIT_V(8); PG8_WAIT_L(0); PG8_BAR; PG8_MMA(0, 0, At, B0); PG8_MMA(0, 1, At, B1); PG8_BAR; PG8_SCHED;
            PG8_LDA(At, 0, 1); PG8_STAGE(PG8_SB(0, 0), b2, voffB); PG8_STAGE(PG8_SB(0, 1), b2 + hstep, voffB); PG8_STAGE(PG8_SA(0, 0), a2, voffA);
            PG8_WAIT_V(8); PG8_WAIT_L(0); PG8_BAR; PG8_MMA(1, 0, At, B0); PG8_MMA(1, 1, At, B1); PG8_BAR; PG8_SCHED;
            PG8_LDB(B0, 1, 0); PG8_LDB(B1, 1, 1); PG8_SCHED; PG8_LDA(At, 1, 0); PG8_STAGE(PG8_SA(0, 1), a2 + hstep, voffA);
            PG8_WAIT_V(8); PG8_WAIT_L(0); PG8_BAR; PG8_MMA(0, 0, At, B0); PG8_MMA(0, 1, At, B1); PG8_BAR; PG8_SCHED;
            PG8_LDA(At, 1, 1); PG8_STAGE(PG8_SB(1, 0), b3, voffB); PG8_STAGE(PG8_SB(1, 1), b3 + hstep, voffB); PG8_STAGE(PG8_SA(1, 0), a3, voffA);
            PG8_WAIT_V(8); PG8_WAIT_L(0); PG8_BAR; PG8_MMA(1, 0, At, B0); PG8_MMA(1, 1, At, B1); PG8_BAR; PG8_SCHED;
            } else {
            PG8_LDB(B0, 0, 0); PG8_SCHED; PG8_LDA(At, 0, 0); PG8_STAGE(PG8_SA(1, 1), a1 + hstep, voffA);
            PG8_WAIT_L(8); PG8_BAR; PG8_WAIT_L(0); PG8_MMA(0, 0, At, B0); PG8_BAR; PG8_SCHED;
            PG8_LDB(B1, 0, 1); PG8_STAGE(PG8_SB(0, 0), b2, voffB);
            PG8_BAR; PG8_WAIT_L(0); PG8_MMA(0, 1, At, B1); PG8_BAR;
            PG8_LDA(At, 0, 1); PG8_STAGE(PG8_SA(0, 0), a2, voffA);
            PG8_BAR; PG8_WAIT_L(0); PG8_MMA(1, 0, At, B0); PG8_BAR; PG8_SCHED;
            PG8_STAGE(PG8_SB(0, 1), b2 + hstep, voffB);
            PG8_WAIT_V(6); PG8_BAR; PG8_MMA(1, 1, At, B1); PG8_BAR;
            PG8_LDB(B0, 1, 0); PG8_SCHED; PG8_LDA(At, 1, 0); PG8_STAGE(PG8_SA(0, 1), a2 + hstep, voffA);
            PG8_WAIT_L(8); PG8_BAR; PG8_WAIT_L(0); PG8_MMA(0, 0, At, B0); PG8_BAR; PG8_SCHED;
            PG8_LDB(B1, 1, 1); PG8_STAGE(PG8_SB(1, 0), b3, voffB);
            PG8_BAR; PG8_WAIT_L(0); PG8_MMA(0, 1, At, B1); PG8_BAR;
            PG8_LDA(At, 1, 1); PG8_STAGE(PG8_SA(1, 0), a3, voffA);
            PG8_BAR; PG8_WAIT_L(0); PG8_MMA(1, 0, At, B0); PG8_BAR; PG8_SCHED;
            PG8_STAGE(PG8_SB(1, 1), b3 + hstep, voffB);
            PG8_WAIT_V(6); PG8_BAR; PG8_MMA(1, 1, At, B1); PG8_BAR;
            }
        }
        if constexpr (ALIGN_EPI) { if (wr == 0) PG8_BAR; }
        if constexpr (!Epi::AFTER_DRAIN) { if (cur.chain) E.scale(acc, cur, wr, wc, fr, fq); else E(acc, cur, wr, wc, fr, fq); S.done(cur); }
        if constexpr (Epi::HOSTS) E.host(ui, !has_next);
        if (!has_next) break;
        if (!cur.chain)
#pragma unroll
        for (int a = 0; a < 2; ++a)
#pragma unroll
            for (int b = 0; b < 2; ++b)
#pragma unroll
                for (int m = 0; m < 4; ++m)
#pragma unroll
                    for (int n = 0; n < 2; ++n) acc[a][b][m][n] = (f32x4){0.f, 0.f, 0.f, 0.f};
        cur = nxt; cA = nA; cB = nB; ++ui;
        if constexpr (ALIGN_EPI) { if (wr == 1) PG8_BAR; }
    }
    PG8_WAIT_V(0);
    if constexpr (!ALIGN_EPI) { if (wr == 0) PG8_BAR; }
    PG8_BAR;
    if constexpr (Epi::AFTER_DRAIN) { E.fused(acc, cur, wr, wc, fr, fq, lds, wid, lane); S.done(cur); }
#undef PG8_SA
#undef PG8_SB
#undef PG8_STAGE
#undef PG8_LDA
#undef PG8_LDB
#undef PG8_MMA
#undef PG8_WAIT_V
#undef PG8_WAIT_L
#undef PG8_BAR
#undef PG8_SCHED
}
}
#ifndef PG8_SP2
#define PG8_SP2 true
#endif
#ifndef PG8_ALIGN
#define PG8_ALIGN true
#endif
namespace att {
typedef unsigned short bf16;
typedef short bf16x8 __attribute__((ext_vector_type(8)));
typedef short s16x4 __attribute__((ext_vector_type(4)));
typedef float f32x16 __attribute__((ext_vector_type(16)));
typedef float f32x4 __attribute__((ext_vector_type(4)));
typedef unsigned u32x4 __attribute__((ext_vector_type(4)));
constexpr int NW = 8, QBLK = 32, KVBLK = 64, QB = NW * QBLK, D = 128, PITCH = 1024;
constexpr int SHM_V = KVBLK * D * 2, SHM_K = KVBLK * D * 2;
constexpr int NBUF = 3;
constexpr int OFF_V = 0, OFF_K = NBUF * SHM_V, OFF_WS = OFF_K + NBUF * SHM_K, OFF_B = OFF_WS + NW * 64 * 4, LDS_BYTES = OFF_B + NBUF * 256;
constexpr float THR = 8.f;
#define KSWZ(row, colB) ((row) * 256 + ((colB) ^ (((row) & 7) << 4)))
#define SBAR() __builtin_amdgcn_sched_barrier(0)
__device__ __forceinline__ int v_st(int k, int c) { const int kk = (k & ~0xC) | ((k & 4) << 1) | ((k & 8) >> 1); return ((kk >> 3) * 4 + (c >> 5)) * 512 + ((kk & 7) * 32 + (c & 31)) * 2; }
__device__ __forceinline__ int v_rd_base(int lane) { return ((lane & 3) << 3) | (((lane >> 2) & 3) << 6) | (((lane >> 4) & 1) << 5) | (((lane >> 5) & 1) << 8); }
constexpr int v_rd_off(int d0, int ks, int half) { return d0 * 512 + ks * 4096 + half * 2048; }
__device__ __forceinline__ int crow(int r, int hi) { return (r & 3) + 8 * (r >> 2) + 4 * hi; }
__device__ __forceinline__ unsigned cvtpk(float lo, float hi) {
    unsigned r; asm volatile("v_cvt_pk_bf16_f32 %0, %1, %2" : "=v"(r) : "v"(lo), "v"(hi)); return r;
}
__device__ __forceinline__ bf16x8 load8(const bf16* p) { return *reinterpret_cast<const bf16x8*>(p); }
__device__ __forceinline__ void mask_tile(f32x16& p0, f32x16& p1, int dq, unsigned W) {
    const float NEG = -__builtin_inff();
#pragma unroll
    for (int r = 0; r < 16; ++r) {
        const int c = (r & 3) + 8 * (r >> 2);
        if ((unsigned)(dq - c) >= W) p0[r] = NEG;
        if ((unsigned)(dq - c - 32) >= W) p1[r] = NEG;
    }
}
template <int DQK>
__device__ __forceinline__ void partialSM(f32x16& p0, f32x16& p1, float& m_reg, float& mn, float& alpha) {
    constexpr float SCALE = DQK == 64 ? 0.125f : 0.08838834764831845f;
    float pmax;
    { float m0 = fmaxf(p0[0], p0[4]), m1 = fmaxf(p0[1], p0[5]), m2 = fmaxf(p0[2], p0[6]), m3 = fmaxf(p0[3], p0[7]);
#pragma unroll
      for (int r = 8; r < 16; r += 4) { m0 = fmaxf(m0, p0[r]); m1 = fmaxf(m1, p0[r + 1]); m2 = fmaxf(m2, p0[r + 2]); m3 = fmaxf(m3, p0[r + 3]); }
#pragma unroll
      for (int r = 0; r < 16; r += 4) { m0 = fmaxf(m0, p1[r]); m1 = fmaxf(m1, p1[r + 1]); m2 = fmaxf(m2, p1[r + 2]); m3 = fmaxf(m3, p1[r + 3]); }
      pmax = fmaxf(fmaxf(m0, m1), fmaxf(m2, m3)); }
    { auto rr = __builtin_amdgcn_permlane32_swap(__float_as_uint(pmax), __float_as_uint(pmax), false, false);
      pmax = fmaxf(__uint_as_float(rr[0]), __uint_as_float(rr[1])); }
    constexpr float C2 = 1.4426950408889634f * SCALE;
    if (__builtin_expect(__all((pmax - m_reg) * SCALE <= THR), 1)) { mn = m_reg; alpha = 1.f; }
    else { mn = fmaxf(m_reg, pmax); alpha = __builtin_amdgcn_exp2f((m_reg - mn) * C2); m_reg = mn; }
    const float mnL = -mn * C2;
    for (int r = 0; r < 16; ++r) p0[r] = fmaf(p0[r], C2, mnL); for (int r = 0; r < 16; ++r) p1[r] = fmaf(p1[r], C2, mnL);
    for (int r = 0; r < 16; ++r) p0[r] = __builtin_amdgcn_exp2f(p0[r]);
}
__device__ __forceinline__ void finishSM(f32x16& p0, f32x16& p1, float alpha, float& l_reg, bf16x8& pa0, bf16x8& pa1, bf16x8& pa2, bf16x8& pa3) {
    for (int r = 0; r < 16; ++r) p1[r] = __builtin_amdgcn_exp2f(p1[r]);
    float ps;
    { float s0 = p0[0] + p1[0], s1 = p0[1] + p1[1], s2 = p0[2] + p1[2], s3 = p0[3] + p1[3];
#pragma unroll
      for (int r = 4; r < 16; r += 4) { s0 += p0[r]; s1 += p0[r + 1]; s2 += p0[r + 2]; s3 += p0[r + 3]; s0 += p1[r]; s1 += p1[r + 1]; s2 += p1[r + 2]; s3 += p1[r + 3]; }
      ps = (s0 + s1) + (s2 + s3); }
    { auto rr = __builtin_amdgcn_permlane32_swap(__float_as_uint(ps), __float_as_uint(ps), false, false);
      ps = __uint_as_float(rr[0]) + __uint_as_float(rr[1]); }
    l_reg = l_reg * alpha + ps;
#define PK4(P, B_, OUT) do { unsigned a0 = cvtpk(P[B_+0], P[B_+1]), a1 = cvtpk(P[B_+2], P[B_+3]);                          \
        unsigned b0 = cvtpk(P[B_+4], P[B_+5]), b1 = cvtpk(P[B_+6], P[B_+7]);                                             \
        auto r0 = __builtin_amdgcn_permlane32_swap(a0, b0, false, false); auto r1 = __builtin_amdgcn_permlane32_swap(a1, b1, false, false); \
        u32x4 w = {r0[0], r1[0], r0[1], r1[1]}; OUT = *reinterpret_cast<bf16x8*>(&w); } while (0)
    PK4(p0, 0, pa0); PK4(p0, 8, pa1); PK4(p1, 0, pa2); PK4(p1, 8, pa3);
#undef PK4
}
__device__ __forceinline__ float rowmax32(const f32x16& p0, const f32x16& p1) {
    float m0 = fmaxf(p0[0], p0[4]), m1 = fmaxf(p0[1], p0[5]), m2 = fmaxf(p0[2], p0[6]), m3 = fmaxf(p0[3], p0[7]);
#pragma unroll
    for (int r = 8; r < 16; r += 4) { m0 = fmaxf(m0, p0[r]); m1 = fmaxf(m1, p0[r + 1]); m2 = fmaxf(m2, p0[r + 2]); m3 = fmaxf(m3, p0[r + 3]); }
#pragma unroll
    for (int r = 0; r < 16; r += 4) { m0 = fmaxf(m0, p1[r]); m1 = fmaxf(m1, p1[r + 1]); m2 = fmaxf(m2, p1[r + 2]); m3 = fmaxf(m3, p1[r + 3]); }
    float pmax = fmaxf(fmaxf(m0, m1), fmaxf(m2, m3));
    auto rr = __builtin_amdgcn_permlane32_swap(__float_as_uint(pmax), __float_as_uint(pmax), false, false);
    return fmaxf(__uint_as_float(rr[0]), __uint_as_float(rr[1]));
}
__device__ __forceinline__ void partialSM_first(f32x16& p0, f32x16& p1, float& m_reg, float& alpha, f32x16& negm) {
    const float mn = fmaxf(m_reg, rowmax32(p0, p1));
    alpha = __builtin_amdgcn_exp2f(m_reg - mn); m_reg = mn;
#pragma unroll
    for (int r = 0; r < 16; ++r) { p0[r] -= mn; p1[r] -= mn; negm[r] = -mn; }
#pragma unroll
    for (int r = 0; r < 16; ++r) p0[r] = __builtin_amdgcn_exp2f(p0[r]);
}
__device__ __forceinline__ void partialSM_shift(f32x16& p0, f32x16& p1, float& m_reg, float& alpha, f32x16& negm) {
    const float pmax = rowmax32(p0, p1);
    if (__builtin_expect(__all(pmax <= THR * 1.4426950408889634f), 1)) alpha = 1.f;
    else { const float d = fmaxf(pmax, 0.f); alpha = __builtin_amdgcn_exp2f(-d); m_reg += d;
#pragma unroll
           for (int r = 0; r < 16; ++r) { p0[r] -= d; p1[r] -= d; negm[r] = -m_reg; } }
#pragma unroll
    for (int r = 0; r < 16; ++r) p0[r] = __builtin_amdgcn_exp2f(p0[r]);
}
template <int KB, int DQK>
__device__ __forceinline__ void qkt(f32x16& p0, f32x16& p1, const unsigned (&kaddr)[4], const char* B_lds, int r32, int hi, const bf16x8* qr, bool use_bias, const f32x16& cinit) {
    const char* bb = B_lds + KB * 256 + hi * 16;
    if (!use_bias) { p0 = cinit; p1 = cinit; } else
#pragma unroll
    for (int g = 0; g < 4; ++g) { const f32x4 t0 = *reinterpret_cast<const f32x4*>(bb + 32 * g), t1 = *reinterpret_cast<const f32x4*>(bb + 32 * g + 128);
        p0[4 * g] = t0[0]; p0[4 * g + 1] = t0[1]; p0[4 * g + 2] = t0[2]; p0[4 * g + 3] = t0[3];
        p1[4 * g] = t1[0]; p1[4 * g + 1] = t1[1]; p1[4 * g + 2] = t1[2]; p1[4 * g + 3] = t1[3]; }
#define KRD(dst, dd, off) asm volatile("ds_read_b128 %0, %1 offset:%2" : "=v"(dst) : "v"(kaddr[dd]), "i"(off) : "memory")
#define KGRP(S, g) do { KRD(S[0], (2 * (g)) & 3, KB * SHM_K + ((g) >> 1) * 128); KRD(S[1], (2 * (g)) & 3, KB * SHM_K + ((g) >> 1) * 128 + 32 * 256);                 \
                        KRD(S[2], (2 * (g) + 1) & 3, KB * SHM_K + ((g) >> 1) * 128); KRD(S[3], (2 * (g) + 1) & 3, KB * SHM_K + ((g) >> 1) * 128 + 32 * 256); } while (0)
#define KWAIT(N, S) do { asm volatile("s_waitcnt lgkmcnt(" #N ")" : "+v"(S[0]), "+v"(S[1]), "+v"(S[2]), "+v"(S[3]) :: "memory"); SBAR(); } while (0)
#define KMM(S, g) do { p0 = __builtin_amdgcn_mfma_f32_32x32x16_bf16(S[0], qr[2 * (g)], p0, 0, 0, 0); p1 = __builtin_amdgcn_mfma_f32_32x32x16_bf16(S[1], qr[2 * (g)], p1, 0, 0, 0);             \
                       p0 = __builtin_amdgcn_mfma_f32_32x32x16_bf16(S[2], qr[2 * (g) + 1], p0, 0, 0, 0); p1 = __builtin_amdgcn_mfma_f32_32x32x16_bf16(S[3], qr[2 * (g) + 1], p1, 0, 0, 0); SBAR(); } while (0)
    bf16x8 ka[4], kb[4];
    KGRP(ka, 0); KGRP(kb, 1);
    if constexpr (DQK == 128) {
        bf16x8 kc[4];
        KGRP(kc, 2);
        KWAIT(8, ka); KMM(ka, 0); KGRP(ka, 3);
        KWAIT(8, kb); KMM(kb, 1);
        KWAIT(4, kc); KMM(kc, 2);
        KWAIT(0, ka); KMM(ka, 3);
    } else {
        KWAIT(4, ka); KMM(ka, 0);
        KWAIT(0, kb); KMM(kb, 1);
    }
#undef KGRP
#undef KWAIT
#undef KMM
#undef KRD
}
template <int VB>
__device__ __forceinline__ void pv_tile(f32x16* o, int vb0, bf16x8 pa0, bf16x8 pa1, bf16x8 pa2, bf16x8 pa3) {
#define TRRD(dst, off) asm volatile("ds_read_b64_tr_b16 %0, %1 offset:%2" : "=&v"(dst) : "v"(vb0), "i"(off) : "memory")
#define PV_RD(S, d0) do { constexpr int b_ = VB * SHM_V + v_rd_off(d0, 0, 0);     \
        TRRD(S[0], b_); TRRD(S[1], b_ + 2048); TRRD(S[2], b_ + 4096); TRRD(S[3], b_ + 6144); TRRD(S[4], b_ + 8192); TRRD(S[5], b_ + 10240); TRRD(S[6], b_ + 12288); TRRD(S[7], b_ + 14336); } while (0)
#define PV_MM(S, d0) do {                                                                                                                   \
        o[d0] = __builtin_amdgcn_mfma_f32_32x32x16_bf16(pa0, (bf16x8){S[0][0], S[0][1], S[0][2], S[0][3], S[1][0], S[1][1], S[1][2], S[1][3]}, o[d0], 0, 0, 0);   \
        o[d0] = __builtin_amdgcn_mfma_f32_32x32x16_bf16(pa1, (bf16x8){S[2][0], S[2][1], S[2][2], S[2][3], S[3][0], S[3][1], S[3][2], S[3][3]}, o[d0], 0, 0, 0);   \
        o[d0] = __builtin_amdgcn_mfma_f32_32x32x16_bf16(pa2, (bf16x8){S[4][0], S[4][1], S[4][2], S[4][3], S[5][0], S[5][1], S[5][2], S[5][3]}, o[d0], 0, 0, 0);   \
        o[d0] = __builtin_amdgcn_mfma_f32_32x32x16_bf16(pa3, (bf16x8){S[6][0], S[6][1], S[6][2], S[6][3], S[7][0], S[7][1], S[7][2], S[7][3]}, o[d0], 0, 0, 0); } while (0)
#define PV_WAIT(N) do { asm volatile("s_waitcnt lgkmcnt(" #N ")" ::: "memory"); SBAR(); } while (0)
    s16x4 A[8], B[8];
    PV_RD(A, 0); PV_RD(B, 1);
    PV_WAIT(8); PV_MM(A, 0); SBAR();
    PV_RD(A, 2);
    PV_WAIT(8); PV_MM(B, 1); SBAR();
    PV_RD(B, 3);
    PV_WAIT(8); PV_MM(A, 2); SBAR();
    PV_WAIT(0); PV_MM(B, 3);
#undef PV_RD
#undef PV_MM
#undef PV_WAIT
#undef TRRD
}
struct BlockRef { const bf16* Q; const bf16* K; const bf16* V; const float* KB; bf16* O; int P0; int dqk; const float* qg; const float* rope; };
#define ROW(p, k0, rr) ((p) + (size_t)((k0) + (rr)) * PITCH + sc)
#define VMW() asm volatile("s_waitcnt vmcnt(0)" ::: "memory")
#define SLOAD_H(k0_) do { const int k0 = (ABL == 1) ? 0 : (k0_); st_v0 = load8(ROW(cur.V, k0, sr)); st_v1 = load8(ROW(cur.V, k0, 32 + sr));              \
                         if (sc < DQK) { st_k0 = load8(ROW(cur.K, k0, sr)); st_k1 = load8(ROW(cur.K, k0, 32 + sr)); }    \
                         if (tid < 64) st_b = cur.KB[(k0) + tid]; } while (0)
#define SWRITE_H(bf) do { *(bf16x8*)(V_lds + (bf) * SHM_V + vst0) = st_v0; *(bf16x8*)(V_lds + (bf) * SHM_V + vst1) = st_v1; \
                         if (sc < DQK) { *(bf16x8*)(K_lds + (bf) * SHM_K + kws) = st_k0; *(bf16x8*)(K_lds + (bf) * SHM_K + kws + 32 * 256) = st_k1; } \
                         if (tid < 64) *(float*)(B_lds + (bf) * 256 + tid * 4) = st_b; } while (0)
template <int DQK, int ABL>
__device__ __forceinline__ void block(const BlockRef& cur, int skv, char* lds) {
    int tid = threadIdx.x; asm volatile("" : "+v"(tid));
    const int wid = __builtin_amdgcn_readfirstlane(tid >> 6), lane = tid & 63, r32 = lane & 31, hi = lane >> 5;
    constexpr unsigned W = 1u << 30;
    int j_hi = (cur.P0 + QB - 1) / KVBLK + 1; if (j_hi > skv / KVBLK) j_hi = skv / KVBLK;
    const int NT = j_hi;
    const int qlo = cur.P0 + wid * QBLK, qm = qlo + r32 - 4 * hi;
    char* V_lds = lds + OFF_V; char* K_lds = lds + OFF_K; char* B_lds = lds + OFF_B;
    float* ws = (float*)(lds + OFF_WS) + wid * 64; float* li_l = ws, * al_l = ws + 32;
    float m_reg = -1e30f, l_reg = 0; f32x16 o[4] = {}; f32x16 negm = {};
    const int sr = tid >> 4, sc = (tid & 15) * 8, vst0 = v_st(sr, sc), vst1 = v_st(32 + sr, sc), kws = KSWZ(sr, sc * 2);
    const int vb0 = (int)(uintptr_t)V_lds + v_rd_base(lane);
    unsigned kaddr[4];
#pragma unroll
    for (int dd = 0; dd < 4; ++dd) kaddr[dd] = (unsigned)(uintptr_t)K_lds + KSWZ(r32, (dd * 16 + hi * 8) * 2);
    bf16x8 qr[DQK / 16];
    {
        float qf[DQK / 16][8]; float ss = 0.f;
#pragma unroll
        for (int d0 = 0; d0 < DQK / 16; ++d0) { const u32x4 w = __builtin_bit_cast(u32x4, load8(cur.Q + (size_t)(wid * QBLK + r32) * PITCH + d0 * 16 + hi * 8));
#pragma unroll
            for (int i = 0; i < 4; ++i) { qf[d0][2 * i] = __uint_as_float(w[i] << 16); qf[d0][2 * i + 1] = __uint_as_float(w[i] & 0xffff0000u); }
#pragma unroll
            for (int i = 0; i < 8; ++i) ss += qf[d0][i] * qf[d0][i]; }
        { auto rr = __builtin_amdgcn_permlane32_swap(__float_as_uint(ss), __float_as_uint(ss), false, false); ss = __uint_as_float(rr[0]) + __uint_as_float(rr[1]); }
        const float rn = (DQK == 64 ? 0.125f * 1.4426950408889634f : 1.f) / sqrtf(ss * (1.f / DQK) + 1e-6f);
#pragma unroll
        for (int d0 = 0; d0 < DQK / 16; ++d0) { const f32x4 g0 = *(const f32x4*)(cur.qg + d0 * 16 + hi * 8), g1 = *(const f32x4*)(cur.qg + d0 * 16 + hi * 8 + 4);
#pragma unroll
            for (int i = 0; i < 4; ++i) { qf[d0][i] *= rn * g0[i]; qf[d0][4 + i] *= rn * g1[i]; } }
        if (DQK == 64) { const float* tb = cur.rope + (size_t)(cur.P0 - 48 + wid * QBLK + r32) * 16;
#pragma unroll
            for (int i = 0; i < 8; ++i) { const float mine = qf[0][i]; auto rr = __builtin_amdgcn_permlane32_swap(__float_as_uint(mine), __float_as_uint(mine), false, false);
                const float other = __uint_as_float(hi ? rr[0] : rr[1]); const float c = tb[2 * i], sn = tb[2 * i + 1];
                qf[0][i] = hi ? (mine * c + other * sn) : (mine * c - other * sn); } }
#pragma unroll
        for (int d0 = 0; d0 < DQK / 16; ++d0) { u32x4 w = {cvtpk(qf[d0][0], qf[d0][1]), cvtpk(qf[d0][2], qf[d0][3]), cvtpk(qf[d0][4], qf[d0][5]), cvtpk(qf[d0][6], qf[d0][7])}; qr[d0] = __builtin_bit_cast(bf16x8, w); }
    }
    bf16x8 st_v0, st_v1, st_k0, st_k1; float st_b;
    SLOAD_H(0); VMW(); SWRITE_H(0);
    if (NT > 1) { SLOAD_H(KVBLK); VMW(); SWRITE_H(1); }
    __syncthreads();
    if (wid >= 4) __builtin_amdgcn_s_barrier();
#define RESC(a) do { if (__any((a) < 1.f)) { if (hi == 0) al_l[r32] = (a); asm volatile("s_waitcnt lgkmcnt(0)" ::: "memory");              \
                     for (int d_ = 0; d_ < 4; ++d_) for (int r = 0; r < 16; ++r) o[d_][r] *= al_l[crow(r, hi)]; } } while (0)
#define BAR() do { asm volatile("s_waitcnt lgkmcnt(0)" ::: "memory"); __builtin_amdgcn_s_barrier(); asm volatile("" ::: "memory"); } while (0)
#define KEEP4(a, b, c, d) asm volatile("" :: "v"(a), "v"(b), "v"(c), "v"(d))
#define TILE(t, BUF) do { f32x16 p0, p1; float mn, al; bf16x8 pa0, pa1, pa2, pa3;                                             \
        if (ABL != 6 && ABL < 7) { if ((t) + 2 < NT) { SLOAD_H(((t) + 2) * KVBLK); } }                                          \
        SBAR();                                                                                                               \
        if (ABL == 4 || ABL == 9 || ABL >= 10) { p0 = f32x16{}; p1 = f32x16{}; asm volatile("" : "+v"(p0), "+v"(p1)); }                                 \
        else qkt<BUF, DQK>(p0, p1, kaddr, B_lds, r32, hi, qr, DQK == 128 || (t) == 0, negm);     \
        { const int kb_ = (t) * KVBLK; if (kb_ + KVBLK - 1 > qlo) mask_tile(p0, p1, qm - kb_, W); }                            \
        if (ABL != 5 && ABL < 7) BAR();                                                                                        \
        if (ABL == 2 || ABL >= 7) { al = 1.f; l_reg += p0[0];                                                                  \
            { u32x4 w0 = {cvtpk(p0[0], p0[1]), cvtpk(p0[2], p0[3]), cvtpk(p0[4], p0[5]), cvtpk(p0[6], p0[7])}; pa0 = *reinterpret_cast<bf16x8*>(&w0);    \
              u32x4 w1 = {cvtpk(p0[8], p0[9]), cvtpk(p0[10], p0[11]), cvtpk(p0[12], p0[13]), cvtpk(p0[14], p0[15])}; pa1 = *reinterpret_cast<bf16x8*>(&w1); \
              u32x4 w2 = {cvtpk(p1[0], p1[1]), cvtpk(p1[2], p1[3]), cvtpk(p1[4], p1[5]), cvtpk(p1[6], p1[7])}; pa2 = *reinterpret_cast<bf16x8*>(&w2);    \
              u32x4 w3 = {cvtpk(p1[8], p1[9]), cvtpk(p1[10], p1[11]), cvtpk(p1[12], p1[13]), cvtpk(p1[14], p1[15])}; pa3 = *reinterpret_cast<bf16x8*>(&w3); } } \
        else { if constexpr (DQK == 64) { if ((t) == 0) partialSM_first(p0, p1, m_reg, al, negm); else partialSM_shift(p0, p1, m_reg, al, negm); (void)mn; } \
               else partialSM<DQK>(p0, p1, m_reg, mn, al);                                                                 \
               RESC(al);                                                                                                      \
               finishSM(p0, p1, al, l_reg, pa0, pa1, pa2, pa3); }                                                              \
        SBAR();                                                                                                               \
        if (ABL == 3 || ABL == 8 || ABL >= 10) { KEEP4(pa0, pa1, pa2, pa3); } else pv_tile<BUF>(o, vb0, pa0, pa1, pa2, pa3);                              \
        if (ABL != 6 && ABL < 7) { if ((t) + 2 < NT) { VMW(); SWRITE_H(((BUF) + 2) % 3); } }                                   \
        if (ABL != 5 && ABL < 7) BAR(); } while (0)
    for (int t = 0; t < (ABL == 11 ? 0 : NT); t += 3) {
        TILE(t, 0);
        if (t + 1 < NT) TILE(t + 1, 1);
        if (t + 2 < NT) TILE(t + 2, 2);
    }
    if (wid < 4) __builtin_amdgcn_s_barrier();
    if (hi == 0) li_l[r32] = l_reg; asm volatile("s_waitcnt lgkmcnt(0)" ::: "memory");
    float rli[16];
#pragma unroll
    for (int r = 0; r < 16; ++r) rli[r] = __builtin_amdgcn_rcpf(li_l[crow(r, hi)]);
    bf16* Ow = cur.O + (size_t)(wid * QBLK) * PITCH;
    {
        unsigned short* stg = (unsigned short*)(lds + OFF_V + wid * 8192);
#pragma unroll
        for (int r = 0; r < 16; ++r) { const int orow = crow(r, hi);
#pragma unroll
            for (int d0 = 0; d0 < 4; ++d0) stg[orow * 128 + d0 * 32 + r32] = (unsigned short)cvtpk(o[d0][r] * rli[r], 0.f); }
        asm volatile("s_waitcnt lgkmcnt(0)" ::: "memory");
#pragma unroll
        for (int i = 0; i < 8; ++i) { const int row = i * 4 + (lane >> 4), ch = lane & 15;
            const u32x4 v = *(const u32x4*)(stg + row * 128 + ch * 8); *(u32x4*)(Ow + (size_t)row * PITCH + ch * 8) = v;
            if (i & 1) asm volatile("" ::: "memory"); } }
    __syncthreads();
#undef RESC
#undef BAR
#undef TILE
}
#undef ROW
#undef VMW
#undef SLOAD_H
#undef SWRITE_H
#undef KSWZ
#undef SBAR
}
constexpr int NWAVES = 8;
#ifndef MK_N_LAUNCHES
#define MK_N_LAUNCHES 1
#endif
constexpr int N_PHASES = 11;
constexpr int N_LAUNCHES = MK_N_LAUNCHES;
static_assert(N_LAUNCHES == 1 || N_LAUNCHES == N_PHASES, "MK_N_LAUNCHES is 1 or 11");

constexpr int BATCH = 2, SEQ = 4096, DM = 2048, NMETA = 16, MREAL = BATCH * SEQ;
constexpr int LSEQ = NMETA + SEQ;
constexpr int LP = 4160, PADF = 48;
constexpr int M1 = 8192;
constexpr int N1 = 10240;
constexpr int WIN_LD = 10248;
constexpr int NEXP = 16384, PEER_H = 8, PEER_K = 16, EROW = 1536;
constexpr float EPS = 1e-6f;

constexpr size_t MiB = 1u << 20;
constexpr size_t WS_CTL = 0, CTL_ZERO_BYTES = 32768;
constexpr size_t WS_WIN = 2 * MiB, WS_WBD = 42 * MiB, WS_WBF = 46 * MiB, WS_WOUT = 50 * MiB, WS_WPQ = 58 * MiB;
constexpr size_t WS_EU = 62 * MiB, WS_EV = 94 * MiB;
constexpr size_t WS_SU = 126 * MiB, WS_SV = 126 * MiB + 65536;
constexpr size_t WS_XN = 190 * MiB;
constexpr size_t WS_H2N = 190 * MiB;
constexpr size_t WS_DQ = 223 * MiB, WS_DK = 239 * MiB, WS_DV = 256 * MiB, WS_FQ = 273 * MiB, WS_FK = 289 * MiB, WS_FV = 306 * MiB;
constexpr size_t WS_GA = 323 * MiB, WS_GB = 355 * MiB;
constexpr size_t WS_O1 = 387 * MiB, WS_O2 = 403 * MiB, WS_OF = 419 * MiB;
constexpr size_t WS_OD = 435 * MiB;
constexpr size_t WS_T = 223 * MiB;
constexpr size_t WS_MG = 289 * MiB;
constexpr size_t WS_QP = 323 * MiB;
constexpr size_t WS_RS = 396 * MiB;
constexpr size_t WS_PART = WS_QP;
constexpr size_t WS_IDX = 387 * MiB, WS_GATE = 391 * MiB;
constexpr size_t WS_SSQ = 395 * MiB;
constexpr size_t WS_LOGF = 451 * MiB;
constexpr size_t WS_KBIAS = 452 * MiB;
constexpr size_t WS_SKH = 451 * MiB + 512 * 1024, WS_SKL = 452 * MiB + 512 * 1024;
constexpr size_t WS_ROPE = 453 * MiB;
constexpr size_t WS_END = 454 * MiB;
static_assert(WS_T + (size_t)MREAL * DM * 4 <= WS_FK && WS_MG + (size_t)MREAL * DM * 2 <= WS_GA && WS_XN + (size_t)M1 * DM * 2 <= WS_DQ, "d_ws map");
static_assert(WS_DK + (size_t)BATCH * LP * 1024 * 2 <= WS_DV && WS_FV + (size_t)BATCH * LP * 1024 * 2 <= WS_GA, "d_ws map");

constexpr int CW_TMO = 0, CW_CODE = 1;
constexpr int CW_BAR = 4096;
constexpr int RING_OFF = 0, RING_BYTES = 131072;
constexpr int LDSCTL_OFF = 143360, MISC_OFF = LDSCTL_OFF + 320;
constexpr int LDS_BYTES = 147456;
#define GAS __attribute__((address_space(1)))
#define LAS __attribute__((address_space(3)))
typedef unsigned short bf16;
typedef unsigned v4u __attribute__((ext_vector_type(4)));
typedef float f32x4 __attribute__((ext_vector_type(4)));
typedef short bf16x8 __attribute__((ext_vector_type(8)));
typedef GAS unsigned gu32;
typedef GAS unsigned long long gu64;
#define RLX_AGENT __ATOMIC_RELAXED, __HIP_MEMORY_SCOPE_AGENT
#define LDS_WAIT() asm volatile("s_waitcnt lgkmcnt(0)" ::: "memory")
#define VM_WAIT() asm volatile("s_waitcnt vmcnt(0)" ::: "memory")
__device__ __forceinline__ unsigned long long rt() { return __builtin_amdgcn_s_memrealtime(); }
__device__ __forceinline__ unsigned f2bf(float f) { unsigned u = __builtin_bit_cast(unsigned, f); return (u + 0x7fffu + ((u >> 16) & 1u)) >> 16; }
__device__ __forceinline__ unsigned pk2(float lo, float hi) { return f2bf(lo) | (f2bf(hi) << 16); }
#define XB_TMO      128
#define XB_XCNT(j)  (256  + 64 * (j))
#define XB_XSUB(j)  (1280 + 64 * (j))
#define XB_XGEN(j)  (2304 + 64 * (j))
#define XB_TOP      3328
#define XB_TOPGEN   3392
#define XCD_BAR_WORDS 3456
#define XB_SPIN_CAP (1u << 18)

__device__ __forceinline__ unsigned xb_ld(unsigned* p)              { return __hip_atomic_load(p, __ATOMIC_RELAXED, __HIP_MEMORY_SCOPE_AGENT); }
__device__ __forceinline__ unsigned xb_add(unsigned* p, unsigned v) { return __hip_atomic_fetch_add(p, v, __ATOMIC_RELAXED, __HIP_MEMORY_SCOPE_AGENT); }
__device__ __forceinline__ unsigned xb_xcc_id() { return (unsigned)__builtin_amdgcn_s_getreg((3 << 11) | 20) & 0xFu; }
#define XB_SPIN(cond, bar) do { unsigned _sp = 0; while (cond) { __builtin_amdgcn_s_sleep(1); \
    if ((++_sp & 255u) == 0u) { if (xb_ld(&(bar)[XB_TMO])) break; if (_sp > XB_SPIN_CAP) { atomicAdd(&(bar)[XB_TMO], 1u); break; } } } } while (0)

struct XcdBarrier {
    unsigned* bar; unsigned x;
    volatile LAS unsigned* st;
};

__device__ __forceinline__ XcdBarrier xcd_barrier_post(unsigned* bar, volatile LAS unsigned* st) {
    XcdBarrier b; b.bar = bar; b.x = xb_xcc_id(); b.st = st;
    if (threadIdx.x == 0) (void)xb_add(&bar[XB_XCNT(b.x)], 1u);
    return b;
}
__device__ __forceinline__ void xcd_barrier_complete(unsigned* bar, unsigned x, unsigned& nloc, unsigned& nx) {
    const unsigned G = gridDim.x * gridDim.y * gridDim.z;
    unsigned sum, cnt, mine, sp = 0u;
    for (;;) {
        sum = 0u; cnt = 0u; mine = 0u;
#pragma unroll
        for (unsigned j = 0; j < 16; ++j) { const unsigned c = xb_ld(&bar[XB_XCNT(j)]); sum += c; cnt += (c > 0u) ? 1u : 0u; mine = (j == x) ? c : mine; }
        if (sum == G) break;
        __builtin_amdgcn_s_sleep(1);
        if ((++sp & 255u) == 0u) { if (xb_ld(&bar[XB_TMO])) break; if (sp > XB_SPIN_CAP) { atomicAdd(&bar[XB_TMO], 1u); break; } }
    }
    nloc = mine > 0u ? mine : 1u; nx = cnt > 0u ? cnt : 1u;
}

__device__ __forceinline__ void xcd_barrier(const XcdBarrier& b) {
    asm volatile("s_waitcnt vmcnt(0)" ::: "memory");
    __syncthreads();
    if (threadIdx.x == 0) {
        unsigned* bar = b.bar;
        __builtin_amdgcn_s_waitcnt(0);
        unsigned nloc = b.st[0], nx = b.st[1];
        if (nloc == 0u) { xcd_barrier_complete(bar, b.x, nloc, nx); b.st[0] = nloc; b.st[1] = nx; }
        const unsigned old = xb_add(&bar[XB_XSUB(b.x)], 1u);
        const unsigned gen = old / nloc;
        if (old + 1u == (gen + 1u) * nloc) {
            __builtin_amdgcn_fence(__ATOMIC_RELEASE, "agent");
            asm volatile("s_waitcnt vmcnt(0)" ::: "memory");
            const unsigned og = xb_add(&bar[XB_TOP], 1u);
            const unsigned tg = og / nx;
            if (og + 1u == (tg + 1u) * nx) xb_add(&bar[XB_TOPGEN], 1u);
            else XB_SPIN(xb_ld(&bar[XB_TOPGEN]) == tg, bar);
            __builtin_amdgcn_fence(__ATOMIC_ACQUIRE, "agent");
            xb_add(&bar[XB_XGEN(b.x)], 1u);
            asm volatile("s_waitcnt vmcnt(0)" ::: "memory");
        } else {
            XB_SPIN(xb_ld(&bar[XB_XGEN(b.x)]) == gen, bar);
            __builtin_amdgcn_fence(__ATOMIC_ACQUIRE, "agent");
            asm volatile("s_waitcnt vmcnt(0)" ::: "memory");
        }
    }
    __syncthreads();
}
__device__ __forceinline__ float wave_sum(float v) {
#pragma unroll
    for (int o = 1; o < 64; o <<= 1) v += __shfl_xor(v, o);
    return v;
}
struct Frame {
    LAS unsigned char* lds;
    volatile LAS unsigned* MISC;
    gu32* ctl;
    int tid, lane, wave;
    int vcu, G;
    int gw, NGW;
    const float* in[23];
    float* out;
    unsigned char* ws;
};
enum { I_X = 0, I_META, I_GMIX, I_WIN, I_BFORGET, I_BGATE, I_DQG, I_DKG, I_FQG, I_FKG, I_LQ1, I_LK1, I_LQ2, I_LK2, I_SUBLN, I_WBD, I_WBF, I_WOUT, I_GPEER, I_WPQ, I_SUBK, I_EU, I_EV };

__device__ __forceinline__ float bf2f(unsigned short b) { return __uint_as_float((unsigned)b << 16); }
__device__ __forceinline__ float bflo(unsigned w) { return __uint_as_float(w << 16); }
__device__ __forceinline__ float bfhi(unsigned w) { return __uint_as_float(w & 0xffff0000u); }
__device__ __forceinline__ float sigmoidf_(float x) { return 1.f / (1.f + __expf(-x)); }

__device__ __forceinline__ void p0_transpose_item2(const float* W, int ldw, int ncols, int K, bf16* WT, int row_off, LAS float* scr, int item, int lane) {
    const int nblk = ncols / 32, kb = item / nblk, nb = item % nblk, k0 = 64 * kb, n0 = 32 * nb;
#pragma unroll 8
    for (int i = 0; i < 32; ++i) { const int kk = 2 * i + (lane >> 5); scr[kk * 33 + (lane & 31)] = __builtin_nontemporal_load(W + (size_t)(k0 + kk) * ldw + n0 + (lane & 31)); }
    LDS_WAIT(); asm volatile("" ::: "memory");
    const int c = lane & 7;
#pragma unroll
    for (int j = 0; j < 4; ++j) { const int n = (lane >> 3) + 8 * j; const LAS float* s = scr + (8 * c) * 33 + n;
        v4u o; o.x = pk2(s[0 * 33], s[1 * 33]); o.y = pk2(s[2 * 33], s[3 * 33]); o.z = pk2(s[4 * 33], s[5 * 33]); o.w = pk2(s[6 * 33], s[7 * 33]);
        *(GAS v4u*)(WT + (size_t)(row_off + n0 + n) * K + k0 + 8 * c) = o; }
    LDS_WAIT(); asm volatile("" ::: "memory");
}

__device__ __forceinline__ void transpose_late_items(Frame& F, LAS float* scr) {
    constexpr int I_BD = (1024 / 64) * (DM / 32), I_O = (DM / 64) * (DM / 32), I_P = (DM / 64) * (1024 / 32), NL = 2 * I_BD + I_O + I_P;
    unsigned char* ws = F.ws; const int lane = F.lane;
#define TL_DECODE(q) const int it##q = F.gw + (q) * F.NGW; const bool ok##q = it##q < NL; int r##q = ok##q ? it##q : NL - 1; \
        const float* W##q; int ldw##q, nc##q, K##q; bf16* WT##q; \
        if (r##q < I_BD) { W##q = F.in[I_WBD]; ldw##q = DM; nc##q = DM; K##q = 1024; WT##q = (bf16*)(ws + WS_WBD); } \
        else if (r##q < 2 * I_BD) { r##q -= I_BD; W##q = F.in[I_WBF]; ldw##q = DM; nc##q = DM; K##q = 1024; WT##q = (bf16*)(ws + WS_WBF); } \
        else if (r##q < 2 * I_BD + I_O) { r##q -= 2 * I_BD; W##q = F.in[I_WOUT]; ldw##q = DM; nc##q = DM; K##q = DM; WT##q = (bf16*)(ws + WS_WOUT); } \
        else { r##q -= 2 * I_BD + I_O; W##q = F.in[I_WPQ]; ldw##q = 1024; nc##q = 1024; K##q = DM; WT##q = (bf16*)(ws + WS_WPQ); } \
        const int nblk##q = nc##q / 32, k0##q = 64 * (r##q / nblk##q), n0##q = 32 * (r##q % nblk##q); float b##q[32]; \
        _Pragma("unroll") for (int i = 0; i < 32; ++i) b##q[i] = __builtin_nontemporal_load(W##q + (size_t)(k0##q + 2 * i + (lane >> 5)) * ldw##q + n0##q + (lane & 31));
#define TL_FINISH(q) if (ok##q) { _Pragma("unroll") for (int i = 0; i < 32; ++i) scr[(2 * i + (lane >> 5)) * 33 + (lane & 31)] = b##q[i]; \
        LDS_WAIT(); asm volatile("" ::: "memory"); \
        const int c = lane & 7; \
        _Pragma("unroll") for (int j = 0; j < 4; ++j) { const int n = (lane >> 3) + 8 * j; const LAS float* s_ = scr + (8 * c) * 33 + n; \
            v4u o; o.x = pk2(s_[0 * 33], s_[1 * 33]); o.y = pk2(s_[2 * 33], s_[3 * 33]); o.z = pk2(s_[4 * 33], s_[5 * 33]); o.w = pk2(s_[6 * 33], s_[7 * 33]); \
            *(GAS v4u*)(WT##q + (size_t)(n0##q + n) * K##q + k0##q + 8 * c) = o; } \
        LDS_WAIT(); asm volatile("" ::: "memory"); }
    TL_DECODE(0) TL_DECODE(1) TL_DECODE(2)
    __builtin_amdgcn_sched_barrier(0);
    TL_FINISH(0) TL_FINISH(1) TL_FINISH(2)
#undef TL_DECODE
#undef TL_FINISH
}

template <int NB>
__device__ __forceinline__ void convert_expert_rows_p(const float* in_eu, const float* in_ev, unsigned char* ws, int lane_, int gw_, int ngw_, int k0, int k1) {
#pragma unroll 1
    for (int kb = k0; kb < k1; kb += NB) {
        f32x4 v[NB][8];
#pragma unroll
        for (int i = 0; i < NB; ++i) { int r = gw_ + (kb + i < k1 ? kb + i : k1 - 1) * ngw_; if (r >= 2 * NEXP) r = 2 * NEXP - 1;
            const int tsel = r >= NEXP, e = r - tsel * NEXP; const GAS f32x4* src = (const GAS f32x4*)((tsel ? in_ev : in_eu) + (size_t)e * DM);
#pragma unroll
            for (int j = 0; j < 8; ++j) v[i][j] = __builtin_nontemporal_load(src + 64 * j + lane_); }
#pragma unroll
        for (int i = 0; i < NB; ++i) { const int r = gw_ + (kb + i) * ngw_; if (kb + i >= k1 || r >= 2 * NEXP) continue;
            const int tsel = r >= NEXP, e = r - tsel * NEXP;
            float amax = 0.f;
#pragma unroll
            for (int j = 0; j < 8; ++j) amax = fmaxf(amax, fmaxf(fmaxf(fabsf(v[i][j].x), fabsf(v[i][j].y)), fmaxf(fabsf(v[i][j].z), fabsf(v[i][j].w))));
#pragma unroll
            for (int o = 1; o < 64; o <<= 1) amax = fmaxf(amax, __shfl_xor(amax, o));
            const float s4 = amax > 0.f ? 6.f / amax : 1.f; v4u q;
#define PK4(J) ({ unsigned w_ = 0u; \
                    w_ = __builtin_amdgcn_cvt_scalef32_pk_fp4_f32(w_, v[i][2 * (J)].x * s4, v[i][2 * (J)].y * s4, 1.0f, 0); w_ = __builtin_amdgcn_cvt_scalef32_pk_fp4_f32(w_, v[i][2 * (J)].z * s4, v[i][2 * (J)].w * s4, 1.0f, 1); \
                    w_ = __builtin_amdgcn_cvt_scalef32_pk_fp4_f32(w_, v[i][2 * (J) + 1].x * s4, v[i][2 * (J) + 1].y * s4, 1.0f, 2); w_ = __builtin_amdgcn_cvt_scalef32_pk_fp4_f32(w_, v[i][2 * (J) + 1].z * s4, v[i][2 * (J) + 1].w * s4, 1.0f, 3); w_; })
            q.x = PK4(0); q.y = PK4(1); q.z = PK4(2); q.w = PK4(3);
#undef PK4
            if (tsel) *(GAS v4u*)(ws + WS_EV + (size_t)e * 1024 + 16 * lane_) = q;
            else {
                GAS unsigned short* up = (GAS unsigned short*)(ws + WS_EU + (size_t)e * 128) + lane_; constexpr size_t SL = (size_t)NEXP * 64;
                up[0] = (unsigned short)q.x; up[SL] = (unsigned short)(q.x >> 16); up[2 * SL] = (unsigned short)q.y; up[3 * SL] = (unsigned short)(q.y >> 16);
                up[4 * SL] = (unsigned short)q.z; up[5 * SL] = (unsigned short)(q.z >> 16); up[6 * SL] = (unsigned short)q.w; up[7 * SL] = (unsigned short)(q.w >> 16); }
            if (lane_ == 0) ((float*)(ws + (tsel ? WS_SV : WS_SU)))[e] = amax > 0.f ? amax / 6.f : 1.f;
        }
    }
}
__device__ __forceinline__ void convert_expert_rows(Frame& F, int k0, int k1) { convert_expert_rows_p<4>(F.in[I_EU], F.in[I_EV], F.ws, F.lane, F.gw, F.NGW, k0, k1); }
__device__ __forceinline__ void p0_prologue(Frame& F) {
    unsigned char* ws = F.ws;
    for (int rpa_ = 0; rpa_ < (((PH_REP_MASK) >> 12) & 1 ? 2 : 1); ++rpa_)
    {   LAS float* WF = (LAS float*)(F.lds + RING_OFF);
        const float* win = F.in[I_WIN];
        for (int i = F.tid; i < DM * 2; i += NWAVES * 64) { const int k = i >> 1, hh = (i & 1) * 4;
            const f32x4 v = *(const f32x4*)(win + (size_t)k * WIN_LD + 6144 + hh);
            WF[(hh + 0) * DM + k] = v.x; WF[(hh + 1) * DM + k] = v.y; WF[(hh + 2) * DM + k] = v.z; WF[(hh + 3) * DM + k] = v.w; }
        __syncthreads();
        bf16* XN = (bf16*)(ws + WS_XN); float* LOGF = (float*)(ws + WS_LOGF);
        const float* gmix = F.in[I_GMIX]; const float* bfg = F.in[I_BFORGET];
        constexpr int NROW = MREAL + NMETA;
#define P0A_SRC(m_) ((const GAS f32x4*)((m_) < MREAL ? F.in[I_X] + (size_t)(m_) * DM : F.in[I_META] + (size_t)((m_) - MREAL) * DM) + F.lane)
#define P0A_LOAD(V, m_) do { const GAS f32x4* xr_ = P0A_SRC(m_); _Pragma("unroll") for (int j = 0; j < 8; ++j) V[j] = __builtin_nontemporal_load(xr_ + 64 * j); } while (0)
#define P0A_FIN(FL, mrow_) do { const int mrow = (mrow_);                                                                                 \
            float a4[4]; { const bool up = (F.lane & 32) != 0;                                                                          \
              _Pragma("unroll") for (int i = 0; i < 4; ++i) { const float snd = up ? FL[i] : FL[i + 4]; const float kp = up ? FL[i + 4] : FL[i]; a4[i] = kp + __shfl_xor(snd, 32); } }   \
            float a2[2]; { const bool up = (F.lane & 16) != 0;                                                                          \
              _Pragma("unroll") for (int i = 0; i < 2; ++i) { const float snd = up ? a4[i] : a4[i + 2]; const float kp = up ? a4[i + 2] : a4[i]; a2[i] = kp + __shfl_xor(snd, 16); } }   \
            float a1; { const bool up = (F.lane & 8) != 0; const float snd = up ? a2[0] : a2[1]; const float kp = up ? a2[1] : a2[0]; a1 = kp + __shfl_xor(snd, 8); }                     \
            a1 += __shfl_xor(a1, 4); a1 += __shfl_xor(a1, 2); a1 += __shfl_xor(a1, 1);                                                 \
                                                       \
            if ((F.lane & 7) == 0) { const int h = ((F.lane >> 5) & 1) * 4 + ((F.lane >> 4) & 1) * 2 + ((F.lane >> 3) & 1);             \
                const float z = a1 + bfg[h];                                                                                           \
                const float lf = fminf(z, 0.f) - log1pf(__expf(-fabsf(z)));                                             \
                if (mrow < MREAL) { const int b = mrow >> 12, s = mrow & 4095; LOGF[((size_t)b * 8 + h) * LSEQ + NMETA + s] = lf; }            \
                else { const int t = mrow - MREAL; LOGF[((size_t)0 * 8 + h) * LSEQ + t] = lf; LOGF[((size_t)1 * 8 + h) * LSEQ + t] = lf; } } } while (0)
#define P0A_ROW2(VA, ma_, VB, mb_, okb_) do { const int mra = (ma_), mrb = (okb_) ? (mb_) : (ma_);                                          \
            GAS unsigned long long* oa8 = (GAS unsigned long long*)(XN + (size_t)mra * DM) + F.lane; GAS unsigned long long* ob8 = (GAS unsigned long long*)(XN + (size_t)mrb * DM) + F.lane; \
            float s2a = 0.f, s2b = 0.f;                                                                                                \
            _Pragma("unroll") for (int j = 0; j < 8; ++j) { s2a += (VA[j].x * VA[j].x + VA[j].y * VA[j].y) + (VA[j].z * VA[j].z + VA[j].w * VA[j].w);  \
                                                            s2b += (VB[j].x * VB[j].x + VB[j].y * VB[j].y) + (VB[j].z * VB[j].z + VB[j].w * VB[j].w); } \
            _Pragma("unroll") for (int o = 1; o < 64; o <<= 1) { s2a += __shfl_xor(s2a, o); s2b += __shfl_xor(s2b, o); }               \
            const float rsa = 1.f / sqrtf(s2a * (1.f / DM) + EPS), rsb = 1.f / sqrtf(s2b * (1.f / DM) + EPS);                           \
            float fla[8], flb[8];                                                                                                      \
            _Pragma("unroll") for (int h = 0; h < 8; ++h) { fla[h] = 0.f; flb[h] = 0.f; }                                              \
            _Pragma("unroll") for (int j = 0; j < 8; ++j) { const f32x4 g = *((const GAS f32x4*)gmix + 64 * j + F.lane);               \
                const f32x4 ya = {VA[j].x * rsa * g.x, VA[j].y * rsa * g.y, VA[j].z * rsa * g.z, VA[j].w * rsa * g.w};                  \
                const f32x4 yb = {VB[j].x * rsb * g.x, VB[j].y * rsb * g.y, VB[j].z * rsb * g.z, VB[j].w * rsb * g.w};                  \
                oa8[64 * j] = (unsigned long long)pk2(ya.x, ya.y) | ((unsigned long long)pk2(ya.z, ya.w) << 32);                        \
                if (okb_) ob8[64 * j] = (unsigned long long)pk2(yb.x, yb.y) | ((unsigned long long)pk2(yb.z, yb.w) << 32);              \
                _Pragma("unroll") for (int hh = 0; hh < 8; hh += 4) { \
                    _Pragma("unroll") for (int h = hh; h < hh + 4; ++h) { const f32x4 w = *(const LAS f32x4*)(WF + h * DM + 256 * j + 4 * F.lane); \
                        fla[h] += (ya.x * w.x + ya.y * w.y) + (ya.z * w.z + ya.w * w.w); flb[h] += (yb.x * w.x + yb.y * w.y) + (yb.z * w.z + yb.w * w.w); } \
                    asm volatile("" : "+v"(fla[0]), "+v"(fla[1]), "+v"(fla[2]), "+v"(fla[3]), "+v"(fla[4]), "+v"(fla[5]), "+v"(fla[6]), "+v"(fla[7]), "+v"(flb[0]), "+v"(flb[1]), "+v"(flb[2]), "+v"(flb[3]), "+v"(flb[4]), "+v"(flb[5]), "+v"(flb[6]), "+v"(flb[7]) :: "memory"); \
                    __builtin_amdgcn_sched_barrier(0); } }     \
            P0A_FIN(fla, mra); if (okb_) P0A_FIN(flb, mrb); } while (0)
        f32x4 va[8], vb[8], vc[8], vd[8];
        { const int m0 = F.gw; if (m0 < NROW) { P0A_LOAD(va, m0); P0A_LOAD(vb, (m0 + F.NGW < NROW) ? m0 + F.NGW : m0); } }
#pragma unroll 1
        for (int m = F.gw; m < NROW; m += 4 * F.NGW) {
            const int m1 = m + F.NGW, m2 = m + 2 * F.NGW, m3 = m + 3 * F.NGW, m4 = m + 4 * F.NGW, m5 = m + 5 * F.NGW;
            if (m2 < NROW) { P0A_LOAD(vc, m2); P0A_LOAD(vd, (m3 < NROW) ? m3 : m2); }
            { const bool okb = m1 < NROW; P0A_ROW2(va, m, vb, m1, okb); }
            if (m2 < NROW) {
                if (m4 < NROW) { P0A_LOAD(va, m4); P0A_LOAD(vb, (m5 < NROW) ? m5 : m4); }
                { const bool okd = m3 < NROW; P0A_ROW2(vc, m2, vd, m3, okd); }
            }
        }
#undef P0A_FIN
#undef P0A_ROW2
#undef P0A_SRC
#undef P0A_LOAD
        __syncthreads();
    }
    {   LAS unsigned short* XM = (LAS unsigned short*)(F.lds + RING_OFF);
        LAS float* PART = (LAS float*)(F.lds + RING_OFF + 66048);
        const float* gmix = F.in[I_GMIX]; const float* win = F.in[I_WIN];
        for (int rr = 0; rr < 2; ++rr) { const int r = 2 * F.wave + rr;
            const GAS f32x4* xr = (const GAS f32x4*)(F.in[I_META] + (size_t)r * DM) + F.lane;
            f32x4 v[8]; float s2 = 0.f;
#pragma unroll
            for (int j = 0; j < 8; ++j) { v[j] = xr[64 * j]; s2 += (v[j].x * v[j].x + v[j].y * v[j].y) + (v[j].z * v[j].z + v[j].w * v[j].w); }
            const float rstd = 1.f / sqrtf(wave_sum(s2) * (1.f / DM) + EPS);
#pragma unroll
            for (int j = 0; j < 8; ++j) { const f32x4 g = *((const GAS f32x4*)gmix + 64 * j + F.lane);
                *(LAS unsigned long long*)(XM + r * 2056 + 256 * j + 4 * F.lane) = (unsigned long long)pk2(v[j].x * rstd * g.x, v[j].y * rstd * g.y) | ((unsigned long long)pk2(v[j].z * rstd * g.z, v[j].w * rstd * g.w) << 32); } }
        __syncthreads();
        const int c = F.lane & 15, kk = F.lane >> 4;
        for (int task = F.vcu; task < 256; task += F.G) {
            const int n = task * 16 + c;
            const int wcol = n < 2048 ? 1024 + n : n + 2048;
            float acc[16];
#pragma unroll
            for (int r = 0; r < 16; ++r) acc[r] = 0.f;
            const LAS unsigned short* xp = XM + 256 * F.wave + kk; const float* wp = win + (size_t)(256 * F.wave + kk) * WIN_LD + wcol;
#pragma unroll 1
            for (int i0 = 0; i0 < 64; i0 += 16) {
                float wv[16];
#pragma unroll
                for (int i = 0; i < 16; ++i) wv[i] = wp[(size_t)(4 * (i0 + i)) * WIN_LD];
                const LAS unsigned short* xq = xp + 4 * i0;
#pragma unroll
                for (int i = 0; i < 16; ++i)
#pragma unroll
                    for (int r = 0; r < 16; ++r) acc[r] += bf2f(xq[r * 2056 + 4 * i]) * wv[i];
            }
#pragma unroll
            for (int r = 0; r < 16; ++r) { float s = acc[r]; s += __shfl_xor(s, 16); s += __shfl_xor(s, 32); if (kk == 0) PART[(F.wave * 16 + r) * 16 + c] = s; }
            __syncthreads();
            if (F.tid < 256) { const int r = F.tid >> 4, cc = F.tid & 15; float s = 0.f;
#pragma unroll
                for (int w = 0; w < 8; ++w) s += PART[(w * 16 + r) * 16 + cc];
                const int nn = task * 16 + cc; const int seg = nn >> 10, col = nn & 1023;
                bf16* base = (bf16*)(ws + (seg == 0 ? WS_DK : seg == 1 ? WS_DV : seg == 2 ? WS_FK : WS_FV));
                const bf16 hv = (bf16)f2bf(s);
                base[(size_t)(PADF + r) * 1024 + col] = hv; base[(size_t)(LP + PADF + r) * 1024 + col] = hv; }
            __syncthreads();
        }
    }
    for (int rpb_ = 0; rpb_ < (((PH_REP_MASK) >> 13) & 1 ? 2 : 1); ++rpb_)
    {   LAS float* scr = (LAS float*)(F.lds + RING_OFF + F.wave * 16384);
        const float* win = F.in[I_WIN];
        constexpr int I_A = (DM / 64) * (6144 / 32), I_G = (DM / 64) * (2048 / 32), I_BD = (1024 / 64) * (DM / 32), I_O = (DM / 64) * (DM / 32), I_P = (DM / 64) * (1024 / 32);
        constexpr int NITEMS = I_A + 2 * I_G + 2 * I_BD + I_O + I_P;
        bf16* WIN = (bf16*)(ws + WS_WIN);
        for (int it = F.gw; it < I_A + 2 * I_G; it += F.NGW) {
            int r = it;
            if (r < I_A) {
                const int nblk = 6144 / 32, kb = r / nblk, nb = r % nblk; const int seg = nb >> 5; int sb = nb;
                if (seg == 1 || seg == 4) { const int pb = nb & 7; sb = (nb & ~7) + 2 * (pb & 3) + (pb >> 2); }
                p0_transpose_item2(win + 32 * sb, WIN_LD, 32, DM, WIN, 32 * nb, scr, kb, F.lane); continue; } r -= I_A;
            if (r < I_G) { p0_transpose_item2(win + 6152, WIN_LD, 2048, DM, WIN, 6144, scr, r, F.lane); continue; } r -= I_G;
            if (r < I_G) { p0_transpose_item2(win + 8200, WIN_LD, 2048, DM, WIN, 8192, scr, r, F.lane); continue; } r -= I_G;
            (void)NITEMS; (void)I_BD; (void)I_O; (void)I_P;
        }
    }
    {   const size_t gt = (size_t)F.vcu * (NWAVES * 64) + F.tid, GT = (size_t)F.G * NWAVES * 64;
        constexpr size_t per = (size_t)PADF * 1024 * 2 / 16;
        for (size_t c = gt; c < 8 * per; c += GT) { const int a = (int)(c / per), off = (int)(c % per); const int arr = a >> 1, b = a & 1;
            const size_t base = arr == 0 ? WS_DK : arr == 1 ? WS_DV : arr == 2 ? WS_FK : WS_FV;
            ((GAS v4u*)(ws + base + (size_t)b * LP * 1024 * 2))[off] = (v4u){0u, 0u, 0u, 0u}; }
        { const float* sk = F.in[I_SUBK]; bf16* skh = (bf16*)(ws + WS_SKH); bf16* skl = (bf16*)(ws + WS_SKL);
          for (size_t i = gt; i < (size_t)8 * 2 * 128 * 64; i += GT) { const float v = sk[i]; const unsigned hb = f2bf(v); skh[i] = (bf16)hb; skl[i] = (bf16)f2bf(v - __uint_as_float(hb << 16)); } }
        { float* rt = (float*)(ws + WS_ROPE);
          const float inv[8] = {1.0f, 0.1939227432012558f, 0.03760603070259094f, 0.007292664609849453f, 0.0014142135623842478f, 0.00027424818836152554f, 5.318296098266728e-05f, 1.0313386155758053e-05f};
          for (size_t i = gt; i < (size_t)LSEQ * 8; i += GT) { const int fi = (int)(i & 7); float iv = inv[0];
#pragma unroll
              for (int q = 1; q < 8; ++q) iv = fi == q ? inv[q] : iv;
              const float ang = (float)(i >> 3) * iv; rt[2 * i] = cosf(ang); rt[2 * i + 1] = sinf(ang); } }
        float* KBD = (float*)(ws + WS_KBIAS) + (size_t)16 * LP;
        for (size_t p = gt; p < LP; p += GT) KBD[p] = p < PADF ? -__builtin_inff() : 0.f;
    }
}
using pg8::Unit;
__device__ __forceinline__ v4u pack8bf(const f32x4& a, const f32x4& b) { v4u w; w.x = pg8::cvt_pk_bf16(a[0], a[1]); w.y = pg8::cvt_pk_bf16(a[2], a[3]); w.z = pg8::cvt_pk_bf16(b[0], b[1]); w.w = pg8::cvt_pk_bf16(b[2], b[3]); return w; }
struct Epi1 {
    static constexpr bool PERM = true, AFTER_DRAIN = false, HOSTS = true;
    unsigned char* ws; LAS float* xch; const float* dkg; const float* fkg;
    const float* in_eu; const float* in_ev; int lane, gw, ngw, host_at; mutable int hosted;
    __device__ __forceinline__ void host(int ui, bool last) const {
        if (hosted || !(ui == host_at || last)) return;
        hosted = 1; convert_expert_rows_p<4>(in_eu, in_ev, ws, lane, gw, ngw, 0, (2 * NEXP + ngw - 1) / ngw);
        asm volatile("s_waitcnt vmcnt(0)" ::: "memory");
    }
    __device__ __forceinline__ void scale(f32x4 (&)[2][2][4][2], const Unit&, int, int, int, int) const {}
    __device__ __forceinline__ void operator()(const f32x4 (&acc)[2][2][4][2], const Unit& u, int wr, int wc, int fr, int fq) const {
        using pg8::HALF;
        asm volatile("" : "+v"(fr), "+v"(fq));
        const int ncol = u.pn * 256;
        if (ncol >= 1024 && ncol < 2048) {
            bf16* base = (bf16*)(ws + WS_DK) + (ncol - 1024) + 64 * wc + 8 * fq; const float* rope = (const float*)(ws + WS_ROPE);
#pragma unroll
            for (int ai = 0; ai < 2; ++ai)
#pragma unroll
                for (int m = 0; m < 4; ++m) { const int mrow = u.pm * 256 + ai * HALF + wr * 64 + m * 16 + fr;
                    f32x4 y[2][2]; float ss = 0.f;
#pragma unroll
                    for (int bj = 0; bj < 2; ++bj)
#pragma unroll
                        for (int n = 0; n < 2; ++n) { y[bj][n] = acc[ai][bj][m][n]; ss += (y[bj][n][0] * y[bj][n][0] + y[bj][n][1] * y[bj][n][1]) + (y[bj][n][2] * y[bj][n][2] + y[bj][n][3] * y[bj][n][3]); }
                    ss += __shfl_xor(ss, 16); ss += __shfl_xor(ss, 32);
                    const float r = 1.f / sqrtf(ss * (1.f / 64.f) + EPS);
#pragma unroll
                    for (int bj = 0; bj < 2; ++bj)
#pragma unroll
                        for (int n = 0; n < 2; ++n) { const f32x4 g = *(const f32x4*)(dkg + 32 * bj + 8 * fq + 4 * n); y[bj][n] = y[bj][n] * r * g; }
                    const float* tb = rope + (size_t)(NMETA + (mrow & 4095)) * 16;
#pragma unroll
                    for (int n = 0; n < 2; ++n)
#pragma unroll
                        for (int i = 0; i < 4; ++i) { const float mine = y[0][n][i], other = __shfl_xor(mine, 16); const float c = tb[2 * (4 * n + i)], sn = tb[2 * (4 * n + i) + 1];
                            y[0][n][i] = fq == 0 ? (mine * c - other * sn) : (fq == 1 ? (mine * c + other * sn) : mine); }
                    bf16* rowp = base + (size_t)(mrow + 64 + 64 * (mrow >> 12)) * 1024;
                    *(GAS v4u*)(rowp) = pack8bf(y[0][0], y[0][1]); *(GAS v4u*)(rowp + 32) = pack8bf(y[1][0], y[1][1]); }
        } else if (ncol >= 4096 && ncol < 5120) {
            bf16* base = (bf16*)(ws + WS_FK) + (ncol - 4096) + 64 * wc + 8 * fq;
#pragma unroll
            for (int ai = 0; ai < 2; ++ai)
#pragma unroll
                for (int m = 0; m < 4; ++m) { const int rt = ai * HALF + wr * 64 + m * 16 + fr; float ss = 0.f;
#pragma unroll
                    for (int bj = 0; bj < 2; ++bj)
#pragma unroll
                        for (int n = 0; n < 2; ++n) { const f32x4 v = acc[ai][bj][m][n]; ss += (v[0] * v[0] + v[1] * v[1]) + (v[2] * v[2] + v[3] * v[3]); }
                    ss += __shfl_xor(ss, 16); ss += __shfl_xor(ss, 32);
                    if (fq == 0) xch[rt * 4 + wc] = ss; }
            asm volatile("s_waitcnt lgkmcnt(0)" ::: "memory"); __builtin_amdgcn_s_barrier(); asm volatile("" ::: "memory");
#pragma unroll
            for (int ai = 0; ai < 2; ++ai)
#pragma unroll
                for (int m = 0; m < 4; ++m) { const int rt = ai * HALF + wr * 64 + m * 16 + fr; const int mrow = u.pm * 256 + rt;
                    const float r = 1.f / sqrtf((xch[rt * 4 + wc] + xch[rt * 4 + (wc ^ 1)]) * (1.f / 128.f) + EPS);
                    bf16* rowp = base + (size_t)(mrow + 64 + 64 * (mrow >> 12)) * 1024;
#pragma unroll
                    for (int bj = 0; bj < 2; ++bj) { const float* gg = fkg + 64 * (wc & 1) + 32 * bj + 8 * fq; const f32x4 g0 = *(const f32x4*)gg, g1 = *(const f32x4*)(gg + 4);
                        *(GAS v4u*)(rowp + 32 * bj) = pack8bf(acc[ai][bj][m][0] * r * g0, acc[ai][bj][m][1] * r * g1); } }
        } else {
            bf16* base; int ldc, colt, kind;
            if (ncol < 6144) { const int seg = ncol >> 10; colt = ncol & 1023; ldc = 1024;
                base = (bf16*)(ws + (seg == 0 ? WS_DQ : seg == 2 ? WS_DV : seg == 3 ? WS_FQ : WS_FV)); kind = (seg == 2 || seg == 5) ? 1 : 0; }
            else if (ncol < 8192) { base = (bf16*)(ws + WS_GA); colt = ncol - 6144; ldc = 2048; kind = 0; }
            else { base = (bf16*)(ws + WS_GB); colt = ncol - 8192; ldc = 2048; kind = 0; }
#pragma unroll
            for (int ai = 0; ai < 2; ++ai)
#pragma unroll
                for (int m = 0; m < 4; ++m) { const int mrow = u.pm * 256 + ai * HALF + wr * 64 + m * 16 + fr; const size_t row = kind ? (size_t)(mrow + 64 + 64 * (mrow >> 12)) : (size_t)mrow;
#pragma unroll
                    for (int bj = 0; bj < 2; ++bj) *(GAS v4u*)(base + row * ldc + colt + bj * HALF + wc * 32 + 8 * fq) = pack8bf(acc[ai][bj][m][0], acc[ai][bj][m][1]); }
        }
    }
};
struct F_Gemm2a {
    const bf16* G; const float* bg; bf16* MG;
    __device__ __forceinline__ bool begin(const Unit&) { return true; }
    __device__ __forceinline__ void row_begin() {}
    __device__ __forceinline__ void scale_chunk(const Unit&, int, int, f32x4&, f32x4&) const {}
    __device__ __forceinline__ void row_end(const Unit&, int, int, int) {}
    __device__ __forceinline__ void chunk(const Unit& u, int rt, int ct, const f32x4& v0, const f32x4& v1) const {
        const size_t row = (size_t)u.pm * 256 + rt; const int col = u.pn * 256 + ct;
        const v4u g = *(const GAS v4u*)(G + row * DM + col); const f32x4 b0 = *(const f32x4*)(bg + col), b1 = *(const f32x4*)(bg + col + 4);
        f32x4 o0, o1;
        o0[0] = sigmoidf_(bflo(g.x) + b0[0]) * v0[0]; o0[1] = sigmoidf_(bfhi(g.x) + b0[1]) * v0[1]; o0[2] = sigmoidf_(bflo(g.y) + b0[2]) * v0[2]; o0[3] = sigmoidf_(bfhi(g.y) + b0[3]) * v0[3];
        o1[0] = sigmoidf_(bflo(g.z) + b1[0]) * v1[0]; o1[1] = sigmoidf_(bfhi(g.z) + b1[1]) * v1[1]; o1[2] = sigmoidf_(bflo(g.w) + b1[2]) * v1[2]; o1[3] = sigmoidf_(bfhi(g.w) + b1[3]) * v1[3];
        *(GAS v4u*)(MG + row * DM + col) = pack8bf(o0, o1);
    }
};
struct F_Gemm2b {
    const bf16* G; const float* bg; bf16* MG;
    __device__ __forceinline__ bool begin(const Unit&) { return true; }
    __device__ __forceinline__ void row_begin() {}
    __device__ __forceinline__ void scale_chunk(const Unit&, int, int, f32x4&, f32x4&) const {}
    __device__ __forceinline__ void row_end(const Unit&, int, int, int) {}
    __device__ __forceinline__ void chunk(const Unit& u, int rt, int ct, const f32x4& v0, const f32x4& v1) const {
        const size_t row = (size_t)u.pm * 256 + rt; const int col = u.pn * 256 + ct;
        const v4u g = *(const GAS v4u*)(G + row * DM + col); const f32x4 b0 = *(const f32x4*)(bg + col), b1 = *(const f32x4*)(bg + col + 4);
        const v4u t = *(const GAS v4u*)(MG + row * DM + col);
        f32x4 o0, o1;
        o0[0] = bflo(t.x) + sigmoidf_(bflo(g.x) + b0[0]) * v0[0]; o0[1] = bfhi(t.x) + sigmoidf_(bfhi(g.x) + b0[1]) * v0[1]; o0[2] = bflo(t.y) + sigmoidf_(bflo(g.y) + b0[2]) * v0[2]; o0[3] = bfhi(t.y) + sigmoidf_(bfhi(g.y) + b0[3]) * v0[3];
        o1[0] = bflo(t.z) + sigmoidf_(bflo(g.z) + b1[0]) * v1[0]; o1[1] = bfhi(t.z) + sigmoidf_(bfhi(g.z) + b1[1]) * v1[1]; o1[2] = bflo(t.w) + sigmoidf_(bflo(g.w) + b1[2]) * v1[2]; o1[3] = bfhi(t.w) + sigmoidf_(bfhi(g.w) + b1[3]) * v1[3];
        *(GAS v4u*)(MG + row * DM + col) = pack8bf(o0, o1);
    }
};
struct F_Gemm2 {
    const bf16* GA; const bf16* GB; const float* bg; bf16* MG;
    __device__ __forceinline__ bool begin(const Unit&) { return true; }
    __device__ __forceinline__ void row_begin() {}
    __device__ __forceinline__ void row_end(const Unit&, int, int, int) {}
    __device__ __forceinline__ void scale_chunk(const Unit& u, int rt, int ct, f32x4& v0, f32x4& v1) const {
        const size_t row = (size_t)u.pm * 256 + rt; const int col = u.pn * 256 + ct;
        const v4u ga = *(const GAS v4u*)(GA + row * DM + col), gb = *(const GAS v4u*)(GB + row * DM + col);
        const f32x4 a0 = *(const f32x4*)(bg + col), a1 = *(const f32x4*)(bg + col + 4), b0 = *(const f32x4*)(bg + DM + col), b1 = *(const f32x4*)(bg + DM + col + 4);
#define RT(GAW, GBW, HI, AB, BB) ((1.f + __expf(-((HI ? bfhi(GBW) : bflo(GBW)) + (BB)))) / (1.f + __expf(-((HI ? bfhi(GAW) : bflo(GAW)) + (AB)))))
        v0[0] *= RT(ga.x, gb.x, 0, a0[0], b0[0]); v0[1] *= RT(ga.x, gb.x, 1, a0[1], b0[1]); v0[2] *= RT(ga.y, gb.y, 0, a0[2], b0[2]); v0[3] *= RT(ga.y, gb.y, 1, a0[3], b0[3]);
        v1[0] *= RT(ga.z, gb.z, 0, a1[0], b1[0]); v1[1] *= RT(ga.z, gb.z, 1, a1[1], b1[1]); v1[2] *= RT(ga.w, gb.w, 0, a1[2], b1[2]); v1[3] *= RT(ga.w, gb.w, 1, a1[3], b1[3]);
#undef RT
    }
    __device__ __forceinline__ void chunk(const Unit& u, int rt, int ct, const f32x4& v0, const f32x4& v1) const {
        const size_t row = (size_t)u.pm * 256 + rt; const int col = u.pn * 256 + ct;
        const v4u g = *(const GAS v4u*)(GB + row * DM + col); const f32x4 b0 = *(const f32x4*)(bg + DM + col), b1 = *(const f32x4*)(bg + DM + col + 4);
        f32x4 o0, o1;
        o0[0] = sigmoidf_(bflo(g.x) + b0[0]) * v0[0]; o0[1] = sigmoidf_(bfhi(g.x) + b0[1]) * v0[1]; o0[2] = sigmoidf_(bflo(g.y) + b0[2]) * v0[2]; o0[3] = sigmoidf_(bfhi(g.y) + b0[3]) * v0[3];
        o1[0] = sigmoidf_(bflo(g.z) + b1[0]) * v1[0]; o1[1] = sigmoidf_(bfhi(g.z) + b1[1]) * v1[1]; o1[2] = sigmoidf_(bflo(g.w) + b1[2]) * v1[2]; o1[3] = sigmoidf_(bfhi(g.w) + b1[3]) * v1[3];
        *(GAS v4u*)(MG + row * DM + col) = pack8bf(o0, o1);
    }
};
struct Pair2Order {
    pg8::StaticOrder S; int dA, dB;
    __device__ void init(int M, int N, int G_, int c_, int dA_, int dB_) { S.init(M, N, G_, c_); dA = dA_; dB = dB_; }
    __device__ bool next(int i, Unit& u) const { if (!S.next(i >> 1, u)) return false; const int br = i & 1; u.ko = br ? dA : 0; u.kob = br ? dB : 0; u.chain = br ? 0 : 1; return true; }
    __device__ __forceinline__ void a_ready(const Unit&) const {}
    __device__ __forceinline__ void done(const Unit&) const {}
};
struct F_Gemm3 {
    const float* X; float* O; const float* gp; bf16* HG; float* SSQ; float ss;
    __device__ __forceinline__ bool begin(const Unit&) { return true; }
    __device__ __forceinline__ void row_begin() { ss = 0.f; }
    __device__ __forceinline__ void scale_chunk(const Unit&, int, int, f32x4&, f32x4&) const {}
    __device__ __forceinline__ void chunk(const Unit& u, int rt, int ct, const f32x4& v0, const f32x4& v1) {
        const int col = u.pn * 256 + ct; const size_t off = ((size_t)u.pm * 256 + rt) * DM + col;
        const f32x4 x0 = *(const GAS f32x4*)(X + off), x1 = *(const GAS f32x4*)(X + off + 4);
        const f32x4 o0 = x0 + v0, o1 = x1 + v1;
        *(GAS f32x4*)(O + off) = o0; *(GAS f32x4*)(O + off + 4) = o1;
        ss += (o0[0] * o0[0] + o0[1] * o0[1]) + (o0[2] * o0[2] + o0[3] * o0[3]) + (o1[0] * o1[0] + o1[1] * o1[1]) + (o1[2] * o1[2] + o1[3] * o1[3]);
        const f32x4 g0 = *(const f32x4*)(gp + col), g1 = *(const f32x4*)(gp + col + 4);
        *(GAS v4u*)(HG + off) = pack8bf(o0 * g0, o1 * g1);
    }
    __device__ __forceinline__ void row_end(const Unit& u, int rt, int wc, int fq) {
        float s = ss; s += __shfl_xor(s, 16); s += __shfl_xor(s, 32);
        if (fq == 0) SSQ[((size_t)u.pm * 256 + rt) * 32 + u.pn * 4 + wc] = s;
    }
};
struct F_Gemm4 {
    float* Q;
    __device__ __forceinline__ bool begin(const Unit&) { return true; }
    __device__ __forceinline__ void row_begin() {}
    __device__ __forceinline__ void scale_chunk(const Unit&, int, int, f32x4&, f32x4&) const {}
    __device__ __forceinline__ void row_end(const Unit&, int, int, int) {}
    __device__ __forceinline__ void chunk(const Unit& u, int rt, int ct, const f32x4& v0, const f32x4& v1) const {
        const size_t off = ((size_t)u.pm * 256 + rt) * 2048 + (u.ko ? 1024 : 0) + u.pn * 256 + ct;
        *(GAS f32x4*)(Q + off) = v0; *(GAS f32x4*)(Q + off + 4) = v1;
    }
};
struct SplitK2Order {
    pg8::StaticOrder S;
    __device__ void init(int M, int N, int G_, int c_) { S.init(M, 2 * N, G_, c_); }
    __device__ bool next(int i, Unit& u) const { if (!S.next(i, u)) return false; u.ko = (u.pn >> 2) * 2048; u.kob = u.ko; u.pn &= 3; return true; }
    __device__ __forceinline__ void a_ready(const Unit&) const {}
    __device__ __forceinline__ void done(const Unit&) const {}
};

__device__ __forceinline__ void p2_norm_row(bf16* rowp, const float* gain, int grp  , bool rope, const float* ropetab  , int lane) {
    const v4u w0 = *(const GAS v4u*)(rowp + 16 * lane), w1 = *(const GAS v4u*)(rowp + 16 * lane + 8);
    float x[16];
    x[0] = bflo(w0.x); x[1] = bfhi(w0.x); x[2] = bflo(w0.y); x[3] = bfhi(w0.y); x[4] = bflo(w0.z); x[5] = bfhi(w0.z); x[6] = bflo(w0.w); x[7] = bfhi(w0.w);
    x[8] = bflo(w1.x); x[9] = bfhi(w1.x); x[10] = bflo(w1.y); x[11] = bfhi(w1.y); x[12] = bflo(w1.z); x[13] = bfhi(w1.z); x[14] = bflo(w1.w); x[15] = bfhi(w1.w);
    float ss = 0.f;
#pragma unroll
    for (int i = 0; i < 16; ++i) ss += x[i] * x[i];
    ss += __shfl_xor(ss, 1); ss += __shfl_xor(ss, 2); if (grp == 128) ss += __shfl_xor(ss, 4);
    const float r = 1.f / sqrtf(ss / (float)grp + EPS);
    const int d0 = (16 * lane) & (grp - 1);
#pragma unroll
    for (int i = 0; i < 16; i += 4) { const f32x4 g = *(const f32x4*)(gain + d0 + i); x[i] = x[i] * r * g[0]; x[i + 1] = x[i + 1] * r * g[1]; x[i + 2] = x[i + 2] * r * g[2]; x[i + 3] = x[i + 3] * r * g[3]; }
    if (rope && (lane & 3) == 0) {
#pragma unroll
        for (int i = 0; i < 8; ++i) { const float c = ropetab[2 * i], s = ropetab[2 * i + 1]; const float a = x[i], b = x[i + 8]; x[i] = a * c - b * s; x[i + 8] = b * c + a * s; }
    }
    v4u o0, o1;
    o0.x = pk2(x[0], x[1]); o0.y = pk2(x[2], x[3]); o0.z = pk2(x[4], x[5]); o0.w = pk2(x[6], x[7]); o1.x = pk2(x[8], x[9]); o1.y = pk2(x[10], x[11]); o1.z = pk2(x[12], x[13]); o1.w = pk2(x[14], x[15]);
    *(GAS v4u*)(rowp + 16 * lane) = o0; *(GAS v4u*)(rowp + 16 * lane + 8) = o1;
}
__device__ __forceinline__ void p1_tail(Frame& F) {
    unsigned char* ws = F.ws;
    if (F.gw < 16) {
        const float* lf = (const float*)(ws + WS_LOGF) + (size_t)F.gw * LSEQ; float* kb = (float*)(ws + WS_KBIAS) + (size_t)F.gw * LP;
        float carry = 0.f;
#pragma unroll 1
        for (int c0 = 0; c0 < LSEQ; c0 += 512) {
            float x[8];
#pragma unroll
            for (int u = 0; u < 8; ++u) { const int t = c0 + 64 * u + F.lane; x[u] = t < LSEQ ? lf[t] : 0.f; }
#pragma unroll
            for (int u = 0; u < 8; ++u) { float incl = x[u];
#pragma unroll
                for (int o = 1; o < 64; o <<= 1) { const float n = __shfl_up(incl, o); if (F.lane >= o) incl += n; }
                incl += carry; const int t = c0 + 64 * u + F.lane; if (t < LSEQ) kb[PADF + t] = -incl * 11.313708498984761f;
                carry = __shfl(incl, 63); }
        }
        if (F.lane < PADF) kb[F.lane] = -__builtin_inff();
    }
    { const int rtask = F.gw - 16;
      if (rtask >= 0 && rtask < 64) { const int arr = rtask >> 5, b = (rtask >> 4) & 1, t = rtask & 15;
          if (arr == 0) p2_norm_row((bf16*)(ws + WS_DK) + ((size_t)b * LP + PADF + t) * 1024, F.in[I_DKG], 64, true, (const float*)(ws + WS_ROPE) + (size_t)t * 16, F.lane);
          else p2_norm_row((bf16*)(ws + WS_FK) + ((size_t)b * LP + PADF + t) * 1024, F.in[I_FKG], 128, false, nullptr, F.lane); } }
}

__device__ const unsigned char ATT_TAB[32][4] = {
{0,95,69,112},{16,79,85,112},{32,94,70,112},{22,78,81,112},{4,36,77,112},{15,38,35,112},{55,93,65,112},{63,33,87,112},{61,6,21,112},{47,20,84,112},{13,42,1,112},{54,92,83,112},{41,18,75,112},{43,17,90,112},{62,7,19,112},{39,51,76,112},{45,71,82,112},{30,8,50,112},{46,40,2,112},{31,9,48,112},{28,53,86,112},{56,3,91,112},{10,57,37,112},{44,23,5,112},{29,73,64,112},{14,58,80,112},{12,11,49,112},{26,34,74,112},{60,72,66,112},{59,25,52,112},{89,88,67,112},{27,24,68,112}};
__device__ __forceinline__ att::BlockRef att_ref(unsigned char* ws, int x, int code, const float* qg64, const float* qg128) {
    const int hl = code >> 4, j = code & 15; att::BlockRef r; r.rope = (const float*)(ws + WS_ROPE);
    if (hl < 4) { const int dp = 2 * x + (hl >> 1), b = dp >> 3, h = dp & 7, i = hl & 1;
        r.Q = (const bf16*)(ws + WS_DQ) + ((size_t)b * SEQ + 256 * j) * 1024 + h * 128 + i * 64;
        r.K = (const bf16*)(ws + WS_DK) + (size_t)b * LP * 1024 + h * 128 + i * 64;
        r.V = (const bf16*)(ws + WS_DV) + (size_t)b * LP * 1024 + h * 128;
        r.KB = (const float*)(ws + WS_KBIAS) + (size_t)16 * LP;
        r.O = (bf16*)(ws + (i ? WS_O2 : WS_O1)) + ((size_t)b * SEQ + 256 * j) * 1024 + h * 128; r.dqk = 64; r.qg = qg64; }
    else { const int fh = 2 * x + (hl - 4), b = fh >> 3, h = fh & 7;
        r.Q = (const bf16*)(ws + WS_FQ) + ((size_t)b * SEQ + 256 * j) * 1024 + h * 128;
        r.K = (const bf16*)(ws + WS_FK) + (size_t)b * LP * 1024 + h * 128;
        r.V = (const bf16*)(ws + WS_FV) + (size_t)b * LP * 1024 + h * 128;
        r.KB = (const float*)(ws + WS_KBIAS) + (size_t)fh * LP;
        r.O = (bf16*)(ws + WS_OF) + ((size_t)b * SEQ + 256 * j) * 1024 + h * 128; r.dqk = 128; r.qg = qg128; }
    r.P0 = 64 + 256 * j; return r;
}
template <int ABL>
__device__ __forceinline__ void p3_attention(Frame& F, char* lds) {
    for (int v = F.vcu; v < 256; v += F.G) {
        const int x = v >> 5, slot = v & 31;
        int n = 0; while (n < 4 && ATT_TAB[slot][n] != 112) ++n;
        if (ABL == 0 && v == F.vcu && n < 2) { transpose_late_items(F, (LAS float*)(F.lds + RING_OFF + F.wave * 16384)); __syncthreads(); }
        if (n == 0) continue;
        for (int i = 0; i < n; ++i) {
            if (ABL == 0 && v == F.vcu && i > 0) {
                if (i == 1) { transpose_late_items(F, (LAS float*)(F.lds + RING_OFF + F.wave * 16384)); __syncthreads(); } }
            att::BlockRef cur = att_ref(F.ws, x, ATT_TAB[slot][i], F.in[I_DQG], F.in[I_FQG]);
            if (ABL != 0) cur.O = (bf16*)(F.ws + WS_XN) + (cur.O - (bf16*)(F.ws + (cur.dqk == 64 ? WS_O1 : WS_OF)) ) % ((size_t)MREAL * 1024);
            if (cur.dqk == 64) att::block<64, ABL>(cur, LP, lds); else att::block<128, ABL>(cur, LP, lds);
        }
    }
}
__device__ __forceinline__ float diff_lambda(Frame& F) {
    const float a = F.in[I_LQ1][F.lane] * F.in[I_LK1][F.lane], b = F.in[I_LQ2][F.lane] * F.in[I_LK2][F.lane];
    return __expf(wave_sum(a)) - __expf(wave_sum(b)) + 0.2f;
}
__device__ __forceinline__ void p4_combine(Frame& F) {
    const float lam = diff_lambda(F);
    const bf16* O1 = (const bf16*)(F.ws + WS_O1); const bf16* O2 = (const bf16*)(F.ws + WS_O2); bf16* OD = (bf16*)(F.ws + WS_OD);
    const float* g = F.in[I_SUBLN];
    const int d0 = (16 * F.lane) & 127;
    for (int m = F.gw; m < MREAL; m += F.NGW) {
        const size_t off = (size_t)m * 1024 + 16 * F.lane;
        const v4u a0 = *(const GAS v4u*)(O1 + off), a1 = *(const GAS v4u*)(O1 + off + 8), b0 = *(const GAS v4u*)(O2 + off), b1 = *(const GAS v4u*)(O2 + off + 8);
        float x[16];
        x[0] = bflo(a0.x) - lam * bflo(b0.x); x[1] = bfhi(a0.x) - lam * bfhi(b0.x); x[2] = bflo(a0.y) - lam * bflo(b0.y); x[3] = bfhi(a0.y) - lam * bfhi(b0.y);
        x[4] = bflo(a0.z) - lam * bflo(b0.z); x[5] = bfhi(a0.z) - lam * bfhi(b0.z); x[6] = bflo(a0.w) - lam * bflo(b0.w); x[7] = bfhi(a0.w) - lam * bfhi(b0.w);
        x[8] = bflo(a1.x) - lam * bflo(b1.x); x[9] = bfhi(a1.x) - lam * bfhi(b1.x); x[10] = bflo(a1.y) - lam * bflo(b1.y); x[11] = bfhi(a1.y) - lam * bfhi(b1.y);
        x[12] = bflo(a1.z) - lam * bflo(b1.z); x[13] = bfhi(a1.z) - lam * bfhi(b1.z); x[14] = bflo(a1.w) - lam * bflo(b1.w); x[15] = bfhi(a1.w) - lam * bfhi(b1.w);
        float ss = 0.f;
#pragma unroll
        for (int i = 0; i < 16; ++i) ss += x[i] * x[i];
        ss += __shfl_xor(ss, 1); ss += __shfl_xor(ss, 2); ss += __shfl_xor(ss, 4);
        const float r = 0.8f / sqrtf(ss * (1.f / 128.f) + EPS);
#pragma unroll
        for (int i = 0; i < 16; i += 4) { const f32x4 gg = *(const f32x4*)(g + d0 + i); x[i] *= r * gg[0]; x[i + 1] *= r * gg[1]; x[i + 2] *= r * gg[2]; x[i + 3] *= r * gg[3]; }
        v4u o0, o1;
        o0.x = pk2(x[0], x[1]); o0.y = pk2(x[2], x[3]); o0.z = pk2(x[4], x[5]); o0.w = pk2(x[6], x[7]); o1.x = pk2(x[8], x[9]); o1.y = pk2(x[10], x[11]); o1.z = pk2(x[12], x[13]); o1.w = pk2(x[14], x[15]);
        *(GAS v4u*)(OD + off) = o0; *(GAS v4u*)(OD + off + 8) = o1;
    }
}
__device__ __forceinline__ unsigned f2ord(float f) { const unsigned u = __float_as_uint(f); return u ^ ((unsigned)((int)u >> 31) | 0x80000000u); }
__device__ __forceinline__ float ord2f(unsigned k) { const unsigned m = (unsigned)((int)(~k) >> 31) | 0x80000000u; return __uint_as_float(k ^ m); }
__device__ __forceinline__ void sort16_desc(unsigned (&a)[16]) {
#pragma unroll
    for (int k = 2; k <= 16; k <<= 1)
#pragma unroll
        for (int j = k >> 1; j > 0; j >>= 1)
#pragma unroll
            for (int i = 0; i < 16; ++i) { const int l = i ^ j; if (l > i) { const bool desc = (i & k) == 0; const unsigned hi_ = max(a[i], a[l]), lo_ = min(a[i], a[l]); a[i] = desc ? hi_ : lo_; a[l] = desc ? lo_ : hi_; } }
}
__device__ __forceinline__ void merge_top16(unsigned (&a)[16], const unsigned (&b)[16]) {
#pragma unroll
    for (int i = 0; i < 16; ++i) a[i] = max(a[i], b[15 - i]);
#pragma unroll
    for (int j = 8; j > 0; j >>= 1)
#pragma unroll
        for (int i = 0; i < 16; ++i) { const int l = i ^ j; if (l > i) { const unsigned hi_ = max(a[i], a[l]), lo_ = min(a[i], a[l]); a[i] = hi_; a[l] = lo_; } }
}
__device__ __forceinline__ void p9_route(Frame& F) {
    typedef float f32x16 __attribute__((ext_vector_type(16)));
    const float* QP0 = (const float*)(F.ws + WS_QP); const float* QP1 = QP0 + 1024;        const float* SSQ = (const float*)(F.ws + WS_SSQ);
    const bf16* SKH = (const bf16*)(F.ws + WS_SKH); const bf16* SKL = (const bf16*)(F.ws + WS_SKL);
    int* IDX = (int*)(F.ws + WS_IDX); float* GATE = (float*)(F.ws + WS_GATE);
    LAS int* XI = (LAS int*)(F.lds + RING_OFF) + F.wave * (64 * 33);
    const int r32 = F.lane & 31, hi = F.lane >> 5;
    for (int task = F.gw; task < PEER_H * (MREAL / 32); task += F.NGW) {
        const int h = task & 7, tok = (task >> 3) * 32 + r32;
        float rs;
        { const GAS f32x4* sp = (const GAS f32x4*)(SSQ + (size_t)tok * 32); f32x4 t = sp[0];
#pragma unroll
          for (int i = 1; i < 8; ++i) t += sp[i];
          rs = 1.f / sqrtf(((t[0] + t[1]) + (t[2] + t[3])) * (1.f / DM) + EPS); }
        if (h == 0 && hi == 0) ((float*)(F.ws + WS_RS))[tok] = rs;
        unsigned T[2][16];
#pragma unroll
        for (int c = 0; c < 2; ++c) {
            f32x16 acc[4];
#pragma unroll
            for (int kb = 0; kb < 4; ++kb) acc[kb] = f32x16{};
            const size_t qoff = (size_t)tok * 2048 + h * 128 + c * 64 + 8 * hi;
            const size_t koff = ((size_t)(h * 2 + c) * 128 + r32) * 64 + 8 * hi;
#pragma unroll
            for (int ks = 0; ks < 4; ++ks) {
                bf16x8 qh, ql;
                { const GAS f32x4* a0 = (const GAS f32x4*)(QP0 + qoff + 16 * ks); const GAS f32x4* a1 = (const GAS f32x4*)(QP1 + qoff + 16 * ks);
                  const f32x4 q0 = (a0[0] + a1[0]) * rs, q1 = (a0[1] + a1[1]) * rs;
                  const v4u hw = pack8bf(q0, q1);
                  f32x4 l0, l1;
                  l0[0] = q0[0] - bflo(hw.x); l0[1] = q0[1] - bfhi(hw.x); l0[2] = q0[2] - bflo(hw.y); l0[3] = q0[3] - bfhi(hw.y);
                  l1[0] = q1[0] - bflo(hw.z); l1[1] = q1[1] - bfhi(hw.z); l1[2] = q1[2] - bflo(hw.w); l1[3] = q1[3] - bfhi(hw.w);
                  const v4u lw = pack8bf(l0, l1);
                  qh = __builtin_bit_cast(bf16x8, hw); ql = __builtin_bit_cast(bf16x8, lw); }
#pragma unroll
                for (int kb = 0; kb < 4; ++kb) {
                    const bf16x8 kh = *(const GAS bf16x8*)(SKH + koff + (size_t)kb * 32 * 64 + 16 * ks), kl = *(const GAS bf16x8*)(SKL + koff + (size_t)kb * 32 * 64 + 16 * ks);
                    acc[kb] = __builtin_amdgcn_mfma_f32_32x32x16_bf16(kh, qh, acc[kb], 0, 0, 0);
                    acc[kb] = __builtin_amdgcn_mfma_f32_32x32x16_bf16(kh, ql, acc[kb], 0, 0, 0);
                    acc[kb] = __builtin_amdgcn_mfma_f32_32x32x16_bf16(kl, qh, acc[kb], 0, 0, 0);
                }
                __builtin_amdgcn_sched_barrier(0);
            }
            unsigned G[4][16];
#pragma unroll
            for (int kb = 0; kb < 4; ++kb) {
#pragma unroll
                for (int r = 0; r < 16; ++r) { const int n = 32 * kb + (r & 3) + 8 * (r >> 2) + 4 * hi; G[kb][r] = (f2ord(acc[kb][r]) & ~0x7Fu) | (unsigned)(127 - n); }
                sort16_desc(G[kb]); }
            merge_top16(G[0], G[1]); merge_top16(G[2], G[3]); merge_top16(G[0], G[2]);
            unsigned P[16];
#pragma unroll
            for (int j = 0; j < 16; ++j) { auto rr = __builtin_amdgcn_permlane32_swap(G[0][j], G[0][j], false, false); P[j] = hi ? rr[0] : rr[1]; }
            merge_top16(G[0], P);
            unsigned (&L)[16] = G[0];
#pragma unroll
            for (int j = 0; j < 16; ++j) T[c][j] = L[j];
        }
        float v1[16], v2[16];
#pragma unroll
        for (int j = 0; j < 16; ++j) { v1[j] = ord2f(T[0][j] & ~0x7Fu); v2[j] = ord2f(T[1][j] & ~0x7Fu);
            XI[F.lane * 33 + j] = 127 - (int)(T[0][j] & 0x7Fu); XI[F.lane * 33 + 16 + j] = 127 - (int)(T[1][j] & 0x7Fu); }
        unsigned Bst[16], C1[16], C2[16], C3[16];
#pragma unroll
        for (int j = 0; j < 16; ++j) { Bst[j] = (f2ord(v1[0] + v2[j]) & ~0xFFu) | (unsigned)(255 - j); C1[j] = 0u; C2[j] = 0u; C3[j] = 0u; }
        { int cnt = 0;
#pragma unroll
          for (int a = 1; a < 16; ++a)
#pragma unroll
            for (int b = 0; b < 16; ++b) if ((a + 1) * (b + 1) <= 16) { const unsigned key = (f2ord(v1[a] + v2[b]) & ~0xFFu) | (unsigned)(255 - (a * 16 + b));
                if (cnt < 16) C1[cnt] = key; else if (cnt < 32) C2[cnt - 16] = key; else C3[cnt - 32] = key; ++cnt; } }
        sort16_desc(C1); sort16_desc(C2); sort16_desc(C3);
        merge_top16(Bst, C1); merge_top16(C2, C3); merge_top16(Bst, C2);
        float e[16], sum = 0.f; const float top = ord2f(Bst[0] & ~0xFFu);
#pragma unroll
        for (int j = 0; j < 16; ++j) { e[j] = __expf(ord2f(Bst[j] & ~0xFFu) - top); sum += e[j]; }
        const float rsum = 1.f / sum;
        LDS_WAIT();
        if (hi == 0) {
            GAS unsigned short* io = (GAS unsigned short*)IDX + (size_t)tok * 128 + h * 16; GAS float* go = (GAS float*)(GATE + (size_t)tok * 128 + h * 16);
#pragma unroll
            for (int j = 0; j < 16; ++j) { const int ab = 255 - (int)(Bst[j] & 0xFFu); const int i1 = XI[F.lane * 33 + (ab >> 4)], i2 = XI[F.lane * 33 + 16 + (ab & 15)];
                io[j] = (unsigned short)(i1 * 128 + i2); go[j] = e[j] * rsum; }
        }
        LDS_WAIT();
    }
}
typedef float f32x2 __attribute__((ext_vector_type(2)));
typedef float f32x32 __attribute__((ext_vector_type(32)));
typedef unsigned u32x6 __attribute__((ext_vector_type(6)));
typedef unsigned u32x16 __attribute__((ext_vector_type(16)));
typedef __bf16 bf16x32_t __attribute__((ext_vector_type(32)));
typedef __bf16 bf16x2_t __attribute__((ext_vector_type(2)));
__device__ __forceinline__ float gelu1(float v) {
    const float av = fabsf(v), t = __builtin_amdgcn_rcpf(av * 0.2316418882f + 1.0f);
    float q = t * 0.5307027145f + (-0.7265760135f); q = q * t + 0.7107068705f; q = q * t + (-0.142248368f); q = q * t + 0.127414796f; q = q * t;
    const float e = __builtin_amdgcn_exp2f((v * v) * (-0.72134752044f));
    const float m = v * (q * e);
    return v < 0.f ? m : v - m;
}

__device__ __forceinline__ float dot32(const float* hf, const v4u& r) {
    float s0 = 0.f, s1 = 0.f;
#define D8(W, T) { const f32x2 a_ = __builtin_amdgcn_cvt_scalef32_pk_f32_fp4((W), 1.0f, 0), b_ = __builtin_amdgcn_cvt_scalef32_pk_f32_fp4((W), 1.0f, 1), \
                               c_ = __builtin_amdgcn_cvt_scalef32_pk_f32_fp4((W), 1.0f, 2), d_ = __builtin_amdgcn_cvt_scalef32_pk_f32_fp4((W), 1.0f, 3); \
                   s0 += hf[T] * a_.x; s1 += hf[T + 1] * a_.y; s0 += hf[T + 2] * b_.x; s1 += hf[T + 3] * b_.y; s0 += hf[T + 4] * c_.x; s1 += hf[T + 5] * c_.y; s0 += hf[T + 6] * d_.x; s1 += hf[T + 7] * d_.y; }
    D8(r.x, 0) D8(r.y, 8) D8(r.z, 16) D8(r.w, 24)
#undef D8
    return s0 + s1;
}
__device__ __forceinline__ void axpy32(float* acc, float w, const v4u& r) {
#define A8(W, T) { const f32x2 a_ = __builtin_amdgcn_cvt_scalef32_pk_f32_fp4((W), 1.0f, 0), b_ = __builtin_amdgcn_cvt_scalef32_pk_f32_fp4((W), 1.0f, 1), \
                               c_ = __builtin_amdgcn_cvt_scalef32_pk_f32_fp4((W), 1.0f, 2), d_ = __builtin_amdgcn_cvt_scalef32_pk_f32_fp4((W), 1.0f, 3); \
                   acc[T] += w * a_.x; acc[T + 1] += w * a_.y; acc[T + 2] += w * b_.x; acc[T + 3] += w * b_.y; acc[T + 4] += w * c_.x; acc[T + 5] += w * c_.y; acc[T + 6] += w * d_.x; acc[T + 7] += w * d_.y; }
    A8(r.x, 0) A8(r.y, 8) A8(r.z, 16) A8(r.w, 24)
#undef A8
}
__device__ __forceinline__ void p10a_udots(Frame& F) {
    typedef int i32x8 __attribute__((ext_vector_type(8)));
    typedef float f32x16 __attribute__((ext_vector_type(16)));
    const bf16* H2N = (const bf16*)(F.ws + WS_H2N); const int* IDX = (const int*)(F.ws + WS_IDX);
    const unsigned char* EU = F.ws + WS_EU; float* PART = (float*)(F.ws + WS_PART);
    LAS unsigned char* wl = F.lds + F.wave * 6144;
    const int l8 = F.lane >> 3, p8 = F.lane & 7;
    const int r32 = F.lane & 31, half = F.lane >> 5;
    int t0, tend, tstep;
    if (F.G % 8 == 0) { const int per = F.G / 8, x = F.vcu / per; t0 = x * MREAL + (F.vcu % per) * NWAVES + F.wave; tend = (x + 1) * MREAL; tstep = per * NWAVES; }
    else { t0 = F.gw; tend = 8 * MREAL; tstep = F.NGW; }
    int zv = 0; asm volatile("" : "+v"(zv));
    const float* RS = (const float*)(F.ws + WS_RS) + zv;
#define PA_CL(T) ((T) < tlast ? (T) : tlast)
#define PA_IDX(I, T) do { const int tk_ = (T) & (MREAL - 1); const GAS v4u* ip_ = (const GAS v4u*)((const unsigned short*)IDX + (size_t)tk_ * 128 + l8 * 16);     \
        _Pragma("unroll") for (int c_ = 0; c_ < 2; ++c_) { const v4u v_ = ip_[c_]; I[8 * c_] = (int)(v_.x & 0xFFFFu); I[8 * c_ + 1] = (int)(v_.x >> 16); I[8 * c_ + 2] = (int)(v_.y & 0xFFFFu); I[8 * c_ + 3] = (int)(v_.y >> 16); \
            I[8 * c_ + 4] = (int)(v_.z & 0xFFFFu); I[8 * c_ + 5] = (int)(v_.z >> 16); I[8 * c_ + 6] = (int)(v_.w & 0xFFFFu); I[8 * c_ + 7] = (int)(v_.w >> 16); } } while (0)
#define PA_LN(A, I, RB, T) do { const int xs_ = (T) >> 13; _Pragma("unroll") for (int g_ = 0; g_ < 4; ++g_) A[RB][g_] = *(const GAS v4u*)(EU + (size_t)xs_ * ((size_t)NEXP * 128) + (size_t)(unsigned)I[4 * (RB) + g_] * 128 + p8 * 16); } while (0)
#define PA_H(HW, RSV, T) do { const int tk_ = (T) & (MREAL - 1), xs_ = (T) >> 13; HW = *(const GAS unsigned long long*)(H2N + (size_t)tk_ * DM + xs_ * 256 + 4 * F.lane); RSV = RS[tk_]; } while (0)
#define PA_W(AC, RB) do { _Pragma("unroll") for (int g_ = 0; g_ < 4; ++g_) *(LAS v4u*)(wl + 1536 + (8 * g_ + l8) * 144 + p8 * 16) = AC[RB][g_]; asm volatile("" ::: "memory"); } while (0)
#define PA_R(AR) do { _Pragma("unroll") for (int s_ = 0; s_ < 4; ++s_) AR[s_] = *(const LAS v4u*)(wl + 1536 + r32 * 144 + half * 64 + s_ * 16); asm volatile("" ::: "memory"); } while (0)
#define PA_M(AR, ACC) do { _Pragma("unroll") for (int i_ = 0; i_ < 16; ++i_) ACC[i_] = 0.f; \
        _Pragma("unroll") for (int s_ = 0; s_ < 4; ++s_) { const i32x8 a_ = (i32x8){(int)AR[s_].x, (int)AR[s_].y, (int)AR[s_].z, (int)AR[s_].w, 0, 0, 0, 0}; \
            ACC = __builtin_amdgcn_mfma_scale_f32_32x32x64_f8f6f4(a_, B_[s_], ACC, 4, 0, 0, 0x7F7F7F7F, 0, 0x7F7F7F7F); } \
        asm volatile("" : "+v"(ACC)); } while (0)
#define PA_D(RB, ACC) do { if (r32 < 2) { LAS f32x4* dp_ = (LAS f32x4*)(wl + 512 + r32 * 512 + ((RB) * 32 + 4 * half) * 4); \
        _Pragma("unroll") for (int g_ = 0; g_ < 4; ++g_) dp_[2 * g_] = (f32x4){ACC[4 * g_], ACC[4 * g_ + 1], ACC[4 * g_ + 2], ACC[4 * g_ + 3]}; } } while (0)
#define PA_SB() __builtin_amdgcn_sched_barrier(0)
#define PA_TASK(AC, AN, I1, I2, HWC, RSC, HWN, RSN, T) do { \
        const int tn_ = PA_CL((T) + tstep), tn2_ = PA_CL((T) + 2 * tstep); \
        PA_H(HWN, RSN, tn_); PA_IDX(I2, tn2_); \
        {   const float x0 = bflo((unsigned)HWC) * RSC, x1 = bfhi((unsigned)HWC) * RSC, x2 = bflo((unsigned)(HWC >> 32)) * RSC, x3 = bfhi((unsigned)(HWC >> 32)) * RSC; \
            int hi_ = 0; hi_ = __builtin_amdgcn_cvt_pk_fp8_f32(x0, x1, hi_, false); hi_ = __builtin_amdgcn_cvt_pk_fp8_f32(x2, x3, hi_, true); \
            const f32x2 b0_ = __builtin_amdgcn_cvt_pk_f32_fp8(hi_, false), b1_ = __builtin_amdgcn_cvt_pk_f32_fp8(hi_, true); \
            int lo_ = 0; lo_ = __builtin_amdgcn_cvt_pk_fp8_f32((x0 - b0_.x) * 16.f, (x1 - b0_.y) * 16.f, lo_, false); lo_ = __builtin_amdgcn_cvt_pk_fp8_f32((x2 - b1_.x) * 16.f, (x3 - b1_.y) * 16.f, lo_, true); \
              \
            LAS int* bp_ = (LAS int*)(wl + ((((F.lane >> 2) & 1) * 4 + ((F.lane >> 3) & 3)) * 64 + (F.lane >> 5) * 16 + 4 * (F.lane & 3))); bp_[0] = hi_; bp_[8] = lo_; } \
        asm volatile("" ::: "memory"); \
        i32x8 B_[4]; \
        _Pragma("unroll") for (int s_ = 0; s_ < 4; ++s_) { const LAS v4u* q_ = (const LAS v4u*)(wl + (half * 4 + s_) * 64 + (r32 & 1) * 32); const v4u c0_ = q_[0], c1_ = q_[1]; \
            B_[s_] = (i32x8){(int)c0_.x, (int)c0_.y, (int)c0_.z, (int)c0_.w, (int)c1_.x, (int)c1_.y, (int)c1_.z, (int)c1_.w}; } \
        asm volatile("" ::: "memory"); \
        v4u ar0_[4], ar1_[4]; f32x16 ac0_, ac1_; \
        PA_LN(AN, I1, 0, tn_); PA_W(AC, 0); PA_R(ar0_); PA_SB(); \
        PA_LN(AN, I1, 1, tn_); PA_W(AC, 1); PA_R(ar1_); PA_SB(); \
        PA_M(ar0_, ac0_); PA_SB(); \
        PA_LN(AN, I1, 2, tn_); PA_W(AC, 2); PA_R(ar0_); PA_SB(); \
        PA_M(ar1_, ac1_); PA_SB(); \
        PA_D(0, ac0_); PA_SB(); \
        PA_LN(AN, I1, 3, tn_); PA_W(AC, 3); PA_R(ar1_); PA_SB(); \
        PA_M(ar0_, ac0_); PA_SB(); \
        PA_D(1, ac1_); PA_SB(); \
        PA_M(ar1_, ac1_); PA_SB(); \
        PA_D(2, ac0_); PA_D(3, ac1_); \
        asm volatile("" ::: "memory"); \
        {   const LAS f32x2* rp_ = (const LAS f32x2*)(wl + 512) + F.lane; const f32x2 h_ = rp_[0], l_ = rp_[64]; \
            *(GAS f32x2*)(PART + ((size_t)((T) & (MREAL - 1)) * 8 + ((T) >> 13)) * 128 + 2 * F.lane) = (f32x2){h_.x + l_.x * 0.0625f, h_.y + l_.y * 0.0625f}; } \
        asm volatile("" ::: "memory"); \
    } while (0)
    if (t0 < tend) {
        const int tlast = t0 + ((tend - 1 - t0) / tstep) * tstep;
        v4u A0[4][4], A1[4][4]; int I0[16], I1[16]; unsigned long long HW0, HW1; float RS0, RS1;
        PA_IDX(I0, t0); PA_H(HW0, RS0, t0);
        { const int t1_ = PA_CL(t0 + tstep); PA_IDX(I1, t1_); }
        PA_LN(A0, I0, 0, t0); PA_LN(A0, I0, 1, t0); PA_LN(A0, I0, 2, t0); PA_LN(A0, I0, 3, t0);
#pragma unroll 1
        for (int t = t0; t < tend; t += 2 * tstep) {
            PA_TASK(A0, A1, I1, I0, HW0, RS0, HW1, RS1, t);
            { const int tb_ = PA_CL(t + tstep); PA_TASK(A1, A0, I0, I1, HW1, RS1, HW0, RS0, tb_); }
        }
    }
#undef PA_LN
#undef PA_W
#undef PA_R
#undef PA_M
#undef PA_D
#undef PA_SB
#undef PA_CL
#undef PA_IDX
#undef PA_H
#undef PA_TASK
}

__device__ __forceinline__ void p10_experts(Frame& F, float* dst) {
    const int* IDX = (const int*)(F.ws + WS_IDX); const float* GATE = (const float*)(F.ws + WS_GATE);
    const unsigned char* EV = F.ws + WS_EV; const float* PART = (const float*)(F.ws + WS_PART);
    const float* SU = (const float*)(F.ws + WS_SU); const float* SV = (const float*)(F.ws + WS_SV);
    for (int tok = F.gw; tok < MREAL; tok += F.NGW) {
        const int e0 = ((const unsigned short*)IDX)[(size_t)tok * 128 + F.lane], e1 = ((const unsigned short*)IDX)[(size_t)tok * 128 + 64 + F.lane];
        float d0 = 0.f, d1 = 0.f;
        const int pk = ((F.lane >> 2) & 3) * 32 + 8 * (F.lane & 3) + (F.lane >> 4);
#pragma unroll
        for (int x = 0; x < 8; ++x) { const float* pp = PART + ((size_t)tok * 8 + x) * 128;        d0 += pp[pk]; d1 += pp[pk + 4]; }
        const float w0 = GATE[(size_t)tok * 128 + F.lane] * SV[e0] * gelu1(d0 * SU[e0]), w1 = GATE[(size_t)tok * 128 + 64 + F.lane] * SV[e1] * gelu1(d1 * SU[e1]);
        float acc[32];
#pragma unroll
        for (int i = 0; i < 32; ++i) acc[i] = 0.f;
#define EIDX(k) __builtin_amdgcn_readlane((k) < 64 ? e0 : e1, (k) & 63)
#define WK(k) __int_as_float(__builtin_amdgcn_readlane(__float_as_int((k) < 64 ? w0 : w1), (k) & 63))
#define LOADV(R, k0) do { _Pragma("unroll") for (int i_ = 0; i_ < 4; ++i_) R[i_] = *(const GAS v4u*)(EV + (size_t)EIDX((k0) + i_) * 1024 + 16 * F.lane); } while (0)
        v4u Va[4], Vb[4];
        LOADV(Va, 0);
#pragma unroll 1
        for (int b = 0; b < 32; b += 2) {
            const int k0 = 4 * b;
            LOADV(Vb, k0 + 4);
            __builtin_amdgcn_sched_barrier(0);
#pragma unroll
            for (int i = 0; i < 4; ++i) { axpy32(acc, WK(k0 + i), Va[i]); __builtin_amdgcn_sched_barrier(0); }
            if (b + 2 < 32) LOADV(Va, k0 + 8);
            __builtin_amdgcn_sched_barrier(0);
#pragma unroll
            for (int i = 0; i < 4; ++i) { axpy32(acc, WK(k0 + 4 + i), Vb[i]); __builtin_amdgcn_sched_barrier(0); }
        }
#undef EIDX
#undef WK
#undef LOADV
        { GAS f32x4* op = (GAS f32x4*)(F.out + (size_t)tok * DM) + F.lane; GAS f32x4* dp = (GAS f32x4*)(dst + (size_t)tok * DM) + F.lane;
#pragma unroll
          for (int j = 0; j < 8; ++j) { f32x4 a = __builtin_nontemporal_load(op + 64 * j);
              a[0] += acc[4 * j]; a[1] += acc[4 * j + 1]; a[2] += acc[4 * j + 2]; a[3] += acc[4 * j + 3]; __builtin_nontemporal_store(a, dp + 64 * j); } }
    }
}
struct Args { const float* in[23]; float* out; unsigned char* ws; int ph_lo, ph_hi, li, pad; };
__global__ void __launch_bounds__(NWAVES * 64, 2) mega_fwd(Args args) {
    extern __shared__ __attribute__((aligned(16))) unsigned char lds[];
    Frame F;
    F.lds = (LAS unsigned char*)lds;
    F.MISC = (volatile LAS unsigned*)(F.lds + MISC_OFF);
    F.tid = threadIdx.x; F.lane = F.tid & 63; F.wave = __builtin_amdgcn_readfirstlane(F.tid >> 6);
    F.G = gridDim.x; { const int bx = blockIdx.x; F.vcu = (F.G % 8 == 0) ? (bx % 8) * (F.G / 8) + bx / 8 : bx; }
    F.gw = F.vcu * NWAVES + F.wave; F.NGW = F.G * NWAVES;
#pragma unroll
    for (int i = 0; i < 23; ++i) F.in[i] = args.in[i];
    F.out = args.out; F.ws = args.ws;
    F.ctl = (gu32*)(args.ws + WS_CTL);
    for (int u = F.tid; u < (LDS_BYTES - LDSCTL_OFF) / 4; u += NWAVES * 64) ((LAS unsigned*)(F.lds + LDSCTL_OFF))[u] = 0u;
    __syncthreads();
    XcdBarrier bar; bar.bar = (unsigned*)(F.ctl + CW_BAR); bar.x = 0; bar.st = nullptr;
    if (N_LAUNCHES == 1) bar = xcd_barrier_post((unsigned*)(F.ctl + CW_BAR), F.MISC + 8);
#define GRID_BAR(seam) do { if (N_LAUNCHES != 1) { if (F.tid == 0) __hip_atomic_store(F.ctl + CW_TMO, 0xBADBA0u | (unsigned)(seam), RLX_AGENT); } else { xcd_barrier(bar); } } while (0)
    const int lo = args.ph_lo, hi = args.ph_hi;
#ifndef PH_MASK
#define PH_MASK 0x7ff
#endif
#define IN(k) ((((PH_MASK) >> (k)) & 1) && lo <= (k) && (k) < hi)
#define BOTH(k) (IN(k) && IN((k) + (((k) == 6 || (k) == 1) ? 2 : 1)))
#ifndef PH_REP_MASK
#define PH_REP_MASK 0
#endif
#define REPEAT(k) for (int rep_ = 0; rep_ < ((((PH_REP_MASK) >> (k)) & 1) ? 2 : 1); ++rep_)
    unsigned char* ws = args.ws;
    typedef pg8::bf16_t pb;
    if (IN(0)) { REPEAT(0) { p0_prologue(F); __syncthreads(); } if (BOTH(0)) GRID_BAR(0); }
    if (IN(1)) { REPEAT(1) {
        pg8::Gemm g{(const pb*)(ws + WS_XN), (const pb*)(ws + WS_WIN), M1, N1, DM, DM}; pg8::StaticOrder S; S.init(M1, N1, F.G, (int)blockIdx.x);
        Epi1 E{ws, (LAS float*)(F.lds + RING_BYTES), F.in[I_DKG], F.in[I_FKG], F.in[I_EU], F.in[I_EV], F.lane, F.gw, F.NGW, F.vcu & 3, 0};
        pg8::gemm_phase<Epi1, pg8::StaticOrder, true, PG8_SP2>(F.lds + RING_OFF, g, S, E); }
        p1_tail(F);
        if (BOTH(1)) GRID_BAR(1);
    }
    if (IN(3)) { p3_attention<0>(F, (char*)lds + RING_OFF);
#if (PH_REP_MASK >> 3) & 1
        p3_attention<ATT_ABL>(F, (char*)lds + RING_OFF);
#endif
        if (BOTH(3)) GRID_BAR(3); }
    if (IN(4)) { REPEAT(4) { p4_combine(F); } if (BOTH(4)) GRID_BAR(4);
#if (PH_REP_MASK >> 11) & 1
        for (int xb_ = 0; xb_ < 10; ++xb_) GRID_BAR(4);
#endif
    }
    if (IN(5)) {
        { pg8::Gemm g{(const pb*)(ws + WS_OD), (const pb*)(ws + WS_WBD), MREAL, DM, 1024, 1024}; pg8::StaticOrder S; S.init(MREAL, DM, F.G, (int)blockIdx.x);
          pg8::EpiGen<F_Gemm2a> E{F_Gemm2a{(const bf16*)(ws + WS_GA), F.in[I_BGATE], (bf16*)(ws + WS_MG)}};
          pg8::gemm_phase<pg8::EpiGen<F_Gemm2a>, pg8::StaticOrder, PG8_ALIGN, PG8_SP2>(F.lds + RING_OFF, g, S, E); }
        { pg8::Gemm g{(const pb*)(ws + WS_OF), (const pb*)(ws + WS_WBF), MREAL, DM, 1024, 1024}; pg8::StaticOrder S; S.init(MREAL, DM, F.G, (int)blockIdx.x);
          pg8::EpiGen<F_Gemm2b> E{F_Gemm2b{(const bf16*)(ws + WS_GB), F.in[I_BGATE] + DM, (bf16*)(ws + WS_MG)}};
          pg8::gemm_phase<pg8::EpiGen<F_Gemm2b>, pg8::StaticOrder, PG8_ALIGN, PG8_SP2>(F.lds + RING_OFF, g, S, E); }
#if (PH_REP_MASK >> 5) & 1
        { pg8::Gemm g{(const pb*)(ws + WS_OD), (const pb*)(ws + WS_WBD), MREAL, DM, 1024, 1024}; pg8::StaticOrder S; S.init(MREAL, DM, F.G, (int)blockIdx.x);
          pg8::EpiGen<F_Gemm2a> E{F_Gemm2a{(const bf16*)(ws + WS_GA), F.in[I_BGATE], (bf16*)(ws + WS_MG)}};
          pg8::gemm_phase<pg8::EpiGen<F_Gemm2a>, pg8::StaticOrder, PG8_ALIGN, PG8_SP2>(F.lds + RING_OFF, g, S, E); }
        { pg8::Gemm g{(const pb*)(ws + WS_OF), (const pb*)(ws + WS_WBF), MREAL, DM, 1024, 1024}; pg8::StaticOrder S; S.init(MREAL, DM, F.G, (int)blockIdx.x);
          pg8::EpiGen<F_Gemm2b> E{F_Gemm2b{(const bf16*)(ws + WS_GB), F.in[I_BGATE] + DM, (bf16*)(ws + WS_MG)}};
          pg8::gemm_phase<pg8::EpiGen<F_Gemm2b>, pg8::StaticOrder, PG8_ALIGN, PG8_SP2>(F.lds + RING_OFF, g, S, E); }
#endif
        if (BOTH(5)) GRID_BAR(5);
    }
    if (IN(6)) {
        {
        pg8::Gemm g{(const pb*)(ws + WS_MG), (const pb*)(ws + WS_WOUT), MREAL, DM, DM, DM}; pg8::StaticOrder S; S.init(MREAL, DM, F.G, (int)blockIdx.x);
        pg8::EpiGen<F_Gemm3> E{F_Gemm3{F.in[I_X], F.out, F.in[I_GPEER], (bf16*)(ws + WS_H2N), (float*)(ws + WS_SSQ), 0.f}};
        pg8::gemm_phase<pg8::EpiGen<F_Gemm3>, pg8::StaticOrder, PG8_ALIGN, PG8_SP2>(F.lds + RING_OFF, g, S, E);
        }
#if (PH_REP_MASK >> 6) & 1
        {
        pg8::Gemm g{(const pb*)(ws + WS_MG), (const pb*)(ws + WS_WOUT), MREAL, DM, DM, DM}; pg8::StaticOrder S; S.init(MREAL, DM, F.G, (int)blockIdx.x);
        pg8::EpiGen<F_Gemm3> E{F_Gemm3{F.in[I_X], F.out, F.in[I_GPEER], (bf16*)(ws + WS_H2N), (float*)(ws + WS_SSQ), 0.f}};
        pg8::gemm_phase<pg8::EpiGen<F_Gemm3>, pg8::StaticOrder, PG8_ALIGN, PG8_SP2>(F.lds + RING_OFF, g, S, E);
        }
#endif
        if (BOTH(6)) GRID_BAR(6);
    }
    if (IN(8)) {
        {
        pg8::Gemm g{(const pb*)(ws + WS_H2N), (const pb*)(ws + WS_WPQ), MREAL, 1024, 1024, DM}; SplitK2Order S; S.init(MREAL, 1024, F.G, (int)blockIdx.x);
        pg8::EpiGen<F_Gemm4> E{F_Gemm4{(float*)(ws + WS_QP)}};
        pg8::gemm_phase<pg8::EpiGen<F_Gemm4>, SplitK2Order, PG8_ALIGN, PG8_SP2>(F.lds + RING_OFF, g, S, E);
        }
#if (PH_REP_MASK >> 8) & 1
        {
        pg8::Gemm g{(const pb*)(ws + WS_H2N), (const pb*)(ws + WS_WPQ), MREAL, 1024, 1024, DM}; SplitK2Order S; S.init(MREAL, 1024, F.G, (int)blockIdx.x);
        pg8::EpiGen<F_Gemm4> E{F_Gemm4{(float*)(ws + WS_QP)}};
        pg8::gemm_phase<pg8::EpiGen<F_Gemm4>, SplitK2Order, PG8_ALIGN, PG8_SP2>(F.lds + RING_OFF, g, S, E);
        }
#endif
        if (BOTH(8)) GRID_BAR(8);
    }
    if (IN(9)) { REPEAT(9) { p9_route(F); } if (BOTH(9)) GRID_BAR(9); }
    if (IN(10)) { for (int rp_ = 0; rp_ < ((((PH_REP_MASK) >> 12) & 1) ? 2 : 1); ++rp_) p10a_udots(F); GRID_BAR(10); REPEAT(10) { p10_experts(F, (rep_ == 0 && ((PH_REP_MASK >> 10) & 1)) ? (float*)(ws + WS_T) : F.out); } }
#undef IN
#undef BOTH
}

extern "C" void kernel_launch(void* const* d_in, const int* in_sizes, int n_in, void* d_out, int out_size, void* d_ws, size_t ws_size, hipStream_t stream) {
    static int grid = 0;
    if (grid == 0) {
        if (n_in != 23 || in_sizes[0] != MREAL * DM || out_size != MREAL * DM || ws_size < WS_END) {
            fprintf(stderr, "kernel_launch: built for 23 inputs, x/out of %d floats, >= %zu bytes of workspace; got n_in %d, in0 %d, out %d, ws %zu; nothing launched\n", MREAL * DM, (size_t)WS_END, n_in, n_in > 0 ? in_sizes[0] : -1, out_size, ws_size); grid = -1; return; }
        int dev = 0, cus = 0, per_cu = 0;
        if (hipGetDevice(&dev) != hipSuccess || hipDeviceGetAttribute(&cus, hipDeviceAttributeMultiprocessorCount, dev) != hipSuccess) { fprintf(stderr, "kernel_launch: device query failed\n"); grid = -1; return; }
        if (hipFuncSetAttribute((const void*)mega_fwd, hipFuncAttributeMaxDynamicSharedMemorySize, LDS_BYTES) != hipSuccess) { fprintf(stderr, "kernel_launch: hipFuncSetAttribute failed\n"); grid = -1; return; }
        if (hipOccupancyMaxActiveBlocksPerMultiprocessor(&per_cu, (const void*)mega_fwd, NWAVES * 64, LDS_BYTES) != hipSuccess || per_cu < 1) {
            fprintf(stderr, "kernel_launch: occupancy query reports %d workgroups per CU; nothing launched\n", per_cu); (void)hipGetLastError(); grid = -1; return; }
        grid = cus;
    }
    if (grid < 0) return;
    if (hipMemsetAsync((char*)d_ws + WS_CTL, 0, CTL_ZERO_BYTES, stream) != hipSuccess) { fprintf(stderr, "kernel_launch: hipMemsetAsync failed\n"); return; }
    Args a{};
    for (int i = 0; i < 23; ++i) a.in[i] = (const float*)d_in[i];
    a.out = (float*)d_out; a.ws = (unsigned char*)d_ws;
    for (int li = 0; li < N_LAUNCHES; ++li) {
        a.ph_lo = (N_LAUNCHES == 1) ? 0 : li; a.ph_hi = (N_LAUNCHES == 1) ? N_PHASES : li + 1; a.li = li;
        hipLaunchKernelGGL(mega_fwd, dim3(grid), dim3(NWAVES * 64), LDS_BYTES, stream, a);
        const hipError_t le = hipPeekAtLastError();
        if (le != hipSuccess) { fprintf(stderr, "kernel_launch: launch %d failed: %s\n", li, hipGetErrorName(le)); break; }
    }
}
```
